# Optimizing an MI355X kernel written in HIP

```python
import math
import jax, jax.numpy as jnp
from jax import lax
import numpy as np

D_MODEL = 1024
BATCH = 8
SEQ = 8192
DEPTH = 2

N_HEADS = 16
HEAD_DIM = 64
N_KV_HEADS = 2
Q_GROUP = N_HEADS // N_KV_HEADS
ATTN_WIDTH = N_HEADS * HEAD_DIM
KV_WIDTH = N_KV_HEADS * HEAD_DIM
WINDOW = 128
BLOCK = 128
N_META = 16
META_PAD = BLOCK - N_META
POOL_WINDOWS = (2, 4, 8, 16)
N_POOL_GROUPS = 4
POOL_GROUP_DIM = 128
POOL_WIDTH = N_POOL_GROUPS * POOL_GROUP_DIM
POOL_GROUP_OUT = D_MODEL // N_POOL_GROUPS
N_BRANCHES = 2
IN_WIDTH = ATTN_WIDTH + 2 * KV_WIDTH + POOL_WIDTH + N_BRANCHES * D_MODEL
D_FF = 2816
N_EXPERTS = 8
TOP_K = 2
D_FF_EXPERT = 3584
N_DENSE = (DEPTH + 1) // 2
N_MOE = DEPTH // 2
RMS_EPS = 1e-5
NEG_INF = -1e30

kernel_name = "hybrid_swa_sink_pool_gated_moe"


def rms_norm(x, gain):
    xf = x.astype(jnp.float32)
    y = xf * lax.rsqrt(jnp.mean(xf * xf, axis=-1, keepdims=True) + RMS_EPS)
    return (y * gain.astype(jnp.float32)).astype(x.dtype)


def alibi_slopes():
    return jnp.asarray(np.array([2.0 ** (-8.0 * (h + 1) / N_HEADS) for h in range(N_HEADS)], dtype=np.float32))


def swa_sink_attention(q, k, v, sinks, slopes):
    B, L = q.shape[0], q.shape[1]
    P = L + META_PAD
    nblk = P // BLOCK

    def pad_front(t, n):
        return jnp.pad(t, ((0, 0), (n, 0), (0, 0), (0, 0)))

    qb = pad_front(q, META_PAD).reshape(B, nblk, BLOCK, N_KV_HEADS, Q_GROUP, HEAD_DIM)

    def band(t):
        tp = pad_front(t, META_PAD)
        prev = pad_front(tp, BLOCK)[:, :P]
        return jnp.concatenate([prev.reshape(B, nblk, BLOCK, N_KV_HEADS, HEAD_DIM),
                                tp.reshape(B, nblk, BLOCK, N_KV_HEADS, HEAD_DIM)], axis=2)

    kb, vb = band(k), band(v)
    km, vm = k[:, :N_META], v[:, :N_META]
    scale = HEAD_DIM ** -0.5
    s_band = jnp.einsum('bnqkgd,bnskd->bkgnqs', qb, kb, preferred_element_type=jnp.float32) * scale
    s_meta = jnp.einsum('bnqkgd,bmkd->bkgnqm', qb, km, preferred_element_type=jnp.float32) * scale

    blk = jnp.arange(nblk)[:, None] * BLOCK
    t_q = blk + jnp.arange(BLOCK)[None, :]
    t_band = blk - BLOCK + jnp.arange(2 * BLOCK)[None, :]
    t_meta = META_PAD + jnp.arange(N_META)
    d_band = t_q[:, :, None] - t_band[:, None, :]
    d_meta = t_q[:, :, None] - t_meta[None, None, :]
    ok_band = (d_band >= 0) & (d_band < WINDOW) & (t_band[:, None, :] >= BLOCK)
    ok_meta = d_meta >= 0
    m = slopes.reshape(N_KV_HEADS, Q_GROUP, 1, 1, 1)
    l_band = jnp.where(ok_band, s_band - m * d_band.astype(jnp.float32), NEG_INF)
    l_meta = jnp.where(ok_meta, s_meta - m * d_meta.astype(jnp.float32), NEG_INF)
    l_sink = jnp.broadcast_to(sinks.astype(jnp.float32).reshape(1, N_KV_HEADS, Q_GROUP, 1, 1, 1),
                              l_band.shape[:-1] + (1,))
    probs = jax.nn.softmax(jnp.concatenate([l_band, l_meta, l_sink], axis=-1), axis=-1)
    p_band = probs[..., :2 * BLOCK].astype(v.dtype)
    p_meta = probs[..., 2 * BLOCK:2 * BLOCK + N_META].astype(v.dtype)
    out = (jnp.einsum('bkgnqs,bnskd->bnqkgd', p_band, vb)
           + jnp.einsum('bkgnqm,bmkd->bnqkgd', p_meta, vm))
    return out.reshape(B, P, ATTN_WIDTH)[:, META_PAD:]


def causal_mean_minus_self(u, w):
    L = u.shape[1]
    cs = jnp.cumsum(u, axis=1)
    lagged = jnp.pad(cs[:, :L - w], ((0, 0), (w, 0), (0, 0)))
    count = jnp.minimum(jnp.arange(1, L + 1), w).astype(jnp.float32)[None, :, None]
    return (cs - lagged) / count - u


def multiscale_pool(u):
    uf = u.astype(jnp.float32)
    groups = [causal_mean_minus_self(uf[..., g * POOL_GROUP_DIM:(g + 1) * POOL_GROUP_DIM], POOL_WINDOWS[g])
              for g in range(N_POOL_GROUPS)]
    return jnp.concatenate(groups, axis=-1).astype(u.dtype)


def hybrid_mixer(h, gain, w_in, sinks, w_attn_br, w_pool_grp, pool_scale, w_out, slopes):
    B, L = h.shape[0], h.shape[1]
    xn = rms_norm(h, gain)
    proj = xn @ w_in
    i0 = ATTN_WIDTH
    i1 = i0 + KV_WIDTH
    i2 = i1 + KV_WIDTH
    i3 = i2 + POOL_WIDTH
    q = proj[..., :i0].reshape(B, L, N_HEADS, HEAD_DIM)
    k = proj[..., i0:i1].reshape(B, L, N_KV_HEADS, HEAD_DIM)
    v = proj[..., i1:i2].reshape(B, L, N_KV_HEADS, HEAD_DIM)
    u = proj[..., i2:i3]
    gates = jax.nn.sigmoid(proj[..., i3:].astype(jnp.float32)).astype(h.dtype).reshape(B, L, N_BRANCHES, D_MODEL)
    a_branch = swa_sink_attention(q, k, v, sinks, slopes) @ w_attn_br
    pooled = multiscale_pool(u).reshape(B, L, N_POOL_GROUPS, POOL_GROUP_DIM)
    p_branch = jnp.einsum('blgc,gcd->blgd', pooled, w_pool_grp).reshape(B, L, D_MODEL) * pool_scale
    merged = gates[..., 0, :] * a_branch + gates[..., 1, :] * p_branch
    return merged @ w_out


def swiglu(x, wg, wu, wd):
    return (jax.nn.silu(x @ wg) * (x @ wu)) @ wd


def moe_swiglu(xn, router, wg, wu, wd):
    logits = (xn @ router).astype(jnp.float32)
    top_vals, top_idx = lax.top_k(logits, TOP_K)
    weights = jax.nn.softmax(top_vals, axis=-1)
    combine = jnp.sum(jax.nn.one_hot(top_idx, N_EXPERTS, dtype=jnp.float32) * weights[..., None], axis=-2)
    combine = combine.astype(xn.dtype)
    y = jnp.zeros_like(xn)
    for e in range(N_EXPERTS):
        y = y + combine[..., e:e + 1] * swiglu(xn, wg[e], wu[e], wd[e])
    return y


def setup_inputs(seed: int = 0) -> dict:
    key = jax.random.key(seed)
    ks = jax.random.split(key, 18)
    f32 = jnp.float32

    def nrm(k, shape, fan_in):
        return jax.random.normal(k, shape, f32) * (fan_in ** -0.5)

    return {
        "x": jax.random.normal(ks[0], (BATCH, SEQ, D_MODEL), f32),
        "meta_tokens": jax.random.normal(ks[1], (N_META, D_MODEL), f32),
        "norm_mix": 1.0 + 0.02 * jax.random.normal(ks[2], (DEPTH, D_MODEL), f32),
        "w_in": nrm(ks[3], (DEPTH, D_MODEL, IN_WIDTH), D_MODEL),
        "attn_sinks": 0.5 * jax.random.normal(ks[4], (DEPTH, N_HEADS), f32),
        "w_attn_br": nrm(ks[5], (DEPTH, ATTN_WIDTH, D_MODEL), ATTN_WIDTH),
        "w_pool_grp": nrm(ks[6], (DEPTH, N_POOL_GROUPS, POOL_GROUP_DIM, POOL_GROUP_OUT), POOL_GROUP_DIM),
        "pool_scale": 1.0 + 0.1 * jax.random.normal(ks[7], (DEPTH, D_MODEL), f32),
        "w_out": nrm(ks[8], (DEPTH, D_MODEL, D_MODEL), D_MODEL),
        "norm_ffn": 1.0 + 0.02 * jax.random.normal(ks[9], (DEPTH, D_MODEL), f32),
        "dense_w_gate": nrm(ks[10], (N_DENSE, D_MODEL, D_FF), D_MODEL),
        "dense_w_up": nrm(ks[11], (N_DENSE, D_MODEL, D_FF), D_MODEL),
        "dense_w_down": nrm(ks[12], (N_DENSE, D_FF, D_MODEL), D_FF),
        "moe_router": nrm(ks[13], (N_MOE, D_MODEL, N_EXPERTS), D_MODEL),
        "moe_w_gate": nrm(ks[14], (N_MOE, N_EXPERTS, D_MODEL, D_FF_EXPERT), D_MODEL),
        "moe_w_up": nrm(ks[15], (N_MOE, N_EXPERTS, D_MODEL, D_FF_EXPERT), D_MODEL),
        "moe_w_down": nrm(ks[16], (N_MOE, N_EXPERTS, D_FF_EXPERT, D_MODEL), D_FF_EXPERT),
        "norm_final": 1.0 + 0.02 * jax.random.normal(ks[17], (D_MODEL,), f32),
    }


def reference(x, meta_tokens, norm_mix, w_in, attn_sinks, w_attn_br, w_pool_grp, pool_scale, w_out,
              norm_ffn, dense_w_gate, dense_w_up, dense_w_down, moe_router, moe_w_gate, moe_w_up,
              moe_w_down, norm_final):
    B = x.shape[0]
    slopes = alibi_slopes()
    meta = jnp.broadcast_to(meta_tokens.astype(x.dtype)[None], (B, N_META, D_MODEL))
    h = jnp.concatenate([meta, x], axis=1)
    for layer in range(DEPTH):
        h = h + hybrid_mixer(h, norm_mix[layer], w_in[layer], attn_sinks[layer], w_attn_br[layer],
                             w_pool_grp[layer], pool_scale[layer], w_out[layer], slopes)
        hn = rms_norm(h, norm_ffn[layer])
        if layer % 2 == 0:
            j = layer // 2
            h = h + swiglu(hn, dense_w_gate[j], dense_w_up[j], dense_w_down[j])
        else:
            j = layer // 2
            h = h + moe_swiglu(hn, moe_router[j], moe_w_gate[j], moe_w_up[j], moe_w_down[j])
    return rms_norm(h, norm_final)[:, N_META:]
```

```cpp
#include <hip/hip_runtime.h>
#include <cstdio>
#include <cstdint>

#define GAS __attribute__((address_space(1)))
#define LAS __attribute__((address_space(3)))
typedef unsigned short bf16;
typedef short bf16x8 __attribute__((ext_vector_type(8)));
typedef short s16x4 __attribute__((ext_vector_type(4)));
typedef float f32x2 __attribute__((ext_vector_type(2)));
typedef float f32x4 __attribute__((ext_vector_type(4)));
typedef float f32x16 __attribute__((ext_vector_type(16)));
typedef unsigned u32x2 __attribute__((ext_vector_type(2)));
typedef unsigned u32x4 __attribute__((ext_vector_type(4)));
typedef GAS unsigned gu32;
#define RLX_AGENT __ATOMIC_RELAXED, __HIP_MEMORY_SCOPE_AGENT
#define LDS_WAIT() asm volatile("s_waitcnt lgkmcnt(0)" ::: "memory")
#define VM_WAIT() asm volatile("s_waitcnt vmcnt(0)" ::: "memory")
#define DI __device__ __forceinline__

constexpr int NB = 8, SEQ = 8192, D = 1024, M = NB * SEQ;
constexpr int NMETA = 16;
constexpr int NH = 16, HD = 64, NKV = 2, QG = 8, KVW = 128, POOLW = 512;
constexpr int INW = 3840;
constexpr int DFF = 2816, NE = 8, DFE = 3584;
constexpr float RMS_EPS = 1e-5f;
constexpr float LOG2E = 1.4426950408889634f;
constexpr float QSCALE = 0.125f * LOG2E;
constexpr int NSLOT = M + NE * 256;
constexpr int MAXTILES = NSLOT / 256;

constexpr size_t MiB = 1u << 20;
constexpr size_t WS_CTL = 0, CTL_ZERO_BYTES = 1 * MiB;
constexpr size_t WS_SSQ = 1 * MiB;
constexpr size_t WS_TOKE = 5 * MiB;
constexpr size_t WS_TOKW = 5 * MiB + 512 * 1024;
constexpr size_t WS_SLOTTOK = 6 * MiB;
constexpr size_t WS_SLOTW = 7 * MiB;
constexpr size_t WS_WGCNT = 8 * MiB;
constexpr size_t WS_MOETAB = 8 * MiB + 64 * 1024;
constexpr size_t WS_META = 9 * MiB;
constexpr size_t WS_WIN = 16 * MiB;
constexpr size_t WS_WA = 31 * MiB;
constexpr size_t WS_WP = 35 * MiB;
constexpr size_t WS_WO = 36 * MiB;
constexpr size_t WS_WGU = 40 * MiB;
constexpr size_t WS_WD = 51 * MiB;
constexpr size_t WS_MGU = 57 * MiB;
constexpr size_t WS_MD = 169 * MiB;
constexpr size_t WS_HB = 225 * MiB;
constexpr size_t WS_POOLED = 353 * MiB;
constexpr size_t WS_Q = 417 * MiB;
constexpr size_t WS_K = 545 * MiB;
constexpr size_t WS_V = 561 * MiB;
constexpr size_t WS_U = 577 * MiB;
constexpr size_t WS_G = 641 * MiB;
constexpr size_t WS_ACT = 417 * MiB;
constexpr size_t WS_END = 897 * MiB;
static_assert(WS_ACT + (size_t)NSLOT * DFE * 2 <= WS_END && WS_ACT + (size_t)M * DFF * 2 <= WS_END, "act overlay");
constexpr size_t MO_HM = 0;
constexpr size_t MO_XM = 64 * 1024;
constexpr size_t MO_PROJ = 96 * 1024;
constexpr size_t MO_KM = 336 * 1024;
constexpr size_t MO_VM = 344 * 1024;
constexpr size_t MO_UM = 352 * 1024;
constexpr size_t MO_ATT = 384 * 1024;
constexpr size_t MO_POOL = 416 * 1024;
constexpr size_t MO_MRG = 432 * 1024;
constexpr size_t MO_ACT = 464 * 1024;
constexpr int CW_TMO = 0, CW_CODE = 1, CW_BAR = 4096;

constexpr int RING_OFF = 0, RING_BYTES = 131072;
constexpr int LDSCTL_OFF = RING_BYTES, MISC_OFF = LDSCTL_OFF + 320;
constexpr int XTRA_OFF = LDSCTL_OFF + 1024;
constexpr int LDS_BYTES = 147456;

DI unsigned f2bf(float f) { unsigned u = __builtin_bit_cast(unsigned, f); return (u + 0x7fffu + ((u >> 16) & 1u)) >> 16; }
DI unsigned pk2(float lo, float hi) { unsigned r; asm volatile("v_cvt_pk_bf16_f32 %0, %1, %2" : "=v"(r) : "v"(lo), "v"(hi)); return r; }
DI float bf2f(unsigned short b) { return __builtin_bit_cast(float, (unsigned)b << 16); }
DI float bflo(unsigned w) { return __builtin_bit_cast(float, w << 16); }
DI float bfhi(unsigned w) { return __builtin_bit_cast(float, w & 0xffff0000u); }
DI float wave_sum(float v) {
#pragma unroll
    for (int o = 1; o < 64; o <<= 1) v += __shfl_xor(v, o);
    return v;
}
DI float fast_sigmoid(float x) { x = fminf(fmaxf(x, -30.f), 30.f); return __builtin_amdgcn_rcpf(1.f + __builtin_amdgcn_exp2f(-x * LOG2E)); }

#define XB_TMO      128
#define XB_XCNT(j)  (256  + 64 * (j))
#define XB_XSUB(j)  (1280 + 64 * (j))
#define XB_XGEN(j)  (2304 + 64 * (j))
#define XB_TOP      3328
#define XB_TOPGEN   3392
#define XCD_BAR_WORDS 3456
#define XB_SPIN_CAP (1u << 18)
DI unsigned xb_ld(unsigned* p)              { return __hip_atomic_load(p, __ATOMIC_RELAXED, __HIP_MEMORY_SCOPE_AGENT); }
DI unsigned xb_add(unsigned* p, unsigned v) { return __hip_atomic_fetch_add(p, v, __ATOMIC_RELAXED, __HIP_MEMORY_SCOPE_AGENT); }
DI unsigned xb_xcc_id() { return (unsigned)__builtin_amdgcn_s_getreg((3 << 11) | 20) & 0xFu; }
#define XB_SPIN(cond, bar) do { unsigned _sp = 0; while (cond) { __builtin_amdgcn_s_sleep(1); \
    if ((++_sp & 255u) == 0u) { if (xb_ld(&(bar)[XB_TMO])) break; if (_sp > XB_SPIN_CAP) { atomicAdd(&(bar)[XB_TMO], 1u); break; } } } } while (0)
struct XcdBarrier { unsigned* bar; unsigned x; volatile LAS unsigned* st; };
DI XcdBarrier xcd_barrier_post(unsigned* bar, volatile LAS unsigned* st) {
    XcdBarrier b; b.bar = bar; b.x = xb_xcc_id(); b.st = st;
    if (threadIdx.x == 0) (void)xb_add(&bar[XB_XCNT(b.x)], 1u);
    return b;
}
DI void xcd_barrier_complete(unsigned* bar, unsigned x, unsigned& nloc, unsigned& nx) {
    const unsigned G = gridDim.x * gridDim.y * gridDim.z;
    unsigned sum, cnt, mine, sp = 0u;
    for (;;) {
        sum = 0u; cnt = 0u; mine = 0u;
#pragma unroll
        for (unsigned j = 0; j < 16; ++j) { const unsigned c = xb_ld(&bar[XB_XCNT(j)]); sum += c; cnt += (c > 0u) ? 1u : 0u; mine = (j == x) ? c : mine; }
        if (sum == G) break;
        __builtin_amdgcn_s_sleep(1);
        if ((++sp & 255u) == 0u) { if (xb_ld(&bar[XB_TMO])) break; if (sp > XB_SPIN_CAP) { atomicAdd(&bar[XB_TMO], 1u); break; } }
    }
    nloc = mine > 0u ? mine : 1u; nx = cnt > 0u ? cnt : 1u;
}
DI void xcd_barrier(const XcdBarrier& b) {
    asm volatile("s_waitcnt vmcnt(0)" ::: "memory");
    __syncthreads();
    if (threadIdx.x == 0) {
        unsigned* bar = b.bar;
        __builtin_amdgcn_s_waitcnt(0);
        unsigned nloc = b.st[0], nx = b.st[1];
        if (nloc == 0u) { xcd_barrier_complete(bar, b.x, nloc, nx); b.st[0] = nloc; b.st[1] = nx; }
        const unsigned old = xb_add(&bar[XB_XSUB(b.x)], 1u);
        const unsigned gen = old / nloc;
        if (old + 1u == (gen + 1u) * nloc) {
            __builtin_amdgcn_fence(__ATOMIC_RELEASE, "agent");
            asm volatile("s_waitcnt vmcnt(0)" ::: "memory");
            const unsigned og = xb_add(&bar[XB_TOP], 1u);
            const unsigned tg = og / nx;
            if (og + 1u == (tg + 1u) * nx) xb_add(&bar[XB_TOPGEN], 1u);
            else XB_SPIN(xb_ld(&bar[XB_TOPGEN]) == tg, bar);
            __builtin_amdgcn_fence(__ATOMIC_ACQUIRE, "agent");
            xb_add(&bar[XB_XGEN(b.x)], 1u);
            asm volatile("s_waitcnt vmcnt(0)" ::: "memory");
        } else {
            XB_SPIN(xb_ld(&bar[XB_XGEN(b.x)]) == gen, bar);
            __builtin_amdgcn_fence(__ATOMIC_ACQUIRE, "agent");
            asm volatile("s_waitcnt vmcnt(0)" ::: "memory");
        }
    }
    __syncthreads();
}
namespace pg8 {
constexpr int BM = 256, BK = 64, HALF = 128, HTB = HALF * BK * 2, STAGE_BYTES = 8 * HTB, NXCD = 8, WGM = 8;
__host__ __device__ __forceinline__ int lds_byte(int r, int c) { const int st = (r >> 4) * 2 + (c >> 5), rr = r & 15, cc = c & 31, ob = rr * 64 + cc * 2; return st * 1024 + (ob ^ (((ob >> 9) & 1) << 5)); }
__host__ __device__ __forceinline__ void stage_rc(int b, int& R, int& C) { const int st = b / 1024, sb = b % 1024, swz = sb ^ (((sb >> 9) & 1) << 5); R = (st >> 1) * 16 + swz / 64; C = (st & 1) * 32 + (swz % 64) / 2; }
__host__ __device__ __forceinline__ int perm32(int rho) { const int n = rho >> 4, i = rho & 15; return 8 * (i >> 2) + 4 * n + (i & 3); }

struct Unit { int pm, pn; };

struct StaticOrder {
    int nM, nN, nwg, G, c;
    DI void init(int M_, int N_, int G_, int c_) { nM = M_ / BM; nN = N_ / BM; nwg = nM * nN; G = G_; c = c_; }
    DI bool next(int i, Unit& u) const {
        const long L = (long)i * G + c; if (L >= nwg) return false;
        int wgid = (int)L; { const int q = nwg / NXCD, r = nwg % NXCD, xcd = wgid % NXCD, off = wgid / NXCD; wgid = (xcd < r ? xcd * (q + 1) : r * (q + 1) + (xcd - r) * q) + off; }
        const int nig = WGM * nN, gid = wgid / nig, fm = gid * WGM, gsz = (nM - fm) < WGM ? (nM - fm) : WGM;
        u.pm = fm + ((wgid % nig) % gsz); u.pn = (wgid % nig) / gsz; return true;
    }
};
struct LinearOrder {
    int ntile, nN, G, c;
    DI bool next(int i, Unit& u) const { const long L = (long)i * G + c; if (L >= (long)ntile * nN) return false; u.pm = (int)(L / nN); u.pn = (int)(L % nN); return true; }
};

struct ProbPlain {
    static constexpr bool GATHER = false;
    const char* A; const char* Bt; unsigned lda2, ldb2; int nt; unsigned acol2;
    DI const char* a_base(const Unit& u) const { return A + (size_t)u.pm * BM * lda2 + (size_t)u.pn * acol2; }
    DI const char* b_base(const Unit& u) const { return Bt + (size_t)u.pn * BM * ldb2; }
    DI unsigned a_row(const Unit&, int r) const { return (unsigned)r * lda2; }
};
struct ProbMoeGU {
    static constexpr bool GATHER = true;
    const char* A; const char* Bt; unsigned lda2, ldb2; int nt; const int* slot_tok; const int* tile_e;
    DI const char* a_base(const Unit&) const { return A; }
    DI const char* b_base(const Unit& u) const { return Bt + (size_t)tile_e[u.pm] * ((size_t)2 * DFE * D * 2) + (size_t)u.pn * BM * ldb2; }
    DI unsigned a_row(const Unit& u, int r) const { int t = slot_tok[u.pm * BM + r]; t = t < 0 ? 0 : t; return (unsigned)t * lda2; }
};
struct ProbMoeDown {
    static constexpr bool GATHER = false;
    const char* A; const char* Bt; unsigned lda2, ldb2; int nt; const int* tile_e;
    DI const char* a_base(const Unit& u) const { return A + (size_t)u.pm * BM * lda2; }
    DI const char* b_base(const Unit& u) const { return Bt + (size_t)tile_e[u.pm] * ((size_t)D * DFE * 2) + (size_t)u.pn * BM * ldb2; }
    DI unsigned a_row(const Unit&, int r) const { return (unsigned)r * lda2; }
};

template <class Prob, class Epi, class Sched, bool ALIGN_EPI>
DI void gemm_phase(LAS unsigned char* lds, const Prob& P, const Sched& S, const Epi& E) {
    int tid = threadIdx.x; asm volatile("" : "+v"(tid));
    const int wid = __builtin_amdgcn_readfirstlane(tid >> 6), lane = tid & 63, wr = wid >> 2, wc = wid & 3, fr = lane & 15, fq = lane >> 4;
    const int nt = P.nt;
    int R0, C0, R1, C1; stage_rc(tid * 16, R0, C0); stage_rc(tid * 16 + 8192, R1, C1);
    const int Rb0 = Epi::PERM ? ((R0 & ~31) + perm32(R0 & 31)) : R0, Rb1 = Epi::PERM ? ((R1 & ~31) + perm32(R1 & 31)) : R1;
    const unsigned voffB0 = (unsigned)Rb0 * P.ldb2 + (unsigned)C0 * 2u, voffB1 = (unsigned)Rb1 * P.ldb2 + (unsigned)C1 * 2u;
    const size_t kstep = (size_t)(BK * 2);
    const size_t hstepB = (size_t)HALF * P.ldb2;
    const unsigned ldsw = (unsigned)wid * 1024u;
    const int aoff = lds_byte(wr * 64 + fr, fq * 8), boff = lds_byte(wc * 32 + fr, fq * 8);
#define PG8_SA(b, h) (((b) * 2 + (h)) * HTB)
#define PG8_SB(b, h) ((4 + (b) * 2 + (h)) * HTB)
#define PG8_STG(bufoff, gbase, v0, v1) do { \
        __builtin_amdgcn_global_load_lds((const unsigned*)((const char*)(gbase) + (v0)), (LAS unsigned*)(lds + (bufoff) + ldsw), 16, 0, 0); \
        __builtin_amdgcn_global_load_lds((const unsigned*)((const char*)(gbase) + (v1)), (LAS unsigned*)(lds + (bufoff) + ldsw + 8192), 16, 0, 0); } while (0)
#define PG8_STGB(bufoff, gbase) PG8_STG(bufoff, gbase, voffB0, voffB1)
#define PG8_LDA(dst, b, h) do { _Pragma("unroll") for (int m = 0; m < 4; ++m) _Pragma("unroll") for (int k = 0; k < 2; ++k) dst[m][k] = *(const LAS bf16x8*)(lds + PG8_SA(b, h) + aoff + m * 2048 + k * 1024); } while (0)
#define PG8_LDB(dst, b, h) do { _Pragma("unroll") for (int n = 0; n < 2; ++n) _Pragma("unroll") for (int k = 0; k < 2; ++k) dst[n][k] = *(const LAS bf16x8*)(lds + PG8_SB(b, h) + boff + n * 2048 + k * 1024); } while (0)
#define PG8_MMA(ai, bj, At, Bt) do { __builtin_amdgcn_s_setprio(1); _Pragma("unroll") for (int m = 0; m < 4; ++m) _Pragma("unroll") for (int n = 0; n < 2; ++n) _Pragma("unroll") for (int k = 0; k < 2; ++k) \
        acc[ai][bj][m][n] = __builtin_amdgcn_mfma_f32_16x16x32_bf16(Bt[n][k], At[m][k], acc[ai][bj][m][n], 0, 0, 0); __builtin_amdgcn_s_setprio(0); } while (0)
#define PG8_WAIT_V(n) asm volatile("s_waitcnt vmcnt(" #n ")" ::: "memory")
#define PG8_WAIT_L(n) asm volatile("s_waitcnt lgkmcnt(" #n ")" ::: "memory")
#define PG8_BAR __builtin_amdgcn_s_barrier()
#define PG8_SCHED __builtin_amdgcn_sched_barrier(0)
    Unit cur, nxt; int ui = 0;
    if (!S.next(0, cur)) return;
    f32x4 acc[2][2][4][2];
#pragma unroll
    for (int a = 0; a < 2; ++a)
#pragma unroll
        for (int b = 0; b < 2; ++b)
#pragma unroll
            for (int m = 0; m < 4; ++m)
#pragma unroll
                for (int n = 0; n < 2; ++n) acc[a][b][m][n] = (f32x4){0.f, 0.f, 0.f, 0.f};
    bf16x8 At[4][2], B0[2][2], B1[2][2];
    unsigned vc00, vc01, vc10, vc11, vn00, vn01, vn10, vn11;
#define PG8_AOFF(u, o00, o01, o10, o11) do { o00 = P.a_row(u, R0) + (unsigned)C0 * 2u; o01 = P.a_row(u, R1) + (unsigned)C1 * 2u; \
        o10 = P.a_row(u, HALF + R0) + (unsigned)C0 * 2u; o11 = P.a_row(u, HALF + R1) + (unsigned)C1 * 2u; } while (0)
    PG8_AOFF(cur, vc00, vc01, vc10, vc11);
    vn00 = vc00; vn01 = vc01; vn10 = vc10; vn11 = vc11;
    const char* cA = P.a_base(cur); const char* cB = P.b_base(cur);
    PG8_STGB(PG8_SB(0, 0), cB); PG8_STGB(PG8_SB(0, 1), cB + hstepB); PG8_STG(PG8_SA(0, 0), cA, vc00, vc01); PG8_STG(PG8_SA(0, 1), cA, vc10, vc11);
    if (wr == 1) PG8_BAR;
    PG8_WAIT_V(2); PG8_BAR;
    PG8_STGB(PG8_SB(1, 0), cB + kstep); PG8_STG(PG8_SA(1, 0), cA + kstep, vc00, vc01); PG8_STGB(PG8_SB(1, 1), cB + hstepB + kstep);
    PG8_WAIT_V(6); PG8_BAR;
    for (;;) {
        const bool has_next = S.next(ui + 1, nxt);
        const char* nA = cA; const char* nB = cB;
        if (has_next) { nA = P.a_base(nxt); nB = P.b_base(nxt); if (Prob::GATHER) { PG8_AOFF(nxt, vn00, vn01, vn10, vn11); } }
        for (int t = 0; t < nt; t += 2) {
            const bool last = (t == nt - 2);
            const char* a1 = cA + (size_t)(t + 1) * kstep;
            const char* a2 = last ? nA : cA + (size_t)(t + 2) * kstep; const char* b2 = last ? nB : cB + (size_t)(t + 2) * kstep;
            const char* a3 = a2 + kstep; const char* b3 = b2 + kstep;
            unsigned w00 = vc00, w01 = vc01, w10 = vc10, w11 = vc11;
            if (Prob::GATHER) { if (last) { w00 = vn00; w01 = vn01; w10 = vn10; w11 = vn11; } }
            PG8_LDB(B0, 0, 0); PG8_LDB(B1, 0, 1); PG8_SCHED; PG8_LDA(At, 0, 0); PG8_STG(PG8_SA(1, 1), a1, vc10, vc11);
            PG8_WAIT_V(8); PG8_WAIT_L(0); PG8_BAR; PG8_MMA(0, 0, At, B0); PG8_MMA(0, 1, At, B1); PG8_BAR; PG8_SCHED;
            PG8_LDA(At, 0, 1); PG8_STGB(PG8_SB(0, 0), b2); PG8_STGB(PG8_SB(0, 1), b2 + hstepB); PG8_STG(PG8_SA(0, 0), a2, w00, w01);
            PG8_WAIT_V(8); PG8_WAIT_L(0); PG8_BAR; PG8_MMA(1, 0, At, B0); PG8_MMA(1, 1, At, B1); PG8_BAR; PG8_SCHED;
            PG8_LDB(B0, 1, 0); PG8_LDB(B1, 1, 1); PG8_SCHED; PG8_LDA(At, 1, 0); PG8_STG(PG8_SA(0, 1), a2, w10, w11);
            PG8_WAIT_V(8); PG8_WAIT_L(0); PG8_BAR; PG8_MMA(0, 0, At, B0); PG8_MMA(0, 1, At, B1); PG8_BAR; PG8_SCHED;
            PG8_LDA(At, 1, 1); PG8_STGB(PG8_SB(1, 0), b3); PG8_STGB(PG8_SB(1, 1), b3 + hstepB); PG8_STG(PG8_SA(1, 0), a3, w00, w01);
            PG8_WAIT_V(8); PG8_WAIT_L(0); PG8_BAR; PG8_MMA(1, 0, At, B0); PG8_MMA(1, 1, At, B1); PG8_BAR; PG8_SCHED;
        }
        if constexpr (ALIGN_EPI) { if (wr == 0) PG8_BAR; }
        PG8_SCHED; E(acc, cur, wr, wc, fr, fq); PG8_SCHED;
        if (!has_next) break;
#pragma unroll
        for (int a = 0; a < 2; ++a)
#pragma unroll
            for (int b = 0; b < 2; ++b)
#pragma unroll
                for (int m = 0; m < 4; ++m)
#pragma unroll
                    for (int n = 0; n < 2; ++n) acc[a][b][m][n] = (f32x4){0.f, 0.f, 0.f, 0.f};
        cur = nxt; cA = nA; cB = nB; ++ui;
        if (Prob::GATHER) { vc00 = vn00; vc01 = vn01; vc10 = vn10; vc11 = vn11; }
        if constexpr (ALIGN_EPI) { if (wr == 1) PG8_BAR; }
    }
    PG8_WAIT_V(0);
    if constexpr (!ALIGN_EPI) { if (wr == 0) PG8_BAR; }
    PG8_BAR;
#undef PG8_SA
#undef PG8_SB
#undef PG8_STG
#undef PG8_STGB
#undef PG8_LDA
#undef PG8_LDB
#undef PG8_MMA
#undef PG8_WAIT_V
#undef PG8_WAIT_L
#undef PG8_BAR
#undef PG8_SCHED
#undef PG8_AOFF
}
}
namespace pg8 {
DI float row_rstd(const float* ssq16, int row, int fq) {
    const f32x4 p = *(const f32x4*)(ssq16 + (size_t)row * 16 + 4 * fq);
    float s = (p[0] + p[1]) + (p[2] + p[3]);
    s += __shfl_xor(s, 16); s += __shfl_xor(s, 32);
    return __builtin_amdgcn_rsqf(s * (1.0f / D) + RMS_EPS);
}
DI u32x4 pack8(const f32x4 v0, const f32x4 v1) { u32x4 w; w.x = pk2(v0[0], v0[1]); w.y = pk2(v0[2], v0[3]); w.z = pk2(v1[0], v1[1]); w.w = pk2(v1[2], v1[3]); return w; }

struct EpiInProj {
    static constexpr bool PERM = true;
    const float* ssq16; bf16 *Q, *K, *V, *U, *G;
    DI void operator()(const f32x4 (&acc)[2][2][4][2], const Unit& u, int wr, int wc, int fr, int fq) const {
        const int row0 = u.pm * BM + wr * 64 + fr, cw = wc * 32 + 8 * fq;
        const int pn = u.pn;
        bf16* base0; bf16* base1; int ldc, col0, col1, mode;
        if (pn < 4) { base0 = base1 = Q; ldc = D; col0 = pn * 256 + cw; col1 = col0 + HALF; mode = 1; }
        else if (pn == 4) { base0 = K; base1 = V; ldc = KVW; col0 = col1 = cw; mode = 0; }
        else if (pn < 7) { base0 = base1 = U; ldc = POOLW; col0 = (pn - 5) * 256 + cw; col1 = col0 + HALF; mode = 0; }
        else { base0 = base1 = G; ldc = 2 * D; col0 = (pn - 7) * 256 + cw; col1 = col0 + HALF; mode = 2; }
#pragma unroll
        for (int ai = 0; ai < 2; ++ai)
#pragma unroll
            for (int m = 0; m < 4; ++m) {
                const int row = row0 + ai * HALF + m * 16;
                const float sc = row_rstd(ssq16, row, fq) * (mode == 1 ? QSCALE : 1.f);
#pragma unroll
                for (int bj = 0; bj < 2; ++bj) {
                    f32x4 v0 = acc[ai][bj][m][0] * sc, v1 = acc[ai][bj][m][1] * sc;
                    if (mode == 2) {
#pragma unroll
                        for (int j = 0; j < 4; ++j) { v0[j] = fast_sigmoid(v0[j]); v1[j] = fast_sigmoid(v1[j]); }
                    }
                    *(u32x4*)((bj ? base1 : base0) + (size_t)row * ldc + (bj ? col1 : col0)) = pack8(v0, v1);
                }
                asm volatile("" ::: "memory");
            }
    }
};
struct EpiPoolLift {
    static constexpr bool PERM = true;
    const bf16* G; bf16* MRG;
    DI void operator()(const f32x4 (&acc)[2][2][4][2], const Unit& u, int wr, int wc, int fr, int fq) const {
        const int row0 = u.pm * BM + wr * 64 + fr, col0 = u.pn * BM + wc * 32 + 8 * fq;
#pragma unroll
        for (int ai = 0; ai < 2; ++ai)
#pragma unroll
            for (int m = 0; m < 4; ++m) { const size_t r = (size_t)(row0 + ai * HALF + m * 16);
#pragma unroll
                for (int bj = 0; bj < 2; ++bj) {
                    const u32x4 g = *(const u32x4*)(G + r * (2 * D) + D + col0 + bj * HALF);
                    f32x4 v0 = acc[ai][bj][m][0], v1 = acc[ai][bj][m][1];
                    v0[0] *= bflo(g.x); v0[1] *= bfhi(g.x); v0[2] *= bflo(g.y); v0[3] *= bfhi(g.y);
                    v1[0] *= bflo(g.z); v1[1] *= bfhi(g.z); v1[2] *= bflo(g.w); v1[3] *= bfhi(g.w);
                    *(u32x4*)(MRG + r * D + col0 + bj * HALF) = pack8(v0, v1);
                }
                asm volatile("" ::: "memory"); }
    }
};
struct EpiMerge {
    static constexpr bool PERM = true;
    const bf16* G; bf16* MRG;
    DI void operator()(const f32x4 (&acc)[2][2][4][2], const Unit& u, int wr, int wc, int fr, int fq) const {
        const int row0 = u.pm * BM + wr * 64 + fr, col0 = u.pn * BM + wc * 32 + 8 * fq;
#pragma unroll
        for (int ai = 0; ai < 2; ++ai)
#pragma unroll
            for (int m = 0; m < 4; ++m) { const size_t r = (size_t)(row0 + ai * HALF + m * 16);
#pragma unroll
                for (int bj = 0; bj < 2; ++bj) {
                    const u32x4 g = *(const u32x4*)(G + r * (2 * D) + col0 + bj * HALF);
                    const u32x4 p = *(const u32x4*)(MRG + r * D + col0 + bj * HALF);
                    f32x4 v0 = acc[ai][bj][m][0], v1 = acc[ai][bj][m][1];
                    v0[0] = v0[0] * bflo(g.x) + bflo(p.x); v0[1] = v0[1] * bfhi(g.x) + bfhi(p.x); v0[2] = v0[2] * bflo(g.y) + bflo(p.y); v0[3] = v0[3] * bfhi(g.y) + bfhi(p.y);
                    v1[0] = v1[0] * bflo(g.z) + bflo(p.z); v1[1] = v1[1] * bfhi(g.z) + bfhi(p.z); v1[2] = v1[2] * bflo(g.w) + bflo(p.w); v1[3] = v1[3] * bfhi(g.w) + bfhi(p.w);
                    *(u32x4*)(MRG + r * D + col0 + bj * HALF) = pack8(v0, v1);
                }
                asm volatile("" ::: "memory"); }
    }
};
struct EpiResid {
    static constexpr bool PERM = false;
    const float* base; float* out; bf16* HB; float* ssq16;
    DI void operator()(const f32x4 (&acc)[2][2][4][2], const Unit& u, int wr, int wc, int fr, int fq) const {
        const int row0 = u.pm * BM + wr * 64 + fr, col0 = u.pn * BM + wc * 32 + 4 * fq;
#pragma unroll
        for (int ai = 0; ai < 2; ++ai)
#pragma unroll
            for (int m = 0; m < 4; ++m) { const size_t r = (size_t)(row0 + ai * HALF + m * 16); float s = 0.f;
#pragma unroll
                for (int bj = 0; bj < 2; ++bj)
#pragma unroll
                    for (int n = 0; n < 2; ++n) { const size_t off = r * D + col0 + bj * HALF + n * 16;
                        const f32x4 h = *(const f32x4*)(base + off) + acc[ai][bj][m][n];
                        *(f32x4*)(out + off) = h; u32x2 w; w.x = pk2(h[0], h[1]); w.y = pk2(h[2], h[3]); *(u32x2*)(HB + off) = w;
                        s += (h[0] * h[0] + h[1] * h[1]) + (h[2] * h[2] + h[3] * h[3]); }
                s += __shfl_xor(s, 16); s += __shfl_xor(s, 32);
                if (fq == 0) ssq16[r * 16 + 4 * u.pn + wc] = s;
                asm volatile("" ::: "memory"); }
    }
};
template <bool MOE> struct EpiSwiGLU {
    static constexpr bool PERM = true;
    const float* ssq16; bf16* ACT; int ldc; const int* slot_tok;
    DI void operator()(const f32x4 (&acc)[2][2][4][2], const Unit& u, int wr, int wc, int fr, int fq) const {
        const int row0 = u.pm * BM + wr * 64 + fr, col0 = u.pn * HALF + wc * 32 + 8 * fq;
#pragma unroll
        for (int ai = 0; ai < 2; ++ai)
#pragma unroll
            for (int m = 0; m < 4; ++m) { const int r = row0 + ai * HALF + m * 16; int hr = r;
                if (MOE) { hr = slot_tok[r]; hr = hr < 0 ? 0 : hr; }
                const float rs = row_rstd(ssq16, hr, fq);
                f32x4 o[2];
#pragma unroll
                for (int n = 0; n < 2; ++n)
#pragma unroll
                    for (int j = 0; j < 4; ++j) { const float g = acc[ai][0][m][n][j] * rs, up = acc[ai][1][m][n][j] * rs; o[n][j] = g * fast_sigmoid(g) * up; }
                *(u32x4*)(ACT + (size_t)r * ldc + col0) = pack8(o[0], o[1]);
                asm volatile("" ::: "memory"); }
    }
};
struct EpiMoeDown {
    static constexpr bool PERM = false;
    float* out; const int* slot_tok; const float* slot_w;
    DI void operator()(const f32x4 (&acc)[2][2][4][2], const Unit& u, int wr, int wc, int fr, int fq) const {
        const int row0 = u.pm * BM + wr * 64 + fr, col0 = u.pn * BM + wc * 32 + 4 * fq;
#pragma unroll
        for (int ai = 0; ai < 2; ++ai)
#pragma unroll
            for (int m = 0; m < 4; ++m) { const int r = row0 + ai * HALF + m * 16; const int tok = slot_tok[r]; const float w = slot_w[r];
                if (tok >= 0) {
#pragma unroll
                    for (int bj = 0; bj < 2; ++bj)
#pragma unroll
                        for (int n = 0; n < 2; ++n) { float* p = out + (size_t)tok * D + col0 + bj * HALF + n * 16; *(f32x4*)p = *(const f32x4*)p + acc[ai][bj][m][n] * w; } }
                asm volatile("" ::: "memory"); }
    }
};
}
namespace att {
constexpr int KS_OFF = 0, KROW = 144, VT_OFF = 36864, VROW = 520, KM_OFF = 70144, VTM_OFF = 74752, VMROW = 72, LDS_END = 79360;
static_assert(LDS_END <= RING_BYTES, "attention LDS");
DI int crow(int i, int h) { return (i & 3) + 8 * (i >> 2) + 4 * h; }
struct Args { const bf16 *Q, *K, *V, *U, *KM, *VM, *UM; const float* sinks; bf16 *O, *POOLED; };
#define MFMA32(a, b, c) __builtin_amdgcn_mfma_f32_32x32x16_bf16((a), (b), (c), 0, 0, 0)
DI unsigned ld_u2(const bf16* U, const bf16* UM, size_t rowb, int tau, int col) {
    return tau >= NMETA ? *(const unsigned*)(U + (rowb + (size_t)(tau - NMETA)) * POOLW + col) : *(const unsigned*)(UM + (size_t)tau * POOLW + col);
}
DI void unit(LAS unsigned char* lds, const Args& A, int b, int nb, int kh) {
    int tid = threadIdx.x; asm volatile("" : "+v"(tid));
    const int lane = tid & 63, wid = __builtin_amdgcn_readfirstlane(tid >> 6), r = lane & 31, h = lane >> 5;
    const size_t rowb = (size_t)b * SEQ;
    const int s0 = (nb - 1) * 128;
#pragma unroll
    for (int pass = 0; pass < 4; ++pass) {
        const int j = (tid >> 3) + 64 * pass, c = tid & 7, s = s0 + j;
        u32x4 v = (u32x4){0u, 0u, 0u, 0u};
        if (s >= 0) v = *(const u32x4*)(A.K + (rowb + (size_t)s) * KVW + kh * 64 + 8 * c);
        *(LAS u32x4*)(lds + KS_OFF + j * KROW + 16 * c) = v;
    }
#pragma unroll
    for (int pass = 0; pass < 4; ++pass) {
        const int j = lane + 64 * pass, s = s0 + j;
        u32x4 v = (u32x4){0u, 0u, 0u, 0u};
        if (s >= 0) v = *(const u32x4*)(A.V + (rowb + (size_t)s) * KVW + kh * 64 + 8 * wid);
#pragma unroll
        for (int jj = 0; jj < 8; ++jj) { const unsigned w = v[jj >> 1]; ((LAS unsigned short*)(lds + VT_OFF + (8 * wid + jj) * VROW))[j] = (unsigned short)((jj & 1) ? (w >> 16) : (w & 0xffffu)); }
    }
    if (tid < 256) {
        const int j = tid >> 3, c = tid & 7;
        u32x4 v = (u32x4){0u, 0u, 0u, 0u};
        if (j < NMETA) v = *(const u32x4*)(A.KM + (size_t)j * KVW + kh * 64 + 8 * c);
        *(LAS u32x4*)(lds + KM_OFF + j * KROW + 16 * c) = v;
    }
    {
        const int d = tid & 63, kg = tid >> 6;
#pragma unroll
        for (int kk = 0; kk < 4; ++kk) { const int key = 4 * kg + kk; unsigned short val = 0; if (key < NMETA) val = A.VM[(size_t)key * KVW + kh * 64 + d];
            ((LAS unsigned short*)(lds + VTM_OFF + d * VMROW))[key] = val; }
    }
    __syncthreads();
    const int head = kh * QG + wid;
    const float slope2 = __builtin_amdgcn_exp2f(-0.5f * (float)(head + 1)) * LOG2E, sink2 = A.sinks[head] * LOG2E;
    for (int qs = 0; qs < 4; ++qs) {
        const int qrow = nb * 128 + 32 * qs + r;
        const bf16* qp = A.Q + (rowb + (size_t)qrow) * D + head * HD + 8 * h;
        bf16x8 qr[4];
#pragma unroll
        for (int d0 = 0; d0 < 4; ++d0) qr[d0] = *(const bf16x8*)(qp + 16 * d0);
        float mx = sink2, lsum = 0.f;
        f32x16 o[2]; o[0] = (f32x16){}; o[1] = (f32x16){};
#pragma unroll
        for (int tt = 0; tt < 6; ++tt) {
            const LAS unsigned char* kp = (tt < 5) ? (lds + KS_OFF + (32 * (qs + tt) + r) * KROW + 16 * h) : (lds + KM_OFF + r * KROW + 16 * h);
            f32x16 S = {};
#pragma unroll
            for (int d0 = 0; d0 < 4; ++d0) S = MFMA32(*(const LAS bf16x8*)(kp + 32 * d0), qr[d0], S);
            float tmax = -1e30f;
#pragma unroll
            for (int i = 0; i < 16; ++i) {
                const int kk = crow(i, h);
                bool ok; float dist;
                if (tt < 5) { ok = (tt == 0) ? (kk > r) : ((tt == 4) ? (kk <= r) : true); if (nb == 0) ok = ok && (32 * (qs + tt) + kk >= 128); dist = (float)(128 - (32 * tt + kk - r)); }
                else { ok = kk < NMETA; dist = (float)(qrow + NMETA - kk); }
                const float v = ok ? S[i] - slope2 * dist : -1e30f;
                S[i] = v; tmax = fmaxf(tmax, v);
            }
            tmax = fmaxf(tmax, __shfl_xor(tmax, 32));
            if (tmax > mx) {
                const float alpha = __builtin_amdgcn_exp2f(mx - tmax); mx = tmax; lsum *= alpha;
#pragma unroll
                for (int i = 0; i < 16; ++i) { o[0][i] *= alpha; o[1][i] *= alpha; }
            }
#pragma unroll
            for (int i = 0; i < 16; ++i) { const float p = __builtin_amdgcn_exp2f(S[i] - mx); S[i] = p; lsum += p; }
#pragma unroll
            for (int s = 0; s < 2; ++s) {
                u32x4 pw; pw.x = pk2(S[8 * s], S[8 * s + 1]); pw.y = pk2(S[8 * s + 2], S[8 * s + 3]); pw.z = pk2(S[8 * s + 4], S[8 * s + 5]); pw.w = pk2(S[8 * s + 6], S[8 * s + 7]);
                const bf16x8 pf = __builtin_bit_cast(bf16x8, pw);
#pragma unroll
                for (int db = 0; db < 2; ++db) {
                    const LAS unsigned char* vp = (tt < 5) ? (lds + VT_OFF + (32 * db + r) * VROW + (32 * (qs + tt) + 16 * s + 4 * h) * 2) : (lds + VTM_OFF + (32 * db + r) * VMROW + (16 * s + 4 * h) * 2);
                    const s16x4 lo = *(const LAS s16x4*)vp, hi = *(const LAS s16x4*)(vp + 16);
                    const bf16x8 vf = __builtin_shufflevector(lo, hi, 0, 1, 2, 3, 4, 5, 6, 7);
                    o[db] = MFMA32(vf, pf, o[db]);
                }
            }
        }
        lsum += __shfl_xor(lsum, 32);
        lsum += __builtin_amdgcn_exp2f(sink2 - mx);
        const float inv = 1.0f / lsum;
        bf16* op = A.O + (rowb + (size_t)qrow) * D + head * HD + 4 * h;
#pragma unroll
        for (int db = 0; db < 2; ++db)
#pragma unroll
            for (int g = 0; g < 4; ++g) { u32x2 w; w.x = pk2(o[db][4 * g] * inv, o[db][4 * g + 1] * inv); w.y = pk2(o[db][4 * g + 2] * inv, o[db][4 * g + 3] * inv);
                *(u32x2*)(op + 32 * db + 8 * g) = w; }
    }
    {
        const int g = 2 * kh + (wid & 1), rq = wid >> 1, win = 2 << g, col = 128 * g + 2 * lane;
        const float invw = 1.0f / (float)win;
        const int tau0 = NMETA + nb * 128 + 32 * rq;
        float a0 = 0.f, a1 = 0.f;
        for (int j = 1; j < win; ++j) { const unsigned w = ld_u2(A.U, A.UM, rowb, tau0 - j, col); a0 += bflo(w); a1 += bfhi(w); }
        for (int t = 0; t < 32; ++t) {
            const int tau = tau0 + t;
            const unsigned x = ld_u2(A.U, A.UM, rowb, tau, col); const float x0 = bflo(x), x1 = bfhi(x);
            a0 += x0; a1 += x1;
            *(unsigned*)(A.POOLED + (rowb + (size_t)(tau - NMETA)) * POOLW + col) = pk2(a0 * invw - x0, a1 * invw - x1);
            const unsigned y = ld_u2(A.U, A.UM, rowb, tau - win + 1, col); a0 -= bflo(y); a1 -= bfhi(y);
        }
    }
    __syncthreads();
}
}
constexpr int NWAVES = 8;
struct Args { const float* in[18]; float* out; unsigned char* ws; int ph_lo, ph_hi; };
struct Frame {
    LAS unsigned char* lds;
    int tid, lane, wave, vcu, G;
    float* out; unsigned char* ws;
};
#define WSP(T, off) ((T*)(F.ws + (off)))
#define METAP(T, off) ((T*)(F.ws + WS_META + (off)))
enum { I_X = 0, I_META, I_NORM_MIX, I_W_IN, I_SINKS, I_W_ATTN_BR, I_W_POOL, I_POOL_SCALE, I_W_OUT, I_NORM_FFN, I_DW_GATE, I_DW_UP, I_DW_DOWN, I_ROUTER, I_MW_GATE, I_MW_UP, I_MW_DOWN, I_NORM_FINAL };

DI void tr_item(const float* W, int N, bf16* WT, int ldw, int k0, int n0, int drow0, const float* kscale, const float* nscale, LAS float* scr, int lane) {
#pragma unroll 8
    for (int i = 0; i < 32; ++i) { const int kk = 2 * i + (lane >> 5); float v = W[(size_t)(k0 + kk) * N + n0 + (lane & 31)]; if (kscale) v *= kscale[k0 + kk]; if (nscale) v *= nscale[n0 + (lane & 31)]; scr[kk * 33 + (lane & 31)] = v; }
    LDS_WAIT(); asm volatile("" ::: "memory");
    const int c = lane & 7;
#pragma unroll
    for (int j = 0; j < 4; ++j) { const int n = (lane >> 3) + 8 * j; const LAS float* s = scr + (8 * c) * 33 + n;
        u32x4 o; o.x = pk2(s[0 * 33], s[1 * 33]); o.y = pk2(s[2 * 33], s[3 * 33]); o.z = pk2(s[4 * 33], s[5 * 33]); o.w = pk2(s[6 * 33], s[7 * 33]);
        *(u32x4*)(WT + (size_t)(drow0 + n) * ldw + k0 + 8 * c) = o; }
    LDS_WAIT(); asm volatile("" ::: "memory");
}
DI void tr_plain(const float* W, int K, int N, bf16* WT, int ldw, int it, const float* kscale, const float* nscale, LAS float* scr, int lane) {
    const int nblk = N / 32, kb = it / nblk, nb = it % nblk; tr_item(W, N, WT, ldw, 64 * kb, 32 * nb, 32 * nb, kscale, nscale, scr, lane);
}
DI void tr_gu(const float* W, int N, bf16* WT, int it, int up, const float* kscale, LAS float* scr, int lane) {
    const int nblk = N / 32, kb = it / nblk, nb = it % nblk, n0 = 32 * nb; tr_item(W, N, WT, D, 64 * kb, n0, (n0 / 128) * 256 + up * 128 + (n0 % 128), kscale, nullptr, scr, lane);
}
DI void p0_prologue(Frame& F, const Args& A) {
    LAS float* scr = (LAS float*)(F.lds + RING_OFF + F.wave * 16384);
    const int gw = F.vcu * NWAVES + F.wave, NGW = F.G * NWAVES, lane = F.lane;
    constexpr int I_IN = 16 * (INW / 32), I_SQ = 16 * 32, I_PL = 2 * 8, I_DGU = 16 * (DFF / 32), I_DD = (DFF / 64) * 32, I_MGU = 16 * (DFE / 32), I_MD = (DFE / 64) * 32;
    constexpr int PER_LAYER = I_IN + I_SQ + 4 * I_PL + I_SQ, N_DENSE = 2 * I_DGU + I_DD, PER_EXP = 2 * I_MGU + I_MD;
    constexpr int NITEMS = 2 * PER_LAYER + N_DENSE + NE * PER_EXP;
    for (int it = gw; it < NITEMS; it += NGW) {
        int r = it;
        if (r < 2 * PER_LAYER) {
            const int l = r / PER_LAYER; r -= l * PER_LAYER;
            if (r < I_IN) { tr_plain(A.in[I_W_IN] + (size_t)l * D * INW, D, INW, WSP(bf16, WS_WIN) + (size_t)l * INW * D, D, r, A.in[I_NORM_MIX] + l * D, nullptr, scr, lane); continue; } r -= I_IN;
            if (r < I_SQ) { tr_plain(A.in[I_W_ATTN_BR] + (size_t)l * D * D, D, D, WSP(bf16, WS_WA) + (size_t)l * D * D, D, r, nullptr, nullptr, scr, lane); continue; } r -= I_SQ;
            if (r < 4 * I_PL) { const int g = r / I_PL; r -= g * I_PL;
                tr_plain(A.in[I_W_POOL] + ((size_t)l * 4 + g) * 128 * 256, 128, 256, WSP(bf16, WS_WP) + ((size_t)l * D + g * 256) * 256, 256, r, nullptr, A.in[I_POOL_SCALE] + l * D + g * 256, scr, lane); continue; } r -= 4 * I_PL;
            tr_plain(A.in[I_W_OUT] + (size_t)l * D * D, D, D, WSP(bf16, WS_WO) + (size_t)l * D * D, D, r, nullptr, nullptr, scr, lane); continue;
        }
        r -= 2 * PER_LAYER;
        if (r < N_DENSE) {
            if (r < I_DGU) { tr_gu(A.in[I_DW_GATE], DFF, WSP(bf16, WS_WGU), r, 0, A.in[I_NORM_FFN], scr, lane); continue; } r -= I_DGU;
            if (r < I_DGU) { tr_gu(A.in[I_DW_UP], DFF, WSP(bf16, WS_WGU), r, 1, A.in[I_NORM_FFN], scr, lane); continue; } r -= I_DGU;
            tr_plain(A.in[I_DW_DOWN], DFF, D, WSP(bf16, WS_WD), DFF, r, nullptr, nullptr, scr, lane); continue;
        }
        r -= N_DENSE;
        { const int e = r / PER_EXP; r -= e * PER_EXP;
            if (r < I_MGU) { tr_gu(A.in[I_MW_GATE] + (size_t)e * D * DFE, DFE, WSP(bf16, WS_MGU) + (size_t)e * 2 * DFE * D, r, 0, A.in[I_NORM_FFN] + D, scr, lane); continue; } r -= I_MGU;
            if (r < I_MGU) { tr_gu(A.in[I_MW_UP] + (size_t)e * D * DFE, DFE, WSP(bf16, WS_MGU) + (size_t)e * 2 * DFE * D, r, 1, A.in[I_NORM_FFN] + D, scr, lane); continue; } r -= I_MGU;
            tr_plain(A.in[I_MW_DOWN] + (size_t)e * DFE * D, DFE, D, WSP(bf16, WS_MD) + (size_t)e * D * DFE, DFE, r, nullptr, nullptr, scr, lane); }
    }
    for (int rr = gw; rr < 2 * D; rr += NGW) *(unsigned*)(WSP(bf16, WS_WP) + (size_t)rr * 256 + 128 + 2 * lane) = 0u;
    const float* x = A.in[I_X]; bf16* HB = WSP(bf16, WS_HB); float* ssq = WSP(float, WS_SSQ);
    for (int m = gw; m < M; m += NGW) {
        const f32x4* xr = (const f32x4*)(x + (size_t)m * D) + lane; float s = 0.f; f32x4 v[4];
#pragma unroll
        for (int j = 0; j < 4; ++j) { v[j] = xr[64 * j]; s += (v[j][0] * v[j][0] + v[j][1] * v[j][1]) + (v[j][2] * v[j][2] + v[j][3] * v[j][3]); }
        u32x2* o8 = (u32x2*)(HB + (size_t)m * D) + lane;
#pragma unroll
        for (int j = 0; j < 4; ++j) { u32x2 w; w.x = pk2(v[j][0], v[j][1]); w.y = pk2(v[j][2], v[j][3]); o8[64 * j] = w; }
        s = wave_sum(s);
        if (lane < 16) ssq[(size_t)m * 16 + lane] = lane == 0 ? s : 0.f;
    }
    for (int m = gw; m < NMETA; m += NGW) {
        const f32x4* xr = (const f32x4*)(A.in[I_META] + (size_t)m * D) + lane; f32x4* ho = (f32x4*)(METAP(float, MO_HM) + (size_t)m * D) + lane; u32x2* o8 = (u32x2*)(METAP(bf16, MO_XM) + (size_t)m * D) + lane;
#pragma unroll
        for (int j = 0; j < 4; ++j) { const f32x4 v = xr[64 * j]; ho[64 * j] = v; u32x2 w; w.x = pk2(v[0], v[1]); w.y = pk2(v[2], v[3]); o8[64 * j] = w; }
    }
}

namespace meta {
DI f32x4 tile(const bf16* X, int ldx, const bf16* Wt, int ldw, int K, int lane) {
    const int i = lane & 15, q = lane >> 4; f32x4 acc = (f32x4){0.f, 0.f, 0.f, 0.f};
    const bf16* xp = X + (size_t)i * ldx + 8 * q; const bf16* wp = Wt + (size_t)i * ldw + 8 * q;
    for (int k0 = 0; k0 < K; k0 += 32) acc = __builtin_amdgcn_mfma_f32_16x16x32_bf16(*(const bf16x8*)(wp + k0), *(const bf16x8*)(xp + k0), acc, 0, 0, 0);
    return acc;
}
DI float rstd_rows(const float* hm, int lane) {
    float mine = 0.f;
    for (int row = 0; row < NMETA; ++row) { const f32x4* p = (const f32x4*)(hm + (size_t)row * D) + lane; float s = 0.f;
#pragma unroll
        for (int j = 0; j < 4; ++j) { const f32x4 v = p[64 * j]; s += (v[0] * v[0] + v[1] * v[1]) + (v[2] * v[2] + v[3] * v[3]); }
        s = wave_sum(s); if ((lane & 15) == row) mine = s; }
    return __builtin_amdgcn_rsqf(mine * (1.0f / D) + RMS_EPS);
}
DI void inproj(Frame& F, int l, int col0) {
    const int lane = F.lane, i = lane & 15, q = lane >> 4;
    const float rs = rstd_rows(METAP(float, MO_HM), lane);
    const f32x4 a = tile(METAP(bf16, MO_XM), D, WSP(bf16, WS_WIN) + ((size_t)l * INW + col0) * D, D, D, lane);
    float* pr = METAP(float, MO_PROJ) + (size_t)i * INW + col0 + 4 * q;
#pragma unroll
    for (int j = 0; j < 4; ++j) { float v = a[j] * rs; const int c = col0 + 4 * q + j;
        if (c < D) v *= QSCALE; else if (c >= 1792) v = fast_sigmoid(v);
        pr[j] = v;
        if (c >= 1024 && c < 1152) METAP(bf16, MO_KM)[((size_t)l * NMETA + i) * KVW + (c - 1024)] = (bf16)f2bf(v);
        else if (c >= 1152 && c < 1280) METAP(bf16, MO_VM)[((size_t)l * NMETA + i) * KVW + (c - 1152)] = (bf16)f2bf(v);
        else if (c >= 1280 && c < 1792) METAP(bf16, MO_UM)[((size_t)l * NMETA + i) * POOLW + (c - 1280)] = (bf16)f2bf(v); }
}
DI void attn_pool(Frame& F, const Args& A, int l) {
    const float* pr = METAP(float, MO_PROJ); const int t = F.tid;
    if (t < 256) {
        const int head = t >> 4, i = t & 15, kvh = head / QG;
        const float slope2 = __builtin_amdgcn_exp2f(-0.5f * (float)(head + 1)) * LOG2E, sink2 = A.in[I_SINKS][l * NH + head] * LOG2E;
        const float* qp = pr + (size_t)i * INW + head * HD;
        float lg[NMETA]; float mx = sink2;
#pragma unroll
        for (int j = 0; j < NMETA; ++j) { float s = -1e30f;
            if (j <= i) { const float* kp = pr + (size_t)j * INW + 1024 + kvh * HD; float acc = 0.f; for (int d = 0; d < HD; ++d) acc += qp[d] * kp[d]; s = acc - slope2 * (float)(i - j); }
            lg[j] = s; mx = fmaxf(mx, s); }
        float lsum = __builtin_amdgcn_exp2f(sink2 - mx);
#pragma unroll
        for (int j = 0; j < NMETA; ++j) { lg[j] = __builtin_amdgcn_exp2f(lg[j] - mx); lsum += lg[j]; }
        const float inv = 1.0f / lsum;
        bf16* op = METAP(bf16, MO_ATT) + (size_t)i * D + head * HD;
        for (int d = 0; d < HD; ++d) { float o = 0.f;
#pragma unroll
            for (int j = 0; j < NMETA; ++j) o += lg[j] * pr[(size_t)j * INW + 1152 + kvh * HD + d];
            op[d] = (bf16)f2bf(o * inv); }
    }
    {
        const int col = t, g = col >> 7, win = 2 << g;
        for (int tt = 0; tt < NMETA; ++tt) { const int cnt = (tt + 1) < win ? (tt + 1) : win; float s = 0.f;
            for (int j = 0; j < cnt; ++j) s += pr[(size_t)(tt - j) * INW + 1280 + col];
            METAP(bf16, MO_POOL)[(size_t)tt * POOLW + col] = (bf16)f2bf(s / (float)cnt - pr[(size_t)tt * INW + 1280 + col]); }
    }
}
DI void merge(Frame& F, int l, int col0) {
    const int lane = F.lane, i = lane & 15, q = lane >> 4, g = col0 >> 8;
    const f32x4 a = tile(METAP(bf16, MO_ATT), D, WSP(bf16, WS_WA) + ((size_t)l * D + col0) * D, D, D, lane);
    const f32x4 p = tile(METAP(bf16, MO_POOL) + g * 128, POOLW, WSP(bf16, WS_WP) + ((size_t)l * D + col0) * 256, 256, 128, lane);
    const float* pr = METAP(float, MO_PROJ) + (size_t)i * INW;
#pragma unroll
    for (int j = 0; j < 4; ++j) { const int c = col0 + 4 * q + j; METAP(bf16, MO_MRG)[(size_t)i * D + c] = (bf16)f2bf(pr[1792 + c] * a[j] + pr[2816 + c] * p[j]); }
}
DI void resid(Frame& F, const f32x4 o, int col0) {
    const int lane = F.lane, i = lane & 15, q = lane >> 4;
    float* hp = METAP(float, MO_HM) + (size_t)i * D + col0 + 4 * q; const f32x4 h = *(const f32x4*)hp + o; *(f32x4*)hp = h;
    u32x2 w; w.x = pk2(h[0], h[1]); w.y = pk2(h[2], h[3]); *(u32x2*)(METAP(bf16, MO_XM) + (size_t)i * D + col0 + 4 * q) = w;
}
DI void outproj(Frame& F, int l, int col0) { resid(F, tile(METAP(bf16, MO_MRG), D, WSP(bf16, WS_WO) + ((size_t)l * D + col0) * D, D, D, F.lane), col0); }
DI void gu(Frame& F, int n0) {
    const int lane = F.lane, i = lane & 15, q = lane >> 4;
    const float rs = rstd_rows(METAP(float, MO_HM), lane);
    const bf16* wg = WSP(bf16, WS_WGU) + (size_t)((n0 / 128) * 256 + (n0 % 128)) * D;
    const f32x4 ga = tile(METAP(bf16, MO_XM), D, wg, D, D, lane), ua = tile(METAP(bf16, MO_XM), D, wg + (size_t)128 * D, D, D, lane);
    f32x4 o;
#pragma unroll
    for (int j = 0; j < 4; ++j) { const float gg = ga[j] * rs; o[j] = gg * fast_sigmoid(gg) * (ua[j] * rs); }
    u32x2 w; w.x = pk2(o[0], o[1]); w.y = pk2(o[2], o[3]); *(u32x2*)(METAP(bf16, MO_ACT) + (size_t)i * DFF + n0 + 4 * q) = w;
}
DI void down(Frame& F, int col0) { resid(F, tile(METAP(bf16, MO_ACT), DFF, WSP(bf16, WS_WD) + (size_t)col0 * DFF, DFF, DFF, F.lane), col0); }
}
DI void moe_route(Frame& F, const Args& A) {
    LAS float* rw = (LAS float*)(F.lds + RING_OFF);
    LAS unsigned* hist = (LAS unsigned*)(F.lds + XTRA_OFF);
    const float* router = A.in[I_ROUTER]; const float* gain = A.in[I_NORM_FFN] + D;
    for (int idx = F.tid; idx < NE * D; idx += NWAVES * 64) { const int k = idx >> 3, e = idx & 7; rw[e * D + k] = router[idx] * gain[k]; }
    const float* h = F.out; float* ssq = WSP(float, WS_SSQ); unsigned* toke = WSP(unsigned, WS_TOKE); float* tokw = WSP(float, WS_TOKW); unsigned* wgcnt = WSP(unsigned, WS_WGCNT);
    const int lane = F.lane;
    for (int tile = F.vcu; tile < M / 256; tile += F.G) {
        if (F.tid < 16) hist[F.tid] = 0u;
        __syncthreads();
        for (int tt = 0; tt < 32; ++tt) {
            const int tok = tile * 256 + F.wave * 32 + tt;
            const f32x4* hr = (const f32x4*)(h + (size_t)tok * D) + lane; f32x4 v[4]; float s = 0.f;
#pragma unroll
            for (int j = 0; j < 4; ++j) { v[j] = hr[64 * j]; s += (v[j][0] * v[j][0] + v[j][1] * v[j][1]) + (v[j][2] * v[j][2] + v[j][3] * v[j][3]); }
            float lg[NE];
#pragma unroll
            for (int e = 0; e < NE; ++e) { float a = 0.f;
#pragma unroll
                for (int j = 0; j < 4; ++j) { const f32x4 w = *((const LAS f32x4*)(rw + e * D) + lane + 64 * j); a += (v[j][0] * w[0] + v[j][1] * w[1]) + (v[j][2] * w[2] + v[j][3] * w[3]); }
                lg[e] = wave_sum(a); }
            s = wave_sum(s);
            const float rs = __builtin_amdgcn_rsqf(s * (1.0f / D) + RMS_EPS);
            int e0 = 0; float v0 = lg[0];
#pragma unroll
            for (int e = 1; e < NE; ++e) if (lg[e] > v0) { v0 = lg[e]; e0 = e; }
            int e1 = -1; float v1 = -INFINITY;
#pragma unroll
            for (int e = 0; e < NE; ++e) if (e != e0 && lg[e] > v1) { v1 = lg[e]; e1 = e; }
            const float w1 = 1.0f / (1.0f + __expf((v0 - v1) * rs)), w0 = 1.0f - w1;
            if (lane < 16) ssq[(size_t)tok * 16 + lane] = lane == 0 ? s : 0.f;
            if (lane == 0) { toke[tok] = (unsigned)e0 | ((unsigned)e1 << 8); tokw[2 * tok] = w0; tokw[2 * tok + 1] = w1; __hip_atomic_fetch_add((unsigned*)&hist[e0], 1u, __ATOMIC_RELAXED, __HIP_MEMORY_SCOPE_WORKGROUP); __hip_atomic_fetch_add((unsigned*)&hist[8 + e1], 1u, __ATOMIC_RELAXED, __HIP_MEMORY_SCOPE_WORKGROUP); }
        }
        __syncthreads();
        if (F.tid < 16) wgcnt[tile * 16 + F.tid] = hist[F.tid];
        __syncthreads();
    }
}
DI void moe_slots(Frame& F) {
    LAS unsigned* cnt = (LAS unsigned*)(F.lds + RING_OFF);
    LAS unsigned* tot = cnt + 4096;
    LAS unsigned* seg = tot + 16;
    LAS unsigned* pre = seg + 16;
    LAS unsigned char* es = (LAS unsigned char*)(pre + 16);
    const unsigned* wgcnt = WSP(unsigned, WS_WGCNT); const unsigned* toke = WSP(unsigned, WS_TOKE); const float* tokw = WSP(float, WS_TOKW);
    int* slot_tok = WSP(int, WS_SLOTTOK); float* slot_w = WSP(float, WS_SLOTW); int* tab = WSP(int, WS_MOETAB);
    for (int i = F.tid; i < 4096; i += NWAVES * 64) cnt[i] = wgcnt[i];
    __syncthreads();
    if (F.tid < 16) { unsigned s = 0; for (int t = 0; t < M / 256; ++t) s += cnt[t * 16 + F.tid]; tot[F.tid] = s; }
    __syncthreads();
    if (F.tid < 16) { const int k = F.tid >> 3, e = F.tid & 7; unsigned s = 0; for (int e2 = 0; e2 < e; ++e2) s += (tot[k * 8 + e2] + 255u) & ~255u; seg[F.tid] = s; }
    __syncthreads();
    if (F.vcu == 0) {
        if (F.tid < 16) tab[F.tid] = (int)seg[F.tid];
        if (F.tid < 2) { unsigned s = 0; for (int e = 0; e < NE; ++e) s += (tot[F.tid * 8 + e] + 255u) >> 8; tab[16 + F.tid] = (int)s; }
        for (int i = F.tid; i < 2 * MAXTILES; i += NWAVES * 64) { const int k = i / MAXTILES, t = i % MAXTILES; int e = NE - 1;
            for (int e2 = NE - 1; e2 >= 0; --e2) if ((unsigned)(t * 256) < seg[k * 8 + e2] + ((tot[k * 8 + e2] + 255u) & ~255u)) e = e2;
            tab[32 + i] = e; }
    }
    for (int sgi = F.vcu; sgi < 16; sgi += F.G) { const int k = sgi >> 3; const unsigned b0 = seg[sgi] + tot[sgi], b1 = seg[sgi] + ((tot[sgi] + 255u) & ~255u);
        for (unsigned p = b0 + F.tid; p < b1; p += NWAVES * 64) { slot_tok[k * NSLOT + p] = -1; slot_w[k * NSLOT + p] = 0.f; } }
    for (int tile = F.vcu; tile < M / 256; tile += F.G) {
        __syncthreads();
        if (F.tid < 16) { unsigned s = 0; for (int t = 0; t < tile; ++t) s += cnt[t * 16 + F.tid]; pre[F.tid] = s; }
        if (F.tid < 256) { const unsigned ee = toke[tile * 256 + F.tid]; es[F.tid] = (unsigned char)(ee & 0xff); es[256 + F.tid] = (unsigned char)((ee >> 8) & 0xff); }
        __syncthreads();
        if (F.tid < 256) {
            const int tok = tile * 256 + F.tid;
#pragma unroll
            for (int k = 0; k < 2; ++k) { const unsigned e = es[k * 256 + F.tid]; unsigned rank = 0; for (int t2 = 0; t2 < F.tid; ++t2) rank += (es[k * 256 + t2] == e) ? 1u : 0u;
                const unsigned p = seg[k * 8 + e] + pre[k * 8 + e] + rank; slot_tok[k * NSLOT + p] = tok; slot_w[k * NSLOT + p] = tokw[2 * tok + k]; }
        }
    }
    __syncthreads();
}
DI void final_norm(Frame& F, const Args& A) {
    const int gw = F.vcu * NWAVES + F.wave, NGW = F.G * NWAVES, lane = F.lane; const float* gain = A.in[I_NORM_FINAL];
    f32x4 gv[4];
#pragma unroll
    for (int j = 0; j < 4; ++j) gv[j] = *((const f32x4*)gain + lane + 64 * j);
    for (int m = gw; m < M; m += NGW) {
        f32x4* xr = (f32x4*)(F.out + (size_t)m * D) + lane; f32x4 v[4]; float s = 0.f;
#pragma unroll
        for (int j = 0; j < 4; ++j) { v[j] = xr[64 * j]; s += (v[j][0] * v[j][0] + v[j][1] * v[j][1]) + (v[j][2] * v[j][2] + v[j][3] * v[j][3]); }
        const float rs = __builtin_amdgcn_rsqf(wave_sum(s) * (1.0f / D) + RMS_EPS);
#pragma unroll
        for (int j = 0; j < 4; ++j) xr[64 * j] = v[j] * rs * gv[j];
    }
}
#ifndef MK_PER_PHASE
#define MK_PER_PHASE 1
#endif
constexpr int NPHASES = 18;

DI void attn_phase(Frame& F, const Args& args, int l) {
    att::Args A{WSP(bf16, WS_Q), WSP(bf16, WS_K), WSP(bf16, WS_V), WSP(bf16, WS_U), METAP(bf16, MO_KM) + (size_t)l * NMETA * KVW, METAP(bf16, MO_VM) + (size_t)l * NMETA * KVW,
                METAP(bf16, MO_UM) + (size_t)l * NMETA * POOLW, args.in[I_SINKS] + l * NH, WSP(bf16, WS_HB), WSP(bf16, WS_POOLED)};
    for (int L = F.vcu; L < NB * 64 * NKV; L += F.G) att::unit(F.lds + RING_OFF, A, L >> 7, (L >> 1) & 63, L & 1);
}

__global__ void __launch_bounds__(NWAVES * 64, 2) fwd(Args args) {
    extern __shared__ __attribute__((aligned(16))) unsigned char lds[];
    Frame F;
    F.lds = (LAS unsigned char*)lds;
    F.tid = threadIdx.x; F.lane = F.tid & 63; F.wave = __builtin_amdgcn_readfirstlane(F.tid >> 6);
    F.G = gridDim.x; { const int bx = blockIdx.x; F.vcu = (F.G % 8 == 0) ? (bx % 8) * (F.G / 8) + bx / 8 : bx; }
    F.out = args.out; F.ws = args.ws;
    for (int u = F.tid; u < (LDS_BYTES - LDSCTL_OFF) / 4; u += NWAVES * 64) ((LAS unsigned*)(F.lds + LDSCTL_OFF))[u] = 0u;
    __syncthreads();
    gu32* ctl = (gu32*)(F.ws + WS_CTL);
    XcdBarrier bar; bar.bar = (unsigned*)(ctl + CW_BAR); bar.x = 0; bar.st = nullptr;
    if (!MK_PER_PHASE) bar = xcd_barrier_post((unsigned*)(ctl + CW_BAR), (volatile LAS unsigned*)(F.lds + MISC_OFF) + 8);
    const int lo = args.ph_lo, hi = args.ph_hi;
#ifndef PHMASK
#define PHMASK 0x3ffff
#endif
#define IN(k) (((PHMASK >> ((k) > 6 && (k) < 11 ? (k) - 6 : ((k) >= 15 ? (k) - 2 : (k)))) & 1) && lo <= (k) && (k) < hi)
#define SEAM(k) do { if (IN(k) && IN((k) + 1)) xcd_barrier(bar); } while (0)
#define LAUNDER() do { F.ws = args.ws; F.out = args.out; F.tid = threadIdx.x; asm volatile("" : "+s"(F.ws), "+s"(F.out), "+v"(F.tid)); F.lane = F.tid & 63; F.wave = __builtin_amdgcn_readfirstlane(F.tid >> 6); ssq = WSP(float, WS_SSQ); } while (0)
#define META_TASK(n, call) do { if (F.wave == 0) { for (int task = F.vcu; task < (n); task += F.G) { call; } } } while (0)

    float* ssq;
    if (IN(0)) { LAUNDER(); p0_prologue(F, args); } SEAM(0);

    for (int l = 0; l < 2; ++l) {
        const int pb = l * 6;
        if (IN(pb + 1)) { LAUNDER();
            if (l == 0) { META_TASK(INW / 16, meta::inproj(F, 0, 16 * task)); } else { META_TASK(768 / 16, meta::inproj(F, 1, 1024 + 16 * task)); }
            pg8::ProbPlain P{(const char*)WSP(bf16, WS_HB), (const char*)(WSP(bf16, WS_WIN) + (size_t)l * INW * D), D * 2, D * 2, D / 64, 0};
            pg8::StaticOrder S; S.init(M, INW, F.G, (int)blockIdx.x);
            pg8::EpiInProj E{ssq, WSP(bf16, WS_Q), WSP(bf16, WS_K), WSP(bf16, WS_V), WSP(bf16, WS_U), WSP(bf16, WS_G)};
            pg8::gemm_phase<pg8::ProbPlain, pg8::EpiInProj, pg8::StaticOrder, true>(F.lds + RING_OFF, P, S, E);
        } SEAM(pb + 1);
        if (IN(pb + 2)) { LAUNDER();
            if (l == 0 && F.vcu == 0) { meta::attn_pool(F, args, 0); }
            attn_phase(F, args, l);
        } SEAM(pb + 2);
        if (IN(pb + 3)) { LAUNDER();
            if (l == 0) { META_TASK(D / 16, meta::merge(F, 0, 16 * task)); }
            { pg8::ProbPlain P{(const char*)WSP(bf16, WS_POOLED), (const char*)(WSP(bf16, WS_WP) + (size_t)l * D * 256), POOLW * 2, 256 * 2, 256 / 64, 128 * 2};
              pg8::StaticOrder S; S.init(M, D, F.G, (int)blockIdx.x);
              pg8::EpiPoolLift E{WSP(bf16, WS_G), WSP(bf16, WS_Q)};
              pg8::gemm_phase<pg8::ProbPlain, pg8::EpiPoolLift, pg8::StaticOrder, true>(F.lds + RING_OFF, P, S, E); }
            VM_WAIT(); __syncthreads();
            { pg8::ProbPlain P{(const char*)WSP(bf16, WS_HB), (const char*)(WSP(bf16, WS_WA) + (size_t)l * D * D), D * 2, D * 2, D / 64, 0};
              pg8::StaticOrder S; S.init(M, D, F.G, (int)blockIdx.x);
              pg8::EpiMerge E{WSP(bf16, WS_G), WSP(bf16, WS_Q)};
              pg8::gemm_phase<pg8::ProbPlain, pg8::EpiMerge, pg8::StaticOrder, true>(F.lds + RING_OFF, P, S, E); }
        } SEAM(pb + 3);
        if (IN(pb + 4)) { LAUNDER();
            if (l == 0) { META_TASK(D / 16, meta::outproj(F, 0, 16 * task)); }
            pg8::ProbPlain P{(const char*)WSP(bf16, WS_Q), (const char*)(WSP(bf16, WS_WO) + (size_t)l * D * D), D * 2, D * 2, D / 64, 0};
            pg8::StaticOrder S; S.init(M, D, F.G, (int)blockIdx.x);
            pg8::EpiResid E{l == 0 ? args.in[I_X] : F.out, F.out, WSP(bf16, WS_HB), ssq};
            pg8::gemm_phase<pg8::ProbPlain, pg8::EpiResid, pg8::StaticOrder, true>(F.lds + RING_OFF, P, S, E);
        } SEAM(pb + 4);
        if (l == 0) {
            if (IN(5)) { LAUNDER();
                META_TASK(DFF / 16, meta::gu(F, 16 * task));
                pg8::ProbPlain P{(const char*)WSP(bf16, WS_HB), (const char*)WSP(bf16, WS_WGU), D * 2, D * 2, D / 64, 0};
                pg8::StaticOrder S; S.init(M, 2 * DFF, F.G, (int)blockIdx.x);
                pg8::EpiSwiGLU<false> E{ssq, WSP(bf16, WS_ACT), DFF, nullptr};
                pg8::gemm_phase<pg8::ProbPlain, pg8::EpiSwiGLU<false>, pg8::StaticOrder, true>(F.lds + RING_OFF, P, S, E);
            } SEAM(5);
            if (IN(6)) { LAUNDER();
                META_TASK(D / 16, meta::down(F, 16 * task));
                pg8::ProbPlain P{(const char*)WSP(bf16, WS_ACT), (const char*)WSP(bf16, WS_WD), DFF * 2, DFF * 2, DFF / 64, 0};
                pg8::StaticOrder S; S.init(M, D, F.G, (int)blockIdx.x);
                pg8::EpiResid E{F.out, F.out, WSP(bf16, WS_HB), ssq};
                pg8::gemm_phase<pg8::ProbPlain, pg8::EpiResid, pg8::StaticOrder, true>(F.lds + RING_OFF, P, S, E);
            } SEAM(6);
        }
    }
    if (IN(11)) { LAUNDER(); moe_route(F, args); } SEAM(11);
    if (IN(12)) { LAUNDER(); moe_slots(F); } SEAM(12);
    for (int k = 0; k < 2; ++k) {
        const int* tab = WSP(int, WS_MOETAB); const int* slot_tok = WSP(int, WS_SLOTTOK) + k * NSLOT; const float* slot_w = WSP(float, WS_SLOTW) + k * NSLOT;
        if (IN(13 + 2 * k)) { LAUNDER();
            const int ntile = __builtin_amdgcn_readfirstlane(tab[16 + k]);
            pg8::ProbMoeGU P{(const char*)WSP(bf16, WS_HB), (const char*)WSP(bf16, WS_MGU), D * 2, D * 2, D / 64, slot_tok, tab + 32 + k * MAXTILES};
            pg8::LinearOrder S{ntile, 2 * DFE / 256, F.G, F.vcu};
            pg8::EpiSwiGLU<true> E{ssq, WSP(bf16, WS_ACT), DFE, slot_tok};
            pg8::gemm_phase<pg8::ProbMoeGU, pg8::EpiSwiGLU<true>, pg8::LinearOrder, true>(F.lds + RING_OFF, P, S, E);
        } SEAM(13 + 2 * k);
        if (IN(14 + 2 * k)) { LAUNDER();
            const int ntile = __builtin_amdgcn_readfirstlane(tab[16 + k]);
            pg8::ProbMoeDown P{(const char*)WSP(bf16, WS_ACT), (const char*)WSP(bf16, WS_MD), DFE * 2, DFE * 2, DFE / 64, tab + 32 + k * MAXTILES};
            pg8::LinearOrder S{ntile, D / 256, F.G, F.vcu};
            pg8::EpiMoeDown E{F.out, slot_tok, slot_w};
            pg8::gemm_phase<pg8::ProbMoeDown, pg8::EpiMoeDown, pg8::LinearOrder, true>(F.lds + RING_OFF, P, S, E);
        } SEAM(14 + 2 * k);
    }
    if (IN(17)) { LAUNDER(); final_norm(F, args); }
#undef IN
#undef SEAM
#undef META_TASK
}

extern "C" void kernel_launch(void* const* d_in, const int* in_sizes, int n_in, void* d_out, int out_size, void* d_ws, size_t ws_size, hipStream_t stream) {
    static int grid = 0;
    if (grid == 0) {
        if (n_in != 18 || in_sizes[0] != M * D || out_size != M * D || ws_size < WS_END) { fprintf(stderr, "kernel_launch: unexpected shapes (n_in %d, in0 %d, out %d, ws %zu); nothing launched\n", n_in, n_in > 0 ? in_sizes[0] : -1, out_size, ws_size); grid = -1; return; }
        int dev = 0, cus = 0, per_cu = 0;
        if (hipGetDevice(&dev) != hipSuccess || hipDeviceGetAttribute(&cus, hipDeviceAttributeMultiprocessorCount, dev) != hipSuccess) { grid = -1; return; }
        if (hipFuncSetAttribute((const void*)fwd, hipFuncAttributeMaxDynamicSharedMemorySize, LDS_BYTES) != hipSuccess) { fprintf(stderr, "kernel_launch: hipFuncSetAttribute failed\n"); grid = -1; return; }
        if (hipOccupancyMaxActiveBlocksPerMultiprocessor(&per_cu, (const void*)fwd, NWAVES * 64, LDS_BYTES) != hipSuccess || per_cu < 1) { fprintf(stderr, "kernel_launch: occupancy query reports %d workgroups per CU\n", per_cu); }
        (void)hipGetLastError();
        grid = cus;
    }
    if (grid < 0) return;
    if (hipMemsetAsync((char*)d_ws + WS_CTL, 0, CTL_ZERO_BYTES, stream) != hipSuccess) return;
    Args a{};
    for (int i = 0; i < 18; ++i) a.in[i] = (const float*)d_in[i];
    a.out = (float*)d_out; a.ws = (unsigned char*)d_ws;
#if MK_PER_PHASE
    for (int p = 0; p < NPHASES; ++p) { a.ph_lo = p; a.ph_hi = p + 1; hipLaunchKernelGGL(fwd, dim3(grid), dim3(NWAVES * 64), LDS_BYTES, stream, a); }
#else
    a.ph_lo = 0; a.ph_hi = NPHASES; hipLaunchKernelGGL(fwd, dim3(grid), dim3(NWAVES * 64), LDS_BYTES, stream, a);
#endif
}
```

```cpp
#include <hip/hip_runtime.h>
#include <cstdio>
#include <cstdint>

#define GAS __attribute__((address_space(1)))
#define LAS __attribute__((address_space(3)))
typedef unsigned short bf16;
typedef short bf16x8 __attribute__((ext_vector_type(8)));
typedef short s16x4 __attribute__((ext_vector_type(4)));
typedef float f32x2 __attribute__((ext_vector_type(2)));
typedef float f32x4 __attribute__((ext_vector_type(4)));
typedef float f32x16 __attribute__((ext_vector_type(16)));
typedef unsigned u32x2 __attribute__((ext_vector_type(2)));
typedef unsigned u32x4 __attribute__((ext_vector_type(4)));
typedef GAS unsigned gu32;
#define RLX_AGENT __ATOMIC_RELAXED, __HIP_MEMORY_SCOPE_AGENT
#define LDS_WAIT() asm volatile("s_waitcnt lgkmcnt(0)" ::: "memory")
#define VM_WAIT() asm volatile("s_waitcnt vmcnt(0)" ::: "memory")
#define DI __device__ __forceinline__

constexpr int NB = 8, SEQ = 8192, D = 1024, M = NB * SEQ;
constexpr int NMETA = 16;
constexpr int NH = 16, HD = 64, NKV = 2, QG = 8, KVW = 128, POOLW = 512;
constexpr int USEQ = SEQ + NMETA;
constexpr int INW = 3840;
constexpr int DFF = 2816, NE = 8, DFE = 3584;
constexpr float RMS_EPS = 1e-5f;
constexpr float LOG2E = 1.4426950408889634f;
constexpr float QSCALE = 0.125f * LOG2E;
constexpr int NSLOT = M + NE * 256;
constexpr int MAXTILES = NSLOT / 256;

constexpr size_t MiB = 1u << 20;
constexpr size_t WS_CTL = 0, CTL_ZERO_BYTES = 1 * MiB;
constexpr size_t WS_SSQ = 1 * MiB;
constexpr size_t WS_TOKE = 5 * MiB;
constexpr size_t WS_TOKW = 5 * MiB + 512 * 1024;
constexpr size_t WS_SLOTTOK = 6 * MiB;
constexpr size_t WS_SLOTW = 7 * MiB;
constexpr size_t WS_WGCNT = 8 * MiB;
constexpr size_t WS_MOETAB = 8 * MiB + 64 * 1024;
constexpr size_t WS_SLOTRS = 8 * MiB + 128 * 1024;
constexpr size_t WS_META = 9 * MiB;
constexpr size_t WS_WIN = 16 * MiB;
constexpr size_t WS_WA = 31 * MiB;
constexpr size_t WS_WP = 35 * MiB;
constexpr size_t WS_WO = 36 * MiB;
constexpr size_t WS_WGU = 40 * MiB;
constexpr size_t WS_WD = 51 * MiB;
constexpr size_t WS_MGU = 57 * MiB;
constexpr size_t WS_MD = 169 * MiB;
constexpr size_t WS_HB = 225 * MiB;
constexpr size_t WS_POOLED = 353 * MiB;
constexpr size_t WS_Q = 417 * MiB;
constexpr size_t WS_K = 545 * MiB;
constexpr size_t WS_V = 561 * MiB;
constexpr size_t WS_U = 577 * MiB;
constexpr size_t WS_G = 642 * MiB;
constexpr size_t WS_ACT = 417 * MiB;
constexpr size_t WS_SLAB = 898 * MiB;
constexpr size_t WS_END = 930 * MiB;
static_assert(WS_ACT + (size_t)NSLOT * DFE * 2 <= WS_END && WS_ACT + (size_t)M * DFF * 2 <= WS_END, "act overlay");
constexpr size_t MO_HM = 0;
constexpr size_t MO_XM = 64 * 1024;
constexpr size_t MO_PROJ = 96 * 1024;
constexpr size_t MO_KM = 336 * 1024;
constexpr size_t MO_VM = 344 * 1024;
constexpr size_t MO_UM = 352 * 1024;
constexpr size_t MO_ATT = 384 * 1024;
constexpr size_t MO_POOL = 416 * 1024;
constexpr size_t MO_MRG = 432 * 1024;
constexpr size_t MO_ACT = 464 * 1024;
constexpr int CW_TMO = 0, CW_CODE = 1, CW_BAR = 4096;

constexpr int RING_OFF = 0, RING_BYTES = 147456;
constexpr int LDSCTL_OFF = RING_BYTES, MISC_OFF = LDSCTL_OFF + 320;
constexpr int XTRA_OFF = LDSCTL_OFF + 1024;
constexpr int LDS_BYTES = RING_BYTES + 4096;

DI unsigned f2bf(float f) { unsigned u = __builtin_bit_cast(unsigned, f); return (u + 0x7fffu + ((u >> 16) & 1u)) >> 16; }
DI unsigned pk2(float lo, float hi) { unsigned r; asm volatile("v_cvt_pk_bf16_f32 %0, %1, %2" : "=v"(r) : "v"(lo), "v"(hi)); return r; }
DI float sat8(float v) { return __builtin_amdgcn_fmed3f(v, -448.f, 448.f); }
DI unsigned pk4_fp8(float a, float b, float c, float d) { int w = __builtin_amdgcn_cvt_pk_fp8_f32(sat8(a), sat8(b), 0, false); w = __builtin_amdgcn_cvt_pk_fp8_f32(sat8(c), sat8(d), w, true); return (unsigned)w; }
constexpr float W8_GU = 64.f, W8_DN = 128.f;
DI float bf2f(unsigned short b) { return __builtin_bit_cast(float, (unsigned)b << 16); }
DI float bflo(unsigned w) { return __builtin_bit_cast(float, w << 16); }
DI float bfhi(unsigned w) { return __builtin_bit_cast(float, w & 0xffff0000u); }
DI int hw_lane() { int l; asm volatile("v_mbcnt_lo_u32_b32 %0, -1, 0\n\tv_mbcnt_hi_u32_b32 %0, -1, %0" : "=v"(l)); return l; }
DI float shx(float v, int mask, int lane) { return __builtin_bit_cast(float, __builtin_amdgcn_ds_bpermute((lane ^ mask) << 2, __builtin_bit_cast(int, v))); }
DI float wave_sum(float v, int lane) {
#pragma unroll
    for (int o = 1; o < 64; o <<= 1) v += shx(v, o, lane);
    return v;
}
DI float fast_sigmoid(float x) { return __builtin_amdgcn_rcpf(1.f + __builtin_amdgcn_exp2f(-x * LOG2E)); }
DI float sigmoid_scaled(float a, float nsl2) { return __builtin_amdgcn_rcpf(1.f + __builtin_amdgcn_exp2f(a * nsl2)); }

#define XB_TMO      128
#define XB_XCNT(j)  (256  + 64 * (j))
#define XB_XSUB(j)  (1280 + 64 * (j))
#define XB_XGEN(j)  (2304 + 64 * (j))
#define XB_TOP      3328
#define XB_TOPGEN   3392
#define XCD_BAR_WORDS 3456
#define XB_SPIN_CAP (1u << 18)
DI unsigned xb_ld(unsigned* p)              { return __hip_atomic_load(p, __ATOMIC_RELAXED, __HIP_MEMORY_SCOPE_AGENT); }
DI unsigned xb_add(unsigned* p, unsigned v) { return __hip_atomic_fetch_add(p, v, __ATOMIC_RELAXED, __HIP_MEMORY_SCOPE_AGENT); }
DI unsigned xb_xcc_id() { return (unsigned)__builtin_amdgcn_s_getreg((3 << 11) | 20) & 0xFu; }
#define XB_SPIN(cond, bar) do { unsigned _sp = 0; while (cond) { __builtin_amdgcn_s_sleep(1); \
    if ((++_sp & 255u) == 0u) { if (xb_ld(&(bar)[XB_TMO])) break; if (_sp > XB_SPIN_CAP) { atomicAdd(&(bar)[XB_TMO], 1u); break; } } } } while (0)
struct XcdBarrier { unsigned* bar; unsigned x; volatile LAS unsigned* st; };
DI XcdBarrier xcd_barrier_post(unsigned* bar, volatile LAS unsigned* st, int tid) {
    XcdBarrier b; b.bar = bar; b.x = xb_xcc_id(); b.st = st;
    if (tid == 0) (void)xb_add(&bar[XB_XCNT(b.x)], 1u);
    return b;
}
DI void xcd_barrier_complete(unsigned* bar, unsigned x, unsigned& nloc, unsigned& nx) {
    const unsigned G = gridDim.x * gridDim.y * gridDim.z;
    unsigned sum, cnt, mine, sp = 0u;
    for (;;) {
        sum = 0u; cnt = 0u; mine = 0u;
#pragma unroll
        for (unsigned j = 0; j < 16; ++j) { const unsigned c = xb_ld(&bar[XB_XCNT(j)]); sum += c; cnt += (c > 0u) ? 1u : 0u; mine = (j == x) ? c : mine; }
        if (sum == G) break;
        __builtin_amdgcn_s_sleep(1);
        if ((++sp & 255u) == 0u) { if (xb_ld(&bar[XB_TMO])) break; if (sp > XB_SPIN_CAP) { atomicAdd(&bar[XB_TMO], 1u); break; } }
    }
    nloc = mine > 0u ? mine : 1u; nx = cnt > 0u ? cnt : 1u;
}
DI void xcd_barrier(const XcdBarrier& b, int tid) {
    asm volatile("s_waitcnt vmcnt(0)" ::: "memory");
    __syncthreads();
    if (tid == 0) {
        unsigned* bar = b.bar;
        __builtin_amdgcn_s_waitcnt(0);
        unsigned nloc = b.st[0], nx = b.st[1];
        if (nloc == 0u) { xcd_barrier_complete(bar, b.x, nloc, nx); b.st[0] = nloc; b.st[1] = nx; }
        const unsigned old = xb_add(&bar[XB_XSUB(b.x)], 1u);
        const unsigned gen = old / nloc;
        if (old + 1u == (gen + 1u) * nloc) {
            __builtin_amdgcn_fence(__ATOMIC_RELEASE, "agent");
            asm volatile("s_waitcnt vmcnt(0)" ::: "memory");
            const unsigned og = xb_add(&bar[XB_TOP], 1u);
            const unsigned tg = og / nx;
            if (og + 1u == (tg + 1u) * nx) xb_add(&bar[XB_TOPGEN], 1u);
            else XB_SPIN(xb_ld(&bar[XB_TOPGEN]) == tg, bar);
            __builtin_amdgcn_fence(__ATOMIC_ACQUIRE, "agent");
            xb_add(&bar[XB_XGEN(b.x)], 1u);
            asm volatile("s_waitcnt vmcnt(0)" ::: "memory");
        } else {
            XB_SPIN(xb_ld(&bar[XB_XGEN(b.x)]) == gen, bar);
            __builtin_amdgcn_fence(__ATOMIC_ACQUIRE, "agent");
            asm volatile("s_waitcnt vmcnt(0)" ::: "memory");
        }
    }
    __syncthreads();
}
namespace pg8 {
constexpr int BM = 256, BK = 64, HALF = 128, HTB = HALF * BK * 2, STAGE_BYTES = 8 * HTB, NXCD = 8, WGM = 8;
__host__ __device__ __forceinline__ int lds_byte(int r, int c) { const int st = (r >> 4) * 2 + (c >> 5), rr = r & 15, cc = c & 31, ob = rr * 64 + cc * 2; return st * 1024 + (ob ^ (((ob >> 9) & 1) << 5)); }
__host__ __device__ __forceinline__ void stage_rc(int b, int& R, int& C) { const int st = b / 1024, sb = b % 1024, swz = sb ^ (((sb >> 9) & 1) << 5); R = (st >> 1) * 16 + swz / 64; C = (st & 1) * 32 + (swz % 64) / 2; }
__host__ __device__ __forceinline__ int perm32(int rho) { const int n = rho >> 4, i = rho & 15; return 8 * (i >> 2) + 4 * n + (i & 3); }

struct Unit { int pm, pn; int kq = 0; };

struct StaticOrder {
    int nM, nN, nwg, G, c; bool rev = false;
    DI void init(int M_, int N_, int G_, int c_) { nM = M_ / BM; nN = N_ / BM; nwg = nM * nN; G = G_; c = c_; }
    DI bool next(int i, Unit& u) const {
        const long L = (long)i * G + c; if (L >= nwg) return false;
        int wgid = (int)L; { const int q = nwg / NXCD, r = nwg % NXCD, xcd = wgid % NXCD, off = wgid / NXCD; wgid = (xcd < r ? xcd * (q + 1) : r * (q + 1) + (xcd - r) * q) + off; }
        const int nig = WGM * nN, gid = wgid / nig, fm = gid * WGM, gsz = (nM - fm) < WGM ? (nM - fm) : WGM;
        u.pm = fm + ((wgid % nig) % gsz); u.pn = (wgid % nig) / gsz; if (rev) u.pm = nM - 1 - u.pm; return true;
    }
};
struct LinearOrder {
    int ntile, nN, G, c; bool rev; int base = 0;
    DI bool next(int i, Unit& u) const {
        const long L = (long)i * G + c; if (L >= (long)ntile * nN) return false;
        constexpr int gt = 8; const int per8 = gt * nN, g = (int)(L / per8), w = (int)(L % per8), gsz = (ntile - gt * g) < gt ? (ntile - gt * g) : gt;
        u.pm = gt * g + w % gsz; u.pn = w / gsz; if (rev) u.pm = ntile - 1 - u.pm; u.pm += base; return true; }
};
constexpr int NQ = 2;
struct QuarterOrder {
    int ntail, G, c;
    DI bool next(int i, Unit& u) const { const long L = (long)i * G + c; if (L >= (long)ntail * 4 * NQ) return false; u.pm = (int)(L / (4 * NQ)); u.pn = (int)((L / NQ) & 3); u.kq = (int)(L % NQ); return true; }
};

struct ProbPlain {
    static constexpr bool GATHER = false;
    const char* A; const char* Bt; unsigned lda2, ldb2; int nt; unsigned acol2;
    unsigned kstepA; size_t panelA;
    unsigned kstepB = 128; size_t panelB = 0;
    DI unsigned a_base(const Unit& u) const { return (unsigned)((size_t)u.pm * panelA + (size_t)u.pn * acol2); }
    DI unsigned b_base(const Unit& u) const { return (unsigned)((size_t)u.pn * (panelB ? panelB : (size_t)BM * ldb2)); }
    DI unsigned a_row(const Unit&, int r) const { return (unsigned)r * lda2; }
};
struct ProbMoeGU {
    static constexpr bool GATHER = true;
    static constexpr unsigned kstepA = 128, kstepB = 128;
    const char* A; const char* Bt; unsigned lda2, ldb2; int nt; const int* slot_tok; const LAS int* tile_e; LAS int* gtab; size_t estride;
    DI unsigned a_base(const Unit&) const { return 0u; }
    DI unsigned a_row_lds(int r) const { int t = gtab[r]; t = t < 0 ? 0 : t; return (unsigned)t * lda2; }
    DI void prefetch_rows(const Unit& u, int wid, int lane) const { if (wid < 4) __builtin_amdgcn_global_load_lds((const unsigned*)(slot_tok + u.pm * BM + wid * 64 + lane), (LAS unsigned*)(gtab + wid * 64), 4, 0, 0); }
    DI unsigned b_base(const Unit& u) const { return (unsigned)((size_t)tile_e[u.pm] * estride + (size_t)u.pn * BM * ldb2); }
    DI unsigned a_row(const Unit& u, int r) const { int t = slot_tok[u.pm * BM + r]; t = t < 0 ? 0 : t; return (unsigned)t * lda2; }
};
struct ProbMoeDown {
    static constexpr bool GATHER = false;
    const char* A; const char* Bt; unsigned lda2, ldb2; int nt; const LAS int* tile_e; unsigned kstepA; size_t panelA; unsigned kstepB; size_t panelB; size_t estride;
    DI unsigned a_base(const Unit& u) const { return (unsigned)((size_t)u.pm * panelA); }
    DI unsigned b_base(const Unit& u) const { return (unsigned)((size_t)tile_e[u.pm] * estride + (size_t)u.pn * panelB); }
    DI unsigned a_row(const Unit&, int r) const { return (unsigned)r * lda2; }
};

struct ProbMoeDownQ {
    static constexpr bool GATHER = false; static constexpr unsigned kstepA = 32768, kstepB = 32768;
    const char* A; const char* Bt; unsigned lda2, ldb2; int nt; const LAS int* tile_e; size_t panelA, panelB, estride;
    DI unsigned a_base(const Unit& u) const { return (unsigned)((size_t)u.pm * panelA + (size_t)u.kq * nt * 32768); }
    DI unsigned b_base(const Unit& u) const { return (unsigned)((size_t)tile_e[u.pm] * estride + (size_t)u.pn * panelB + (size_t)u.kq * nt * 32768); }
    DI unsigned a_row(const Unit&, int r) const { return (unsigned)r * lda2; }
};

template <class Prob, class Epi, class Sched, bool ALIGN_EPI, bool FP8 = false>
DI void gemm_phase(LAS unsigned char* lds, const Prob& P, const Sched& S, const Epi& E, int tid) {
    asm volatile("" : "+v"(tid));
    const int wid = __builtin_amdgcn_readfirstlane(tid >> 6), lane = tid & 63, wr = wid >> 2, wc = wid & 3, fr = lane & 15, fq = lane >> 4;
    const int nt = P.nt;
    int R0, C0, R1, C1; stage_rc(tid * 16, R0, C0); stage_rc(tid * 16 + 8192, R1, C1);
    const int Rb0 = Epi::PERM ? ((R0 & ~31) + perm32(R0 & 31)) : R0, Rb1 = Epi::PERM ? ((R1 & ~31) + perm32(R1 & 31)) : R1;
    const unsigned voffB0 = (unsigned)Rb0 * P.ldb2 + (unsigned)C0 * 2u, voffB1 = (unsigned)Rb1 * P.ldb2 + (unsigned)C1 * 2u;
    const unsigned kstep = P.kstepB, kstepA = P.kstepA;
    const unsigned hstepB = (unsigned)HALF * P.ldb2;
    const __amdgpu_buffer_rsrc_t rsA = __builtin_amdgcn_make_buffer_rsrc((void*)P.A, 0, -1, 0x00020000), rsB = __builtin_amdgcn_make_buffer_rsrc((void*)P.Bt, 0, -1, 0x00020000);
    const unsigned ldsw = (unsigned)wid * 1024u;
    const int aoff = lds_byte(wr * 64 + fr, FP8 ? fq * 16 : fq * 8), boff = lds_byte(wc * 32 + fr, FP8 ? fq * 16 : fq * 8);
#define PG8_SA(b, h) (((b) * 2 + (h)) * HTB)
#define PG8_SB(b, h) ((4 + (b) * 2 + (h)) * HTB)
#define PG8_STGX(rs, bufoff, soff, v0, v1) do { \
        __builtin_amdgcn_raw_ptr_buffer_load_lds(rs, (LAS unsigned*)(lds + (bufoff) + ldsw), 16, (int)(v0), (int)(soff), 0, 0); \
        __builtin_amdgcn_raw_ptr_buffer_load_lds(rs, (LAS unsigned*)(lds + (bufoff) + ldsw + 8192), 16, (int)(v1), (int)(soff), 0, 0); } while (0)
#define PG8_STG(bufoff, soff, v0, v1) PG8_STGX(rsA, bufoff, soff, v0, v1)
#define PG8_STGB(bufoff, soff) PG8_STGX(rsB, bufoff, soff, voffB0, voffB1)
#define PG8_LDA(dst, b, h) do { if constexpr (FP8) { _Pragma("unroll") for (int m = 0; m < 4; ++m) dst##8[m] = *(const LAS i32x8u_*)(lds + PG8_SA(b, h) + aoff + m * 2048); } \
        else { _Pragma("unroll") for (int m = 0; m < 4; ++m) _Pragma("unroll") for (int k = 0; k < 2; ++k) dst[m][k] = *(const LAS bf16x8*)(lds + PG8_SA(b, h) + aoff + m * 2048 + k * 1024); } } while (0)
#define PG8_LDB(dst, b, h) do { if constexpr (FP8) { _Pragma("unroll") for (int n = 0; n < 2; ++n) dst##8[n] = *(const LAS i32x8u_*)(lds + PG8_SB(b, h) + boff + n * 2048); } \
        else { _Pragma("unroll") for (int n = 0; n < 2; ++n) _Pragma("unroll") for (int k = 0; k < 2; ++k) dst[n][k] = *(const LAS bf16x8*)(lds + PG8_SB(b, h) + boff + n * 2048 + k * 1024); } } while (0)
#define PG8_MMA(ai, bj, At, Bt) do { __builtin_amdgcn_s_setprio(1); _Pragma("unroll") for (int m = 0; m < 4; ++m) _Pragma("unroll") for (int n = 0; n < 2; ++n) { \
        if constexpr (FP8) { acc[ai][bj][m][n] = __builtin_amdgcn_mfma_scale_f32_16x16x128_f8f6f4(Bt##8[n], At##8[m], acc[ai][bj][m][n], 0, 0, 0, 0x7f7f7f7f, 0, 0x7f7f7f7f); } \
        else { _Pragma("unroll") for (int k = 0; k < 2; ++k) acc[ai][bj][m][n] = __builtin_amdgcn_mfma_f32_16x16x32_bf16(Bt[n][k], At[m][k], acc[ai][bj][m][n], 0, 0, 0); } } \
        __builtin_amdgcn_s_setprio(0); } while (0)
#define PG8_WAIT_V(n) asm volatile("s_waitcnt vmcnt(" #n ")" ::: "memory")
#define PG8_WAIT_L(n) asm volatile("s_waitcnt lgkmcnt(" #n ")" ::: "memory")
#define PG8_BAR __builtin_amdgcn_s_barrier()
#define PG8_SCHED __builtin_amdgcn_sched_barrier(0)
    Unit cur, nxt; int ui = 0;
    if (!S.next(0, cur)) return;
    f32x4 acc[2][2][4][2];
#pragma unroll
    for (int a = 0; a < 2; ++a)
#pragma unroll
        for (int b = 0; b < 2; ++b)
#pragma unroll
            for (int m = 0; m < 4; ++m)
#pragma unroll
                for (int n = 0; n < 2; ++n) acc[a][b][m][n] = (f32x4){0.f, 0.f, 0.f, 0.f};
    bf16x8 At[4][2], B0[2][2], B1[2][2];
    typedef int i32x8_ __attribute__((ext_vector_type(8))); typedef i32x8_ i32x8u_ __attribute__((aligned(16)));
    i32x8_ At8[4], B08[2], B18[2];
    unsigned vc00, vc01, vc10, vc11;
#define PG8_AOFF(u, o00, o01, o10, o11) do { o00 = P.a_row(u, R0) + (unsigned)C0 * 2u; o01 = P.a_row(u, R1) + (unsigned)C1 * 2u; \
        o10 = P.a_row(u, HALF + R0) + (unsigned)C0 * 2u; o11 = P.a_row(u, HALF + R1) + (unsigned)C1 * 2u; } while (0)
    PG8_AOFF(cur, vc00, vc01, vc10, vc11);
    unsigned cA = P.a_base(cur), cB = P.b_base(cur);
    PG8_STGB(PG8_SB(0, 0), cB); PG8_STGB(PG8_SB(0, 1), cB + hstepB); PG8_STG(PG8_SA(0, 0), cA, vc00, vc01); PG8_STG(PG8_SA(0, 1), cA, vc10, vc11);
    if (wr == 1) PG8_BAR;
    PG8_WAIT_V(2); PG8_BAR;
    PG8_STGB(PG8_SB(1, 0), cB + kstep); PG8_STG(PG8_SA(1, 0), cA + kstepA, vc00, vc01); PG8_STGB(PG8_SB(1, 1), cB + hstepB + kstep);
    PG8_WAIT_V(6); PG8_BAR;
    for (;;) {
        const bool has_next = S.next(ui + 1, nxt);
        unsigned nA = cA, nB = cB;
        if (has_next) { nA = P.a_base(nxt); nB = P.b_base(nxt); if constexpr (Prob::GATHER) { P.prefetch_rows(nxt, wid, lane); } }
        for (int t = 0; t < nt; t += 2) {
            const bool last = (t == nt - 2);
            const unsigned a1 = cA + (unsigned)(t + 1) * kstepA;
            const unsigned a2 = last ? nA : cA + (unsigned)(t + 2) * kstepA, b2 = last ? nB : cB + (unsigned)(t + 2) * kstep;
            const unsigned a3 = a2 + kstepA, b3 = b2 + kstep;
            PG8_LDB(B0, 0, 0); PG8_LDB(B1, 0, 1); PG8_SCHED; PG8_LDA(At, 0, 0); PG8_STG(PG8_SA(1, 1), a1, vc10, vc11);
            if constexpr (Prob::GATHER) { if (last && has_next) {
                vc00 = P.a_row_lds(R0) + (unsigned)C0 * 2u; vc01 = P.a_row_lds(R1) + (unsigned)C1 * 2u; vc10 = P.a_row_lds(HALF + R0) + (unsigned)C0 * 2u; vc11 = P.a_row_lds(HALF + R1) + (unsigned)C1 * 2u; } }
            PG8_WAIT_V(8); PG8_WAIT_L(0); PG8_BAR; PG8_MMA(0, 0, At, B0); PG8_MMA(0, 1, At, B1); PG8_BAR; PG8_SCHED;
            PG8_LDA(At, 0, 1); PG8_STGB(PG8_SB(0, 0), b2); PG8_STGB(PG8_SB(0, 1), b2 + hstepB); PG8_STG(PG8_SA(0, 0), a2, vc00, vc01);
            PG8_WAIT_V(8); PG8_WAIT_L(0); PG8_BAR; PG8_MMA(1, 0, At, B0); PG8_MMA(1, 1, At, B1); PG8_BAR; PG8_SCHED;
            PG8_LDB(B0, 1, 0); PG8_LDB(B1, 1, 1); PG8_SCHED; PG8_LDA(At, 1, 0); PG8_STG(PG8_SA(0, 1), a2, vc10, vc11);
            PG8_WAIT_V(8); PG8_WAIT_L(0); PG8_BAR; PG8_MMA(0, 0, At, B0); PG8_MMA(0, 1, At, B1); PG8_BAR; PG8_SCHED;
            PG8_LDA(At, 1, 1); PG8_STGB(PG8_SB(1, 0), b3); PG8_STGB(PG8_SB(1, 1), b3 + hstepB); PG8_STG(PG8_SA(1, 0), a3, vc00, vc01);
            PG8_WAIT_V(8); PG8_WAIT_L(0); PG8_BAR; PG8_MMA(1, 0, At, B0); PG8_MMA(1, 1, At, B1); PG8_BAR; PG8_SCHED;
        }
        if constexpr (ALIGN_EPI) { if (wr == 0) PG8_BAR; }
        PG8_SCHED; E(acc, cur, wr, wc, fr, fq); PG8_SCHED;
        if (!has_next) break;
#pragma unroll
        for (int a = 0; a < 2; ++a)
#pragma unroll
            for (int b = 0; b < 2; ++b)
#pragma unroll
                for (int m = 0; m < 4; ++m)
#pragma unroll
                    for (int n = 0; n < 2; ++n) acc[a][b][m][n] = (f32x4){0.f, 0.f, 0.f, 0.f};
        cur = nxt; cA = nA; cB = nB; ++ui;
        if constexpr (ALIGN_EPI) { if (wr == 1) PG8_BAR; }
    }
    PG8_WAIT_V(0);
    if constexpr (!ALIGN_EPI) { if (wr == 0) PG8_BAR; }
    PG8_BAR;
#undef PG8_SA
#undef PG8_SB
#undef PG8_STG
#undef PG8_STGX
#undef PG8_STGB
#undef PG8_LDA
#undef PG8_LDB
#undef PG8_MMA
#undef PG8_WAIT_V
#undef PG8_WAIT_L
#undef PG8_BAR
#undef PG8_SCHED
#undef PG8_AOFF
}
}
namespace pg8 {
DI u32x4 pack8(const f32x4 v0, const f32x4 v1) { u32x4 w; w.x = pk2(v0[0], v0[1]); w.y = pk2(v0[2], v0[3]); w.z = pk2(v1[0], v1[1]); w.w = pk2(v1[2], v1[3]); return w; }

DI void rstd4_load(f32x4 (&p)[4], const float* ssq16, int row0, int fq) {
#pragma unroll
    for (int m = 0; m < 4; ++m) p[m] = *(const f32x4*)(ssq16 + (size_t)(row0 + m * 16) * 16 + 4 * fq);
}
DI float rstd_finish(const f32x4 p, int lane) { float s = (p[0] + p[1]) + (p[2] + p[3]); s += shx(s, 16, lane); s += shx(s, 32, lane); return __builtin_amdgcn_rsqf(s * (1.0f / D) + RMS_EPS); }
#define EPI_FENCE() asm volatile("" ::: "memory")

struct EpiInProj {
    static constexpr bool PERM = true, TWICE_OK = true;
    const float* ssq16; bf16 *Q, *K, *V, *U, *G;
    DI void operator()(const f32x4 (&acc)[2][2][4][2], const Unit& u, int wr, int wc, int fr, int fq) const {
        const int row0 = u.pm * BM + wr * 64 + fr, cw = wc * 32 + 8 * fq;
        const int pn = u.pn;
        bf16* base0; bf16* base1; int ldc, col0, col1, mode;
        if (pn < 4) { base0 = base1 = Q; ldc = D; col0 = pn * 256 + cw; col1 = col0 + HALF; mode = 1; }
        else if (pn == 4) { base0 = K; base1 = V; ldc = KVW; col0 = col1 = cw; mode = 0; }
        else if (pn < 7) { base0 = base1 = U + (size_t)(NMETA * ((u.pm >> 5) + 1)) * POOLW; ldc = POOLW; col0 = (pn - 5) * 256 + cw; col1 = col0 + HALF; mode = 0; }
        else { base0 = base1 = G; ldc = 2 * D; col0 = (pn - 7) * 256 + cw; col1 = col0 + HALF; mode = 2; }
        f32x4 pp[2][4]; rstd4_load(pp[0], ssq16, row0, fq); rstd4_load(pp[1], ssq16, row0 + HALF, fq);
#pragma unroll
        for (int ai = 0; ai < 2; ++ai) {
#pragma unroll
            for (int m = 0; m < 4; ++m) {
                const int row = row0 + ai * HALF + m * 16;
                const float sc = rstd_finish(pp[ai][m], fq * 16 + fr) * (mode == 1 ? QSCALE : 1.f);
#pragma unroll
                for (int bj = 0; bj < 2; ++bj) {
                    f32x4 v0, v1;
                    if (mode == 2) { const float nsl2 = -sc * LOG2E;
#pragma unroll
                        for (int j = 0; j < 4; ++j) { v0[j] = sigmoid_scaled(acc[ai][bj][m][0][j], nsl2); v1[j] = sigmoid_scaled(acc[ai][bj][m][1][j], nsl2); }
                    } else { v0 = acc[ai][bj][m][0] * sc; v1 = acc[ai][bj][m][1] * sc; }
                    *(u32x4*)((bj ? base1 : base0) + (size_t)row * ldc + (bj ? col1 : col0)) = pack8(v0, v1);
                }
            }
            EPI_FENCE();
        }
    }
};
struct EpiPoolLift {
    static constexpr bool PERM = true, TWICE_OK = false;
    const bf16* G; bf16* MRG;
    DI void operator()(const f32x4 (&acc)[2][2][4][2], const Unit& u, int wr, int wc, int fr, int fq) const {
        const int row0 = u.pm * BM + wr * 64 + fr, col0 = u.pn * BM + wc * 32 + 8 * fq;
#pragma unroll
        for (int ai = 0; ai < 2; ++ai) {
            u32x4 g[4][2];
#pragma unroll
            for (int m = 0; m < 4; ++m)
#pragma unroll
                for (int bj = 0; bj < 2; ++bj) g[m][bj] = *(const u32x4*)(G + (size_t)(row0 + ai * HALF + m * 16) * (2 * D) + D + col0 + bj * HALF);
#pragma unroll
            for (int m = 0; m < 4; ++m) { const size_t r = (size_t)(row0 + ai * HALF + m * 16);
#pragma unroll
                for (int bj = 0; bj < 2; ++bj) { const u32x4 gg = g[m][bj];
                    f32x4 v0 = acc[ai][bj][m][0], v1 = acc[ai][bj][m][1];
                    v0[0] *= bflo(gg.x); v0[1] *= bfhi(gg.x); v0[2] *= bflo(gg.y); v0[3] *= bfhi(gg.y);
                    v1[0] *= bflo(gg.z); v1[1] *= bfhi(gg.z); v1[2] *= bflo(gg.w); v1[3] *= bfhi(gg.w);
                    *(u32x4*)(MRG + r * D + col0 + bj * HALF) = pack8(v0, v1); } }
            EPI_FENCE();
        }
    }
};
struct EpiMerge {
    static constexpr bool PERM = true, TWICE_OK = false;
    const bf16* G; bf16* MRG;
    DI void operator()(const f32x4 (&acc)[2][2][4][2], const Unit& u, int wr, int wc, int fr, int fq) const {
        const int row0 = u.pm * BM + wr * 64 + fr, col0 = u.pn * BM + wc * 32 + 8 * fq;
#pragma unroll
        for (int ai = 0; ai < 2; ++ai) {
            u32x4 g[4][2], pv[4][2];
#pragma unroll
            for (int m = 0; m < 4; ++m)
#pragma unroll
                for (int bj = 0; bj < 2; ++bj) { const size_t r = (size_t)(row0 + ai * HALF + m * 16); g[m][bj] = *(const u32x4*)(G + r * (2 * D) + col0 + bj * HALF); pv[m][bj] = *(const u32x4*)(MRG + r * D + col0 + bj * HALF); }
#pragma unroll
            for (int m = 0; m < 4; ++m) { const size_t r = (size_t)(row0 + ai * HALF + m * 16);
#pragma unroll
                for (int bj = 0; bj < 2; ++bj) { const u32x4 gg = g[m][bj], p = pv[m][bj];
                    f32x4 v0 = acc[ai][bj][m][0], v1 = acc[ai][bj][m][1];
                    v0[0] = v0[0] * bflo(gg.x) + bflo(p.x); v0[1] = v0[1] * bfhi(gg.x) + bfhi(p.x); v0[2] = v0[2] * bflo(gg.y) + bflo(p.y); v0[3] = v0[3] * bfhi(gg.y) + bfhi(p.y);
                    v1[0] = v1[0] * bflo(gg.z) + bflo(p.z); v1[1] = v1[1] * bfhi(gg.z) + bfhi(p.z); v1[2] = v1[2] * bflo(gg.w) + bflo(p.w); v1[3] = v1[3] * bfhi(gg.w) + bfhi(p.w);
                    *(u32x4*)(MRG + r * D + col0 + bj * HALF) = pack8(v0, v1); } }
            EPI_FENCE();
        }
    }
};
struct EpiResid {
    static constexpr bool PERM = true, TWICE_OK = false;
    bf16* HB; float* ssq16;
    DI void operator()(const f32x4 (&acc)[2][2][4][2], const Unit& u, int wr, int wc, int fr, int fq) const {
        const int row0 = u.pm * BM + wr * 64 + fr, col0 = u.pn * BM + wc * 32 + 8 * fq;
#pragma unroll
        for (int ai = 0; ai < 2; ++ai) {
            u32x4 hv[4][2];
#pragma unroll
            for (int m = 0; m < 4; ++m)
#pragma unroll
                for (int bj = 0; bj < 2; ++bj) hv[m][bj] = *(const u32x4*)(HB + (size_t)(row0 + ai * HALF + m * 16) * D + col0 + bj * HALF);
#pragma unroll
            for (int m = 0; m < 4; ++m) { const size_t r = (size_t)(row0 + ai * HALF + m * 16); float s = 0.f;
#pragma unroll
                for (int bj = 0; bj < 2; ++bj) { const u32x4 h = hv[m][bj];
                    f32x4 v0 = acc[ai][bj][m][0], v1 = acc[ai][bj][m][1];
                    v0[0] += bflo(h.x); v0[1] += bfhi(h.x); v0[2] += bflo(h.y); v0[3] += bfhi(h.y); v1[0] += bflo(h.z); v1[1] += bfhi(h.z); v1[2] += bflo(h.w); v1[3] += bfhi(h.w);
                    const u32x4 w = pack8(v0, v1); *(u32x4*)(HB + r * D + col0 + bj * HALF) = w;
                    s += (bflo(w.x) * bflo(w.x) + bfhi(w.x) * bfhi(w.x)) + (bflo(w.y) * bflo(w.y) + bfhi(w.y) * bfhi(w.y)) + (bflo(w.z) * bflo(w.z) + bfhi(w.z) * bfhi(w.z)) + (bflo(w.w) * bflo(w.w) + bfhi(w.w) * bfhi(w.w)); }
                s += shx(s, 16, fq * 16 + fr); s += shx(s, 32, fq * 16 + fr);
                if (fq == 0) ssq16[r * 16 + 4 * u.pn + wc] = s; }
            EPI_FENCE();
        }
    }
};
template <bool MOE> struct EpiSwiGLU {
    static constexpr bool PERM = true, TWICE_OK = false;
    const float* rsrc; bf16* ACT; int nkt;
    DI void operator()(const f32x4 (&acc)[2][2][4][2], const Unit& u, int wr, int wc, int fr, int fq) const {
        const int row0 = u.pm * BM + wr * 64 + fr;
        bf16* abase = ACT + ((size_t)(u.pm * nkt + 2 * u.pn + (wc >> 1)) * 256 + (wr * 64 + fr)) * 64 + (wc & 1) * 32 + 8 * fq;
        f32x4 pp[2][4]; float rsv[2][4];
        if (MOE) {
#pragma unroll
            for (int ai = 0; ai < 2; ++ai)
#pragma unroll
                for (int m = 0; m < 4; ++m) rsv[ai][m] = rsrc[row0 + ai * HALF + m * 16];
        } else { rstd4_load(pp[0], rsrc, row0, fq); rstd4_load(pp[1], rsrc, row0 + HALF, fq); }
#pragma unroll
        for (int ai = 0; ai < 2; ++ai) {
#pragma unroll
            for (int m = 0; m < 4; ++m) { const int r = row0 + ai * HALF + m * 16;
                const float rs = MOE ? rsv[ai][m] : rstd_finish(pp[ai][m], fq * 16 + fr); const float rs2 = rs * rs, nsl2 = -rs * LOG2E;
                f32x4 o[2];
#pragma unroll
                for (int n = 0; n < 2; ++n) { const f32x4 gu = acc[ai][0][m][n] * acc[ai][1][m][n] * rs2;
#pragma unroll
                    for (int j = 0; j < 4; ++j) o[n][j] = gu[j] * sigmoid_scaled(acc[ai][0][m][n][j], nsl2); }
                *(u32x4*)(abase + (ai * HALF + m * 16) * 64) = pack8(o[0], o[1]); }
            EPI_FENCE();
        }
    }
};
struct EpiSwiGLU8 {
    static constexpr bool PERM = true, TWICE_OK = false;
    const float* slot_rs; unsigned char* ACT8;
    DI void operator()(const f32x4 (&acc)[2][2][4][2], const Unit& u, int wr, int wc, int fr, int fq) const {
        const int row0 = wr * 64 + fr;
        unsigned char* base = ACT8 + ((size_t)(u.pm * (DFE / 128) + u.pn) * 256 + row0) * 128 + wc * 32 + 8 * fq;
        float rsv[2][4];
#pragma unroll
        for (int ai = 0; ai < 2; ++ai)
#pragma unroll
            for (int m = 0; m < 4; ++m) rsv[ai][m] = slot_rs[u.pm * BM + row0 + ai * HALF + m * 16];
#pragma unroll
        for (int ai = 0; ai < 2; ++ai) {
#pragma unroll
            for (int m = 0; m < 4; ++m) { const float rs = rsv[ai][m] * (1.0f / W8_GU), rs2 = rs * rs, nsl2 = -rs * LOG2E;
                f32x4 o[2];
#pragma unroll
                for (int n = 0; n < 2; ++n) { const f32x4 gu = acc[ai][0][m][n] * acc[ai][1][m][n] * rs2;
#pragma unroll
                    for (int j = 0; j < 4; ++j) o[n][j] = gu[j] * sigmoid_scaled(acc[ai][0][m][n][j], nsl2); }
                u32x2 w; w.x = pk4_fp8(o[0][0], o[0][1], o[0][2], o[0][3]); w.y = pk4_fp8(o[1][0], o[1][1], o[1][2], o[1][3]);
                *(u32x2*)(base + (size_t)(ai * HALF + m * 16) * 128) = w; }
            EPI_FENCE();
        }
    }
};
struct EpiMoeDown {
    static constexpr bool PERM = true, TWICE_OK = false;
    const bf16* SRC; bf16* DST; const int* slot_tok; const float* slot_w; float scale;
    DI void operator()(const f32x4 (&acc)[2][2][4][2], const Unit& u, int wr, int wc, int fr, int fq) const {
        const int row0 = u.pm * BM + wr * 64 + fr, col0 = u.pn * BM + wc * 32 + 8 * fq;
        int tk[2][4]; float wk[2][4];
#pragma unroll
        for (int ai = 0; ai < 2; ++ai)
#pragma unroll
            for (int m = 0; m < 4; ++m) { tk[ai][m] = slot_tok[row0 + ai * HALF + m * 16]; wk[ai][m] = slot_w[row0 + ai * HALF + m * 16] * scale; }
#pragma unroll
        for (int ai = 0; ai < 2; ++ai) {
            u32x4 hv[4][2];
#pragma unroll
            for (int m = 0; m < 4; ++m) { const int tok = tk[ai][m] < 0 ? 0 : tk[ai][m];
#pragma unroll
                for (int bj = 0; bj < 2; ++bj) hv[m][bj] = *(const u32x4*)(SRC + (size_t)tok * D + col0 + bj * HALF); }
#pragma unroll
            for (int m = 0; m < 4; ++m) { const int tok = tk[ai][m]; const float w = wk[ai][m];
                if (tok >= 0) {
#pragma unroll
                    for (int bj = 0; bj < 2; ++bj) { const u32x4 h = hv[m][bj];
                        f32x4 v0 = acc[ai][bj][m][0] * w, v1 = acc[ai][bj][m][1] * w;
                        v0[0] += bflo(h.x); v0[1] += bfhi(h.x); v0[2] += bflo(h.y); v0[3] += bfhi(h.y); v1[0] += bflo(h.z); v1[1] += bfhi(h.z); v1[2] += bflo(h.w); v1[3] += bfhi(h.w);
                        *(u32x4*)(DST + (size_t)tok * D + col0 + bj * HALF) = pack8(v0, v1); } } }
            EPI_FENCE();
        }
    }
};
struct EpiSlab {
    static constexpr bool PERM = false, TWICE_OK = false;
    float* slab;
    DI void operator()(const f32x4 (&acc)[2][2][4][2], const Unit& u, int wr, int wc, int fr, int fq) const {
        float* base = slab + ((size_t)(u.pm * NQ + u.kq) * BM + wr * 64 + fr) * D + u.pn * BM + wc * 32 + 4 * fq;
#pragma unroll
        for (int ai = 0; ai < 2; ++ai)
#pragma unroll
            for (int m = 0; m < 4; ++m)
#pragma unroll
                for (int bj = 0; bj < 2; ++bj)
#pragma unroll
                    for (int n = 0; n < 2; ++n) *(f32x4*)(base + (size_t)(ai * HALF + m * 16) * D + bj * HALF + n * 16) = acc[ai][bj][m][n];
    }
};
}
namespace att {
constexpr int KS_OFF = 0, KROW = 144, VT_OFF = 36864, VROW = 520, KM_OFF = 70144, VTM_OFF = 74752, VMROW = 72, RAWK_OFF = 79872, RAWV_OFF = RAWK_OFF + 32768, LDS_END = RAWV_OFF + 32768;
static_assert(LDS_END <= RING_BYTES, "attention LDS");
DI int crow(int i, int h) { return (i & 3) + 8 * (i >> 2) + 4 * h; }
struct Args { const bf16 *Q, *K, *V, *U, *KM, *VM, *UM; const float* sinks; bf16 *O, *POOLED; };
#define MFMA32(a, b, c) __builtin_amdgcn_mfma_f32_32x32x16_bf16((a), (b), (c), 0, 0, 0)
template <int WIN> DI void pool_load(unsigned (&xs)[47], const bf16* U, unsigned urow0, int col) {
    const char* ub = (const char*)U; const unsigned off0 = ((urow0 - (unsigned)(WIN - 1)) * POOLW + (unsigned)col) * 2u;
#pragma unroll
    for (int i = 0; i < 31 + WIN; ++i) xs[i] = *(const unsigned*)(ub + (off0 + (unsigned)i * (POOLW * 2u)));
}
template <int WIN> DI void pool_store(const unsigned (&xs)[47], bf16* POOLED, unsigned prow0, int col) {
    float a0 = 0.f, a1 = 0.f; const float invw = 1.0f / (float)WIN;
#pragma unroll
    for (int j = 0; j < WIN - 1; ++j) { a0 += bflo(xs[j]); a1 += bfhi(xs[j]); }
#pragma unroll
    for (int t = 0; t < 32; ++t) { const float x0 = bflo(xs[WIN - 1 + t]), x1 = bfhi(xs[WIN - 1 + t]); a0 += x0; a1 += x1;
        *(unsigned*)((char*)POOLED + ((prow0 + (unsigned)t) * POOLW + (unsigned)col) * 2u) = pk2(a0 * invw - x0, a1 * invw - x1);
        a0 -= bflo(xs[t]); a1 -= bfhi(xs[t]); }
}
DI void phase(LAS unsigned char* lds, const Args& A, int c, int G, int tid0) {
    asm volatile("" : "+v"(tid0));
    const int wid = __builtin_amdgcn_readfirstlane(tid0 >> 6);
    constexpr int NUNIT = NB * 64 * NKV;
    if (c >= NUNIT) return;
    bf16x8 qa[4], qb[4];
#define ATT_DECODE(L_, b_, nb_, kh_) const int b_ = (L_) >> 7, nb_ = ((L_) >> 1) & 63, kh_ = (L_) & 1
#define ATT_LOAD_KV(L_) do { ATT_DECODE(L_, b2, nb2, kh2); const size_t rb2 = (size_t)b2 * SEQ; const int s02 = (nb2 - 1) * 128; \
        _Pragma("unroll") for (int pass = 0; pass < 4; ++pass) { const int s = s02 + (tid >> 3) + 64 * pass; \
            kv[pass] = *(const u32x4*)(A.K + (rb2 + (size_t)(s < 0 ? 0 : s)) * KVW + kh2 * 64 + 8 * (tid & 7)); } \
        _Pragma("unroll") for (int pass = 0; pass < 4; ++pass) { const int s = s02 + lane + 64 * pass; \
            vv[pass] = *(const u32x4*)(A.V + (rb2 + (size_t)(s < 0 ? 0 : s)) * KVW + kh2 * 64 + 8 * wid); } } while (0)
#define ATT_DMA_KV(L_) do { ATT_DECODE(L_, b2, nb2, kh2); const size_t rb2 = (size_t)b2 * SEQ; const int s02 = (nb2 - 1) * 128; \
        _Pragma("unroll") for (int pass = 0; pass < 4; ++pass) { const int s = s02 + (tid >> 3) + 64 * pass; const size_t go = (rb2 + (size_t)(s < 0 ? 0 : s)) * KVW + kh2 * 64 + 8 * (tid & 7); \
            __builtin_amdgcn_global_load_lds((const unsigned*)(A.K + go), (LAS unsigned*)(lds + RAWK_OFF + (pass * 512 + wid * 64) * 16), 16, 0, 0); \
            __builtin_amdgcn_global_load_lds((const unsigned*)(A.V + go), (LAS unsigned*)(lds + RAWV_OFF + (pass * 512 + wid * 64) * 16), 16, 0, 0); } } while (0)
#define ATT_RAW_KV() do { _Pragma("unroll") for (int pass = 0; pass < 4; ++pass) { kv[pass] = *(const LAS u32x4*)(lds + RAWK_OFF + (pass * 512 + tid) * 16); \
            vv[pass] = *(const LAS u32x4*)(lds + RAWV_OFF + ((lane + 64 * pass) * 8 + wid) * 16); } } while (0)
#define ATT_LOAD_Q(dst, L_, qs_) do { ATT_DECODE(L_, b2, nb2, kh2); const bf16* qp = A.Q + ((size_t)b2 * SEQ + (size_t)(nb2 * 128 + 32 * (qs_) + r)) * D + (kh2 * QG + wid) * HD + 8 * h; \
        _Pragma("unroll") for (int d0 = 0; d0 < 4; ++d0) dst[d0] = *(const bf16x8*)(qp + 16 * d0); } while (0)
    { const int tid = tid0, lane = tid & 63, r = lane & 31, h = lane >> 5; ATT_LOAD_Q(qa, c, 0); }
    for (int L = c; L < NUNIT; L += G) {
        int tid = tid0; asm volatile("" : "+v"(tid));
        const int lane = tid & 63, r = lane & 31, h = lane >> 5;
        ATT_DECODE(L, b, nb, kh);
        const size_t rowb = (size_t)b * SEQ;
        const int head = kh * QG + wid;
        const bool has_next = (L + G) < NUNIT;
        const float slope2 = __builtin_amdgcn_exp2f(-0.5f * (float)(head + 1)) * LOG2E, sink2 = A.sinks[head] * LOG2E;
        const int pg = 2 * kh + (wid & 1), pcol = 128 * pg + 2 * lane;
        const unsigned prow0 = (unsigned)(b * SEQ + nb * 128 + 32 * (wid >> 1)), urow0 = prow0 + (unsigned)(NMETA * (b + 1));
        unsigned xs[47];
        if (pg == 0) pool_load<2>(xs, A.U, urow0, pcol); else if (pg == 1) pool_load<4>(xs, A.U, urow0, pcol);
        else if (pg == 2) pool_load<8>(xs, A.U, urow0, pcol); else pool_load<16>(xs, A.U, urow0, pcol);
        __builtin_amdgcn_sched_barrier(0);
        u32x4 kv[4], vv[4];
        if (L == c) ATT_LOAD_KV(L); else ATT_RAW_KV();
#pragma unroll
        for (int pass = 0; pass < 4; ++pass) { const int j = (tid >> 3) + 64 * pass, cc = tid & 7; *(LAS u32x4*)(lds + KS_OFF + j * KROW + 16 * cc) = kv[pass]; }
#pragma unroll
        for (int pass = 0; pass < 4; ++pass) { const int j = lane + 64 * pass;
#pragma unroll
            for (int jj = 0; jj < 8; ++jj) { const unsigned w = vv[pass][jj >> 1]; ((LAS unsigned short*)(lds + VT_OFF + (8 * wid + jj) * VROW))[j] = (unsigned short)((jj & 1) ? (w >> 16) : (w & 0xffffu)); } }
        if (L == c) {
            u32x4 kmv = *(const u32x4*)(A.KM + (size_t)((tid >> 3) & (NMETA - 1)) * KVW + kh * 64 + 8 * (tid & 7));
            if (tid >= 8 * NMETA) kmv = (u32x4){0u, 0u, 0u, 0u};
            if (tid < 256) *(LAS u32x4*)(lds + KM_OFF + (tid >> 3) * KROW + 16 * (tid & 7)) = kmv;
            const int d = tid & 63, kg = tid >> 6;
#pragma unroll
            for (int kk = 0; kk < 4; ++kk) { const int key = 4 * kg + kk; unsigned short val = A.VM[(size_t)(key & (NMETA - 1)) * KVW + kh * 64 + d]; if (key >= NMETA) val = 0;
                ((LAS unsigned short*)(lds + VTM_OFF + d * VMROW))[key] = val; }
        }
        __syncthreads();
        if (pg == 0) pool_store<2>(xs, A.POOLED, prow0, pcol); else if (pg == 1) pool_store<4>(xs, A.POOLED, prow0, pcol);
        else if (pg == 2) pool_store<8>(xs, A.POOLED, prow0, pcol); else pool_store<16>(xs, A.POOLED, prow0, pcol);
        __builtin_amdgcn_sched_barrier(0);
        if (has_next) ATT_DMA_KV(L + G);
        __builtin_amdgcn_sched_barrier(0);
        f32x16 Bb;
#pragma unroll
        for (int i = 0; i < 16; ++i) Bb[i] = -slope2 * (float)(128 - crow(i, h) + r);
#define ATT_BB(i) Bb[i]
#pragma unroll
        for (int qs = 0; qs < 4; ++qs) {
            bf16x8 (&qr)[4] = (qs & 1) ? qb : qa;
            if (qs == 0) ATT_LOAD_Q(qb, L, 1); else if (qs == 1) ATT_LOAD_Q(qa, L, 2); else if (qs == 2) ATT_LOAD_Q(qb, L, 3); else if (has_next) ATT_LOAD_Q(qa, L + G, 0);
            __builtin_amdgcn_sched_barrier(0);
            const int qrow = nb * 128 + 32 * qs + r;
            float mx = sink2, lsum = 0.f;
            f32x16 o[2]; o[0] = (f32x16){}; o[1] = (f32x16){};
#define ATT_QK(S_, kt_) do { const LAS unsigned char* kp_ = lds + KS_OFF + (32 * (kt_) + r) * KROW + 16 * h; \
                _Pragma("unroll") for (int d0 = 0; d0 < 4; ++d0) S_ = MFMA32(*(const LAS bf16x8*)(kp_ + 32 * d0), qr[d0], S_); } while (0)
#define ATT_MAX16(S_) fmaxf(fmaxf(fmaxf(fmaxf(S_[0], S_[1]), fmaxf(S_[2], S_[3])), fmaxf(fmaxf(S_[4], S_[5]), fmaxf(S_[6], S_[7]))), fmaxf(fmaxf(fmaxf(S_[8], S_[9]), fmaxf(S_[10], S_[11])), fmaxf(fmaxf(S_[12], S_[13]), fmaxf(S_[14], S_[15]))))
#define ATT_RESCALE(tmax_) do { if ((tmax_) > mx) { const float alpha = __builtin_amdgcn_exp2f(mx - (tmax_)); mx = (tmax_); lsum *= alpha; \
                _Pragma("unroll") for (int i = 0; i < 16; ++i) { o[0][i] *= alpha; o[1][i] *= alpha; } } } while (0)
#define ATT_PV(P_, kt_, s_) do { u32x4 pw; pw.x = pk2(P_[8 * (s_)], P_[8 * (s_) + 1]); pw.y = pk2(P_[8 * (s_) + 2], P_[8 * (s_) + 3]); pw.z = pk2(P_[8 * (s_) + 4], P_[8 * (s_) + 5]); pw.w = pk2(P_[8 * (s_) + 6], P_[8 * (s_) + 7]); \
                const bf16x8 pf = __builtin_bit_cast(bf16x8, pw); \
                _Pragma("unroll") for (int db = 0; db < 2; ++db) { const LAS unsigned char* vp = lds + VT_OFF + (32 * db + r) * VROW + (32 * (kt_) + 16 * (s_) + 4 * h) * 2; \
                    const s16x4 lo = *(const LAS s16x4*)vp, hi = *(const LAS s16x4*)(vp + 16); o[db] = MFMA32(__builtin_shufflevector(lo, hi, 0, 1, 2, 3, 4, 5, 6, 7), pf, o[db]); } } while (0)
#pragma unroll
            for (int tt = 1; tt < 4; ++tt) {
                if (nb == 0 && qs + tt < 4) continue;
                f32x16 S;
#pragma unroll
                for (int i = 0; i < 16; ++i) S[i] = ATT_BB(i);
                ATT_QK(S, qs + tt);
                const float shift = (32.0f * (float)tt) * slope2;
                float tmax = ATT_MAX16(S); tmax = fmaxf(tmax, shx(tmax, 32, lane)) + shift;
                ATT_RESCALE(tmax);
                const float mxs = mx - shift;
#pragma unroll
                for (int i = 0; i < 16; ++i) { const float p = __builtin_amdgcn_exp2f(S[i] - mxs); S[i] = p; lsum += p; }
                ATT_PV(S, qs + tt, 0); ATT_PV(S, qs + tt, 1);
            }
            {
                const bool t0ok = !(nb == 0 && qs < 4);
                f32x16 S0, S4;
#pragma unroll
                for (int i = 0; i < 16; ++i) { S0[i] = ATT_BB(i); S4[i] = ATT_BB(i); }
                if (t0ok) ATT_QK(S0, qs);
                ATT_QK(S4, qs + 4);
                const float sh4 = 128.0f * slope2;
#pragma unroll
                for (int i = 0; i < 16; ++i) { const bool lo_ = crow(i, h) > r; S4[i] = lo_ ? (t0ok ? S0[i] : -1e30f) : S4[i] + sh4; }
                float tmax = ATT_MAX16(S4); tmax = fmaxf(tmax, shx(tmax, 32, lane));
                ATT_RESCALE(tmax);
#pragma unroll
                for (int i = 0; i < 16; ++i) { const float p = __builtin_amdgcn_exp2f(S4[i] - mx); lsum += p; const bool lo_ = crow(i, h) > r; S0[i] = lo_ ? p : 0.f; S4[i] = lo_ ? 0.f : p; }
                if (t0ok) { ATT_PV(S0, qs, 0); ATT_PV(S0, qs, 1); }
                ATT_PV(S4, qs + 4, 0); ATT_PV(S4, qs + 4, 1);
            }
            {
                f32x16 S;
#pragma unroll
                for (int i = 0; i < 16; ++i) S[i] = (i < 8) ? -slope2 * (float)(NMETA - crow(i, h)) : 0.f;
                { const LAS unsigned char* kp_ = lds + KM_OFF + r * KROW + 16 * h;
#pragma unroll
                  for (int d0 = 0; d0 < 4; ++d0) S = MFMA32(*(const LAS bf16x8*)(kp_ + 32 * d0), qr[d0], S); }
                const float shift = -slope2 * (float)qrow;
                float tmax = fmaxf(fmaxf(fmaxf(S[0], S[1]), fmaxf(S[2], S[3])), fmaxf(fmaxf(S[4], S[5]), fmaxf(S[6], S[7])));
                tmax = fmaxf(tmax, shx(tmax, 32, lane)) + shift;
                ATT_RESCALE(tmax);
                const float mxs = mx - shift;
#pragma unroll
                for (int i = 0; i < 8; ++i) { const float p = __builtin_amdgcn_exp2f(S[i] - mxs); S[i] = p; lsum += p; }
                u32x4 pw; pw.x = pk2(S[0], S[1]); pw.y = pk2(S[2], S[3]); pw.z = pk2(S[4], S[5]); pw.w = pk2(S[6], S[7]);
                const bf16x8 pf = __builtin_bit_cast(bf16x8, pw);
#pragma unroll
                for (int db = 0; db < 2; ++db) { const LAS unsigned char* vp = lds + VTM_OFF + (32 * db + r) * VMROW + (4 * h) * 2;
                    const s16x4 lo = *(const LAS s16x4*)vp, hi = *(const LAS s16x4*)(vp + 16); o[db] = MFMA32(__builtin_shufflevector(lo, hi, 0, 1, 2, 3, 4, 5, 6, 7), pf, o[db]); }
            }
#undef ATT_QK
#undef ATT_MAX16
#undef ATT_RESCALE
#undef ATT_PV
            lsum += shx(lsum, 32, lane);
            lsum += __builtin_amdgcn_exp2f(sink2 - mx);
            const float inv = 1.0f / lsum;
            bf16* op = A.O + (rowb + (size_t)qrow) * D + head * HD + 4 * h;
#pragma unroll
            for (int db = 0; db < 2; ++db)
#pragma unroll
                for (int g = 0; g < 4; ++g) { u32x2 w; w.x = pk2(o[db][4 * g] * inv, o[db][4 * g + 1] * inv); w.y = pk2(o[db][4 * g + 2] * inv, o[db][4 * g + 3] * inv);
                    *(u32x2*)(op + 32 * db + 8 * g) = w; }
        }
        asm volatile("s_waitcnt vmcnt(8)" ::: "memory");
        __syncthreads();
    }
#undef ATT_DECODE
#undef ATT_BB
#undef ATT_LOAD_KV
#undef ATT_DMA_KV
#undef ATT_RAW_KV
#undef ATT_LOAD_Q
}
}
constexpr int NWAVES = 8;
struct Args { const float* in[18]; float* out; unsigned char* ws; int ph_lo, ph_hi; };
struct Frame {
    LAS unsigned char* lds;
    int tid, lane, wave, vcu, G;
    float* out; unsigned char* ws;
};
#define WSP(T, off) ((T*)(F.ws + (off)))
#define METAP(T, off) ((T*)(F.ws + WS_META + (off)))
enum { I_X = 0, I_META, I_NORM_MIX, I_W_IN, I_SINKS, I_W_ATTN_BR, I_W_POOL, I_POOL_SCALE, I_W_OUT, I_NORM_FFN, I_DW_GATE, I_DW_UP, I_DW_DOWN, I_ROUTER, I_MW_GATE, I_MW_UP, I_MW_DOWN, I_NORM_FINAL };

DI void tr_item(const float* W, int N, bf16* WT, int ldw, int k0, int n0, int drow0, const float* kscale, const float* nscale, LAS float* scr, int lane, int tiled_nkt = 0) {
    float wv[32];
#pragma unroll
    for (int i = 0; i < 32; ++i) wv[i] = W[(size_t)(k0 + 2 * i + (lane >> 5)) * N + n0 + (lane & 31)];
    const float ns = nscale ? nscale[n0 + (lane & 31)] : 1.f;
#pragma unroll
    for (int i = 0; i < 32; ++i) { const int kk = 2 * i + (lane >> 5); float v = wv[i] * ns; if (kscale) v *= kscale[k0 + kk]; scr[kk * 33 + (lane & 31)] = v; }
    LDS_WAIT(); asm volatile("" ::: "memory");
    const int c = lane & 7;
#pragma unroll
    for (int j = 0; j < 4; ++j) { const int n = (lane >> 3) + 8 * j; const LAS float* s = scr + (8 * c) * 33 + n;
        u32x4 o; o.x = pk2(s[0 * 33], s[1 * 33]); o.y = pk2(s[2 * 33], s[3 * 33]); o.z = pk2(s[4 * 33], s[5 * 33]); o.w = pk2(s[6 * 33], s[7 * 33]);
        const int dr = drow0 + n;
        bf16* dst = tiled_nkt ? WT + ((size_t)((dr >> 8) * tiled_nkt + (k0 >> 6)) * 256 + (dr & 255)) * 64 + 8 * c
                              : WT + (size_t)dr * ldw + k0 + 8 * c;
        *(u32x4*)dst = o; }
    LDS_WAIT(); asm volatile("" ::: "memory");
}
DI void tr_item8(const float* W, int N, unsigned char* WT, int ldw, int k0, int n0, int drow0, const float* kscale, float scale, LAS float* scr, int lane, int tiled_nkt) {
    float wv[32];
#pragma unroll
    for (int i = 0; i < 32; ++i) wv[i] = W[(size_t)(k0 + 2 * i + (lane >> 5)) * N + n0 + (lane & 31)];
#pragma unroll
    for (int i = 0; i < 32; ++i) { const int kk = 2 * i + (lane >> 5); float v = wv[i] * scale; if (kscale) v *= kscale[k0 + kk]; scr[kk * 33 + (lane & 31)] = v; }
    LDS_WAIT(); asm volatile("" ::: "memory");
#pragma unroll
    for (int j = 0; j < 2; ++j) { const int o = lane + 64 * j, n = o >> 2, c = o & 3; const LAS float* s = scr + (16 * c) * 33 + n;
        u32x4 w; w.x = pk4_fp8(s[0 * 33], s[1 * 33], s[2 * 33], s[3 * 33]); w.y = pk4_fp8(s[4 * 33], s[5 * 33], s[6 * 33], s[7 * 33]);
        w.z = pk4_fp8(s[8 * 33], s[9 * 33], s[10 * 33], s[11 * 33]); w.w = pk4_fp8(s[12 * 33], s[13 * 33], s[14 * 33], s[15 * 33]);
        const int dr = drow0 + n;
        unsigned char* dst = tiled_nkt ? WT + ((size_t)((dr >> 8) * tiled_nkt + (k0 >> 7)) * 256 + (dr & 255)) * 128 + (k0 & 127) + 16 * c : WT + (size_t)dr * ldw + k0 + 16 * c;
        *(u32x4*)dst = w; }
    LDS_WAIT(); asm volatile("" ::: "memory");
}
DI void tr_plain(const float* W, int K, int N, bf16* WT, int ldw, int it, const float* kscale, const float* nscale, LAS float* scr, int lane, int tiled_nkt = 0) {
    const int nblk = N / 32, kb = it / nblk, nb = it % nblk; tr_item(W, N, WT, ldw, 64 * kb, 32 * nb, 32 * nb, kscale, nscale, scr, lane, tiled_nkt);
}
DI void tr_gu(const float* W, int N, bf16* WT, int it, int up, const float* kscale, LAS float* scr, int lane) {
    const int nblk = N / 32, kb = it / nblk, nb = it % nblk, n0 = 32 * nb; tr_item(W, N, WT, D, 64 * kb, n0, (n0 / 128) * 256 + up * 128 + (n0 % 128), kscale, nullptr, scr, lane);
}
DI void p0_prologue(Frame& F, const Args& A) {
    LAS float* scr = (LAS float*)(F.lds + RING_OFF + F.wave * 16384);
    const int gw = F.vcu * NWAVES + F.wave, NGW = F.G * NWAVES, lane = F.lane;
    constexpr int I_IN = 16 * (INW / 32), I_SQ = 16 * 32, I_PL = 2 * 8, I_DGU = 16 * (DFF / 32), I_DD = (DFF / 64) * 32, I_MGU = 16 * (DFE / 32), I_MD = (DFE / 64) * 32;
    constexpr int PER_LAYER = I_IN + I_SQ + 4 * I_PL + I_SQ, N_DENSE = 2 * I_DGU + I_DD, PER_EXP = 2 * I_MGU + I_MD;
    constexpr int NITEMS = 2 * PER_LAYER + N_DENSE + NE * PER_EXP;
    for (int it = gw; it < NITEMS; it += NGW) {
        int r = it;
        if (r < 2 * PER_LAYER) {
            const int l = r / PER_LAYER; r -= l * PER_LAYER;
            if (r < I_IN) { tr_plain(A.in[I_W_IN] + (size_t)l * D * INW, D, INW, WSP(bf16, WS_WIN) + (size_t)l * INW * D, D, r, A.in[I_NORM_MIX] + l * D, nullptr, scr, lane); continue; } r -= I_IN;
            if (r < I_SQ) { tr_plain(A.in[I_W_ATTN_BR] + (size_t)l * D * D, D, D, WSP(bf16, WS_WA) + (size_t)l * D * D, D, r, nullptr, nullptr, scr, lane); continue; } r -= I_SQ;
            if (r < 4 * I_PL) { const int g = r / I_PL; r -= g * I_PL;
                tr_plain(A.in[I_W_POOL] + ((size_t)l * 4 + g) * 128 * 256, 128, 256, WSP(bf16, WS_WP) + ((size_t)l * D + g * 256) * 256, 256, r, nullptr, A.in[I_POOL_SCALE] + l * D + g * 256, scr, lane); continue; } r -= 4 * I_PL;
            tr_plain(A.in[I_W_OUT] + (size_t)l * D * D, D, D, WSP(bf16, WS_WO) + (size_t)l * D * D, D, r, nullptr, nullptr, scr, lane); continue;
        }
        r -= 2 * PER_LAYER;
        if (r < N_DENSE) {
            if (r < I_DGU) { tr_gu(A.in[I_DW_GATE], DFF, WSP(bf16, WS_WGU), r, 0, A.in[I_NORM_FFN], scr, lane); continue; } r -= I_DGU;
            if (r < I_DGU) { tr_gu(A.in[I_DW_UP], DFF, WSP(bf16, WS_WGU), r, 1, A.in[I_NORM_FFN], scr, lane); continue; } r -= I_DGU;
            tr_plain(A.in[I_DW_DOWN], DFF, D, WSP(bf16, WS_WD), DFF, r, nullptr, nullptr, scr, lane, DFF / 64); continue;
        }
        r -= N_DENSE;
        { const int e = r / PER_EXP; r -= e * PER_EXP;
            unsigned char* gu8 = WSP(unsigned char, WS_MGU) + (size_t)e * 2 * DFE * D; unsigned char* dn8 = WSP(unsigned char, WS_MD) + (size_t)e * D * DFE;
            if (r < 2 * I_MGU) { const int up = r >= I_MGU ? 1 : 0; if (up) r -= I_MGU; const int nblk = DFE / 32, kb = r / nblk, nb = r % nblk, n0 = 32 * nb;
                tr_item8((up ? A.in[I_MW_UP] : A.in[I_MW_GATE]) + (size_t)e * D * DFE, DFE, gu8, D, 64 * kb, n0, (n0 / 128) * 256 + up * 128 + (n0 % 128), A.in[I_NORM_FFN] + D, W8_GU, scr, lane, 0); continue; }
            r -= 2 * I_MGU;
            { const int nblk = D / 32, kb = r / nblk, nb = r % nblk; tr_item8(A.in[I_MW_DOWN] + (size_t)e * DFE * D, D, dn8, 0, 64 * kb, 32 * nb, 32 * nb, nullptr, W8_DN, scr, lane, DFE / 128); } }
    }
    for (int rr = gw; rr < 2 * D; rr += NGW) *(unsigned*)(WSP(bf16, WS_WP) + (size_t)rr * 256 + 128 + 2 * lane) = 0u;
    const float* x = A.in[I_X]; bf16* HB = WSP(bf16, WS_HB); float* ssq = WSP(float, WS_SSQ);
    for (int m0 = gw * 4; m0 < M; m0 += NGW * 4) {
        f32x4 v[4][4];
#pragma unroll
        for (int q = 0; q < 4; ++q)
#pragma unroll
            for (int j = 0; j < 4; ++j) v[q][j] = *((const f32x4*)(x + (size_t)(m0 + q) * D) + lane + 64 * j);
#pragma unroll
        for (int q = 0; q < 4; ++q) { float s = 0.f; u32x2* o8 = (u32x2*)(HB + (size_t)(m0 + q) * D) + lane;
#pragma unroll
            for (int j = 0; j < 4; ++j) { s += (v[q][j][0] * v[q][j][0] + v[q][j][1] * v[q][j][1]) + (v[q][j][2] * v[q][j][2] + v[q][j][3] * v[q][j][3]); u32x2 w; w.x = pk2(v[q][j][0], v[q][j][1]); w.y = pk2(v[q][j][2], v[q][j][3]); o8[64 * j] = w; }
            s = wave_sum(s, lane);
            if (lane < 16) ssq[(size_t)(m0 + q) * 16 + lane] = lane == 0 ? s : 0.f; }
    }
    for (int m = gw; m < NMETA; m += NGW) {
        const f32x4* xr = (const f32x4*)(A.in[I_META] + (size_t)m * D) + lane; f32x4* ho = (f32x4*)(METAP(float, MO_HM) + (size_t)m * D) + lane; u32x2* o8 = (u32x2*)(METAP(bf16, MO_XM) + (size_t)m * D) + lane;
#pragma unroll
        for (int j = 0; j < 4; ++j) { const f32x4 v = xr[64 * j]; ho[64 * j] = v; u32x2 w; w.x = pk2(v[0], v[1]); w.y = pk2(v[2], v[3]); o8[64 * j] = w; }
    }
}

namespace meta {
DI f32x4 tile(const bf16* X, int ldx, const bf16* Wt, int ldw, int K, int lane) {
    const int i = lane & 15, q = lane >> 4; f32x4 acc = (f32x4){0.f, 0.f, 0.f, 0.f};
    const bf16* xp = X + (size_t)i * ldx + 8 * q; const bf16* wp = Wt + (size_t)i * ldw + 8 * q;
    for (int k0 = 0; k0 < K; k0 += 32) acc = __builtin_amdgcn_mfma_f32_16x16x32_bf16(*(const bf16x8*)(wp + k0), *(const bf16x8*)(xp + k0), acc, 0, 0, 0);
    return acc;
}
template <int NST, bool SSQ, int TILED_NKT = 0> DI f32x4 tile_split(const bf16* X, int ldx, const bf16* Wt, int ldw, int wave, int lane, LAS float* scr, float& ssq) {
    const int i = lane & 15, q = lane >> 4, ks = 32 * NST;
    const bf16* xp = X + (size_t)i * ldx + wave * ks + 8 * q; const bf16* wp = Wt + (size_t)i * ldw + wave * ks + 8 * q;
    bf16x8 a[NST], b[NST];
#pragma unroll
    for (int s = 0; s < NST; ++s) { const int kk = wave * ks + 32 * s + 8 * q, wr_ = ldw + i;
        a[s] = TILED_NKT ? *(const bf16x8*)(Wt + ((size_t)((wr_ >> 8) * TILED_NKT + (kk >> 6)) * 256 + (wr_ & 255)) * 64 + (kk & 63)) : *(const bf16x8*)(wp + 32 * s);
        b[s] = *(const bf16x8*)(xp + 32 * s); }
    f32x4 acc = (f32x4){0.f, 0.f, 0.f, 0.f}; float sq = 0.f;
#pragma unroll
    for (int s = 0; s < NST; ++s) { acc = __builtin_amdgcn_mfma_f32_16x16x32_bf16(a[s], b[s], acc, 0, 0, 0);
        if (SSQ) {
#pragma unroll
            for (int j = 0; j < 8; ++j) { const float x = bf2f((unsigned short)b[s][j]); sq += x * x; } } }
    __syncthreads();
    *(LAS f32x4*)(scr + (wave * 64 + lane) * 4) = acc;
    if (SSQ) { sq += shx(sq, 16, lane); sq += shx(sq, 32, lane); if (q == 0) scr[2048 + wave * 16 + i] = sq; }
    __syncthreads();
    f32x4 r = (f32x4){0.f, 0.f, 0.f, 0.f}; float t = 0.f;
#pragma unroll
    for (int w = 0; w < 8; ++w) { r += *(const LAS f32x4*)(scr + (w * 64 + lane) * 4); if (SSQ) t += scr[2048 + w * 16 + i]; }
    ssq = t; return r;
}
DI void inproj(Frame& F, LAS float* scr, int l, int col0) {
    const int lane = F.lane, i = lane & 15, q = lane >> 4; float ss;
    const f32x4 a = tile_split<4, true>(METAP(bf16, MO_XM), D, WSP(bf16, WS_WIN) + ((size_t)l * INW + col0) * D, D, F.wave, lane, scr, ss);
    if (F.wave != 0) return;
    const float rs = __builtin_amdgcn_rsqf(ss * (1.0f / D) + RMS_EPS);
    float* pr = METAP(float, MO_PROJ) + (size_t)i * INW + col0 + 4 * q;
#pragma unroll
    for (int j = 0; j < 4; ++j) { float v = a[j] * rs; const int c = col0 + 4 * q + j;
        if (c < D) v *= QSCALE; else if (c >= 1792) v = fast_sigmoid(v);
        pr[j] = v;
        if (c >= 1024 && c < 1152) METAP(bf16, MO_KM)[((size_t)l * NMETA + i) * KVW + (c - 1024)] = (bf16)f2bf(v);
        else if (c >= 1152 && c < 1280) METAP(bf16, MO_VM)[((size_t)l * NMETA + i) * KVW + (c - 1152)] = (bf16)f2bf(v);
        else if (c >= 1280 && c < 1792) { const bf16 ub = (bf16)f2bf(v);
#pragma unroll
            for (int b = 0; b < NB; ++b) WSP(bf16, WS_U)[((size_t)b * USEQ + i) * POOLW + (c - 1280)] = ub; } }
}
DI void attn_head(Frame& F, const Args& A, int l, int head) {
    const float* pr = METAP(float, MO_PROJ); const int t = F.tid, i = t >> 5, dl = t & 31, kvh = head / QG;
    const float slope2 = __builtin_amdgcn_exp2f(-0.5f * (float)(head + 1)) * LOG2E, sink2 = A.in[I_SINKS][l * NH + head] * LOG2E;
    const float q0 = pr[(size_t)i * INW + head * HD + dl], q1 = pr[(size_t)i * INW + head * HD + dl + 32];
    float k0[NMETA], k1[NMETA], v0[NMETA], v1[NMETA];
#pragma unroll
    for (int j = 0; j < NMETA; ++j) { const float* kp = pr + (size_t)j * INW + 1024 + kvh * HD + dl; k0[j] = kp[0]; k1[j] = kp[32]; v0[j] = kp[128]; v1[j] = kp[160]; }
    float lg[NMETA]; float mx = sink2;
#pragma unroll
    for (int j = 0; j < NMETA; ++j) { float s = q0 * k0[j] + q1 * k1[j];
#pragma unroll
        for (int o = 1; o < 32; o <<= 1) s += shx(s, o, F.lane);
        s = (j <= i) ? s - slope2 * (float)(i - j) : -1e30f; lg[j] = s; mx = fmaxf(mx, s); }
    float lsum = __builtin_amdgcn_exp2f(sink2 - mx), o0 = 0.f, o1 = 0.f;
#pragma unroll
    for (int j = 0; j < NMETA; ++j) { const float p = __builtin_amdgcn_exp2f(lg[j] - mx); lsum += p; o0 += p * v0[j]; o1 += p * v1[j]; }
    const float inv = 1.0f / lsum;
    bf16* op = METAP(bf16, MO_ATT) + (size_t)i * D + head * HD + dl;
    op[0] = (bf16)f2bf(o0 * inv); op[32] = (bf16)f2bf(o1 * inv);
}
DI void pool_rows(Frame& F) {
    const float* pr = METAP(float, MO_PROJ); const int col = F.tid, g = col >> 7, win = 2 << g;
    float u[NMETA];
#pragma unroll
    for (int tt = 0; tt < NMETA; ++tt) u[tt] = pr[(size_t)tt * INW + 1280 + col];
#pragma unroll
    for (int tt = 0; tt < NMETA; ++tt) { float s = 0.f; int cnt = 0;
#pragma unroll
        for (int j = 0; j < NMETA; ++j) if (j <= tt && j < win) { s += u[tt - j]; ++cnt; }
        METAP(bf16, MO_POOL)[(size_t)tt * POOLW + col] = (bf16)f2bf(s / (float)cnt - u[tt]); }
}
DI void merge(Frame& F, LAS float* scr, int l, int col0) {
    const int lane = F.lane, i = lane & 15, q = lane >> 4, g = col0 >> 8; float dummy;
    const f32x4 a = tile_split<4, false>(METAP(bf16, MO_ATT), D, WSP(bf16, WS_WA) + ((size_t)l * D + col0) * D, D, F.wave, lane, scr, dummy);
    if (F.wave != 0) return;
    const f32x4 p = tile(METAP(bf16, MO_POOL) + g * 128, POOLW, WSP(bf16, WS_WP) + ((size_t)l * D + col0) * 256, 256, 128, lane);
    const float* pr = METAP(float, MO_PROJ) + (size_t)i * INW;
#pragma unroll
    for (int j = 0; j < 4; ++j) { const int c = col0 + 4 * q + j; METAP(bf16, MO_MRG)[(size_t)i * D + c] = (bf16)f2bf(pr[1792 + c] * a[j] + pr[2816 + c] * p[j]); }
}
DI void resid(Frame& F, const f32x4 o, int col0) {
    const int lane = F.lane, i = lane & 15, q = lane >> 4;
    float* hp = METAP(float, MO_HM) + (size_t)i * D + col0 + 4 * q; const f32x4 h = *(const f32x4*)hp + o; *(f32x4*)hp = h;
    u32x2 w; w.x = pk2(h[0], h[1]); w.y = pk2(h[2], h[3]); *(u32x2*)(METAP(bf16, MO_XM) + (size_t)i * D + col0 + 4 * q) = w;
}
DI void outproj(Frame& F, LAS float* scr, int l, int col0) { float dummy;
    const f32x4 o = tile_split<4, false>(METAP(bf16, MO_MRG), D, WSP(bf16, WS_WO) + ((size_t)l * D + col0) * D, D, F.wave, F.lane, scr, dummy);
    if (F.wave == 0) resid(F, o, col0); }
DI void gu(Frame& F, LAS float* scr, int n0) {
    const int lane = F.lane, i = lane & 15, q = lane >> 4; float ss, dummy;
    const bf16* wg = WSP(bf16, WS_WGU) + (size_t)((n0 / 128) * 256 + (n0 % 128)) * D;
    const f32x4 ga = tile_split<4, true>(METAP(bf16, MO_XM), D, wg, D, F.wave, lane, scr, ss);
    const f32x4 ua = tile_split<4, false>(METAP(bf16, MO_XM), D, wg + (size_t)128 * D, D, F.wave, lane, scr, dummy);
    if (F.wave != 0) return;
    const float rs = __builtin_amdgcn_rsqf(ss * (1.0f / D) + RMS_EPS);
    f32x4 o;
#pragma unroll
    for (int j = 0; j < 4; ++j) { const float gg = ga[j] * rs; o[j] = gg * fast_sigmoid(gg) * (ua[j] * rs); }
    u32x2 w; w.x = pk2(o[0], o[1]); w.y = pk2(o[2], o[3]); *(u32x2*)(METAP(bf16, MO_ACT) + (size_t)i * DFF + n0 + 4 * q) = w;
}
DI void down(Frame& F, LAS float* scr, int col0) { float dummy;
    const f32x4 o = tile_split<DFF / 256, false, DFF / 64>(METAP(bf16, MO_ACT), DFF, WSP(bf16, WS_WD), col0, F.wave, F.lane, scr, dummy);
    if (F.wave == 0) resid(F, o, col0); }
}
DI void moe_route(Frame& F, const Args& A) {
    LAS float* rw = (LAS float*)(F.lds + RING_OFF);
    LAS unsigned* hist = (LAS unsigned*)(F.lds + XTRA_OFF);
    const float* router = A.in[I_ROUTER]; const float* gain = A.in[I_NORM_FFN] + D;
    for (int idx = F.tid; idx < NE * D; idx += NWAVES * 64) { const int k = idx >> 3, e = idx & 7; rw[e * D + k] = router[idx] * gain[k]; }
    unsigned char* hb8 = WSP(unsigned char, WS_POOLED);
    const bf16* h = WSP(bf16, WS_HB); float* ssq = WSP(float, WS_SSQ); unsigned* toke = WSP(unsigned, WS_TOKE); float* tokw = WSP(float, WS_TOKW); unsigned* wgcnt = WSP(unsigned, WS_WGCNT);
    const int lane = F.lane;
    for (int tile = F.vcu; tile < M / 256; tile += F.G) {
        if (F.tid < 16) hist[F.tid] = 0u;
        __syncthreads();
        for (int t4 = 0; t4 < 32; t4 += 4) {
            u32x2 hq[4][4];
#pragma unroll
            for (int t = 0; t < 4; ++t)
#pragma unroll
                for (int j = 0; j < 4; ++j) hq[t][j] = *((const u32x2*)(h + (size_t)(tile * 256 + F.wave * 32 + t4 + t) * D) + lane + 64 * j);
#pragma unroll
            for (int t = 0; t < 4; ++t) {
                const int tok = tile * 256 + F.wave * 32 + t4 + t;
                f32x4 v[4]; float s = 0.f;
#pragma unroll
                for (int j = 0; j < 4; ++j) { const u32x2 q = hq[t][j]; v[j] = (f32x4){bflo(q.x), bfhi(q.x), bflo(q.y), bfhi(q.y)}; s += (v[j][0] * v[j][0] + v[j][1] * v[j][1]) + (v[j][2] * v[j][2] + v[j][3] * v[j][3]); }
                float lg[NE];
#pragma unroll
                for (int e = 0; e < NE; ++e) { float a = 0.f;
#pragma unroll
                    for (int j = 0; j < 4; ++j) { const f32x4 w = *((const LAS f32x4*)(rw + e * D) + lane + 64 * j); a += (v[j][0] * w[0] + v[j][1] * w[1]) + (v[j][2] * w[2] + v[j][3] * w[3]); }
                    lg[e] = wave_sum(a, lane); }
                s = wave_sum(s, lane);
                const float rs = __builtin_amdgcn_rsqf(s * (1.0f / D) + RMS_EPS);
                int e0 = 0; float v0 = lg[0];
#pragma unroll
                for (int e = 1; e < NE; ++e) if (lg[e] > v0) { v0 = lg[e]; e0 = e; }
                int e1 = -1; float v1 = -INFINITY;
#pragma unroll
                for (int e = 0; e < NE; ++e) if (e != e0 && lg[e] > v1) { v1 = lg[e]; e1 = e; }
                const float w1 = 1.0f / (1.0f + __expf((v0 - v1) * rs)), w0 = 1.0f - w1;
                if (lane < 16) ssq[(size_t)tok * 16 + lane] = lane == 0 ? s : 0.f;
#pragma unroll
                for (int j = 0; j < 4; ++j) *((unsigned*)(hb8 + (size_t)tok * D) + lane + 64 * j) = pk4_fp8(v[j][0], v[j][1], v[j][2], v[j][3]);
                if (lane == 0) { toke[tok] = (unsigned)e0 | ((unsigned)e1 << 8); tokw[2 * tok] = w0; tokw[2 * tok + 1] = w1; __hip_atomic_fetch_add((unsigned*)&hist[e0], 1u, __ATOMIC_RELAXED, __HIP_MEMORY_SCOPE_WORKGROUP); __hip_atomic_fetch_add((unsigned*)&hist[8 + e1], 1u, __ATOMIC_RELAXED, __HIP_MEMORY_SCOPE_WORKGROUP); }
            }
        }
        __syncthreads();
        if (F.tid < 16) wgcnt[tile * 16 + F.tid] = hist[F.tid];
        __syncthreads();
    }
}
DI void moe_slots(Frame& F) {
    LAS unsigned* cnt = (LAS unsigned*)(F.lds + RING_OFF);
    LAS unsigned* tot = cnt + 4096;
    LAS unsigned* seg = tot + 16;
    LAS unsigned* pre = seg + 16;
    LAS unsigned char* es = (LAS unsigned char*)(pre + 16);
    const unsigned* wgcnt = WSP(unsigned, WS_WGCNT); const unsigned* toke = WSP(unsigned, WS_TOKE); const float* tokw = WSP(float, WS_TOKW);
    int* slot_tok = WSP(int, WS_SLOTTOK); float* slot_w = WSP(float, WS_SLOTW); float* slot_rs = WSP(float, WS_SLOTRS); const float* ssq = WSP(float, WS_SSQ); int* tab = WSP(int, WS_MOETAB);
    for (int i = F.tid; i < 4096; i += NWAVES * 64) cnt[i] = wgcnt[i];
    __syncthreads();
    { const int col = F.tid >> 5, pp = F.tid & 31; unsigned s = 0;
#pragma unroll
      for (int j = 0; j < 8; ++j) s += cnt[(pp * 8 + j) * 16 + col];
#pragma unroll
      for (int o = 1; o < 32; o <<= 1) s += (unsigned)__builtin_amdgcn_ds_bpermute((F.lane ^ o) << 2, (int)s);
      if (pp == 0) tot[col] = s; }
    __syncthreads();
    if (F.tid < 16) { const int k = F.tid >> 3, e = F.tid & 7; unsigned s = 0; for (int e2 = 0; e2 < e; ++e2) s += (tot[k * 8 + e2] + 255u) & ~255u; seg[F.tid] = s; }
    __syncthreads();
    if (F.vcu == 0) {
        if (F.tid < 16) tab[F.tid] = (int)seg[F.tid];
        if (F.tid < 2) { unsigned s = 0; for (int e = 0; e < NE; ++e) s += (tot[F.tid * 8 + e] + 255u) >> 8; tab[16 + F.tid] = (int)s; }
        for (int i = F.tid; i < 2 * MAXTILES; i += NWAVES * 64) { const int k = i / MAXTILES, t = i % MAXTILES; int e = NE - 1;
            for (int e2 = NE - 1; e2 >= 0; --e2) if ((unsigned)(t * 256) < seg[k * 8 + e2] + ((tot[k * 8 + e2] + 255u) & ~255u)) e = e2;
            tab[32 + i] = e; }
    }
    for (int sgi = F.vcu; sgi < 16; sgi += F.G) { const int k = sgi >> 3; const unsigned b0 = seg[sgi] + tot[sgi], b1 = seg[sgi] + ((tot[sgi] + 255u) & ~255u);
        for (unsigned p = b0 + F.tid; p < b1; p += NWAVES * 64) { slot_tok[k * NSLOT + p] = -1; slot_w[k * NSLOT + p] = 0.f; slot_rs[k * NSLOT + p] = 0.f; } }
    for (int tile = F.vcu; tile < M / 256; tile += F.G) {
        __syncthreads();
        { const int col = F.tid >> 5, pp = F.tid & 31; unsigned s = 0;
#pragma unroll
          for (int j = 0; j < 8; ++j) { const int t = pp * 8 + j; s += t < tile ? cnt[t * 16 + col] : 0u; }
#pragma unroll
          for (int o = 1; o < 32; o <<= 1) s += (unsigned)__builtin_amdgcn_ds_bpermute((F.lane ^ o) << 2, (int)s);
          if (pp == 0) pre[col] = s; }
        unsigned ee = 0u;
        if (F.tid < 256) ee = toke[tile * 256 + F.tid];
        LAS unsigned* wcnt = (LAS unsigned*)es;
        unsigned rk[2] = {0u, 0u};
        if (F.tid < 256) {
#pragma unroll
            for (int k = 0; k < 2; ++k) { const unsigned e = (ee >> (8 * k)) & 0xffu;
#pragma unroll
                for (int ex = 0; ex < NE; ++ex) { const unsigned long long b = __ballot(e == (unsigned)ex);
                    if (e == (unsigned)ex) rk[k] = (unsigned)__builtin_popcountll(b & ((1ull << F.lane) - 1ull));
                    if (F.lane == 0) wcnt[F.wave * 16 + k * 8 + ex] = (unsigned)__builtin_popcountll(b); } }
        }
        __syncthreads();
        if (F.tid < 256) {
            const int tok = tile * 256 + F.tid; const float rs = __builtin_amdgcn_rsqf(ssq[(size_t)tok * 16] * (1.0f / D) + RMS_EPS);
#pragma unroll
            for (int k = 0; k < 2; ++k) { const unsigned e = (ee >> (8 * k)) & 0xffu; unsigned rank = rk[k];
                for (int w = 0; w < F.wave; ++w) rank += wcnt[w * 16 + k * 8 + e];
                const unsigned p = seg[k * 8 + e] + pre[k * 8 + e] + rank; slot_tok[k * NSLOT + p] = tok; slot_w[k * NSLOT + p] = tokw[2 * tok + k]; slot_rs[k * NSLOT + p] = rs; }
        }
    }
    __syncthreads();
}
DI void moe_fix(Frame& F, int k, int ntail) {
    const int gw = F.vcu * NWAVES + F.wave, NGW = F.G * NWAVES, lane = F.lane;
    const int* slot_tok = WSP(int, WS_SLOTTOK) + k * NSLOT; const float* slot_w = WSP(float, WS_SLOTW) + k * NSLOT; const float* slab = WSP(float, WS_SLAB);
    const bf16* SRC = k == 0 ? WSP(bf16, WS_HB) : (const bf16*)F.out; bf16* DST = k == 0 ? (bf16*)F.out : WSP(bf16, WS_HB);
    for (int r = gw; r < ntail * 256; r += NGW) {
        const int tok = slot_tok[r]; if (tok < 0) continue;
        const float w = slot_w[r] * (1.0f / W8_DN); const int tile = r >> 8, row = r & 255;
#pragma unroll
        for (int j = 0; j < 4; ++j) {
            f32x4 s = (f32x4){0.f, 0.f, 0.f, 0.f};
#pragma unroll
            for (int kq = 0; kq < pg8::NQ; ++kq) s += *((const f32x4*)(slab + ((size_t)(tile * pg8::NQ + kq) * 256 + row) * D) + lane + 64 * j);
            const u32x2 h = *((const u32x2*)(SRC + (size_t)tok * D) + lane + 64 * j);
            u32x2 o; o.x = pk2(bflo(h.x) + w * s[0], bfhi(h.x) + w * s[1]); o.y = pk2(bflo(h.y) + w * s[2], bfhi(h.y) + w * s[3]);
            *((u32x2*)(DST + (size_t)tok * D) + lane + 64 * j) = o;
        }
    }
}
DI void final_norm(Frame& F, const Args& A) {
    const int gw = F.vcu * NWAVES + F.wave, NGW = F.G * NWAVES, lane = F.lane; const float* gain = A.in[I_NORM_FINAL]; const bf16* HB = WSP(bf16, WS_HB);
    f32x4 gv[4];
#pragma unroll
    for (int j = 0; j < 4; ++j) gv[j] = *((const f32x4*)gain + lane + 64 * j);
    for (int m0 = gw * 4; m0 < M; m0 += NGW * 4) {
        u32x2 q[4][4];
#pragma unroll
        for (int t = 0; t < 4; ++t)
#pragma unroll
            for (int j = 0; j < 4; ++j) q[t][j] = *((const u32x2*)(HB + (size_t)(m0 + t) * D) + lane + 64 * j);
#pragma unroll
        for (int t = 0; t < 4; ++t) { f32x4 v[4]; float s = 0.f; f32x4* xr = (f32x4*)(F.out + (size_t)(m0 + t) * D) + lane;
#pragma unroll
            for (int j = 0; j < 4; ++j) { v[j] = (f32x4){bflo(q[t][j].x), bfhi(q[t][j].x), bflo(q[t][j].y), bfhi(q[t][j].y)}; s += (v[j][0] * v[j][0] + v[j][1] * v[j][1]) + (v[j][2] * v[j][2] + v[j][3] * v[j][3]); }
            const float rs = __builtin_amdgcn_rsqf(wave_sum(s, lane) * (1.0f / D) + RMS_EPS);
#pragma unroll
            for (int j = 0; j < 4; ++j) xr[64 * j] = v[j] * rs * gv[j]; }
    }
}
#ifndef MK_PER_PHASE
#define MK_PER_PHASE 0
#endif
constexpr int NPHASES = 19;

DI void attn_phase(Frame& F, const Args& args, int l) {
    att::Args A{WSP(bf16, WS_Q), WSP(bf16, WS_K), WSP(bf16, WS_V), WSP(bf16, WS_U), METAP(bf16, MO_KM) + (size_t)l * NMETA * KVW, METAP(bf16, MO_VM) + (size_t)l * NMETA * KVW,
                METAP(bf16, MO_UM) + (size_t)l * NMETA * POOLW, args.in[I_SINKS] + l * NH, (bf16*)F.out, WSP(bf16, WS_POOLED)};
    att::phase(F.lds + RING_OFF, A, F.vcu, F.G, F.tid);
}

__global__ void __launch_bounds__(NWAVES * 64, 2) fwd(Args args) {
    extern __shared__ __attribute__((aligned(16))) unsigned char lds[];
    Frame F;
    F.lds = (LAS unsigned char*)lds;
    F.tid = threadIdx.x; F.lane = F.tid & 63; F.wave = __builtin_amdgcn_readfirstlane(F.tid >> 6);
    const int wave0 = F.wave;
    F.G = gridDim.x; { const int bx = blockIdx.x; F.vcu = (F.G % 8 == 0) ? (bx % 8) * (F.G / 8) + bx / 8 : bx; }
    F.out = args.out; F.ws = args.ws;
    for (int u = F.tid; u < (LDS_BYTES - LDSCTL_OFF) / 4; u += NWAVES * 64) ((LAS unsigned*)(F.lds + LDSCTL_OFF))[u] = 0u;
    __syncthreads();
    gu32* ctl = (gu32*)(F.ws + WS_CTL);
    XcdBarrier bar; bar.bar = (unsigned*)(ctl + CW_BAR); bar.x = 0; bar.st = nullptr;
    if (!MK_PER_PHASE) bar = xcd_barrier_post((unsigned*)(ctl + CW_BAR), (volatile LAS unsigned*)(F.lds + MISC_OFF) + 8, F.tid);
    const int lo = args.ph_lo, hi = args.ph_hi;
#define IN(k) (lo <= (k) && (k) < hi)
#define SEAM(k) do { if (IN(k) && IN((k) + 1)) xcd_barrier(bar, (wave0 << 6) | hw_lane()); } while (0)
#define LAUNDER() do { F.ws = args.ws; F.out = args.out; F.tid = (wave0 << 6) | hw_lane(); asm volatile("" : "+s"(F.ws), "+s"(F.out), "+v"(F.tid)); F.lane = F.tid & 63; F.wave = __builtin_amdgcn_readfirstlane(F.tid >> 6); ssq = WSP(float, WS_SSQ); } while (0)
#define META_TASK(n, call) do { LAS float* mscr = (LAS float*)(F.lds + RING_OFF); for (int task = F.vcu; task < (n); task += F.G) { call; } __syncthreads(); } while (0)

    float* ssq;
    if (IN(0)) { LAUNDER(); p0_prologue(F, args); } SEAM(0);

    for (int l = 0; l < 2; ++l) {
        const int pb = l * 6;
        if (IN(pb + 1)) { LAUNDER();
            if (l == 0) { META_TASK(INW / 16, meta::inproj(F, mscr, 0, 16 * task)); } else { META_TASK(768 / 16, meta::inproj(F, mscr, 1, 1024 + 16 * task)); }
            pg8::ProbPlain P{(const char*)WSP(bf16, WS_HB), (const char*)(WSP(bf16, WS_WIN) + (size_t)l * INW * D), D * 2, D * 2, D / 64, 0, 128, (size_t)256 * (D * 2)};
            pg8::StaticOrder S; S.init(M, INW, F.G, (int)blockIdx.x);
            pg8::EpiInProj E{ssq, WSP(bf16, WS_Q), WSP(bf16, WS_K), WSP(bf16, WS_V), WSP(bf16, WS_U), WSP(bf16, WS_G)};
            pg8::gemm_phase<pg8::ProbPlain, pg8::EpiInProj, pg8::StaticOrder, true>(F.lds + RING_OFF, P, S, E, F.tid);
        } SEAM(pb + 1);
        if (IN(pb + 2)) { LAUNDER();
            if (l == 0) { for (int hd = F.vcu; hd < NH + 1; hd += F.G) { if (hd < NH) meta::attn_head(F, args, 0, hd); else meta::pool_rows(F); } }
            attn_phase(F, args, l);
        } SEAM(pb + 2);
        if (IN(pb + 3)) { LAUNDER();
            if (l == 0) { META_TASK(D / 16, meta::merge(F, mscr, 0, 16 * task)); }
            { pg8::ProbPlain P{(const char*)WSP(bf16, WS_POOLED), (const char*)(WSP(bf16, WS_WP) + (size_t)l * D * 256), POOLW * 2, 256 * 2, 256 / 64, 128 * 2, 128, (size_t)256 * (POOLW * 2)};
              pg8::StaticOrder S; S.init(M, D, F.G, (int)blockIdx.x);
              pg8::EpiPoolLift E{WSP(bf16, WS_G), WSP(bf16, WS_Q)};
              pg8::gemm_phase<pg8::ProbPlain, pg8::EpiPoolLift, pg8::StaticOrder, true>(F.lds + RING_OFF, P, S, E, F.tid); }
            VM_WAIT(); __syncthreads();
            { pg8::ProbPlain P{(const char*)F.out, (const char*)(WSP(bf16, WS_WA) + (size_t)l * D * D), D * 2, D * 2, D / 64, 0, 128, (size_t)256 * (D * 2)};
              pg8::StaticOrder S; S.init(M, D, F.G, (int)blockIdx.x);
              pg8::EpiMerge E{WSP(bf16, WS_G), WSP(bf16, WS_Q)};
              pg8::gemm_phase<pg8::ProbPlain, pg8::EpiMerge, pg8::StaticOrder, true>(F.lds + RING_OFF, P, S, E, F.tid); }
        } SEAM(pb + 3);
        if (IN(pb + 4)) { LAUNDER();
            if (l == 0) { META_TASK(D / 16, meta::outproj(F, mscr, 0, 16 * task)); }
            pg8::ProbPlain P{(const char*)WSP(bf16, WS_Q), (const char*)(WSP(bf16, WS_WO) + (size_t)l * D * D), D * 2, D * 2, D / 64, 0, 128, (size_t)256 * (D * 2)};
            pg8::StaticOrder S; S.init(M, D, F.G, (int)blockIdx.x);
            pg8::EpiResid E{WSP(bf16, WS_HB), ssq};
            pg8::gemm_phase<pg8::ProbPlain, pg8::EpiResid, pg8::StaticOrder, true>(F.lds + RING_OFF, P, S, E, F.tid);
        } SEAM(pb + 4);
        if (l == 0) {
            if (IN(5)) { LAUNDER();
                META_TASK(DFF / 16, meta::gu(F, mscr, 16 * task));
                pg8::ProbPlain P{(const char*)WSP(bf16, WS_HB), (const char*)WSP(bf16, WS_WGU), D * 2, D * 2, D / 64, 0, 128, (size_t)256 * (D * 2)};
                pg8::StaticOrder S; S.init(M, 2 * DFF, F.G, (int)blockIdx.x);
                pg8::EpiSwiGLU<false> E{ssq, WSP(bf16, WS_ACT), DFF / 64};
                pg8::gemm_phase<pg8::ProbPlain, pg8::EpiSwiGLU<false>, pg8::StaticOrder, true>(F.lds + RING_OFF, P, S, E, F.tid);
            } SEAM(5);
            if (IN(6)) { LAUNDER();
                META_TASK(D / 16, meta::down(F, mscr, 16 * task));
                pg8::ProbPlain P{(const char*)WSP(bf16, WS_ACT), (const char*)WSP(bf16, WS_WD), 128, 128, DFF / 64, 0, 32768, (size_t)(DFF / 64) * 32768, 32768, (size_t)(DFF / 64) * 32768};
                pg8::StaticOrder S; S.init(M, D, F.G, (int)blockIdx.x); S.rev = true;
                pg8::EpiResid E{WSP(bf16, WS_HB), ssq};
                pg8::gemm_phase<pg8::ProbPlain, pg8::EpiResid, pg8::StaticOrder, true>(F.lds + RING_OFF, P, S, E, F.tid);
            } SEAM(6);
        }
    }
    if (IN(11)) { LAUNDER(); moe_route(F, args); } SEAM(11);
    if (IN(12)) { LAUNDER(); moe_slots(F); } SEAM(12);
    for (int k = 0; k < 2; ++k) {
        const int* tab = WSP(int, WS_MOETAB); const int* slot_tok = WSP(int, WS_SLOTTOK) + k * NSLOT; const float* slot_w = WSP(float, WS_SLOTW) + k * NSLOT;
        if (IN(13 + 2 * k)) { LAUNDER();
            if (k == 1) moe_fix(F, 0, __builtin_amdgcn_readfirstlane(tab[16]) - 256);
            const int ntile = __builtin_amdgcn_readfirstlane(tab[16 + k]);
            LAS int* etab = (LAS int*)(F.lds + XTRA_OFF + 1024);
            for (int i = F.tid; i < MAXTILES; i += NWAVES * 64) etab[i] = tab[32 + k * MAXTILES + i];
            __syncthreads();
            pg8::ProbMoeGU P{(const char*)WSP(unsigned char, WS_POOLED), (const char*)WSP(unsigned char, WS_MGU), D, D, D / 128, slot_tok, etab, (LAS int*)(F.lds + XTRA_OFF), (size_t)2 * DFE * D};
            pg8::LinearOrder S{ntile, 2 * DFE / 256, F.G, F.vcu, false};
            pg8::EpiSwiGLU8 E{WSP(float, WS_SLOTRS) + k * NSLOT, WSP(unsigned char, WS_ACT)};
            pg8::gemm_phase<pg8::ProbMoeGU, pg8::EpiSwiGLU8, pg8::LinearOrder, true, true>(F.lds + RING_OFF, P, S, E, F.tid);
        } SEAM(13 + 2 * k);
        if (IN(14 + 2 * k)) { LAUNDER();
            const int ntile = __builtin_amdgcn_readfirstlane(tab[16 + k]);
            LAS int* etab = (LAS int*)(F.lds + XTRA_OFF + 1024);
            for (int i = F.tid; i < MAXTILES; i += NWAVES * 64) etab[i] = tab[32 + k * MAXTILES + i];
            __syncthreads();
            { pg8::ProbMoeDown P{(const char*)WSP(unsigned char, WS_ACT), (const char*)WSP(unsigned char, WS_MD), 128, 128, DFE / 128, etab, 32768, (size_t)(DFE / 128) * 32768, 32768, (size_t)(DFE / 128) * 32768, (size_t)D * DFE};
              pg8::LinearOrder S{256, D / 256, F.G, F.vcu, true}; S.base = ntile - 256;
              pg8::EpiMoeDown E{k == 0 ? WSP(bf16, WS_HB) : (bf16*)F.out, k == 0 ? (bf16*)F.out : WSP(bf16, WS_HB), slot_tok, slot_w, 1.0f / W8_DN};
              pg8::gemm_phase<pg8::ProbMoeDown, pg8::EpiMoeDown, pg8::LinearOrder, true, true>(F.lds + RING_OFF, P, S, E, F.tid); }
            { pg8::ProbMoeDownQ P{(const char*)WSP(unsigned char, WS_ACT), (const char*)WSP(unsigned char, WS_MD), 128, 128, DFE / 128 / pg8::NQ, etab, (size_t)(DFE / 128) * 32768, (size_t)(DFE / 128) * 32768, (size_t)D * DFE};
              pg8::QuarterOrder S{ntile - 256, F.G, F.vcu};
              pg8::EpiSlab E{WSP(float, WS_SLAB)};
              pg8::gemm_phase<pg8::ProbMoeDownQ, pg8::EpiSlab, pg8::QuarterOrder, true, true>(F.lds + RING_OFF, P, S, E, F.tid); }
        } SEAM(14 + 2 * k);
    }
    if (IN(17)) { LAUNDER(); moe_fix(F, 1, __builtin_amdgcn_readfirstlane(WSP(int, WS_MOETAB)[17]) - 256); } SEAM(17);
    if (IN(18)) { LAUNDER(); final_norm(F, args); }
#undef IN
#undef SEAM
#undef META_TASK
#undef LAUNDER
}

extern "C" void kernel_launch(void* const* d_in, const int* in_sizes, int n_in, void* d_out, int out_size, void* d_ws, size_t ws_size, hipStream_t stream) {
    static int grid = 0;
    if (grid == 0) {
        if (n_in != 18 || in_sizes[0] != M * D || out_size != M * D || ws_size < WS_END) { fprintf(stderr, "kernel_launch: unexpected shapes (n_in %d, in0 %d, out %d, ws %zu); nothing launched\n", n_in, n_in > 0 ? in_sizes[0] : -1, out_size, ws_size); grid = -1; return; }
        int dev = 0, cus = 0, per_cu = 0;
        if (hipGetDevice(&dev) != hipSuccess || hipDeviceGetAttribute(&cus, hipDeviceAttributeMultiprocessorCount, dev) != hipSuccess) { grid = -1; return; }
        if (hipFuncSetAttribute((const void*)fwd, hipFuncAttributeMaxDynamicSharedMemorySize, LDS_BYTES) != hipSuccess) { fprintf(stderr, "kernel_launch: hipFuncSetAttribute failed\n"); grid = -1; return; }
        if (hipOccupancyMaxActiveBlocksPerMultiprocessor(&per_cu, (const void*)fwd, NWAVES * 64, LDS_BYTES) != hipSuccess || per_cu < 1) { fprintf(stderr, "kernel_launch: occupancy query reports %d workgroups per CU\n", per_cu); }
        (void)hipGetLastError();
        grid = cus;
    }
    if (grid < 0) return;
    if (hipMemsetAsync((char*)d_ws + WS_CTL, 0, CTL_ZERO_BYTES, stream) != hipSuccess) return;
    Args a{};
    for (int i = 0; i < 18; ++i) a.in[i] = (const float*)d_in[i];
    a.out = (float*)d_out; a.ws = (unsigned char*)d_ws;
#if MK_PER_PHASE
    for (int p = 0; p < NPHASES; ++p) { a.ph_lo = p; a.ph_hi = p + 1; hipLaunchKernelGGL(fwd, dim3(grid), dim3(NWAVES * 64), LDS_BYTES, stream, a); }
#else
    a.ph_lo = 0; a.ph_hi = NPHASES; hipLaunchKernelGGL(fwd, dim3(grid), dim3(NWAVES * 64), LDS_BYTES, stream, a);
#endif
}
```

```cpp
#include <hip/hip_runtime.h>
#include <cstdio>
#include <cstdint>

#define GAS __attribute__((address_space(1)))
#define LAS __attribute__((address_space(3)))
typedef unsigned short bf16;
typedef short bf16x8 __attribute__((ext_vector_type(8)));
typedef short s16x4 __attribute__((ext_vector_type(4)));
typedef float f32x2 __attribute__((ext_vector_type(2)));
typedef float f32x4 __attribute__((ext_vector_type(4)));
typedef float f32x16 __attribute__((ext_vector_type(16)));
typedef unsigned u32x2 __attribute__((ext_vector_type(2)));
typedef unsigned u32x4 __attribute__((ext_vector_type(4)));
typedef GAS unsigned gu32;
#define RLX_AGENT __ATOMIC_RELAXED, __HIP_MEMORY_SCOPE_AGENT
#define LDS_WAIT() asm volatile("s_waitcnt lgkmcnt(0)" ::: "memory")
#define VM_WAIT() asm volatile("s_waitcnt vmcnt(0)" ::: "memory")
#define DI __device__ __forceinline__

constexpr int NB = 8, SEQ = 8192, D = 1024, M = NB * SEQ;
constexpr int NMETA = 16;
constexpr int NH = 16, HD = 64, NKV = 2, QG = 8, KVW = 128, POOLW = 512;
constexpr int USEQ = SEQ + NMETA;
constexpr int INW = 3840;
constexpr int DFF = 2816, NE = 8, DFE = 3584;
constexpr float RMS_EPS = 1e-5f;
constexpr float LOG2E = 1.4426950408889634f;
constexpr float QSCALE = 0.125f * LOG2E;
constexpr int NSLOT = M + NE * 256;
constexpr int MAXTILES = NSLOT / 256;

constexpr size_t MiB = 1u << 20;
constexpr size_t WS_CTL = 0, CTL_ZERO_BYTES = 1 * MiB;
constexpr size_t WS_SSQ = 1 * MiB;
constexpr size_t WS_TOKE = 5 * MiB;
constexpr size_t WS_TOKW = 5 * MiB + 512 * 1024;
constexpr size_t WS_SLOTTOK = 6 * MiB;
constexpr size_t WS_SLOTW = 7 * MiB;
constexpr size_t WS_WGCNT = 8 * MiB;
constexpr size_t WS_MOETAB = 8 * MiB + 64 * 1024;
constexpr size_t WS_SLOTRS = 8 * MiB + 128 * 1024;
constexpr size_t WS_META = 9 * MiB;
constexpr size_t WS_WIN = 16 * MiB;
constexpr size_t WS_WA = 31 * MiB;
constexpr size_t WS_WP = 35 * MiB;
constexpr size_t WS_WO = 36 * MiB;
constexpr size_t WS_WGU = 40 * MiB;
constexpr size_t WS_WD = 51 * MiB;
constexpr size_t WS_MGU = 57 * MiB;
constexpr size_t WS_MD = 169 * MiB;
constexpr size_t WS_HB = 225 * MiB;
constexpr size_t WS_POOLED = 353 * MiB;
constexpr size_t WS_Q = 417 * MiB;
constexpr size_t WS_K = 545 * MiB;
constexpr size_t WS_V = 561 * MiB;
constexpr size_t WS_U = 577 * MiB;
constexpr size_t WS_G = 642 * MiB;
constexpr size_t WS_ACT = 417 * MiB;
constexpr size_t WS_SLAB = 898 * MiB;
constexpr size_t WS_END = 930 * MiB;
static_assert(WS_ACT + (size_t)NSLOT * DFE * 2 <= WS_END && WS_ACT + (size_t)M * DFF * 2 <= WS_END, "act overlay");
constexpr size_t MO_HM = 0;
constexpr size_t MO_XM = 64 * 1024;
constexpr size_t MO_PROJ = 96 * 1024;
constexpr size_t MO_KM = 336 * 1024;
constexpr size_t MO_VM = 344 * 1024;
constexpr size_t MO_UM = 352 * 1024;
constexpr size_t MO_ATT = 384 * 1024;
constexpr size_t MO_POOL = 416 * 1024;
constexpr size_t MO_MRG = 432 * 1024;
constexpr size_t MO_ACT = 464 * 1024;
constexpr int CW_TMO = 0, CW_CODE = 1, CW_BAR = 4096;

constexpr int RING_OFF = 0, RING_BYTES = 147456;
constexpr int LDSCTL_OFF = RING_BYTES, MISC_OFF = LDSCTL_OFF + 320;
constexpr int XTRA_OFF = LDSCTL_OFF + 1024;
constexpr int LDS_BYTES = RING_BYTES + 4096;

DI unsigned f2bf(float f) { unsigned u = __builtin_bit_cast(unsigned, f); return (u + 0x7fffu + ((u >> 16) & 1u)) >> 16; }
DI unsigned pk2(float lo, float hi) { unsigned r; asm volatile("v_cvt_pk_bf16_f32 %0, %1, %2" : "=v"(r) : "v"(lo), "v"(hi)); return r; }
DI float sat8(float v) { return __builtin_amdgcn_fmed3f(v, -448.f, 448.f); }
DI unsigned pk4_fp8(float a, float b, float c, float d) { int w = __builtin_amdgcn_cvt_pk_fp8_f32(sat8(a), sat8(b), 0, false); w = __builtin_amdgcn_cvt_pk_fp8_f32(sat8(c), sat8(d), w, true); return (unsigned)w; }
constexpr float W8_GU = 64.f, W8_DN = 128.f;
DI float bf2f(unsigned short b) { return __builtin_bit_cast(float, (unsigned)b << 16); }
DI float bflo(unsigned w) { return __builtin_bit_cast(float, w << 16); }
DI float bfhi(unsigned w) { return __builtin_bit_cast(float, w & 0xffff0000u); }
DI int hw_lane() { int l; asm volatile("v_mbcnt_lo_u32_b32 %0, -1, 0\n\tv_mbcnt_hi_u32_b32 %0, -1, %0" : "=v"(l)); return l; }
DI float shx(float v, int mask, int lane) { return __builtin_bit_cast(float, __builtin_amdgcn_ds_bpermute((lane ^ mask) << 2, __builtin_bit_cast(int, v))); }
DI float wave_sum(float v, int lane) {
#pragma unroll
    for (int o = 1; o < 64; o <<= 1) v += shx(v, o, lane);
    return v;
}
DI float fast_sigmoid(float x) { return __builtin_amdgcn_rcpf(1.f + __builtin_amdgcn_exp2f(-x * LOG2E)); }
DI float sigmoid_scaled(float a, float nsl2) { return __builtin_amdgcn_rcpf(1.f + __builtin_amdgcn_exp2f(a * nsl2)); }

#define XB_TMO      128
#define XB_XCNT(j)  (256  + 64 * (j))
#define XB_XSUB(j)  (1280 + 64 * (j))
#define XB_XGEN(j)  (2304 + 64 * (j))
#define XB_TOP      3328
#define XB_TOPGEN   3392
#define XCD_BAR_WORDS 3456
#define XB_SPIN_CAP (1u << 18)
DI unsigned xb_ld(unsigned* p)              { return __hip_atomic_load(p, __ATOMIC_RELAXED, __HIP_MEMORY_SCOPE_AGENT); }
DI unsigned xb_add(unsigned* p, unsigned v) { return __hip_atomic_fetch_add(p, v, __ATOMIC_RELAXED, __HIP_MEMORY_SCOPE_AGENT); }
DI unsigned xb_xcc_id() { return (unsigned)__builtin_amdgcn_s_getreg((3 << 11) | 20) & 0xFu; }
#define XB_SPIN(cond, bar) do { unsigned _sp = 0; while (cond) { __builtin_amdgcn_s_sleep(1); \
    if ((++_sp & 255u) == 0u) { if (xb_ld(&(bar)[XB_TMO])) break; if (_sp > XB_SPIN_CAP) { atomicAdd(&(bar)[XB_TMO], 1u); break; } } } } while (0)
struct XcdBarrier { unsigned* bar; unsigned x; volatile LAS unsigned* st; };
DI XcdBarrier xcd_barrier_post(unsigned* bar, volatile LAS unsigned* st, int tid) {
    XcdBarrier b; b.bar = bar; b.x = xb_xcc_id(); b.st = st;
    if (tid == 0) (void)xb_add(&bar[XB_XCNT(b.x)], 1u);
    return b;
}
DI void xcd_barrier_complete(unsigned* bar, unsigned x, unsigned& nloc, unsigned& nx) {
    const unsigned G = gridDim.x * gridDim.y * gridDim.z;
    unsigned sum, cnt, mine, sp = 0u;
    for (;;) {
        sum = 0u; cnt = 0u; mine = 0u;
#pragma unroll
        for (unsigned j = 0; j < 16; ++j) { const unsigned c = xb_ld(&bar[XB_XCNT(j)]); sum += c; cnt += (c > 0u) ? 1u : 0u; mine = (j == x) ? c : mine; }
        if (sum == G) break;
        __builtin_amdgcn_s_sleep(1);
        if ((++sp & 255u) == 0u) { if (xb_ld(&bar[XB_TMO])) break; if (sp > XB_SPIN_CAP) { atomicAdd(&bar[XB_TMO], 1u); break; } }
    }
    nloc = mine > 0u ? mine : 1u; nx = cnt > 0u ? cnt : 1u;
}
DI void xcd_barrier(const XcdBarrier& b, int tid) {
    asm volatile("s_waitcnt vmcnt(0)" ::: "memory");
    __syncthreads();
    if (tid == 0) {
        unsigned* bar = b.bar;
        __builtin_amdgcn_s_waitcnt(0);
        unsigned nloc = b.st[0], nx = b.st[1];
        if (nloc == 0u) { xcd_barrier_complete(bar, b.x, nloc, nx); b.st[0] = nloc; b.st[1] = nx; }
        const unsigned old = xb_add(&bar[XB_XSUB(b.x)], 1u);
        const unsigned gen = old / nloc;
        if (old + 1u == (gen + 1u) * nloc) {
            __builtin_amdgcn_fence(__ATOMIC_RELEASE, "agent");
            asm volatile("s_waitcnt vmcnt(0)" ::: "memory");
            const unsigned og = xb_add(&bar[XB_TOP], 1u);
            const unsigned tg = og / nx;
            if (og + 1u == (tg + 1u) * nx) xb_add(&bar[XB_TOPGEN], 1u);
            else XB_SPIN(xb_ld(&bar[XB_TOPGEN]) == tg, bar);
            __builtin_amdgcn_fence(__ATOMIC_ACQUIRE, "agent");
            xb_add(&bar[XB_XGEN(b.x)], 1u);
            asm volatile("s_waitcnt vmcnt(0)" ::: "memory");
        } else {
            XB_SPIN(xb_ld(&bar[XB_XGEN(b.x)]) == gen, bar);
            __builtin_amdgcn_fence(__ATOMIC_ACQUIRE, "agent");
            asm volatile("s_waitcnt vmcnt(0)" ::: "memory");
        }
    }
    __syncthreads();
}
namespace pg8 {
constexpr int BM = 256, BK = 64, HALF = 128, HTB = HALF * BK * 2, STAGE_BYTES = 8 * HTB, NXCD = 8, WGM = 8;
__host__ __device__ __forceinline__ int lds_byte(int r, int c) { const int st = (r >> 4) * 2 + (c >> 5), rr = r & 15, cc = c & 31, ob = rr * 64 + cc * 2; return st * 1024 + (ob ^ (((ob >> 9) & 1) << 5)); }
__host__ __device__ __forceinline__ void stage_rc(int b, int& R, int& C) { const int st = b / 1024, sb = b % 1024, swz = sb ^ (((sb >> 9) & 1) << 5); R = (st >> 1) * 16 + swz / 64; C = (st & 1) * 32 + (swz % 64) / 2; }
__host__ __device__ __forceinline__ int perm32(int rho) { const int n = rho >> 4, i = rho & 15; return 8 * (i >> 2) + 4 * n + (i & 3); }

struct Unit { int pm, pn; int kq = 0; };

struct StaticOrder {
    int nM, nN, nwg, G, c; bool rev = false;
    DI void init(int M_, int N_, int G_, int c_) { nM = M_ / BM; nN = N_ / BM; nwg = nM * nN; G = G_; c = c_; }
    DI bool next(int i, Unit& u) const {
        const long L = (long)i * G + c; if (L >= nwg) return false;
        int wgid = (int)L; { const int q = nwg / NXCD, r = nwg % NXCD, xcd = wgid % NXCD, off = wgid / NXCD; wgid = (xcd < r ? xcd * (q + 1) : r * (q + 1) + (xcd - r) * q) + off; }
        const int nig = WGM * nN, gid = wgid / nig, fm = gid * WGM, gsz = (nM - fm) < WGM ? (nM - fm) : WGM;
        u.pm = fm + ((wgid % nig) % gsz); u.pn = (wgid % nig) / gsz; if (rev) u.pm = nM - 1 - u.pm; return true;
    }
};
struct LinearOrder {
    int ntile, nN, G, c; bool rev; int base = 0;
    DI bool next(int i, Unit& u) const {
        const long L = (long)i * G + c; if (L >= (long)ntile * nN) return false;
        constexpr int gt = 8; const int per8 = gt * nN, g = (int)(L / per8), w = (int)(L % per8), gsz = (ntile - gt * g) < gt ? (ntile - gt * g) : gt;
        u.pm = gt * g + w % gsz; u.pn = w / gsz; if (rev) u.pm = ntile - 1 - u.pm; u.pm += base; return true; }
};
constexpr int NQ = 2;
struct QuarterOrder {
    int ntail, G, c;
    DI bool next(int i, Unit& u) const { const long L = (long)i * G + c; if (L >= (long)ntail * 4 * NQ) return false; u.pm = (int)(L / (4 * NQ)); u.pn = (int)((L / NQ) & 3); u.kq = (int)(L % NQ); return true; }
};

struct ProbPlain {
    static constexpr bool GATHER = false;
    const char* A; const char* Bt; unsigned lda2, ldb2; int nt; unsigned acol2;
    unsigned kstepA; size_t panelA;
    unsigned kstepB = 128; size_t panelB = 0;
    DI unsigned a_base(const Unit& u) const { return (unsigned)((size_t)u.pm * panelA + (size_t)u.pn * acol2); }
    DI unsigned b_base(const Unit& u) const { return (unsigned)((size_t)u.pn * (panelB ? panelB : (size_t)BM * ldb2)); }
    DI unsigned a_row(const Unit&, int r) const { return (unsigned)r * lda2; }
};
struct ProbMoeGU {
    static constexpr bool GATHER = true;
    static constexpr unsigned kstepA = 128, kstepB = 128;
    const char* A; const char* Bt; unsigned lda2, ldb2; int nt; const int* slot_tok; const LAS int* tile_e; LAS int* gtab; size_t estride;
    DI unsigned a_base(const Unit&) const { return 0u; }
    DI unsigned a_row_lds(int r) const { int t = gtab[r]; t = t < 0 ? 0 : t; return (unsigned)t * lda2; }
    DI void prefetch_rows(const Unit& u, int wid, int lane) const { if (wid < 4) __builtin_amdgcn_global_load_lds((const unsigned*)(slot_tok + u.pm * BM + wid * 64 + lane), (LAS unsigned*)(gtab + wid * 64), 4, 0, 0); }
    DI unsigned b_base(const Unit& u) const { return (unsigned)((size_t)tile_e[u.pm] * estride + (size_t)u.pn * BM * ldb2); }
    DI unsigned a_row(const Unit& u, int r) const { int t = slot_tok[u.pm * BM + r]; t = t < 0 ? 0 : t; return (unsigned)t * lda2; }
};
struct ProbMoeDown {
    static constexpr bool GATHER = false;
    const char* A; const char* Bt; unsigned lda2, ldb2; int nt; const LAS int* tile_e; unsigned kstepA; size_t panelA; unsigned kstepB; size_t panelB; size_t estride;
    DI unsigned a_base(const Unit& u) const { return (unsigned)((size_t)u.pm * panelA); }
    DI unsigned b_base(const Unit& u) const { return (unsigned)((size_t)tile_e[u.pm] * estride + (size_t)u.pn * panelB); }
    DI unsigned a_row(const Unit&, int r) const { return (unsigned)r * lda2; }
};

struct ProbMoeDownQ {
    static constexpr bool GATHER = false; static constexpr unsigned kstepA = 32768, kstepB = 32768;
    const char* A; const char* Bt; unsigned lda2, ldb2; int nt; const LAS int* tile_e; size_t panelA, panelB, estride;
    DI unsigned a_base(const Unit& u) const { return (unsigned)((size_t)u.pm * panelA + (size_t)u.kq * nt * 32768); }
    DI unsigned b_base(const Unit& u) const { return (unsigned)((size_t)tile_e[u.pm] * estride + (size_t)u.pn * panelB + (size_t)u.kq * nt * 32768); }
    DI unsigned a_row(const Unit&, int r) const { return (unsigned)r * lda2; }
};

template <class Prob, class Epi, class Sched, bool ALIGN_EPI, bool FP8 = false>
DI void gemm_phase(LAS unsigned char* lds, const Prob& P, const Sched& S, const Epi& E, int tid) {
    asm volatile("" : "+v"(tid));
    const int wid = __builtin_amdgcn_readfirstlane(tid >> 6), lane = tid & 63, wr = wid >> 2, wc = wid & 3, fr = lane & 15, fq = lane >> 4;
    const int nt = P.nt;
    int R0, C0, R1, C1; stage_rc(tid * 16, R0, C0); stage_rc(tid * 16 + 8192, R1, C1);
    const int Rb0 = Epi::PERM ? ((R0 & ~31) + perm32(R0 & 31)) : R0, Rb1 = Epi::PERM ? ((R1 & ~31) + perm32(R1 & 31)) : R1;
    const unsigned voffB0 = (unsigned)Rb0 * P.ldb2 + (unsigned)C0 * 2u, voffB1 = (unsigned)Rb1 * P.ldb2 + (unsigned)C1 * 2u;
    const unsigned kstep = P.kstepB, kstepA = P.kstepA;
    const unsigned hstepB = (unsigned)HALF * P.ldb2;
    const __amdgpu_buffer_rsrc_t rsA = __builtin_amdgcn_make_buffer_rsrc((void*)P.A, 0, -1, 0x00020000), rsB = __builtin_amdgcn_make_buffer_rsrc((void*)P.Bt, 0, -1, 0x00020000);
    const unsigned ldsw = (unsigned)wid * 1024u;
    const int aoff = lds_byte(wr * 64 + fr, FP8 ? fq * 16 : fq * 8), boff = lds_byte(wc * 32 + fr, FP8 ? fq * 16 : fq * 8);
#define PG8_SA(b, h) (((b) * 2 + (h)) * HTB)
#define PG8_SB(b, h) ((4 + (b) * 2 + (h)) * HTB)
#define PG8_STGX(rs, bufoff, soff, v0, v1) do { \
        __builtin_amdgcn_raw_ptr_buffer_load_lds(rs, (LAS unsigned*)(lds + (bufoff) + ldsw), 16, (int)(v0), (int)(soff), 0, 0); \
        __builtin_amdgcn_raw_ptr_buffer_load_lds(rs, (LAS unsigned*)(lds + (bufoff) + ldsw + 8192), 16, (int)(v1), (int)(soff), 0, 0); } while (0)
#define PG8_STG(bufoff, soff, v0, v1) PG8_STGX(rsA, bufoff, soff, v0, v1)
#define PG8_STGB(bufoff, soff) PG8_STGX(rsB, bufoff, soff, voffB0, voffB1)
#define PG8_LDA(dst, b, h) do { if constexpr (FP8) { _Pragma("unroll") for (int m = 0; m < 4; ++m) dst##8[m] = *(const LAS i32x8u_*)(lds + PG8_SA(b, h) + aoff + m * 2048); } \
        else { _Pragma("unroll") for (int m = 0; m < 4; ++m) _Pragma("unroll") for (int k = 0; k < 2; ++k) dst[m][k] = *(const LAS bf16x8*)(lds + PG8_SA(b, h) + aoff + m * 2048 + k * 1024); } } while (0)
#define PG8_LDB(dst, b, h) do { if constexpr (FP8) { _Pragma("unroll") for (int n = 0; n < 2; ++n) dst##8[n] = *(const LAS i32x8u_*)(lds + PG8_SB(b, h) + boff + n * 2048); } \
        else { _Pragma("unroll") for (int n = 0; n < 2; ++n) _Pragma("unroll") for (int k = 0; k < 2; ++k) dst[n][k] = *(const LAS bf16x8*)(lds + PG8_SB(b, h) + boff + n * 2048 + k * 1024); } } while (0)
#define PG8_MMA(ai, bj, At, Bt) do { __builtin_amdgcn_s_setprio(1); _Pragma("unroll") for (int m = 0; m < 4; ++m) _Pragma("unroll") for (int n = 0; n < 2; ++n) { \
        if constexpr (FP8) { acc[ai][bj][m][n] = __builtin_amdgcn_mfma_scale_f32_16x16x128_f8f6f4(Bt##8[n], At##8[m], acc[ai][bj][m][n], 0, 0, 0, 0x7f7f7f7f, 0, 0x7f7f7f7f); } \
        else { _Pragma("unroll") for (int k = 0; k < 2; ++k) acc[ai][bj][m][n] = __builtin_amdgcn_mfma_f32_16x16x32_bf16(Bt[n][k], At[m][k], acc[ai][bj][m][n], 0, 0, 0); } } \
        __builtin_amdgcn_s_setprio(0); } while (0)
#define PG8_WAIT_V(n) asm volatile("s_waitcnt vmcnt(" #n ")" ::: "memory")
#define PG8_WAIT_L(n) asm volatile("s_waitcnt lgkmcnt(" #n ")" ::: "memory")
#define PG8_BAR __builtin_amdgcn_s_barrier()
#define PG8_SCHED __builtin_amdgcn_sched_barrier(0)
    Unit cur, nxt; int ui = 0;
    if (!S.next(0, cur)) return;
    f32x4 acc[2][2][4][2];
#pragma unroll
    for (int a = 0; a < 2; ++a)
#pragma unroll
        for (int b = 0; b < 2; ++b)
#pragma unroll
            for (int m = 0; m < 4; ++m)
#pragma unroll
                for (int n = 0; n < 2; ++n) acc[a][b][m][n] = (f32x4){0.f, 0.f, 0.f, 0.f};
    bf16x8 At[4][2], B0[2][2], B1[2][2];
    typedef int i32x8_ __attribute__((ext_vector_type(8))); typedef i32x8_ i32x8u_ __attribute__((aligned(16)));
    i32x8_ At8[4], B08[2], B18[2];
    unsigned vc00, vc01, vc10, vc11;
#define PG8_AOFF(u, o00, o01, o10, o11) do { o00 = P.a_row(u, R0) + (unsigned)C0 * 2u; o01 = P.a_row(u, R1) + (unsigned)C1 * 2u; \
        o10 = P.a_row(u, HALF + R0) + (unsigned)C0 * 2u; o11 = P.a_row(u, HALF + R1) + (unsigned)C1 * 2u; } while (0)
    PG8_AOFF(cur, vc00, vc01, vc10, vc11);
    unsigned cA = P.a_base(cur), cB = P.b_base(cur);
    PG8_STGB(PG8_SB(0, 0), cB); PG8_STGB(PG8_SB(0, 1), cB + hstepB); PG8_STG(PG8_SA(0, 0), cA, vc00, vc01); PG8_STG(PG8_SA(0, 1), cA, vc10, vc11);
    if (wr == 1) PG8_BAR;
    PG8_WAIT_V(2); PG8_BAR;
    PG8_STGB(PG8_SB(1, 0), cB + kstep); PG8_STG(PG8_SA(1, 0), cA + kstepA, vc00, vc01); PG8_STGB(PG8_SB(1, 1), cB + hstepB + kstep);
    PG8_WAIT_V(6); PG8_BAR;
    for (;;) {
        const bool has_next = S.next(ui + 1, nxt);
        unsigned nA = cA, nB = cB;
        if (has_next) { nA = P.a_base(nxt); nB = P.b_base(nxt); if constexpr (Prob::GATHER) { P.prefetch_rows(nxt, wid, lane); } }
        for (int t = 0; t < nt; t += 2) {
            const bool last = (t == nt - 2);
            const unsigned a1 = cA + (unsigned)(t + 1) * kstepA;
            const unsigned a2 = last ? nA : cA + (unsigned)(t + 2) * kstepA, b2 = last ? nB : cB + (unsigned)(t + 2) * kstep;
            const unsigned a3 = a2 + kstepA, b3 = b2 + kstep;
            PG8_LDB(B0, 0, 0); PG8_LDB(B1, 0, 1); PG8_SCHED; PG8_LDA(At, 0, 0); PG8_STG(PG8_SA(1, 1), a1, vc10, vc11);
            if constexpr (Prob::GATHER) { if (last && has_next) {
                vc00 = P.a_row_lds(R0) + (unsigned)C0 * 2u; vc01 = P.a_row_lds(R1) + (unsigned)C1 * 2u; vc10 = P.a_row_lds(HALF + R0) + (unsigned)C0 * 2u; vc11 = P.a_row_lds(HALF + R1) + (unsigned)C1 * 2u; } }
            PG8_WAIT_V(8); PG8_WAIT_L(0); PG8_BAR; PG8_MMA(0, 0, At, B0); PG8_MMA(0, 1, At, B1); PG8_BAR; PG8_SCHED;
            PG8_LDA(At, 0, 1); PG8_STGB(PG8_SB(0, 0), b2); PG8_STGB(PG8_SB(0, 1), b2 + hstepB); PG8_STG(PG8_SA(0, 0), a2, vc00, vc01);
            PG8_WAIT_V(8); PG8_WAIT_L(0); PG8_BAR; PG8_MMA(1, 0, At, B0); PG8_MMA(1, 1, At, B1); PG8_BAR; PG8_SCHED;
            PG8_LDB(B0, 1, 0); PG8_LDB(B1, 1, 1); PG8_SCHED; PG8_LDA(At, 1, 0); PG8_STG(PG8_SA(0, 1), a2, vc10, vc11);
            PG8_WAIT_V(8); PG8_WAIT_L(0); PG8_BAR; PG8_MMA(0, 0, At, B0); PG8_MMA(0, 1, At, B1); PG8_BAR; PG8_SCHED;
            PG8_LDA(At, 1, 1); PG8_STGB(PG8_SB(1, 0), b3); PG8_STGB(PG8_SB(1, 1), b3 + hstepB); PG8_STG(PG8_SA(1, 0), a3, vc00, vc01);
            PG8_WAIT_V(8); PG8_WAIT_L(0); PG8_BAR; PG8_MMA(1, 0, At, B0); PG8_MMA(1, 1, At, B1); PG8_BAR; PG8_SCHED;
        }
        if constexpr (ALIGN_EPI) { if (wr == 0) PG8_BAR; }
        PG8_SCHED; E(acc, cur, wr, wc, fr, fq); PG8_SCHED;
        if (!has_next) break;
#pragma unroll
        for (int a = 0; a < 2; ++a)
#pragma unroll
            for (int b = 0; b < 2; ++b)
#pragma unroll
                for (int m = 0; m < 4; ++m)
#pragma unroll
                    for (int n = 0; n < 2; ++n) acc[a][b][m][n] = (f32x4){0.f, 0.f, 0.f, 0.f};
        cur = nxt; cA = nA; cB = nB; ++ui;
        if constexpr (ALIGN_EPI) { if (wr == 1) PG8_BAR; }
    }
    PG8_WAIT_V(0);
    if constexpr (!ALIGN_EPI) { if (wr == 0) PG8_BAR; }
    PG8_BAR;
#undef PG8_SA
#undef PG8_SB
#undef PG8_STG
#undef PG8_STGX
#undef PG8_STGB
#undef PG8_LDA
#undef PG8_LDB
#undef PG8_MMA
#undef PG8_WAIT_V
#undef PG8_WAIT_L
#undef PG8_BAR
#undef PG8_SCHED
#undef PG8_AOFF
}
}
namespace pg8 {
DI u32x4 pack8(const f32x4 v0, const f32x4 v1) { u32x4 w; w.x = pk2(v0[0], v0[1]); w.y = pk2(v0[2], v0[3]); w.z = pk2(v1[0], v1[1]); w.w = pk2(v1[2], v1[3]); return w; }

DI void rstd4_load(f32x4 (&p)[4], const float* ssq16, int row0, int fq) {
#pragma unroll
    for (int m = 0; m < 4; ++m) p[m] = *(const f32x4*)(ssq16 + (size_t)(row0 + m * 16) * 16 + 4 * fq);
}
DI float rstd_finish(const f32x4 p, int lane) { float s = (p[0] + p[1]) + (p[2] + p[3]); s += shx(s, 16, lane); s += shx(s, 32, lane); return __builtin_amdgcn_rsqf(s * (1.0f / D) + RMS_EPS); }
#define EPI_FENCE() asm volatile("" ::: "memory")

struct EpiInProj {
    static constexpr bool PERM = true, TWICE_OK = true;
    const float* ssq16; bf16 *Q, *K, *V, *U, *G;
    DI void operator()(const f32x4 (&acc)[2][2][4][2], const Unit& u, int wr, int wc, int fr, int fq) const {
        const int row0 = u.pm * BM + wr * 64 + fr, cw = wc * 32 + 8 * fq;
        const int pn = u.pn;
        bf16* base0; bf16* base1; int ldc, col0, col1, mode;
        if (pn < 4) { base0 = base1 = Q; ldc = D; col0 = pn * 256 + cw; col1 = col0 + HALF; mode = 1; }
        else if (pn == 4) { base0 = K; base1 = V; ldc = KVW; col0 = col1 = cw; mode = 0; }
        else if (pn < 7) { base0 = base1 = U + (size_t)(NMETA * ((u.pm >> 5) + 1)) * POOLW; ldc = POOLW; col0 = (pn - 5) * 256 + cw; col1 = col0 + HALF; mode = 0; }
        else { base0 = base1 = G; ldc = 2 * D; col0 = (pn - 7) * 256 + cw; col1 = col0 + HALF; mode = 2; }
        f32x4 pp[2][4]; rstd4_load(pp[0], ssq16, row0, fq); rstd4_load(pp[1], ssq16, row0 + HALF, fq);
#pragma unroll
        for (int ai = 0; ai < 2; ++ai) {
#pragma unroll
            for (int m = 0; m < 4; ++m) {
                const int row = row0 + ai * HALF + m * 16;
                const float sc = rstd_finish(pp[ai][m], fq * 16 + fr) * (mode == 1 ? QSCALE : 1.f);
#pragma unroll
                for (int bj = 0; bj < 2; ++bj) {
                    f32x4 v0, v1;
                    if (mode == 2) { const float nsl2 = -sc * LOG2E;
#pragma unroll
                        for (int j = 0; j < 4; ++j) { v0[j] = sigmoid_scaled(acc[ai][bj][m][0][j], nsl2); v1[j] = sigmoid_scaled(acc[ai][bj][m][1][j], nsl2); }
                    } else { v0 = acc[ai][bj][m][0] * sc; v1 = acc[ai][bj][m][1] * sc; }
                    *(u32x4*)((bj ? base1 : base0) + (size_t)row * ldc + (bj ? col1 : col0)) = pack8(v0, v1);
                }
            }
            EPI_FENCE();
        }
    }
};
struct EpiPoolLift {
    static constexpr bool PERM = true, TWICE_OK = false;
    const bf16* G; bf16* MRG;
    DI void operator()(const f32x4 (&acc)[2][2][4][2], const Unit& u, int wr, int wc, int fr, int fq) const {
        const int row0 = u.pm * BM + wr * 64 + fr, col0 = u.pn * BM + wc * 32 + 8 * fq;
#pragma unroll
        for (int ai = 0; ai < 2; ++ai) {
            u32x4 g[4][2];
#pragma unroll
            for (int m = 0; m < 4; ++m)
#pragma unroll
                for (int bj = 0; bj < 2; ++bj) g[m][bj] = *(const u32x4*)(G + (size_t)(row0 + ai * HALF + m * 16) * (2 * D) + D + col0 + bj * HALF);
#pragma unroll
            for (int m = 0; m < 4; ++m) { const size_t r = (size_t)(row0 + ai * HALF + m * 16);
#pragma unroll
                for (int bj = 0; bj < 2; ++bj) { const u32x4 gg = g[m][bj];
                    f32x4 v0 = acc[ai][bj][m][0], v1 = acc[ai][bj][m][1];
                    v0[0] *= bflo(gg.x); v0[1] *= bfhi(gg.x); v0[2] *= bflo(gg.y); v0[3] *= bfhi(gg.y);
                    v1[0] *= bflo(gg.z); v1[1] *= bfhi(gg.z); v1[2] *= bflo(gg.w); v1[3] *= bfhi(gg.w);
                    *(u32x4*)(MRG + r * D + col0 + bj * HALF) = pack8(v0, v1); } }
            EPI_FENCE();
        }
    }
};
struct EpiMerge {
    static constexpr bool PERM = true, TWICE_OK = false;
    const bf16* G; bf16* MRG;
    DI void operator()(const f32x4 (&acc)[2][2][4][2], const Unit& u, int wr, int wc, int fr, int fq) const {
        const int row0 = u.pm * BM + wr * 64 + fr, col0 = u.pn * BM + wc * 32 + 8 * fq;
#pragma unroll
        for (int ai = 0; ai < 2; ++ai) {
            u32x4 g[4][2], pv[4][2];
#pragma unroll
            for (int m = 0; m < 4; ++m)
#pragma unroll
                for (int bj = 0; bj < 2; ++bj) { const size_t r = (size_t)(row0 + ai * HALF + m * 16); g[m][bj] = *(const u32x4*)(G + r * (2 * D) + col0 + bj * HALF); pv[m][bj] = *(const u32x4*)(MRG + r * D + col0 + bj * HALF); }
#pragma unroll
            for (int m = 0; m < 4; ++m) { const size_t r = (size_t)(row0 + ai * HALF + m * 16);
#pragma unroll
                for (int bj = 0; bj < 2; ++bj) { const u32x4 gg = g[m][bj], p = pv[m][bj];
                    f32x4 v0 = acc[ai][bj][m][0], v1 = acc[ai][bj][m][1];
                    v0[0] = v0[0] * bflo(gg.x) + bflo(p.x); v0[1] = v0[1] * bfhi(gg.x) + bfhi(p.x); v0[2] = v0[2] * bflo(gg.y) + bflo(p.y); v0[3] = v0[3] * bfhi(gg.y) + bfhi(p.y);
                    v1[0] = v1[0] * bflo(gg.z) + bflo(p.z); v1[1] = v1[1] * bfhi(gg.z) + bfhi(p.z); v1[2] = v1[2] * bflo(gg.w) + bflo(p.w); v1[3] = v1[3] * bfhi(gg.w) + bfhi(p.w);
                    *(u32x4*)(MRG + r * D + col0 + bj * HALF) = pack8(v0, v1); } }
            EPI_FENCE();
        }
    }
};
struct EpiResid {
    static constexpr bool PERM = true, TWICE_OK = false;
    bf16* HB; float* ssq16;
    DI void operator()(const f32x4 (&acc)[2][2][4][2], const Unit& u, int wr, int wc, int fr, int fq) const {
        const int row0 = u.pm * BM + wr * 64 + fr, col0 = u.pn * BM + wc * 32 + 8 * fq;
#pragma unroll
        for (int ai = 0; ai < 2; ++ai) {
            u32x4 hv[4][2];
#pragma unroll
            for (int m = 0; m < 4; ++m)
#pragma unroll
                for (int bj = 0; bj < 2; ++bj) hv[m][bj] = *(const u32x4*)(HB + (size_t)(row0 + ai * HALF + m * 16) * D + col0 + bj * HALF);
#pragma unroll
            for (int m = 0; m < 4; ++m) { const size_t r = (size_t)(row0 + ai * HALF + m * 16); float s = 0.f;
#pragma unroll
                for (int bj = 0; bj < 2; ++bj) { const u32x4 h = hv[m][bj];
                    f32x4 v0 = acc[ai][bj][m][0], v1 = acc[ai][bj][m][1];
                    v0[0] += bflo(h.x); v0[1] += bfhi(h.x); v0[2] += bflo(h.y); v0[3] += bfhi(h.y); v1[0] += bflo(h.z); v1[1] += bfhi(h.z); v1[2] += bflo(h.w); v1[3] += bfhi(h.w);
                    const u32x4 w = pack8(v0, v1); *(u32x4*)(HB + r * D + col0 + bj * HALF) = w;
                    s += (bflo(w.x) * bflo(w.x) + bfhi(w.x) * bfhi(w.x)) + (bflo(w.y) * bflo(w.y) + bfhi(w.y) * bfhi(w.y)) + (bflo(w.z) * bflo(w.z) + bfhi(w.z) * bfhi(w.z)) + (bflo(w.w) * bflo(w.w) + bfhi(w.w) * bfhi(w.w)); }
                s += shx(s, 16, fq * 16 + fr); s += shx(s, 32, fq * 16 + fr);
                if (fq == 0) ssq16[r * 16 + 4 * u.pn + wc] = s; }
            EPI_FENCE();
        }
    }
};
template <bool MOE> struct EpiSwiGLU {
    static constexpr bool PERM = true, TWICE_OK = false;
    const float* rsrc; bf16* ACT; int nkt;
    DI void operator()(const f32x4 (&acc)[2][2][4][2], const Unit& u, int wr, int wc, int fr, int fq) const {
        const int row0 = u.pm * BM + wr * 64 + fr;
        bf16* abase = ACT + ((size_t)(u.pm * nkt + 2 * u.pn + (wc >> 1)) * 256 + (wr * 64 + fr)) * 64 + (wc & 1) * 32 + 8 * fq;
        f32x4 pp[2][4]; float rsv[2][4];
        if (MOE) {
#pragma unroll
            for (int ai = 0; ai < 2; ++ai)
#pragma unroll
                for (int m = 0; m < 4; ++m) rsv[ai][m] = rsrc[row0 + ai * HALF + m * 16];
        } else { rstd4_load(pp[0], rsrc, row0, fq); rstd4_load(pp[1], rsrc, row0 + HALF, fq); }
#pragma unroll
        for (int ai = 0; ai < 2; ++ai) {
#pragma unroll
            for (int m = 0; m < 4; ++m) { const int r = row0 + ai * HALF + m * 16;
                const float rs = MOE ? rsv[ai][m] : rstd_finish(pp[ai][m], fq * 16 + fr); const float rs2 = rs * rs, nsl2 = -rs * LOG2E;
                f32x4 o[2];
#pragma unroll
                for (int n = 0; n < 2; ++n) { const f32x4 gu = acc[ai][0][m][n] * acc[ai][1][m][n] * rs2;
#pragma unroll
                    for (int j = 0; j < 4; ++j) o[n][j] = gu[j] * sigmoid_scaled(acc[ai][0][m][n][j], nsl2); }
                *(u32x4*)(abase + (ai * HALF + m * 16) * 64) = pack8(o[0], o[1]); }
            EPI_FENCE();
        }
    }
};
struct EpiSwiGLU8 {
    static constexpr bool PERM = true, TWICE_OK = false;
    const float* slot_rs; unsigned char* ACT8;
    DI void operator()(const f32x4 (&acc)[2][2][4][2], const Unit& u, int wr, int wc, int fr, int fq) const {
        const int row0 = wr * 64 + fr;
        unsigned char* base = ACT8 + ((size_t)(u.pm * (DFE / 128) + u.pn) * 256 + row0) * 128 + wc * 32 + 8 * fq;
        float rsv[2][4];
#pragma unroll
        for (int ai = 0; ai < 2; ++ai)
#pragma unroll
            for (int m = 0; m < 4; ++m) rsv[ai][m] = slot_rs[u.pm * BM + row0 + ai * HALF + m * 16];
#pragma unroll
        for (int ai = 0; ai < 2; ++ai) {
#pragma unroll
            for (int m = 0; m < 4; ++m) { const float rs = rsv[ai][m] * (1.0f / W8_GU), rs2 = rs * rs, nsl2 = -rs * LOG2E;
                f32x4 o[2];
#pragma unroll
                for (int n = 0; n < 2; ++n) { const f32x4 gu = acc[ai][0][m][n] * acc[ai][1][m][n] * rs2;
#pragma unroll
                    for (int j = 0; j < 4; ++j) o[n][j] = gu[j] * sigmoid_scaled(acc[ai][0][m][n][j], nsl2); }
                u32x2 w; w.x = pk4_fp8(o[0][0], o[0][1], o[0][2], o[0][3]); w.y = pk4_fp8(o[1][0], o[1][1], o[1][2], o[1][3]);
                *(u32x2*)(base + (size_t)(ai * HALF + m * 16) * 128) = w; }
            EPI_FENCE();
        }
    }
};
struct EpiMoeDown {
    static constexpr bool PERM = true, TWICE_OK = false;
    const bf16* SRC; bf16* DST; const int* slot_tok; const float* slot_w; float scale;
    DI void operator()(const f32x4 (&acc)[2][2][4][2], const Unit& u, int wr, int wc, int fr, int fq) const {
        const int row0 = u.pm * BM + wr * 64 + fr, col0 = u.pn * BM + wc * 32 + 8 * fq;
        int tk[2][4]; float wk[2][4];
#pragma unroll
        for (int ai = 0; ai < 2; ++ai)
#pragma unroll
            for (int m = 0; m < 4; ++m) { tk[ai][m] = slot_tok[row0 + ai * HALF + m * 16]; wk[ai][m] = slot_w[row0 + ai * HALF + m * 16] * scale; }
#pragma unroll
        for (int ai = 0; ai < 2; ++ai) {
            u32x4 hv[4][2];
#pragma unroll
            for (int m = 0; m < 4; ++m) { const int tok = tk[ai][m] < 0 ? 0 : tk[ai][m];
#pragma unroll
                for (int bj = 0; bj < 2; ++bj) hv[m][bj] = *(const u32x4*)(SRC + (size_t)tok * D + col0 + bj * HALF); }
#pragma unroll
            for (int m = 0; m < 4; ++m) { const int tok = tk[ai][m]; const float w = wk[ai][m];
                if (tok >= 0) {
#pragma unroll
                    for (int bj = 0; bj < 2; ++bj) { const u32x4 h = hv[m][bj];
                        f32x4 v0 = acc[ai][bj][m][0] * w, v1 = acc[ai][bj][m][1] * w;
                        v0[0] += bflo(h.x); v0[1] += bfhi(h.x); v0[2] += bflo(h.y); v0[3] += bfhi(h.y); v1[0] += bflo(h.z); v1[1] += bfhi(h.z); v1[2] += bflo(h.w); v1[3] += bfhi(h.w);
                        *(u32x4*)(DST + (size_t)tok * D + col0 + bj * HALF) = pack8(v0, v1); } } }
            EPI_FENCE();
        }
    }
};
struct EpiSlab {
    static constexpr bool PERM = false, TWICE_OK = false;
    float* slab;
    DI void operator()(const f32x4 (&acc)[2][2][4][2], const Unit& u, int wr, int wc, int fr, int fq) const {
        float* base = slab + ((size_t)(u.pm * NQ + u.kq) * BM + wr * 64 + fr) * D + u.pn * BM + wc * 32 + 4 * fq;
#pragma unroll
        for (int ai = 0; ai < 2; ++ai)
#pragma unroll
            for (int m = 0; m < 4; ++m)
#pragma unroll
                for (int bj = 0; bj < 2; ++bj)
#pragma unroll
                    for (int n = 0; n < 2; ++n) *(f32x4*)(base + (size_t)(ai * HALF + m * 16) * D + bj * HALF + n * 16) = acc[ai][bj][m][n];
    }
};
}
namespace att {
constexpr int KS_OFF = 0, KROW = 144, VT_OFF = 36864, VROW = 520, KM_OFF = 70144, VTM_OFF = 74752, VMROW = 72, RAWK_OFF = 79872, RAWV_OFF = RAWK_OFF + 32768, LDS_END = RAWV_OFF + 32768;
static_assert(LDS_END <= RING_BYTES, "attention LDS");
DI int crow(int i, int h) { return (i & 3) + 8 * (i >> 2) + 4 * h; }
struct Args { const bf16 *Q, *K, *V, *U, *KM, *VM, *UM; const float* sinks; bf16 *O, *POOLED; };
#define MFMA32(a, b, c) __builtin_amdgcn_mfma_f32_32x32x16_bf16((a), (b), (c), 0, 0, 0)
template <int WIN> DI void pool_load(unsigned (&xs)[47], const bf16* U, unsigned urow0, int col) {
    const char* ub = (const char*)U; const unsigned off0 = ((urow0 - (unsigned)(WIN - 1)) * POOLW + (unsigned)col) * 2u;
#pragma unroll
    for (int i = 0; i < 31 + WIN; ++i) xs[i] = *(const unsigned*)(ub + (off0 + (unsigned)i * (POOLW * 2u)));
}
template <int WIN> DI void pool_store(const unsigned (&xs)[47], bf16* POOLED, unsigned prow0, int col) {
    float a0 = 0.f, a1 = 0.f; const float invw = 1.0f / (float)WIN;
#pragma unroll
    for (int j = 0; j < WIN - 1; ++j) { a0 += bflo(xs[j]); a1 += bfhi(xs[j]); }
#pragma unroll
    for (int t = 0; t < 32; ++t) { const float x0 = bflo(xs[WIN - 1 + t]), x1 = bfhi(xs[WIN - 1 + t]); a0 += x0; a1 += x1;
        *(unsigned*)((char*)POOLED + ((prow0 + (unsigned)t) * POOLW + (unsigned)col) * 2u) = pk2(a0 * invw - x0, a1 * invw - x1);
        a0 -= bflo(xs[t]); a1 -= bfhi(xs[t]); }
}
DI void phase(LAS unsigned char* lds, const Args& A, int c, int G, int tid0) {
    asm volatile("" : "+v"(tid0));
    const int wid = __builtin_amdgcn_readfirstlane(tid0 >> 6);
    constexpr int NUNIT = NB * 64 * NKV;
    if (c >= NUNIT) return;
    bf16x8 qa[4], qb[4];
#define ATT_DECODE(L_, b_, nb_, kh_) const int b_ = (L_) >> 7, nb_ = ((L_) >> 1) & 63, kh_ = (L_) & 1
#define ATT_LOAD_KV(L_) do { ATT_DECODE(L_, b2, nb2, kh2); const size_t rb2 = (size_t)b2 * SEQ; const int s02 = (nb2 - 1) * 128; \
        _Pragma("unroll") for (int pass = 0; pass < 4; ++pass) { const int s = s02 + (tid >> 3) + 64 * pass; \
            kv[pass] = *(const u32x4*)(A.K + (rb2 + (size_t)(s < 0 ? 0 : s)) * KVW + kh2 * 64 + 8 * (tid & 7)); } \
        _Pragma("unroll") for (int pass = 0; pass < 4; ++pass) { const int s = s02 + lane + 64 * pass; \
            vv[pass] = *(const u32x4*)(A.V + (rb2 + (size_t)(s < 0 ? 0 : s)) * KVW + kh2 * 64 + 8 * wid); } } while (0)
#define ATT_DMA_KV(L_) do { ATT_DECODE(L_, b2, nb2, kh2); const size_t rb2 = (size_t)b2 * SEQ; const int s02 = (nb2 - 1) * 128; \
        _Pragma("unroll") for (int pass = 0; pass < 4; ++pass) { const int s = s02 + (tid >> 3) + 64 * pass; const size_t go = (rb2 + (size_t)(s < 0 ? 0 : s)) * KVW + kh2 * 64 + 8 * (tid & 7); \
            __builtin_amdgcn_global_load_lds((const unsigned*)(A.K + go), (LAS unsigned*)(lds + RAWK_OFF + (pass * 512 + wid * 64) * 16), 16, 0, 0); \
            __builtin_amdgcn_global_load_lds((const unsigned*)(A.V + go), (LAS unsigned*)(lds + RAWV_OFF + (pass * 512 + wid * 64) * 16), 16, 0, 0); } } while (0)
#define ATT_RAW_KV() do { _Pragma("unroll") for (int pass = 0; pass < 4; ++pass) { kv[pass] = *(const LAS u32x4*)(lds + RAWK_OFF + (pass * 512 + tid) * 16); \
            vv[pass] = *(const LAS u32x4*)(lds + RAWV_OFF + ((lane + 64 * pass) * 8 + wid) * 16); } } while (0)
#define ATT_LOAD_Q(dst, L_, qs_) do { ATT_DECODE(L_, b2, nb2, kh2); const bf16* qp = A.Q + ((size_t)b2 * SEQ + (size_t)(nb2 * 128 + 32 * (qs_) + r)) * D + (kh2 * QG + wid) * HD + 8 * h; \
        _Pragma("unroll") for (int d0 = 0; d0 < 4; ++d0) dst[d0] = *(const bf16x8*)(qp + 16 * d0); } while (0)
    { const int tid = tid0, lane = tid & 63, r = lane & 31, h = lane >> 5; ATT_LOAD_Q(qa, c, 0); }
    for (int L = c; L < NUNIT; L += G) {
        int tid = tid0; asm volatile("" : "+v"(tid));
        const int lane = tid & 63, r = lane & 31, h = lane >> 5;
        ATT_DECODE(L, b, nb, kh);
        const size_t rowb = (size_t)b * SEQ;
        const int head = kh * QG + wid;
        const bool has_next = (L + G) < NUNIT;
        const float slope2 = __builtin_amdgcn_exp2f(-0.5f * (float)(head + 1)) * LOG2E, sink2 = A.sinks[head] * LOG2E;
        const int pg = 2 * kh + (wid & 1), pcol = 128 * pg + 2 * lane;
        const unsigned prow0 = (unsigned)(b * SEQ + nb * 128 + 32 * (wid >> 1)), urow0 = prow0 + (unsigned)(NMETA * (b + 1));
        unsigned xs[47];
        if (pg == 0) pool_load<2>(xs, A.U, urow0, pcol); else if (pg == 1) pool_load<4>(xs, A.U, urow0, pcol);
        else if (pg == 2) pool_load<8>(xs, A.U, urow0, pcol); else pool_load<16>(xs, A.U, urow0, pcol);
        __builtin_amdgcn_sched_barrier(0);
        u32x4 kv[4], vv[4];
        if (L == c) ATT_LOAD_KV(L); else ATT_RAW_KV();
#pragma unroll
        for (int pass = 0; pass < 4; ++pass) { const int j = (tid >> 3) + 64 * pass, cc = tid & 7; *(LAS u32x4*)(lds + KS_OFF + j * KROW + 16 * cc) = kv[pass]; }
#pragma unroll
        for (int pass = 0; pass < 4; ++pass) { const int j = lane + 64 * pass;
#pragma unroll
            for (int jj = 0; jj < 8; ++jj) { const unsigned w = vv[pass][jj >> 1]; ((LAS unsigned short*)(lds + VT_OFF + (8 * wid + jj) * VROW))[j] = (unsigned short)((jj & 1) ? (w >> 16) : (w & 0xffffu)); } }
        if (L == c) {
            u32x4 kmv = *(const u32x4*)(A.KM + (size_t)((tid >> 3) & (NMETA - 1)) * KVW + kh * 64 + 8 * (tid & 7));
            if (tid >= 8 * NMETA) kmv = (u32x4){0u, 0u, 0u, 0u};
            if (tid < 256) *(LAS u32x4*)(lds + KM_OFF + (tid >> 3) * KROW + 16 * (tid & 7)) = kmv;
            const int d = tid & 63, kg = tid >> 6;
#pragma unroll
            for (int kk = 0; kk < 4; ++kk) { const int key = 4 * kg + kk; unsigned short val = A.VM[(size_t)(key & (NMETA - 1)) * KVW + kh * 64 + d]; if (key >= NMETA) val = 0;
                ((LAS unsigned short*)(lds + VTM_OFF + d * VMROW))[key] = val; }
        }
        __syncthreads();
        if (pg == 0) pool_store<2>(xs, A.POOLED, prow0, pcol); else if (pg == 1) pool_store<4>(xs, A.POOLED, prow0, pcol);
        else if (pg == 2) pool_store<8>(xs, A.POOLED, prow0, pcol); else pool_store<16>(xs, A.POOLED, prow0, pcol);
        __builtin_amdgcn_sched_barrier(0);
        if (has_next) ATT_DMA_KV(L + G);
        __builtin_amdgcn_sched_barrier(0);
        f32x16 Bb;
#pragma unroll
        for (int i = 0; i < 16; ++i) Bb[i] = -slope2 * (float)(128 - crow(i, h) + r);
#define ATT_BB(i) Bb[i]
#pragma unroll
        for (int qs = 0; qs < 4; ++qs) {
            bf16x8 (&qr)[4] = (qs & 1) ? qb : qa;
            if (qs == 0) ATT_LOAD_Q(qb, L, 1); else if (qs == 1) ATT_LOAD_Q(qa, L, 2); else if (qs == 2) ATT_LOAD_Q(qb, L, 3); else if (has_next) ATT_LOAD_Q(qa, L + G, 0);
            __builtin_amdgcn_sched_barrier(0);
            const int qrow = nb * 128 + 32 * qs + r;
            float mx = sink2, lsum = 0.f;
            f32x16 o[2]; o[0] = (f32x16){}; o[1] = (f32x16){};
#define ATT_QK(S_, kt_) do { const LAS unsigned char* kp_ = lds + KS_OFF + (32 * (kt_) + r) * KROW + 16 * h; \
                _Pragma("unroll") for (int d0 = 0; d0 < 4; ++d0) S_ = MFMA32(*(const LAS bf16x8*)(kp_ + 32 * d0), qr[d0], S_); } while (0)
#define ATT_MAX16(S_) fmaxf(fmaxf(fmaxf(fmaxf(S_[0], S_[1]), fmaxf(S_[2], S_[3])), fmaxf(fmaxf(S_[4], S_[5]), fmaxf(S_[6], S_[7]))), fmaxf(fmaxf(fmaxf(S_[8], S_[9]), fmaxf(S_[10], S_[11])), fmaxf(fmaxf(S_[12], S_[13]), fmaxf(S_[14], S_[15]))))
#define ATT_RESCALE(tmax_) do { if ((tmax_) > mx) { const float alpha = __builtin_amdgcn_exp2f(mx - (tmax_)); mx = (tmax_); lsum *= alpha; \
                _Pragma("unroll") for (int i = 0; i < 16; ++i) { o[0][i] *= alpha; o[1][i] *= alpha; } } } while (0)
#define ATT_PV(P_, kt_, s_) do { u32x4 pw; pw.x = pk2(P_[8 * (s_)], P_[8 * (s_) + 1]); pw.y = pk2(P_[8 * (s_) + 2], P_[8 * (s_) + 3]); pw.z = pk2(P_[8 * (s_) + 4], P_[8 * (s_) + 5]); pw.w = pk2(P_[8 * (s_) + 6], P_[8 * (s_) + 7]); \
                const bf16x8 pf = __builtin_bit_cast(bf16x8, pw); \
                _Pragma("unroll") for (int db = 0; db < 2; ++db) { const LAS unsigned char* vp = lds + VT_OFF + (32 * db + r) * VROW + (32 * (kt_) + 16 * (s_) + 4 * h) * 2; \
                    const s16x4 lo = *(const LAS s16x4*)vp, hi = *(const LAS s16x4*)(vp + 16); o[db] = MFMA32(__builtin_shufflevector(lo, hi, 0, 1, 2, 3, 4, 5, 6, 7), pf, o[db]); } } while (0)
#pragma unroll
            for (int tt = 1; tt < 4; ++tt) {
                if (nb == 0 && qs + tt < 4) continue;
                f32x16 S;
#pragma unroll
                for (int i = 0; i < 16; ++i) S[i] = ATT_BB(i);
                ATT_QK(S, qs + tt);
                const float shift = (32.0f * (float)tt) * slope2;
                float tmax = ATT_MAX16(S); tmax = fmaxf(tmax, shx(tmax, 32, lane)) + shift;
                ATT_RESCALE(tmax);
                const float mxs = mx - shift;
#pragma unroll
                for (int i = 0; i < 16; ++i) { const float p = __builtin_amdgcn_exp2f(S[i] - mxs); S[i] = p; lsum += p; }
                ATT_PV(S, qs + tt, 0); ATT_PV(S, qs + tt, 1);
            }
            {
                const bool t0ok = !(nb == 0 && qs < 4);
                f32x16 S0, S4;
#pragma unroll
                for (int i = 0; i < 16; ++i) { S0[i] = ATT_BB(i); S4[i] = ATT_BB(i); }
                if (t0ok) ATT_QK(S0, qs);
                ATT_QK(S4, qs + 4);
                const float sh4 = 128.0f * slope2;
#pragma unroll
                for (int i = 0; i < 16; ++i) { const bool lo_ = crow(i, h) > r; S4[i] = lo_ ? (t0ok ? S0[i] : -1e30f) : S4[i] + sh4; }
                float tmax = ATT_MAX16(S4); tmax = fmaxf(tmax, shx(tmax, 32, lane));
                ATT_RESCALE(tmax);
#pragma unroll
                for (int i = 0; i < 16; ++i) { const float p = __builtin_amdgcn_exp2f(S4[i] - mx); lsum += p; const bool lo_ = crow(i, h) > r; S0[i] = lo_ ? p : 0.f; S4[i] = lo_ ? 0.f : p; }
                if (t0ok) { ATT_PV(S0, qs, 0); ATT_PV(S0, qs, 1); }
                ATT_PV(S4, qs + 4, 0); ATT_PV(S4, qs + 4, 1);
            }
            {
                f32x16 S;
#pragma unroll
                for (int i = 0; i < 16; ++i) S[i] = (i < 8) ? -slope2 * (float)(NMETA - crow(i, h)) : 0.f;
                { const LAS unsigned char* kp_ = lds + KM_OFF + r * KROW + 16 * h;
#pragma unroll
                  for (int d0 = 0; d0 < 4; ++d0) S = MFMA32(*(const LAS bf16x8*)(kp_ + 32 * d0), qr[d0], S); }
                const float shift = -slope2 * (float)qrow;
                float tmax = fmaxf(fmaxf(fmaxf(S[0], S[1]), fmaxf(S[2], S[3])), fmaxf(fmaxf(S[4], S[5]), fmaxf(S[6], S[7])));
                tmax = fmaxf(tmax, shx(tmax, 32, lane)) + shift;
                ATT_RESCALE(tmax);
                const float mxs = mx - shift;
#pragma unroll
                for (int i = 0; i < 8; ++i) { const float p = __builtin_amdgcn_exp2f(S[i] - mxs); S[i] = p; lsum += p; }
                u32x4 pw; pw.x = pk2(S[0], S[1]); pw.y = pk2(S[2], S[3]); pw.z = pk2(S[4], S[5]); pw.w = pk2(S[6], S[7]);
                const bf16x8 pf = __builtin_bit_cast(bf16x8, pw);
#pragma unroll
                for (int db = 0; db < 2; ++db) { const LAS unsigned char* vp = lds + VTM_OFF + (32 * db + r) * VMROW + (4 * h) * 2;
                    const s16x4 lo = *(const LAS s16x4*)vp, hi = *(const LAS s16x4*)(vp + 16); o[db] = MFMA32(__builtin_shufflevector(lo, hi, 0, 1, 2, 3, 4, 5, 6, 7), pf, o[db]); }
            }
#undef ATT_QK
#undef ATT_MAX16
#undef ATT_RESCALE
#undef ATT_PV
            lsum += shx(lsum, 32, lane);
            lsum += __builtin_amdgcn_exp2f(sink2 - mx);
            const float inv = 1.0f / lsum;
            bf16* op = A.O + (rowb + (size_t)qrow) * D + head * HD;
#pragma unroll
            for (int db = 0; db < 2; ++db)
#pragma unroll
                for (int j = 0; j < 2; ++j) { const int g0 = 2 * j, g1 = 2 * j + 1;
                    const unsigned w0x = pk2(o[db][4 * g0] * inv, o[db][4 * g0 + 1] * inv), w0y = pk2(o[db][4 * g0 + 2] * inv, o[db][4 * g0 + 3] * inv);
                    const unsigned w1x = pk2(o[db][4 * g1] * inv, o[db][4 * g1 + 1] * inv), w1y = pk2(o[db][4 * g1 + 2] * inv, o[db][4 * g1 + 3] * inv);
                    const auto rx = __builtin_amdgcn_permlane32_swap(w1x, w0x, false, false), ry = __builtin_amdgcn_permlane32_swap(w1y, w0y, false, false);
                    u32x4 w; w.x = rx[0]; w.y = ry[0]; w.z = rx[1]; w.w = ry[1];
                    *(u32x4*)(op + 32 * db + 8 * (h ? g0 : g1)) = w; }
        }
        asm volatile("s_waitcnt vmcnt(8)" ::: "memory");
        __syncthreads();
    }
#undef ATT_DECODE
#undef ATT_BB
#undef ATT_LOAD_KV
#undef ATT_DMA_KV
#undef ATT_RAW_KV
#undef ATT_LOAD_Q
}
}
constexpr int NWAVES = 8;
struct Args { const float* in[18]; float* out; unsigned char* ws; int ph_lo, ph_hi; };
struct Frame {
    LAS unsigned char* lds;
    int tid, lane, wave, vcu, G;
    float* out; unsigned char* ws;
};
#define WSP(T, off) ((T*)(F.ws + (off)))
#define METAP(T, off) ((T*)(F.ws + WS_META + (off)))
enum { I_X = 0, I_META, I_NORM_MIX, I_W_IN, I_SINKS, I_W_ATTN_BR, I_W_POOL, I_POOL_SCALE, I_W_OUT, I_NORM_FFN, I_DW_GATE, I_DW_UP, I_DW_DOWN, I_ROUTER, I_MW_GATE, I_MW_UP, I_MW_DOWN, I_NORM_FINAL };

DI void tr_item(const float* W, int N, bf16* WT, int ldw, int k0, int n0, int drow0, const float* kscale, const float* nscale, LAS float* scr, int lane, int tiled_nkt = 0) {
    float wv[32];
#pragma unroll
    for (int i = 0; i < 32; ++i) wv[i] = W[(size_t)(k0 + 2 * i + (lane >> 5)) * N + n0 + (lane & 31)];
    const float ns = nscale ? nscale[n0 + (lane & 31)] : 1.f;
#pragma unroll
    for (int i = 0; i < 32; ++i) { const int kk = 2 * i + (lane >> 5); float v = wv[i] * ns; if (kscale) v *= kscale[k0 + kk]; scr[kk * 33 + (lane & 31)] = v; }
    LDS_WAIT(); asm volatile("" ::: "memory");
    const int c = lane & 7;
#pragma unroll
    for (int j = 0; j < 4; ++j) { const int n = (lane >> 3) + 8 * j; const LAS float* s = scr + (8 * c) * 33 + n;
        u32x4 o; o.x = pk2(s[0 * 33], s[1 * 33]); o.y = pk2(s[2 * 33], s[3 * 33]); o.z = pk2(s[4 * 33], s[5 * 33]); o.w = pk2(s[6 * 33], s[7 * 33]);
        const int dr = drow0 + n;
        bf16* dst = tiled_nkt ? WT + ((size_t)((dr >> 8) * tiled_nkt + (k0 >> 6)) * 256 + (dr & 255)) * 64 + 8 * c
                              : WT + (size_t)dr * ldw + k0 + 8 * c;
        *(u32x4*)dst = o; }
    LDS_WAIT(); asm volatile("" ::: "memory");
}
DI void tr_item8(const float* W, int N, unsigned char* WT, int ldw, int k0, int n0, int drow0, const float* kscale, float scale, LAS float* scr, int lane, int tiled_nkt) {
    float wv[32];
#pragma unroll
    for (int i = 0; i < 32; ++i) wv[i] = W[(size_t)(k0 + 2 * i + (lane >> 5)) * N + n0 + (lane & 31)];
#pragma unroll
    for (int i = 0; i < 32; ++i) { const int kk = 2 * i + (lane >> 5); float v = wv[i] * scale; if (kscale) v *= kscale[k0 + kk]; scr[kk * 33 + (lane & 31)] = v; }
    LDS_WAIT(); asm volatile("" ::: "memory");
#pragma unroll
    for (int j = 0; j < 2; ++j) { const int o = lane + 64 * j, n = o >> 2, c = o & 3; const LAS float* s = scr + (16 * c) * 33 + n;
        u32x4 w; w.x = pk4_fp8(s[0 * 33], s[1 * 33], s[2 * 33], s[3 * 33]); w.y = pk4_fp8(s[4 * 33], s[5 * 33], s[6 * 33], s[7 * 33]);
        w.z = pk4_fp8(s[8 * 33], s[9 * 33], s[10 * 33], s[11 * 33]); w.w = pk4_fp8(s[12 * 33], s[13 * 33], s[14 * 33], s[15 * 33]);
        const int dr = drow0 + n;
        unsigned char* dst = tiled_nkt ? WT + ((size_t)((dr >> 8) * tiled_nkt + (k0 >> 7)) * 256 + (dr & 255)) * 128 + (k0 & 127) + 16 * c : WT + (size_t)dr * ldw + k0 + 16 * c;
        *(u32x4*)dst = w; }
    LDS_WAIT(); asm volatile("" ::: "memory");
}
DI void tr_plain(const float* W, int K, int N, bf16* WT, int ldw, int it, const float* kscale, const float* nscale, LAS float* scr, int lane, int tiled_nkt = 0) {
    const int nblk = N / 32, kb = it / nblk, nb = it % nblk; tr_item(W, N, WT, ldw, 64 * kb, 32 * nb, 32 * nb, kscale, nscale, scr, lane, tiled_nkt);
}
DI void tr_gu(const float* W, int N, bf16* WT, int it, int up, const float* kscale, LAS float* scr, int lane) {
    const int nblk = N / 32, kb = it / nblk, nb = it % nblk, n0 = 32 * nb; tr_item(W, N, WT, D, 64 * kb, n0, (n0 / 128) * 256 + up * 128 + (n0 % 128), kscale, nullptr, scr, lane);
}
DI void p0_prologue(Frame& F, const Args& A) {
    LAS float* scr = (LAS float*)(F.lds + RING_OFF + F.wave * 16384);
    const int gw = F.vcu * NWAVES + F.wave, NGW = F.G * NWAVES, lane = F.lane;
    constexpr int I_IN = 16 * (INW / 32), I_SQ = 16 * 32, I_PL = 2 * 8, I_DGU = 16 * (DFF / 32), I_DD = (DFF / 64) * 32, I_MGU = 16 * (DFE / 32), I_MD = (DFE / 64) * 32;
    constexpr int PER_LAYER = I_IN + I_SQ + 4 * I_PL + I_SQ, N_DENSE = 2 * I_DGU + I_DD, PER_EXP = 2 * I_MGU + I_MD;
    constexpr int NITEMS = 2 * PER_LAYER + N_DENSE + NE * PER_EXP;
    for (int it = gw; it < NITEMS; it += NGW) {
        int r = it;
        if (r < 2 * PER_LAYER) {
            const int l = r / PER_LAYER; r -= l * PER_LAYER;
            if (r < I_IN) { tr_plain(A.in[I_W_IN] + (size_t)l * D * INW, D, INW, WSP(bf16, WS_WIN) + (size_t)l * INW * D, D, r, A.in[I_NORM_MIX] + l * D, nullptr, scr, lane); continue; } r -= I_IN;
            if (r < I_SQ) { tr_plain(A.in[I_W_ATTN_BR] + (size_t)l * D * D, D, D, WSP(bf16, WS_WA) + (size_t)l * D * D, D, r, nullptr, nullptr, scr, lane); continue; } r -= I_SQ;
            if (r < 4 * I_PL) { const int g = r / I_PL; r -= g * I_PL;
                tr_plain(A.in[I_W_POOL] + ((size_t)l * 4 + g) * 128 * 256, 128, 256, WSP(bf16, WS_WP) + ((size_t)l * D + g * 256) * 256, 256, r, nullptr, A.in[I_POOL_SCALE] + l * D + g * 256, scr, lane); continue; } r -= 4 * I_PL;
            tr_plain(A.in[I_W_OUT] + (size_t)l * D * D, D, D, WSP(bf16, WS_WO) + (size_t)l * D * D, D, r, nullptr, nullptr, scr, lane); continue;
        }
        r -= 2 * PER_LAYER;
        if (r < N_DENSE) {
            if (r < I_DGU) { tr_gu(A.in[I_DW_GATE], DFF, WSP(bf16, WS_WGU), r, 0, A.in[I_NORM_FFN], scr, lane); continue; } r -= I_DGU;
            if (r < I_DGU) { tr_gu(A.in[I_DW_UP], DFF, WSP(bf16, WS_WGU), r, 1, A.in[I_NORM_FFN], scr, lane); continue; } r -= I_DGU;
            tr_plain(A.in[I_DW_DOWN], DFF, D, WSP(bf16, WS_WD), DFF, r, nullptr, nullptr, scr, lane, DFF / 64); continue;
        }
        r -= N_DENSE;
        { const int e = r / PER_EXP; r -= e * PER_EXP;
            unsigned char* gu8 = WSP(unsigned char, WS_MGU) + (size_t)e * 2 * DFE * D; unsigned char* dn8 = WSP(unsigned char, WS_MD) + (size_t)e * D * DFE;
            if (r < 2 * I_MGU) { const int up = r >= I_MGU ? 1 : 0; if (up) r -= I_MGU; const int nblk = DFE / 32, kb = r / nblk, nb = r % nblk, n0 = 32 * nb;
                tr_item8((up ? A.in[I_MW_UP] : A.in[I_MW_GATE]) + (size_t)e * D * DFE, DFE, gu8, D, 64 * kb, n0, (n0 / 128) * 256 + up * 128 + (n0 % 128), A.in[I_NORM_FFN] + D, W8_GU, scr, lane, 0); continue; }
            r -= 2 * I_MGU;
            { const int nblk = D / 32, kb = r / nblk, nb = r % nblk; tr_item8(A.in[I_MW_DOWN] + (size_t)e * DFE * D, D, dn8, 0, 64 * kb, 32 * nb, 32 * nb, nullptr, W8_DN, scr, lane, DFE / 128); } }
    }
    for (int rr = gw; rr < 2 * D; rr += NGW) *(unsigned*)(WSP(bf16, WS_WP) + (size_t)rr * 256 + 128 + 2 * lane) = 0u;
    const float* x = A.in[I_X]; bf16* HB = WSP(bf16, WS_HB); float* ssq = WSP(float, WS_SSQ);
    for (int m0 = gw * 4; m0 < M; m0 += NGW * 4) {
        f32x4 v[4][4];
#pragma unroll
        for (int q = 0; q < 4; ++q)
#pragma unroll
            for (int j = 0; j < 4; ++j) v[q][j] = *((const f32x4*)(x + (size_t)(m0 + q) * D) + lane + 64 * j);
#pragma unroll
        for (int q = 0; q < 4; ++q) { float s = 0.f; u32x2* o8 = (u32x2*)(HB + (size_t)(m0 + q) * D) + lane;
#pragma unroll
            for (int j = 0; j < 4; ++j) { s += (v[q][j][0] * v[q][j][0] + v[q][j][1] * v[q][j][1]) + (v[q][j][2] * v[q][j][2] + v[q][j][3] * v[q][j][3]); u32x2 w; w.x = pk2(v[q][j][0], v[q][j][1]); w.y = pk2(v[q][j][2], v[q][j][3]); o8[64 * j] = w; }
            s = wave_sum(s, lane);
            if (lane < 16) ssq[(size_t)(m0 + q) * 16 + lane] = lane == 0 ? s : 0.f; }
    }
    for (int m = gw; m < NMETA; m += NGW) {
        const f32x4* xr = (const f32x4*)(A.in[I_META] + (size_t)m * D) + lane; f32x4* ho = (f32x4*)(METAP(float, MO_HM) + (size_t)m * D) + lane; u32x2* o8 = (u32x2*)(METAP(bf16, MO_XM) + (size_t)m * D) + lane;
#pragma unroll
        for (int j = 0; j < 4; ++j) { const f32x4 v = xr[64 * j]; ho[64 * j] = v; u32x2 w; w.x = pk2(v[0], v[1]); w.y = pk2(v[2], v[3]); o8[64 * j] = w; }
    }
}

namespace meta {
DI f32x4 tile(const bf16* X, int ldx, const bf16* Wt, int ldw, int K, int lane) {
    const int i = lane & 15, q = lane >> 4; f32x4 acc = (f32x4){0.f, 0.f, 0.f, 0.f};
    const bf16* xp = X + (size_t)i * ldx + 8 * q; const bf16* wp = Wt + (size_t)i * ldw + 8 * q;
    for (int k0 = 0; k0 < K; k0 += 32) acc = __builtin_amdgcn_mfma_f32_16x16x32_bf16(*(const bf16x8*)(wp + k0), *(const bf16x8*)(xp + k0), acc, 0, 0, 0);
    return acc;
}
template <int NST, bool SSQ, int TILED_NKT = 0> DI f32x4 tile_split(const bf16* X, int ldx, const bf16* Wt, int ldw, int wave, int lane, LAS float* scr, float& ssq) {
    const int i = lane & 15, q = lane >> 4, ks = 32 * NST;
    const bf16* xp = X + (size_t)i * ldx + wave * ks + 8 * q; const bf16* wp = Wt + (size_t)i * ldw + wave * ks + 8 * q;
    bf16x8 a[NST], b[NST];
#pragma unroll
    for (int s = 0; s < NST; ++s) { const int kk = wave * ks + 32 * s + 8 * q, wr_ = ldw + i;
        a[s] = TILED_NKT ? *(const bf16x8*)(Wt + ((size_t)((wr_ >> 8) * TILED_NKT + (kk >> 6)) * 256 + (wr_ & 255)) * 64 + (kk & 63)) : *(const bf16x8*)(wp + 32 * s);
        b[s] = *(const bf16x8*)(xp + 32 * s); }
    f32x4 acc = (f32x4){0.f, 0.f, 0.f, 0.f}; float sq = 0.f;
#pragma unroll
    for (int s = 0; s < NST; ++s) { acc = __builtin_amdgcn_mfma_f32_16x16x32_bf16(a[s], b[s], acc, 0, 0, 0);
        if (SSQ) {
#pragma unroll
            for (int j = 0; j < 8; ++j) { const float x = bf2f((unsigned short)b[s][j]); sq += x * x; } } }
    __syncthreads();
    *(LAS f32x4*)(scr + (wave * 64 + lane) * 4) = acc;
    if (SSQ) { sq += shx(sq, 16, lane); sq += shx(sq, 32, lane); if (q == 0) scr[2048 + wave * 16 + i] = sq; }
    __syncthreads();
    f32x4 r = (f32x4){0.f, 0.f, 0.f, 0.f}; float t = 0.f;
#pragma unroll
    for (int w = 0; w < 8; ++w) { r += *(const LAS f32x4*)(scr + (w * 64 + lane) * 4); if (SSQ) t += scr[2048 + w * 16 + i]; }
    ssq = t; return r;
}
DI void inproj(Frame& F, LAS float* scr, int l, int col0) {
    const int lane = F.lane, i = lane & 15, q = lane >> 4; float ss;
    const f32x4 a = tile_split<4, true>(METAP(bf16, MO_XM), D, WSP(bf16, WS_WIN) + ((size_t)l * INW + col0) * D, D, F.wave, lane, scr, ss);
    if (F.wave != 0) return;
    const float rs = __builtin_amdgcn_rsqf(ss * (1.0f / D) + RMS_EPS);
    float* pr = METAP(float, MO_PROJ) + (size_t)i * INW + col0 + 4 * q;
#pragma unroll
    for (int j = 0; j < 4; ++j) { float v = a[j] * rs; const int c = col0 + 4 * q + j;
        if (c < D) v *= QSCALE; else if (c >= 1792) v = fast_sigmoid(v);
        pr[j] = v;
        if (c >= 1024 && c < 1152) METAP(bf16, MO_KM)[((size_t)l * NMETA + i) * KVW + (c - 1024)] = (bf16)f2bf(v);
        else if (c >= 1152 && c < 1280) METAP(bf16, MO_VM)[((size_t)l * NMETA + i) * KVW + (c - 1152)] = (bf16)f2bf(v);
        else if (c >= 1280 && c < 1792) { const bf16 ub = (bf16)f2bf(v);
#pragma unroll
            for (int b = 0; b < NB; ++b) WSP(bf16, WS_U)[((size_t)b * USEQ + i) * POOLW + (c - 1280)] = ub; } }
}
DI void attn_head(Frame& F, const Args& A, int l, int head) {
    const float* pr = METAP(float, MO_PROJ); const int t = F.tid, i = t >> 5, dl = t & 31, kvh = head / QG;
    const float slope2 = __builtin_amdgcn_exp2f(-0.5f * (float)(head + 1)) * LOG2E, sink2 = A.in[I_SINKS][l * NH + head] * LOG2E;
    const float q0 = pr[(size_t)i * INW + head * HD + dl], q1 = pr[(size_t)i * INW + head * HD + dl + 32];
    float k0[NMETA], k1[NMETA], v0[NMETA], v1[NMETA];
#pragma unroll
    for (int j = 0; j < NMETA; ++j) { const float* kp = pr + (size_t)j * INW + 1024 + kvh * HD + dl; k0[j] = kp[0]; k1[j] = kp[32]; v0[j] = kp[128]; v1[j] = kp[160]; }
    float lg[NMETA]; float mx = sink2;
#pragma unroll
    for (int j = 0; j < NMETA; ++j) { float s = q0 * k0[j] + q1 * k1[j];
#pragma unroll
        for (int o = 1; o < 32; o <<= 1) s += shx(s, o, F.lane);
        s = (j <= i) ? s - slope2 * (float)(i - j) : -1e30f; lg[j] = s; mx = fmaxf(mx, s); }
    float lsum = __builtin_amdgcn_exp2f(sink2 - mx), o0 = 0.f, o1 = 0.f;
#pragma unroll
    for (int j = 0; j < NMETA; ++j) { const float p = __builtin_amdgcn_exp2f(lg[j] - mx); lsum += p; o0 += p * v0[j]; o1 += p * v1[j]; }
    const float inv = 1.0f / lsum;
    bf16* op = METAP(bf16, MO_ATT) + (size_t)i * D + head * HD + dl;
    op[0] = (bf16)f2bf(o0 * inv); op[32] = (bf16)f2bf(o1 * inv);
}
DI void pool_rows(Frame& F) {
    const float* pr = METAP(float, MO_PROJ); const int col = F.tid, g = col >> 7, win = 2 << g;
    float u[NMETA];
#pragma unroll
    for (int tt = 0; tt < NMETA; ++tt) u[tt] = pr[(size_t)tt * INW + 1280 + col];
#pragma unroll
    for (int tt = 0; tt < NMETA; ++tt) { float s = 0.f; int cnt = 0;
#pragma unroll
        for (int j = 0; j < NMETA; ++j) if (j <= tt && j < win) { s += u[tt - j]; ++cnt; }
        METAP(bf16, MO_POOL)[(size_t)tt * POOLW + col] = (bf16)f2bf(s / (float)cnt - u[tt]); }
}
DI void merge(Frame& F, LAS float* scr, int l, int col0) {
    const int lane = F.lane, i = lane & 15, q = lane >> 4, g = col0 >> 8; float dummy;
    const f32x4 a = tile_split<4, false>(METAP(bf16, MO_ATT), D, WSP(bf16, WS_WA) + ((size_t)l * D + col0) * D, D, F.wave, lane, scr, dummy);
    if (F.wave != 0) return;
    const f32x4 p = tile(METAP(bf16, MO_POOL) + g * 128, POOLW, WSP(bf16, WS_WP) + ((size_t)l * D + col0) * 256, 256, 128, lane);
    const float* pr = METAP(float, MO_PROJ) + (size_t)i * INW;
#pragma unroll
    for (int j = 0; j < 4; ++j) { const int c = col0 + 4 * q + j; METAP(bf16, MO_MRG)[(size_t)i * D + c] = (bf16)f2bf(pr[1792 + c] * a[j] + pr[2816 + c] * p[j]); }
}
DI void resid(Frame& F, const f32x4 o, int col0) {
    const int lane = F.lane, i = lane & 15, q = lane >> 4;
    float* hp = METAP(float, MO_HM) + (size_t)i * D + col0 + 4 * q; const f32x4 h = *(const f32x4*)hp + o; *(f32x4*)hp = h;
    u32x2 w; w.x = pk2(h[0], h[1]); w.y = pk2(h[2], h[3]); *(u32x2*)(METAP(bf16, MO_XM) + (size_t)i * D + col0 + 4 * q) = w;
}
DI void outproj(Frame& F, LAS float* scr, int l, int col0) { float dummy;
    const f32x4 o = tile_split<4, false>(METAP(bf16, MO_MRG), D, WSP(bf16, WS_WO) + ((size_t)l * D + col0) * D, D, F.wave, F.lane, scr, dummy);
    if (F.wave == 0) resid(F, o, col0); }
DI void gu(Frame& F, LAS float* scr, int n0) {
    const int lane = F.lane, i = lane & 15, q = lane >> 4; float ss, dummy;
    const bf16* wg = WSP(bf16, WS_WGU) + (size_t)((n0 / 128) * 256 + (n0 % 128)) * D;
    const f32x4 ga = tile_split<4, true>(METAP(bf16, MO_XM), D, wg, D, F.wave, lane, scr, ss);
    const f32x4 ua = tile_split<4, false>(METAP(bf16, MO_XM), D, wg + (size_t)128 * D, D, F.wave, lane, scr, dummy);
    if (F.wave != 0) return;
    const float rs = __builtin_amdgcn_rsqf(ss * (1.0f / D) + RMS_EPS);
    f32x4 o;
#pragma unroll
    for (int j = 0; j < 4; ++j) { const float gg = ga[j] * rs; o[j] = gg * fast_sigmoid(gg) * (ua[j] * rs); }
    u32x2 w; w.x = pk2(o[0], o[1]); w.y = pk2(o[2], o[3]); *(u32x2*)(METAP(bf16, MO_ACT) + (size_t)i * DFF + n0 + 4 * q) = w;
}
DI void down(Frame& F, LAS float* scr, int col0) { float dummy;
    const f32x4 o = tile_split<DFF / 256, false, DFF / 64>(METAP(bf16, MO_ACT), DFF, WSP(bf16, WS_WD), col0, F.wave, F.lane, scr, dummy);
    if (F.wave == 0) resid(F, o, col0); }
}
DI void moe_route(Frame& F, const Args& A) {
    LAS float* rw = (LAS float*)(F.lds + RING_OFF);
    LAS unsigned* hist = (LAS unsigned*)(F.lds + XTRA_OFF);
    const float* router = A.in[I_ROUTER]; const float* gain = A.in[I_NORM_FFN] + D;
    for (int idx = F.tid; idx < NE * D; idx += NWAVES * 64) { const int k = idx >> 3, e = idx & 7; rw[e * D + k] = router[idx] * gain[k]; }
    unsigned char* hb8 = WSP(unsigned char, WS_POOLED);
    const bf16* h = WSP(bf16, WS_HB); float* ssq = WSP(float, WS_SSQ); unsigned* toke = WSP(unsigned, WS_TOKE); float* tokw = WSP(float, WS_TOKW); unsigned* wgcnt = WSP(unsigned, WS_WGCNT);
    const int lane = F.lane;
    for (int tile = F.vcu; tile < M / 256; tile += F.G) {
        if (F.tid < 16) hist[F.tid] = 0u;
        __syncthreads();
        for (int t4 = 0; t4 < 32; t4 += 4) {
            u32x2 hq[4][4];
#pragma unroll
            for (int t = 0; t < 4; ++t)
#pragma unroll
                for (int j = 0; j < 4; ++j) hq[t][j] = *((const u32x2*)(h + (size_t)(tile * 256 + F.wave * 32 + t4 + t) * D) + lane + 64 * j);
#pragma unroll
            for (int t = 0; t < 4; ++t) {
                const int tok = tile * 256 + F.wave * 32 + t4 + t;
                f32x4 v[4]; float s = 0.f;
#pragma unroll
                for (int j = 0; j < 4; ++j) { const u32x2 q = hq[t][j]; v[j] = (f32x4){bflo(q.x), bfhi(q.x), bflo(q.y), bfhi(q.y)}; s += (v[j][0] * v[j][0] + v[j][1] * v[j][1]) + (v[j][2] * v[j][2] + v[j][3] * v[j][3]); }
                float lg[NE];
#pragma unroll
                for (int e = 0; e < NE; ++e) { float a = 0.f;
#pragma unroll
                    for (int j = 0; j < 4; ++j) { const f32x4 w = *((const LAS f32x4*)(rw + e * D) + lane + 64 * j); a += (v[j][0] * w[0] + v[j][1] * w[1]) + (v[j][2] * w[2] + v[j][3] * w[3]); }
                    lg[e] = wave_sum(a, lane); }
                s = wave_sum(s, lane);
                const float rs = __builtin_amdgcn_rsqf(s * (1.0f / D) + RMS_EPS);
                int e0 = 0; float v0 = lg[0];
#pragma unroll
                for (int e = 1; e < NE; ++e) if (lg[e] > v0) { v0 = lg[e]; e0 = e; }
                int e1 = -1; float v1 = -INFINITY;
#pragma unroll
                for (int e = 0; e < NE; ++e) if (e != e0 && lg[e] > v1) { v1 = lg[e]; e1 = e; }
                const float w1 = 1.0f / (1.0f + __expf((v0 - v1) * rs)), w0 = 1.0f - w1;
                if (lane < 16) ssq[(size_t)tok * 16 + lane] = lane == 0 ? s : 0.f;
#pragma unroll
                for (int j = 0; j < 4; ++j) *((unsigned*)(hb8 + (size_t)tok * D) + lane + 64 * j) = pk4_fp8(v[j][0], v[j][1], v[j][2], v[j][3]);
                if (lane == 0) { toke[tok] = (unsigned)e0 | ((unsigned)e1 << 8); tokw[2 * tok] = w0; tokw[2 * tok + 1] = w1; __hip_atomic_fetch_add((unsigned*)&hist[e0], 1u, __ATOMIC_RELAXED, __HIP_MEMORY_SCOPE_WORKGROUP); __hip_atomic_fetch_add((unsigned*)&hist[8 + e1], 1u, __ATOMIC_RELAXED, __HIP_MEMORY_SCOPE_WORKGROUP); }
            }
        }
        __syncthreads();
        if (F.tid < 16) wgcnt[tile * 16 + F.tid] = hist[F.tid];
        __syncthreads();
    }
}
DI void moe_slots(Frame& F) {
    LAS unsigned* cnt = (LAS unsigned*)(F.lds + RING_OFF);
    LAS unsigned* tot = cnt + 4096;
    LAS unsigned* seg = tot + 16;
    LAS unsigned* pre = seg + 16;
    LAS unsigned char* es = (LAS unsigned char*)(pre + 16);
    const unsigned* wgcnt = WSP(unsigned, WS_WGCNT); const unsigned* toke = WSP(unsigned, WS_TOKE); const float* tokw = WSP(float, WS_TOKW);
    int* slot_tok = WSP(int, WS_SLOTTOK); float* slot_w = WSP(float, WS_SLOTW); float* slot_rs = WSP(float, WS_SLOTRS); const float* ssq = WSP(float, WS_SSQ); int* tab = WSP(int, WS_MOETAB);
    for (int i = F.tid; i < 4096; i += NWAVES * 64) cnt[i] = wgcnt[i];
    __syncthreads();
    { const int col = F.tid >> 5, pp = F.tid & 31; unsigned s = 0;
#pragma unroll
      for (int j = 0; j < 8; ++j) s += cnt[(pp * 8 + j) * 16 + col];
#pragma unroll
      for (int o = 1; o < 32; o <<= 1) s += (unsigned)__builtin_amdgcn_ds_bpermute((F.lane ^ o) << 2, (int)s);
      if (pp == 0) tot[col] = s; }
    __syncthreads();
    if (F.tid < 16) { const int k = F.tid >> 3, e = F.tid & 7; unsigned s = 0; for (int e2 = 0; e2 < e; ++e2) s += (tot[k * 8 + e2] + 255u) & ~255u; seg[F.tid] = s; }
    __syncthreads();
    if (F.vcu == 0) {
        if (F.tid < 16) tab[F.tid] = (int)seg[F.tid];
        if (F.tid < 2) { unsigned s = 0; for (int e = 0; e < NE; ++e) s += (tot[F.tid * 8 + e] + 255u) >> 8; tab[16 + F.tid] = (int)s; }
        for (int i = F.tid; i < 2 * MAXTILES; i += NWAVES * 64) { const int k = i / MAXTILES, t = i % MAXTILES; int e = NE - 1;
            for (int e2 = NE - 1; e2 >= 0; --e2) if ((unsigned)(t * 256) < seg[k * 8 + e2] + ((tot[k * 8 + e2] + 255u) & ~255u)) e = e2;
            tab[32 + i] = e; }
    }
    for (int sgi = F.vcu; sgi < 16; sgi += F.G) { const int k = sgi >> 3; const unsigned b0 = seg[sgi] + tot[sgi], b1 = seg[sgi] + ((tot[sgi] + 255u) & ~255u);
        for (unsigned p = b0 + F.tid; p < b1; p += NWAVES * 64) { slot_tok[k * NSLOT + p] = -1; slot_w[k * NSLOT + p] = 0.f; slot_rs[k * NSLOT + p] = 0.f; } }
    for (int tile = F.vcu; tile < M / 256; tile += F.G) {
        __syncthreads();
        { const int col = F.tid >> 5, pp = F.tid & 31; unsigned s = 0;
#pragma unroll
          for (int j = 0; j < 8; ++j) { const int t = pp * 8 + j; s += t < tile ? cnt[t * 16 + col] : 0u; }
#pragma unroll
          for (int o = 1; o < 32; o <<= 1) s += (unsigned)__builtin_amdgcn_ds_bpermute((F.lane ^ o) << 2, (int)s);
          if (pp == 0) pre[col] = s; }
        unsigned ee = 0u;
        if (F.tid < 256) ee = toke[tile * 256 + F.tid];
        LAS unsigned* wcnt = (LAS unsigned*)es;
        unsigned rk[2] = {0u, 0u};
        if (F.tid < 256) {
#pragma unroll
            for (int k = 0; k < 2; ++k) { const unsigned e = (ee >> (8 * k)) & 0xffu;
#pragma unroll
                for (int ex = 0; ex < NE; ++ex) { const unsigned long long b = __ballot(e == (unsigned)ex);
                    if (e == (unsigned)ex) rk[k] = (unsigned)__builtin_popcountll(b & ((1ull << F.lane) - 1ull));
                    if (F.lane == 0) wcnt[F.wave * 16 + k * 8 + ex] = (unsigned)__builtin_popcountll(b); } }
        }
        __syncthreads();
        if (F.tid < 256) {
            const int tok = tile * 256 + F.tid; const float rs = __builtin_amdgcn_rsqf(ssq[(size_t)tok * 16] * (1.0f / D) + RMS_EPS);
#pragma unroll
            for (int k = 0; k < 2; ++k) { const unsigned e = (ee >> (8 * k)) & 0xffu; unsigned rank = rk[k];
                for (int w = 0; w < F.wave; ++w) rank += wcnt[w * 16 + k * 8 + e];
                const unsigned p = seg[k * 8 + e] + pre[k * 8 + e] + rank; slot_tok[k * NSLOT + p] = tok; slot_w[k * NSLOT + p] = tokw[2 * tok + k]; slot_rs[k * NSLOT + p] = rs; }
        }
    }
    __syncthreads();
}
DI void moe_fix(Frame& F, int k, int ntail) {
    const int gw = F.vcu * NWAVES + F.wave, NGW = F.G * NWAVES, lane = F.lane;
    const int* slot_tok = WSP(int, WS_SLOTTOK) + k * NSLOT; const float* slot_w = WSP(float, WS_SLOTW) + k * NSLOT; const float* slab = WSP(float, WS_SLAB);
    const bf16* SRC = k == 0 ? WSP(bf16, WS_HB) : (const bf16*)F.out; bf16* DST = k == 0 ? (bf16*)F.out : WSP(bf16, WS_HB);
    for (int r = gw; r < ntail * 256; r += NGW) {
        const int tok = slot_tok[r]; if (tok < 0) continue;
        const float w = slot_w[r] * (1.0f / W8_DN); const int tile = r >> 8, row = r & 255;
#pragma unroll
        for (int j = 0; j < 4; ++j) {
            f32x4 s = (f32x4){0.f, 0.f, 0.f, 0.f};
#pragma unroll
            for (int kq = 0; kq < pg8::NQ; ++kq) s += *((const f32x4*)(slab + ((size_t)(tile * pg8::NQ + kq) * 256 + row) * D) + lane + 64 * j);
            const u32x2 h = *((const u32x2*)(SRC + (size_t)tok * D) + lane + 64 * j);
            u32x2 o; o.x = pk2(bflo(h.x) + w * s[0], bfhi(h.x) + w * s[1]); o.y = pk2(bflo(h.y) + w * s[2], bfhi(h.y) + w * s[3]);
            *((u32x2*)(DST + (size_t)tok * D) + lane + 64 * j) = o;
        }
    }
}
DI void final_norm(Frame& F, const Args& A) {
    const int gw = F.vcu * NWAVES + F.wave, NGW = F.G * NWAVES, lane = F.lane; const float* gain = A.in[I_NORM_FINAL]; const bf16* HB = WSP(bf16, WS_HB);
    f32x4 gv[4];
#pragma unroll
    for (int j = 0; j < 4; ++j) gv[j] = *((const f32x4*)gain + lane + 64 * j);
    for (int m0 = gw * 4; m0 < M; m0 += NGW * 4) {
        u32x2 q[4][4];
#pragma unroll
        for (int t = 0; t < 4; ++t)
#pragma unroll
            for (int j = 0; j < 4; ++j) q[t][j] = *((const u32x2*)(HB + (size_t)(m0 + t) * D) + lane + 64 * j);
#pragma unroll
        for (int t = 0; t < 4; ++t) { f32x4 v[4]; float s = 0.f; f32x4* xr = (f32x4*)(F.out + (size_t)(m0 + t) * D) + lane;
#pragma unroll
            for (int j = 0; j < 4; ++j) { v[j] = (f32x4){bflo(q[t][j].x), bfhi(q[t][j].x), bflo(q[t][j].y), bfhi(q[t][j].y)}; s += (v[j][0] * v[j][0] + v[j][1] * v[j][1]) + (v[j][2] * v[j][2] + v[j][3] * v[j][3]); }
            const float rs = __builtin_amdgcn_rsqf(wave_sum(s, lane) * (1.0f / D) + RMS_EPS);
#pragma unroll
            for (int j = 0; j < 4; ++j) xr[64 * j] = v[j] * rs * gv[j]; }
    }
}
#ifndef MK_PER_PHASE
#define MK_PER_PHASE 0
#endif
constexpr int NPHASES = 19;

DI void attn_phase(Frame& F, const Args& args, int l) {
    att::Args A{WSP(bf16, WS_Q), WSP(bf16, WS_K), WSP(bf16, WS_V), WSP(bf16, WS_U), METAP(bf16, MO_KM) + (size_t)l * NMETA * KVW, METAP(bf16, MO_VM) + (size_t)l * NMETA * KVW,
                METAP(bf16, MO_UM) + (size_t)l * NMETA * POOLW, args.in[I_SINKS] + l * NH, (bf16*)F.out, WSP(bf16, WS_POOLED)};
    att::phase(F.lds + RING_OFF, A, F.vcu, F.G, F.tid);
}

__global__ void __launch_bounds__(NWAVES * 64, 2) fwd(Args args) {
    extern __shared__ __attribute__((aligned(16))) unsigned char lds[];
    Frame F;
    F.lds = (LAS unsigned char*)lds;
    F.tid = threadIdx.x; F.lane = F.tid & 63; F.wave = __builtin_amdgcn_readfirstlane(F.tid >> 6);
    const int wave0 = F.wave;
    F.G = gridDim.x; { const int bx = blockIdx.x; F.vcu = (F.G % 8 == 0) ? (bx % 8) * (F.G / 8) + bx / 8 : bx; }
    F.out = args.out; F.ws = args.ws;
    for (int u = F.tid; u < (LDS_BYTES - LDSCTL_OFF) / 4; u += NWAVES * 64) ((LAS unsigned*)(F.lds + LDSCTL_OFF))[u] = 0u;
    __syncthreads();
    gu32* ctl = (gu32*)(F.ws + WS_CTL);
    XcdBarrier bar; bar.bar = (unsigned*)(ctl + CW_BAR); bar.x = 0; bar.st = nullptr;
    if (!MK_PER_PHASE) bar = xcd_barrier_post((unsigned*)(ctl + CW_BAR), (volatile LAS unsigned*)(F.lds + MISC_OFF) + 8, F.tid);
    const int lo = args.ph_lo, hi = args.ph_hi;
#define IN(k) (lo <= (k) && (k) < hi)
#define SEAM(k) do { if (IN(k) && IN((k) + 1)) xcd_barrier(bar, (wave0 << 6) | hw_lane()); } while (0)
#define LAUNDER() do { F.ws = args.ws; F.out = args.out; F.tid = (wave0 << 6) | hw_lane(); asm volatile("" : "+s"(F.ws), "+s"(F.out), "+v"(F.tid)); F.lane = F.tid & 63; F.wave = __builtin_amdgcn_readfirstlane(F.tid >> 6); ssq = WSP(float, WS_SSQ); } while (0)
#define META_TASK(n, call) do { LAS float* mscr = (LAS float*)(F.lds + RING_OFF); for (int task = F.vcu; task < (n); task += F.G) { call; } __syncthreads(); } while (0)

    float* ssq;
    if (IN(0)) { LAUNDER(); p0_prologue(F, args); } SEAM(0);

    for (int l = 0; l < 2; ++l) {
        const int pb = l * 6;
        if (IN(pb + 1)) { LAUNDER();
            if (l == 0) { META_TASK(INW / 16, meta::inproj(F, mscr, 0, 16 * task)); } else { META_TASK(768 / 16, meta::inproj(F, mscr, 1, 1024 + 16 * task)); }
            pg8::ProbPlain P{(const char*)WSP(bf16, WS_HB), (const char*)(WSP(bf16, WS_WIN) + (size_t)l * INW * D), D * 2, D * 2, D / 64, 0, 128, (size_t)256 * (D * 2)};
            pg8::StaticOrder S; S.init(M, INW, F.G, (int)blockIdx.x);
            pg8::EpiInProj E{ssq, WSP(bf16, WS_Q), WSP(bf16, WS_K), WSP(bf16, WS_V), WSP(bf16, WS_U), WSP(bf16, WS_G)};
            pg8::gemm_phase<pg8::ProbPlain, pg8::EpiInProj, pg8::StaticOrder, true>(F.lds + RING_OFF, P, S, E, F.tid);
        } SEAM(pb + 1);
        if (IN(pb + 2)) { LAUNDER();
            if (l == 0) { for (int hd = F.vcu; hd < NH + 1; hd += F.G) { if (hd < NH) meta::attn_head(F, args, 0, hd); else meta::pool_rows(F); } }
            attn_phase(F, args, l);
        } SEAM(pb + 2);
        if (IN(pb + 3)) { LAUNDER();
            if (l == 0) { META_TASK(D / 16, meta::merge(F, mscr, 0, 16 * task)); }
            { pg8::ProbPlain P{(const char*)WSP(bf16, WS_POOLED), (const char*)(WSP(bf16, WS_WP) + (size_t)l * D * 256), POOLW * 2, 256 * 2, 256 / 64, 128 * 2, 128, (size_t)256 * (POOLW * 2)};
              pg8::StaticOrder S; S.init(M, D, F.G, (int)blockIdx.x);
              pg8::EpiPoolLift E{WSP(bf16, WS_G), WSP(bf16, WS_Q)};
              pg8::gemm_phase<pg8::ProbPlain, pg8::EpiPoolLift, pg8::StaticOrder, true>(F.lds + RING_OFF, P, S, E, F.tid); }
            VM_WAIT(); __syncthreads();
            { pg8::ProbPlain P{(const char*)F.out, (const char*)(WSP(bf16, WS_WA) + (size_t)l * D * D), D * 2, D * 2, D / 64, 0, 128, (size_t)256 * (D * 2)};
              pg8::StaticOrder S; S.init(M, D, F.G, (int)blockIdx.x);
              pg8::EpiMerge E{WSP(bf16, WS_G), WSP(bf16, WS_Q)};
              pg8::gemm_phase<pg8::ProbPlain, pg8::EpiMerge, pg8::StaticOrder, true>(F.lds + RING_OFF, P, S, E, F.tid); }
        } SEAM(pb + 3);
        if (IN(pb + 4)) { LAUNDER();
            if (l == 0) { META_TASK(D / 16, meta::outproj(F, mscr, 0, 16 * task)); }
            pg8::ProbPlain P{(const char*)WSP(bf16, WS_Q), (const char*)(WSP(bf16, WS_WO) + (size_t)l * D * D), D * 2, D * 2, D / 64, 0, 128, (size_t)256 * (D * 2)};
            pg8::StaticOrder S; S.init(M, D, F.G, (int)blockIdx.x);
            pg8::EpiResid E{WSP(bf16, WS_HB), ssq};
            pg8::gemm_phase<pg8::ProbPlain, pg8::EpiResid, pg8::StaticOrder, true>(F.lds + RING_OFF, P, S, E, F.tid);
        } SEAM(pb + 4);
        if (l == 0) {
            if (IN(5)) { LAUNDER();
                META_TASK(DFF / 16, meta::gu(F, mscr, 16 * task));
                pg8::ProbPlain P{(const char*)WSP(bf16, WS_HB), (const char*)WSP(bf16, WS_WGU), D * 2, D * 2, D / 64, 0, 128, (size_t)256 * (D * 2)};
                pg8::StaticOrder S; S.init(M, 2 * DFF, F.G, (int)blockIdx.x);
                pg8::EpiSwiGLU<false> E{ssq, WSP(bf16, WS_ACT), DFF / 64};
                pg8::gemm_phase<pg8::ProbPlain, pg8::EpiSwiGLU<false>, pg8::StaticOrder, true>(F.lds + RING_OFF, P, S, E, F.tid);
            } SEAM(5);
            if (IN(6)) { LAUNDER();
                META_TASK(D / 16, meta::down(F, mscr, 16 * task));
                pg8::ProbPlain P{(const char*)WSP(bf16, WS_ACT), (const char*)WSP(bf16, WS_WD), 128, 128, DFF / 64, 0, 32768, (size_t)(DFF / 64) * 32768, 32768, (size_t)(DFF / 64) * 32768};
                pg8::StaticOrder S; S.init(M, D, F.G, (int)blockIdx.x); S.rev = true;
                pg8::EpiResid E{WSP(bf16, WS_HB), ssq};
                pg8::gemm_phase<pg8::ProbPlain, pg8::EpiResid, pg8::StaticOrder, true>(F.lds + RING_OFF, P, S, E, F.tid);
            } SEAM(6);
        }
    }
    if (IN(11)) { LAUNDER(); moe_route(F, args); } SEAM(11);
    if (IN(12)) { LAUNDER(); moe_slots(F); } SEAM(12);
    for (int k = 0; k < 2; ++k) {
        const int* tab = WSP(int, WS_MOETAB); const int* slot_tok = WSP(int, WS_SLOTTOK) + k * NSLOT; const float* slot_w = WSP(float, WS_SLOTW) + k * NSLOT;
        if (IN(13 + 2 * k)) { LAUNDER();
            if (k == 1) moe_fix(F, 0, __builtin_amdgcn_readfirstlane(tab[16]) - 256);
            const int ntile = __builtin_amdgcn_readfirstlane(tab[16 + k]);
            LAS int* etab = (LAS int*)(F.lds + XTRA_OFF + 1024);
            for (int i = F.tid; i < MAXTILES; i += NWAVES * 64) etab[i] = tab[32 + k * MAXTILES + i];
            __syncthreads();
            pg8::ProbMoeGU P{(const char*)WSP(unsigned char, WS_POOLED), (const char*)WSP(unsigned char, WS_MGU), D, D, D / 128, slot_tok, etab, (LAS int*)(F.lds + XTRA_OFF), (size_t)2 * DFE * D};
            pg8::LinearOrder S{ntile, 2 * DFE / 256, F.G, F.vcu, false};
            pg8::EpiSwiGLU8 E{WSP(float, WS_SLOTRS) + k * NSLOT, WSP(unsigned char, WS_ACT)};
            pg8::gemm_phase<pg8::ProbMoeGU, pg8::EpiSwiGLU8, pg8::LinearOrder, true, true>(F.lds + RING_OFF, P, S, E, F.tid);
        } SEAM(13 + 2 * k);
        if (IN(14 + 2 * k)) { LAUNDER();
            const int ntile = __builtin_amdgcn_readfirstlane(tab[16 + k]);
            LAS int* etab = (LAS int*)(F.lds + XTRA_OFF + 1024);
            for (int i = F.tid; i < MAXTILES; i += NWAVES * 64) etab[i] = tab[32 + k * MAXTILES + i];
            __syncthreads();
            { pg8::ProbMoeDown P{(const char*)WSP(unsigned char, WS_ACT), (const char*)WSP(unsigned char, WS_MD), 128, 128, DFE / 128, etab, 32768, (size_t)(DFE / 128) * 32768, 32768, (size_t)(DFE / 128) * 32768, (size_t)D * DFE};
              pg8::LinearOrder S{256, D / 256, F.G, F.vcu, true}; S.base = ntile - 256;
              pg8::EpiMoeDown E{k == 0 ? WSP(bf16, WS_HB) : (bf16*)F.out, k == 0 ? (bf16*)F.out : WSP(bf16, WS_HB), slot_tok, slot_w, 1.0f / W8_DN};
              pg8::gemm_phase<pg8::ProbMoeDown, pg8::EpiMoeDown, pg8::LinearOrder, true, true>(F.lds + RING_OFF, P, S, E, F.tid); }
            { pg8::ProbMoeDownQ P{(const char*)WSP(unsigned char, WS_ACT), (const char*)WSP(unsigned char, WS_MD), 128, 128, DFE / 128 / pg8::NQ, etab, (size_t)(DFE / 128) * 32768, (size_t)(DFE / 128) * 32768, (size_t)D * DFE};
              pg8::QuarterOrder S{ntile - 256, F.G, F.vcu};
              pg8::EpiSlab E{WSP(float, WS_SLAB)};
              pg8::gemm_phase<pg8::ProbMoeDownQ, pg8::EpiSlab, pg8::QuarterOrder, true, true>(F.lds + RING_OFF, P, S, E, F.tid); }
        } SEAM(14 + 2 * k);
    }
    if (IN(17)) { LAUNDER(); moe_fix(F, 1, __builtin_amdgcn_readfirstlane(WSP(int, WS_MOETAB)[17]) - 256); } SEAM(17);
    if (IN(18)) { LAUNDER(); final_norm(F, args); }
#undef IN
#undef SEAM
#undef META_TASK
#undef LAUNDER
}

extern "C" void kernel_launch(void* const* d_in, const int* in_sizes, int n_in, void* d_out, int out_size, void* d_ws, size_t ws_size, hipStream_t stream) {
    static int grid = 0;
    if (grid == 0) {
        if (n_in != 18 || in_sizes[0] != M * D || out_size != M * D || ws_size < WS_END) { fprintf(stderr, "kernel_launch: unexpected shapes (n_in %d, in0 %d, out %d, ws %zu); nothing launched\n", n_in, n_in > 0 ? in_sizes[0] : -1, out_size, ws_size); grid = -1; return; }
        int dev = 0, cus = 0, per_cu = 0;
        if (hipGetDevice(&dev) != hipSuccess || hipDeviceGetAttribute(&cus, hipDeviceAttributeMultiprocessorCount, dev) != hipSuccess) { grid = -1; return; }
        if (hipFuncSetAttribute((const void*)fwd, hipFuncAttributeMaxDynamicSharedMemorySize, LDS_BYTES) != hipSuccess) { fprintf(stderr, "kernel_launch: hipFuncSetAttribute failed\n"); grid = -1; return; }
        if (hipOccupancyMaxActiveBlocksPerMultiprocessor(&per_cu, (const void*)fwd, NWAVES * 64, LDS_BYTES) != hipSuccess || per_cu < 1) { fprintf(stderr, "kernel_launch: occupancy query reports %d workgroups per CU\n", per_cu); }
        (void)hipGetLastError();
        grid = cus;
    }
    if (grid < 0) return;
    if (hipMemsetAsync((char*)d_ws + WS_CTL, 0, CTL_ZERO_BYTES, stream) != hipSuccess) return;
    Args a{};
    for (int i = 0; i < 18; ++i) a.in[i] = (const float*)d_in[i];
    a.out = (float*)d_out; a.ws = (unsigned char*)d_ws;
#if MK_PER_PHASE
    for (int p = 0; p < NPHASES; ++p) { a.ph_lo = p; a.ph_hi = p + 1; hipLaunchKernelGGL(fwd, dim3(grid), dim3(NWAVES * 64), LDS_BYTES, stream, a); }
#else
    a.ph_lo = 0; a.ph_hi = NPHASES; hipLaunchKernelGGL(fwd, dim3(grid), dim3(NWAVES * 64), LDS_BYTES, stream, a);
#endif
}
```

```cpp
#include <hip/hip_runtime.h>
#include <cstdio>
#include <cstdint>

#define GAS __attribute__((address_space(1)))
#define LAS __attribute__((address_space(3)))
typedef unsigned short bf16;
typedef short bf16x8 __attribute__((ext_vector_type(8)));
typedef short s16x4 __attribute__((ext_vector_type(4)));
typedef float f32x2 __attribute__((ext_vector_type(2)));
typedef float f32x4 __attribute__((ext_vector_type(4)));
typedef float f32x16 __attribute__((ext_vector_type(16)));
typedef unsigned u32x2 __attribute__((ext_vector_type(2)));
typedef unsigned u32x4 __attribute__((ext_vector_type(4)));
typedef GAS unsigned gu32;
#define RLX_AGENT __ATOMIC_RELAXED, __HIP_MEMORY_SCOPE_AGENT
#define LDS_WAIT() asm volatile("s_waitcnt lgkmcnt(0)" ::: "memory")
#define VM_WAIT() asm volatile("s_waitcnt vmcnt(0)" ::: "memory")
#define DI __device__ __forceinline__

constexpr int NB = 8, SEQ = 8192, D = 1024, M = NB * SEQ;
constexpr int NMETA = 16;
constexpr int NH = 16, HD = 64, NKV = 2, QG = 8, KVW = 128, POOLW = 512;
constexpr int USEQ = SEQ + NMETA;
constexpr int INW = 3840;
constexpr int DFF = 2816, NE = 8, DFE = 3584;
constexpr float RMS_EPS = 1e-5f;
constexpr float LOG2E = 1.4426950408889634f;
constexpr float QSCALE = 0.125f * LOG2E;
constexpr int NSLOT = M + NE * 256;
constexpr int MAXTILES = NSLOT / 256;

constexpr size_t MiB = 1u << 20;
constexpr size_t WS_CTL = 0, CTL_ZERO_BYTES = 1 * MiB;
constexpr size_t WS_SSQ = 1 * MiB;
constexpr size_t WS_TOKE = 5 * MiB;
constexpr size_t WS_TOKW = 5 * MiB + 512 * 1024;
constexpr size_t WS_SLOTTOK = 6 * MiB;
constexpr size_t WS_SLOTW = 7 * MiB;
constexpr size_t WS_WGCNT = 8 * MiB;
constexpr size_t WS_MOETAB = 8 * MiB + 64 * 1024;
constexpr size_t WS_SLOTRS = 8 * MiB + 128 * 1024;
constexpr size_t WS_META = 9 * MiB;
constexpr size_t WS_WIN = 16 * MiB;
constexpr size_t WS_WA = 31 * MiB;
constexpr size_t WS_WP = 35 * MiB;
constexpr size_t WS_WO = 36 * MiB;
constexpr size_t WS_WGU = 40 * MiB;
constexpr size_t WS_WD = 51 * MiB;
constexpr size_t WS_MGU = 57 * MiB;
constexpr size_t WS_MD = 169 * MiB;
constexpr size_t WS_HB = 225 * MiB;
constexpr size_t WS_POOLED = 353 * MiB;
constexpr size_t WS_Q = 417 * MiB;
constexpr size_t WS_K = 545 * MiB;
constexpr size_t WS_V = 561 * MiB;
constexpr size_t WS_U = 577 * MiB;
constexpr size_t WS_G = 642 * MiB;
constexpr size_t WS_ACT = 417 * MiB;
constexpr size_t WS_SLAB = 898 * MiB;
constexpr size_t WS_END = 930 * MiB;
static_assert(WS_ACT + (size_t)NSLOT * DFE * 2 <= WS_END && WS_ACT + (size_t)M * DFF * 2 <= WS_END, "act overlay");
constexpr size_t MO_HM = 0;
constexpr size_t MO_XM = 64 * 1024;
constexpr size_t MO_PROJ = 96 * 1024;
constexpr size_t MO_KM = 336 * 1024;
constexpr size_t MO_VM = 344 * 1024;
constexpr size_t MO_UM = 352 * 1024;
constexpr size_t MO_ATT = 384 * 1024;
constexpr size_t MO_POOL = 416 * 1024;
constexpr size_t MO_MRG = 432 * 1024;
constexpr size_t MO_ACT = 464 * 1024;
constexpr int CW_TMO = 0, CW_CODE = 1, CW_BAR = 4096;

constexpr int RING_OFF = 0, RING_BYTES = 147456;
constexpr int LDSCTL_OFF = RING_BYTES, MISC_OFF = LDSCTL_OFF + 320;
constexpr int XTRA_OFF = LDSCTL_OFF + 1024;
constexpr int LDS_BYTES = RING_BYTES + 4096;

DI unsigned f2bf(float f) { unsigned u = __builtin_bit_cast(unsigned, f); return (u + 0x7fffu + ((u >> 16) & 1u)) >> 16; }
DI unsigned pk2(float lo, float hi) { unsigned r; asm volatile("v_cvt_pk_bf16_f32 %0, %1, %2" : "=v"(r) : "v"(lo), "v"(hi)); return r; }
DI float sat8(float v) { return __builtin_amdgcn_fmed3f(v, -448.f, 448.f); }
DI unsigned pk4_fp8(float a, float b, float c, float d) { int w = __builtin_amdgcn_cvt_pk_fp8_f32(sat8(a), sat8(b), 0, false); w = __builtin_amdgcn_cvt_pk_fp8_f32(sat8(c), sat8(d), w, true); return (unsigned)w; }
constexpr float W8_GU = 64.f, W8_DN = 128.f;
DI float bf2f(unsigned short b) { return __builtin_bit_cast(float, (unsigned)b << 16); }
DI float bflo(unsigned w) { return __builtin_bit_cast(float, w << 16); }
DI float bfhi(unsigned w) { return __builtin_bit_cast(float, w & 0xffff0000u); }
DI int hw_lane() { int l; asm volatile("v_mbcnt_lo_u32_b32 %0, -1, 0\n\tv_mbcnt_hi_u32_b32 %0, -1, %0" : "=v"(l)); return l; }
DI float shx(float v, int mask, int lane) { return __builtin_bit_cast(float, __builtin_amdgcn_ds_bpermute((lane ^ mask) << 2, __builtin_bit_cast(int, v))); }
DI float wave_sum(float v, int lane) {
#pragma unroll
    for (int o = 1; o < 64; o <<= 1) v += shx(v, o, lane);
    return v;
}
DI float fast_sigmoid(float x) { return __builtin_amdgcn_rcpf(1.f + __builtin_amdgcn_exp2f(-x * LOG2E)); }
DI float sigmoid_scaled(float a, float nsl2) { return __builtin_amdgcn_rcpf(1.f + __builtin_amdgcn_exp2f(a * nsl2)); }

#define XB_TMO      128
#define XB_XCNT(j)  (256  + 64 * (j))
#define XB_XSUB(j)  (1280 + 64 * (j))
#define XB_XGEN(j)  (2304 + 64 * (j))
#define XB_TOP      3328
#define XB_TOPGEN   3392
#define XCD_BAR_WORDS 3456
#define XB_SPIN_CAP (1u << 18)
DI unsigned xb_ld(unsigned* p)              { return __hip_atomic_load(p, __ATOMIC_RELAXED, __HIP_MEMORY_SCOPE_AGENT); }
DI unsigned xb_add(unsigned* p, unsigned v) { return __hip_atomic_fetch_add(p, v, __ATOMIC_RELAXED, __HIP_MEMORY_SCOPE_AGENT); }
DI unsigned xb_xcc_id() { return (unsigned)__builtin_amdgcn_s_getreg((3 << 11) | 20) & 0xFu; }
#define XB_SPIN(cond, bar) do { unsigned _sp = 0; while (cond) { __builtin_amdgcn_s_sleep(1); \
    if ((++_sp & 255u) == 0u) { if (xb_ld(&(bar)[XB_TMO])) break; if (_sp > XB_SPIN_CAP) { atomicAdd(&(bar)[XB_TMO], 1u); break; } } } } while (0)
struct XcdBarrier { unsigned* bar; unsigned x; volatile LAS unsigned* st; };
DI XcdBarrier xcd_barrier_post(unsigned* bar, volatile LAS unsigned* st, int tid) {
    XcdBarrier b; b.bar = bar; b.x = xb_xcc_id(); b.st = st;
    if (tid == 0) (void)xb_add(&bar[XB_XCNT(b.x)], 1u);
    return b;
}
DI void xcd_barrier_complete(unsigned* bar, unsigned x, unsigned& nloc, unsigned& nx) {
    const unsigned G = gridDim.x * gridDim.y * gridDim.z;
    unsigned sum, cnt, mine, sp = 0u;
    for (;;) {
        sum = 0u; cnt = 0u; mine = 0u;
#pragma unroll
        for (unsigned j = 0; j < 16; ++j) { const unsigned c = xb_ld(&bar[XB_XCNT(j)]); sum += c; cnt += (c > 0u) ? 1u : 0u; mine = (j == x) ? c : mine; }
        if (sum == G) break;
        __builtin_amdgcn_s_sleep(1);
        if ((++sp & 255u) == 0u) { if (xb_ld(&bar[XB_TMO])) break; if (sp > XB_SPIN_CAP) { atomicAdd(&bar[XB_TMO], 1u); break; } }
    }
    nloc = mine > 0u ? mine : 1u; nx = cnt > 0u ? cnt : 1u;
}
DI void xcd_barrier(const XcdBarrier& b, int tid) {
    asm volatile("s_waitcnt vmcnt(0)" ::: "memory");
    __syncthreads();
    if (tid == 0) {
        unsigned* bar = b.bar;
        __builtin_amdgcn_s_waitcnt(0);
        unsigned nloc = b.st[0], nx = b.st[1];
        if (nloc == 0u) { xcd_barrier_complete(bar, b.x, nloc, nx); b.st[0] = nloc; b.st[1] = nx; }
        const unsigned old = xb_add(&bar[XB_XSUB(b.x)], 1u);
        const unsigned gen = old / nloc;
        if (old + 1u == (gen + 1u) * nloc) {
            __builtin_amdgcn_fence(__ATOMIC_RELEASE, "agent");
            asm volatile("s_waitcnt vmcnt(0)" ::: "memory");
            const unsigned og = xb_add(&bar[XB_TOP], 1u);
            const unsigned tg = og / nx;
            if (og + 1u == (tg + 1u) * nx) xb_add(&bar[XB_TOPGEN], 1u);
            else XB_SPIN(xb_ld(&bar[XB_TOPGEN]) == tg, bar);
            __builtin_amdgcn_fence(__ATOMIC_ACQUIRE, "agent");
            xb_add(&bar[XB_XGEN(b.x)], 1u);
            asm volatile("s_waitcnt vmcnt(0)" ::: "memory");
        } else {
            XB_SPIN(xb_ld(&bar[XB_XGEN(b.x)]) == gen, bar);
            __builtin_amdgcn_fence(__ATOMIC_ACQUIRE, "agent");
            asm volatile("s_waitcnt vmcnt(0)" ::: "memory");
        }
    }
    __syncthreads();
}
namespace pg8 {
constexpr int BM = 256, BK = 64, HALF = 128, HTB = HALF * BK * 2, STAGE_BYTES = 8 * HTB, NXCD = 8, WGM = 8;
__host__ __device__ __forceinline__ int lds_byte(int r, int c) { const int st = (r >> 4) * 2 + (c >> 5), rr = r & 15, cc = c & 31, ob = rr * 64 + cc * 2; return st * 1024 + (ob ^ (((ob >> 9) & 1) << 5)); }
__host__ __device__ __forceinline__ void stage_rc(int b, int& R, int& C) { const int st = b / 1024, sb = b % 1024, swz = sb ^ (((sb >> 9) & 1) << 5); R = (st >> 1) * 16 + swz / 64; C = (st & 1) * 32 + (swz % 64) / 2; }
__host__ __device__ __forceinline__ int perm32(int rho) { const int n = rho >> 4, i = rho & 15; return 8 * (i >> 2) + 4 * n + (i & 3); }

struct Unit { int pm, pn; int kq = 0; };

struct StaticOrder {
    int nM, nN, nwg, G, c; bool rev = false;
    DI void init(int M_, int N_, int G_, int c_) { nM = M_ / BM; nN = N_ / BM; nwg = nM * nN; G = G_; c = c_; }
    DI bool next(int i, Unit& u) const {
        const long L = (long)i * G + c; if (L >= nwg) return false;
        int wgid = (int)L; { const int q = nwg / NXCD, r = nwg % NXCD, xcd = wgid % NXCD, off = wgid / NXCD; wgid = (xcd < r ? xcd * (q + 1) : r * (q + 1) + (xcd - r) * q) + off; }
        const int nig = WGM * nN, gid = wgid / nig, fm = gid * WGM, gsz = (nM - fm) < WGM ? (nM - fm) : WGM;
        u.pm = fm + ((wgid % nig) % gsz); u.pn = (wgid % nig) / gsz; if (rev) u.pm = nM - 1 - u.pm; return true;
    }
};
struct LinearOrder {
    int ntile, nN, G, c; bool rev; int base = 0;
    DI bool next(int i, Unit& u) const {
        const long L = (long)i * G + c; if (L >= (long)ntile * nN) return false;
        constexpr int gt = 8; const int per8 = gt * nN, g = (int)(L / per8), w = (int)(L % per8), gsz = (ntile - gt * g) < gt ? (ntile - gt * g) : gt;
        u.pm = gt * g + w % gsz; u.pn = w / gsz; if (rev) u.pm = ntile - 1 - u.pm; u.pm += base; return true; }
};
constexpr int NQ = 2;
struct QuarterOrder {
    int ntail, G, c;
    DI bool next(int i, Unit& u) const { const long L = (long)i * G + c; if (L >= (long)ntail * 4 * NQ) return false; u.pm = (int)(L / (4 * NQ)); u.pn = (int)((L / NQ) & 3); u.kq = (int)(L % NQ); return true; }
};

struct ProbPlain {
    static constexpr bool GATHER = false;
    const char* A; const char* Bt; unsigned lda2, ldb2; int nt; unsigned acol2;
    unsigned kstepA; size_t panelA;
    unsigned kstepB = 128; size_t panelB = 0;
    DI unsigned a_base(const Unit& u) const { return (unsigned)((size_t)u.pm * panelA + (size_t)u.pn * acol2); }
    DI unsigned b_base(const Unit& u) const { return (unsigned)((size_t)u.pn * (panelB ? panelB : (size_t)BM * ldb2)); }
    DI unsigned a_row(const Unit&, int r) const { return (unsigned)r * lda2; }
};
struct ProbMoeGU {
    static constexpr bool GATHER = true;
    static constexpr unsigned kstepA = 128, kstepB = 128;
    const char* A; const char* Bt; unsigned lda2, ldb2; int nt; const int* slot_tok; const LAS int* tile_e; LAS int* gtab; size_t estride;
    DI unsigned a_base(const Unit&) const { return 0u; }
    DI unsigned a_row_lds(int r) const { int t = gtab[r]; t = t < 0 ? 0 : t; return (unsigned)t * lda2; }
    DI void prefetch_rows(const Unit& u, int wid, int lane) const { if (wid < 4) __builtin_amdgcn_global_load_lds((const unsigned*)(slot_tok + u.pm * BM + wid * 64 + lane), (LAS unsigned*)(gtab + wid * 64), 4, 0, 0); }
    DI unsigned b_base(const Unit& u) const { return (unsigned)((size_t)tile_e[u.pm] * estride + (size_t)u.pn * BM * ldb2); }
    DI unsigned a_row(const Unit& u, int r) const { int t = slot_tok[u.pm * BM + r]; t = t < 0 ? 0 : t; return (unsigned)t * lda2; }
};
struct ProbMoeDown {
    static constexpr bool GATHER = false;
    const char* A; const char* Bt; unsigned lda2, ldb2; int nt; const LAS int* tile_e; unsigned kstepA; size_t panelA; unsigned kstepB; size_t panelB; size_t estride;
    DI unsigned a_base(const Unit& u) const { return (unsigned)((size_t)u.pm * panelA); }
    DI unsigned b_base(const Unit& u) const { return (unsigned)((size_t)tile_e[u.pm] * estride + (size_t)u.pn * panelB); }
    DI unsigned a_row(const Unit&, int r) const { return (unsigned)r * lda2; }
};

struct ProbMoeDownQ {
    static constexpr bool GATHER = false; static constexpr unsigned kstepA = 32768, kstepB = 32768;
    const char* A; const char* Bt; unsigned lda2, ldb2; int nt; const LAS int* tile_e; size_t panelA, panelB, estride;
    DI unsigned a_base(const Unit& u) const { return (unsigned)((size_t)u.pm * panelA + (size_t)u.kq * nt * 32768); }
    DI unsigned b_base(const Unit& u) const { return (unsigned)((size_t)tile_e[u.pm] * estride + (size_t)u.pn * panelB + (size_t)u.kq * nt * 32768); }
    DI unsigned a_row(const Unit&, int r) const { return (unsigned)r * lda2; }
};

template <class Prob, class Epi, class Sched, bool ALIGN_EPI, bool FP8 = false>
DI void gemm_phase(LAS unsigned char* lds, const Prob& P, const Sched& S, const Epi& E, int tid) {
    asm volatile("" : "+v"(tid));
    const int wid = __builtin_amdgcn_readfirstlane(tid >> 6), lane = tid & 63, wr = wid >> 2, wc = wid & 3, fr = lane & 15, fq = lane >> 4;
    const int nt = P.nt;
    int R0, C0, R1, C1; stage_rc(tid * 16, R0, C0); stage_rc(tid * 16 + 8192, R1, C1);
    const int Rb0 = Epi::PERM ? ((R0 & ~31) + perm32(R0 & 31)) : R0, Rb1 = Epi::PERM ? ((R1 & ~31) + perm32(R1 & 31)) : R1;
    const unsigned voffB0 = (unsigned)Rb0 * P.ldb2 + (unsigned)C0 * 2u, voffB1 = (unsigned)Rb1 * P.ldb2 + (unsigned)C1 * 2u;
    const unsigned kstep = P.kstepB, kstepA = P.kstepA;
    const unsigned hstepB = (unsigned)HALF * P.ldb2;
    const __amdgpu_buffer_rsrc_t rsA = __builtin_amdgcn_make_buffer_rsrc((void*)P.A, 0, -1, 0x00020000), rsB = __builtin_amdgcn_make_buffer_rsrc((void*)P.Bt, 0, -1, 0x00020000);
    const unsigned ldsw = (unsigned)wid * 1024u;
    const int aoff = lds_byte(wr * 64 + fr, fq * 8), boff = lds_byte(wc * 32 + fr, fq * 8);
#define PG8_SA(b, h) (((b) * 2 + (h)) * HTB)
#define PG8_SB(b, h) ((4 + (b) * 2 + (h)) * HTB)
#define PG8_STGX(rs, bufoff, soff, v0, v1) do { \
        __builtin_amdgcn_raw_ptr_buffer_load_lds(rs, (LAS unsigned*)(lds + (bufoff) + ldsw), 16, (int)(v0), (int)(soff), 0, 0); \
        __builtin_amdgcn_raw_ptr_buffer_load_lds(rs, (LAS unsigned*)(lds + (bufoff) + ldsw + 8192), 16, (int)(v1), (int)(soff), 0, 0); } while (0)
#define PG8_STG(bufoff, soff, v0, v1) PG8_STGX(rsA, bufoff, soff, v0, v1)
#define PG8_STGB(bufoff, soff) PG8_STGX(rsB, bufoff, soff, voffB0, voffB1)
#define PG8_LDA(dst, b, h) do { if constexpr (FP8) { _Pragma("unroll") for (int m = 0; m < 4; ++m) { const i32x4_ lo_ = *(const LAS i32x4_*)(lds + PG8_SA(b, h) + aoff + m * 2048), hi_ = *(const LAS i32x4_*)(lds + PG8_SA(b, h) + aoff + m * 2048 + 1024); dst##8[m] = __builtin_shufflevector(lo_, hi_, 0, 1, 2, 3, 4, 5, 6, 7); } } \
        else { _Pragma("unroll") for (int m = 0; m < 4; ++m) _Pragma("unroll") for (int k = 0; k < 2; ++k) dst[m][k] = *(const LAS bf16x8*)(lds + PG8_SA(b, h) + aoff + m * 2048 + k * 1024); } } while (0)
#define PG8_LDB(dst, b, h) do { if constexpr (FP8) { _Pragma("unroll") for (int n = 0; n < 2; ++n) { const i32x4_ lo_ = *(const LAS i32x4_*)(lds + PG8_SB(b, h) + boff + n * 2048), hi_ = *(const LAS i32x4_*)(lds + PG8_SB(b, h) + boff + n * 2048 + 1024); dst##8[n] = __builtin_shufflevector(lo_, hi_, 0, 1, 2, 3, 4, 5, 6, 7); } } \
        else { _Pragma("unroll") for (int n = 0; n < 2; ++n) _Pragma("unroll") for (int k = 0; k < 2; ++k) dst[n][k] = *(const LAS bf16x8*)(lds + PG8_SB(b, h) + boff + n * 2048 + k * 1024); } } while (0)
#define PG8_MMA(ai, bj, At, Bt) do { __builtin_amdgcn_s_setprio(1); _Pragma("unroll") for (int m = 0; m < 4; ++m) _Pragma("unroll") for (int n = 0; n < 2; ++n) { \
        if constexpr (FP8) { acc[ai][bj][m][n] = __builtin_amdgcn_mfma_scale_f32_16x16x128_f8f6f4(Bt##8[n], At##8[m], acc[ai][bj][m][n], 0, 0, 0, 0x7f7f7f7f, 0, 0x7f7f7f7f); } \
        else { _Pragma("unroll") for (int k = 0; k < 2; ++k) acc[ai][bj][m][n] = __builtin_amdgcn_mfma_f32_16x16x32_bf16(Bt[n][k], At[m][k], acc[ai][bj][m][n], 0, 0, 0); } } \
        __builtin_amdgcn_s_setprio(0); } while (0)
#define PG8_WAIT_V(n) asm volatile("s_waitcnt vmcnt(" #n ")" ::: "memory")
#define PG8_WAIT_L(n) asm volatile("s_waitcnt lgkmcnt(" #n ")" ::: "memory")
#define PG8_BAR __builtin_amdgcn_s_barrier()
#define PG8_SCHED __builtin_amdgcn_sched_barrier(0)
    Unit cur, nxt; int ui = 0;
    if (!S.next(0, cur)) return;
    f32x4 acc[2][2][4][2];
#pragma unroll
    for (int a = 0; a < 2; ++a)
#pragma unroll
        for (int b = 0; b < 2; ++b)
#pragma unroll
            for (int m = 0; m < 4; ++m)
#pragma unroll
                for (int n = 0; n < 2; ++n) acc[a][b][m][n] = (f32x4){0.f, 0.f, 0.f, 0.f};
    bf16x8 At[4][2], B0[2][2], B1[2][2];
    typedef int i32x8_ __attribute__((ext_vector_type(8))); typedef int i32x4_ __attribute__((ext_vector_type(4)));
    i32x8_ At8[4], B08[2], B18[2];
    unsigned vc00, vc01, vc10, vc11;
#define PG8_AOFF(u, o00, o01, o10, o11) do { o00 = P.a_row(u, R0) + (unsigned)C0 * 2u; o01 = P.a_row(u, R1) + (unsigned)C1 * 2u; \
        o10 = P.a_row(u, HALF + R0) + (unsigned)C0 * 2u; o11 = P.a_row(u, HALF + R1) + (unsigned)C1 * 2u; } while (0)
    PG8_AOFF(cur, vc00, vc01, vc10, vc11);
    unsigned cA = P.a_base(cur), cB = P.b_base(cur);
    PG8_STGB(PG8_SB(0, 0), cB); PG8_STGB(PG8_SB(0, 1), cB + hstepB); PG8_STG(PG8_SA(0, 0), cA, vc00, vc01); PG8_STG(PG8_SA(0, 1), cA, vc10, vc11);
    if (wr == 1) PG8_BAR;
    PG8_WAIT_V(2); PG8_BAR;
    PG8_STGB(PG8_SB(1, 0), cB + kstep); PG8_STG(PG8_SA(1, 0), cA + kstepA, vc00, vc01); PG8_STGB(PG8_SB(1, 1), cB + hstepB + kstep);
    PG8_WAIT_V(6); PG8_BAR;
    for (;;) {
        const bool has_next = S.next(ui + 1, nxt);
        unsigned nA = cA, nB = cB;
        if (has_next) { nA = P.a_base(nxt); nB = P.b_base(nxt); if constexpr (Prob::GATHER) { P.prefetch_rows(nxt, wid, lane); } }
        for (int t = 0; t < nt; t += 2) {
            const bool last = (t == nt - 2);
            const unsigned a1 = cA + (unsigned)(t + 1) * kstepA;
            const unsigned a2 = last ? nA : cA + (unsigned)(t + 2) * kstepA, b2 = last ? nB : cB + (unsigned)(t + 2) * kstep;
            const unsigned a3 = a2 + kstepA, b3 = b2 + kstep;
            PG8_LDB(B0, 0, 0); PG8_LDB(B1, 0, 1); PG8_SCHED; PG8_LDA(At, 0, 0); PG8_STG(PG8_SA(1, 1), a1, vc10, vc11);
            if constexpr (Prob::GATHER) { if (last && has_next) {
                vc00 = P.a_row_lds(R0) + (unsigned)C0 * 2u; vc01 = P.a_row_lds(R1) + (unsigned)C1 * 2u; vc10 = P.a_row_lds(HALF + R0) + (unsigned)C0 * 2u; vc11 = P.a_row_lds(HALF + R1) + (unsigned)C1 * 2u; } }
            PG8_WAIT_V(8); PG8_WAIT_L(0); PG8_BAR; PG8_MMA(0, 0, At, B0); PG8_MMA(0, 1, At, B1); PG8_BAR; PG8_SCHED;
            PG8_LDA(At, 0, 1); PG8_STGB(PG8_SB(0, 0), b2); PG8_STGB(PG8_SB(0, 1), b2 + hstepB); PG8_STG(PG8_SA(0, 0), a2, vc00, vc01);
            PG8_WAIT_V(8); PG8_WAIT_L(0); PG8_BAR; PG8_MMA(1, 0, At, B0); PG8_MMA(1, 1, At, B1); PG8_BAR; PG8_SCHED;
            PG8_LDB(B0, 1, 0); PG8_LDB(B1, 1, 1); PG8_SCHED; PG8_LDA(At, 1, 0); PG8_STG(PG8_SA(0, 1), a2, vc10, vc11);
            PG8_WAIT_V(8); PG8_WAIT_L(0); PG8_BAR; PG8_MMA(0, 0, At, B0); PG8_MMA(0, 1, At, B1); PG8_BAR; PG8_SCHED;
            PG8_LDA(At, 1, 1); PG8_STGB(PG8_SB(1, 0), b3); PG8_STGB(PG8_SB(1, 1), b3 + hstepB); PG8_STG(PG8_SA(1, 0), a3, vc00, vc01);
            PG8_WAIT_V(8); PG8_WAIT_L(0); PG8_BAR; PG8_MMA(1, 0, At, B0); PG8_MMA(1, 1, At, B1); PG8_BAR; PG8_SCHED;
        }
        if constexpr (ALIGN_EPI) { if (wr == 0) PG8_BAR; }
        PG8_SCHED; E(acc, cur, wr, wc, fr, fq); PG8_SCHED;
        if (!has_next) break;
#pragma unroll
        for (int a = 0; a < 2; ++a)
#pragma unroll
            for (int b = 0; b < 2; ++b)
#pragma unroll
                for (int m = 0; m < 4; ++m)
#pragma unroll
                    for (int n = 0; n < 2; ++n) acc[a][b][m][n] = (f32x4){0.f, 0.f, 0.f, 0.f};
        cur = nxt; cA = nA; cB = nB; ++ui;
        if constexpr (ALIGN_EPI) { if (wr == 1) PG8_BAR; }
    }
    PG8_WAIT_V(0);
    if constexpr (!ALIGN_EPI) { if (wr == 0) PG8_BAR; }
    PG8_BAR;
#undef PG8_SA
#undef PG8_SB
#undef PG8_STG
#undef PG8_STGX
#undef PG8_STGB
#undef PG8_LDA
#undef PG8_LDB
#undef PG8_MMA
#undef PG8_WAIT_V
#undef PG8_WAIT_L
#undef PG8_BAR
#undef PG8_SCHED
#undef PG8_AOFF
}
}
namespace pg8 {
DI u32x4 pack8(const f32x4 v0, const f32x4 v1) { u32x4 w; w.x = pk2(v0[0], v0[1]); w.y = pk2(v0[2], v0[3]); w.z = pk2(v1[0], v1[1]); w.w = pk2(v1[2], v1[3]); return w; }

DI void rstd4_load(f32x4 (&p)[4], const float* ssq16, int row0, int fq) {
#pragma unroll
    for (int m = 0; m < 4; ++m) p[m] = *(const f32x4*)(ssq16 + (size_t)(row0 + m * 16) * 16 + 4 * fq);
}
DI float rstd_finish(const f32x4 p, int lane) { float s = (p[0] + p[1]) + (p[2] + p[3]); s += shx(s, 16, lane); s += shx(s, 32, lane); return __builtin_amdgcn_rsqf(s * (1.0f / D) + RMS_EPS); }
#define EPI_FENCE() asm volatile("" ::: "memory")

struct EpiInProj {
    static constexpr bool PERM = true, TWICE_OK = true;
    const float* ssq16; bf16 *Q, *K, *V, *U, *G;
    DI void operator()(const f32x4 (&acc)[2][2][4][2], const Unit& u, int wr, int wc, int fr, int fq) const {
        const int row0 = u.pm * BM + wr * 64 + fr, cw = wc * 32 + 8 * fq;
        const int pn = u.pn;
        bf16* base0; bf16* base1; int ldc, col0, col1, mode;
        if (pn < 4) { base0 = base1 = Q; ldc = D; col0 = pn * 256 + cw; col1 = col0 + HALF; mode = 1; }
        else if (pn == 4) { base0 = K; base1 = V; ldc = KVW; col0 = col1 = cw; mode = 0; }
        else if (pn < 7) { base0 = base1 = U + (size_t)(NMETA * ((u.pm >> 5) + 1)) * POOLW; ldc = POOLW; col0 = (pn - 5) * 256 + cw; col1 = col0 + HALF; mode = 0; }
        else { base0 = base1 = G; ldc = 2 * D; col0 = (pn - 7) * 256 + cw; col1 = col0 + HALF; mode = 2; }
        f32x4 pp[2][4]; rstd4_load(pp[0], ssq16, row0, fq); rstd4_load(pp[1], ssq16, row0 + HALF, fq);
#pragma unroll
        for (int ai = 0; ai < 2; ++ai) {
#pragma unroll
            for (int m = 0; m < 4; ++m) {
                const int row = row0 + ai * HALF + m * 16;
                const float sc = rstd_finish(pp[ai][m], fq * 16 + fr) * (mode == 1 ? QSCALE : 1.f);
#pragma unroll
                for (int bj = 0; bj < 2; ++bj) {
                    f32x4 v0, v1;
                    if (mode == 2) { const float nsl2 = -sc * LOG2E;
#pragma unroll
                        for (int j = 0; j < 4; ++j) { v0[j] = sigmoid_scaled(acc[ai][bj][m][0][j], nsl2); v1[j] = sigmoid_scaled(acc[ai][bj][m][1][j], nsl2); }
                    } else { v0 = acc[ai][bj][m][0] * sc; v1 = acc[ai][bj][m][1] * sc; }
                    *(u32x4*)((bj ? base1 : base0) + (size_t)row * ldc + (bj ? col1 : col0)) = pack8(v0, v1);
                }
            }
            EPI_FENCE();
        }
    }
};
struct EpiPoolLift {
    static constexpr bool PERM = true, TWICE_OK = false;
    const bf16* G; bf16* MRG;
    DI void operator()(const f32x4 (&acc)[2][2][4][2], const Unit& u, int wr, int wc, int fr, int fq) const {
        const int row0 = u.pm * BM + wr * 64 + fr, col0 = u.pn * BM + wc * 32 + 8 * fq;
#pragma unroll
        for (int ai = 0; ai < 2; ++ai) {
            u32x4 g[4][2];
#pragma unroll
            for (int m = 0; m < 4; ++m)
#pragma unroll
                for (int bj = 0; bj < 2; ++bj) g[m][bj] = *(const u32x4*)(G + (size_t)(row0 + ai * HALF + m * 16) * (2 * D) + D + col0 + bj * HALF);
#pragma unroll
            for (int m = 0; m < 4; ++m) { const size_t r = (size_t)(row0 + ai * HALF + m * 16);
#pragma unroll
                for (int bj = 0; bj < 2; ++bj) { const u32x4 gg = g[m][bj];
                    f32x4 v0 = acc[ai][bj][m][0], v1 = acc[ai][bj][m][1];
                    v0[0] *= bflo(gg.x); v0[1] *= bfhi(gg.x); v0[2] *= bflo(gg.y); v0[3] *= bfhi(gg.y);
                    v1[0] *= bflo(gg.z); v1[1] *= bfhi(gg.z); v1[2] *= bflo(gg.w); v1[3] *= bfhi(gg.w);
                    *(u32x4*)(MRG + r * D + col0 + bj * HALF) = pack8(v0, v1); } }
            EPI_FENCE();
        }
    }
};
struct EpiMerge {
    static constexpr bool PERM = true, TWICE_OK = false;
    const bf16* G; bf16* MRG;
    DI void operator()(const f32x4 (&acc)[2][2][4][2], const Unit& u, int wr, int wc, int fr, int fq) const {
        const int row0 = u.pm * BM + wr * 64 + fr, col0 = u.pn * BM + wc * 32 + 8 * fq;
#pragma unroll
        for (int ai = 0; ai < 2; ++ai) {
            u32x4 g[4][2], pv[4][2];
#pragma unroll
            for (int m = 0; m < 4; ++m)
#pragma unroll
                for (int bj = 0; bj < 2; ++bj) { const size_t r = (size_t)(row0 + ai * HALF + m * 16); g[m][bj] = *(const u32x4*)(G + r * (2 * D) + col0 + bj * HALF); pv[m][bj] = *(const u32x4*)(MRG + r * D + col0 + bj * HALF); }
#pragma unroll
            for (int m = 0; m < 4; ++m) { const size_t r = (size_t)(row0 + ai * HALF + m * 16);
#pragma unroll
                for (int bj = 0; bj < 2; ++bj) { const u32x4 gg = g[m][bj], p = pv[m][bj];
                    f32x4 v0 = acc[ai][bj][m][0], v1 = acc[ai][bj][m][1];
                    v0[0] = v0[0] * bflo(gg.x) + bflo(p.x); v0[1] = v0[1] * bfhi(gg.x) + bfhi(p.x); v0[2] = v0[2] * bflo(gg.y) + bflo(p.y); v0[3] = v0[3] * bfhi(gg.y) + bfhi(p.y);
                    v1[0] = v1[0] * bflo(gg.z) + bflo(p.z); v1[1] = v1[1] * bfhi(gg.z) + bfhi(p.z); v1[2] = v1[2] * bflo(gg.w) + bflo(p.w); v1[3] = v1[3] * bfhi(gg.w) + bfhi(p.w);
                    *(u32x4*)(MRG + r * D + col0 + bj * HALF) = pack8(v0, v1); } }
            EPI_FENCE();
        }
    }
};
struct EpiResid {
    static constexpr bool PERM = true, TWICE_OK = false;
    bf16* HB; float* ssq16;
    DI void operator()(const f32x4 (&acc)[2][2][4][2], const Unit& u, int wr, int wc, int fr, int fq) const {
        const int row0 = u.pm * BM + wr * 64 + fr, col0 = u.pn * BM + wc * 32 + 8 * fq;
#pragma unroll
        for (int ai = 0; ai < 2; ++ai) {
            u32x4 hv[4][2];
#pragma unroll
            for (int m = 0; m < 4; ++m)
#pragma unroll
                for (int bj = 0; bj < 2; ++bj) hv[m][bj] = *(const u32x4*)(HB + (size_t)(row0 + ai * HALF + m * 16) * D + col0 + bj * HALF);
#pragma unroll
            for (int m = 0; m < 4; ++m) { const size_t r = (size_t)(row0 + ai * HALF + m * 16); float s = 0.f;
#pragma unroll
                for (int bj = 0; bj < 2; ++bj) { const u32x4 h = hv[m][bj];
                    f32x4 v0 = acc[ai][bj][m][0], v1 = acc[ai][bj][m][1];
                    v0[0] += bflo(h.x); v0[1] += bfhi(h.x); v0[2] += bflo(h.y); v0[3] += bfhi(h.y); v1[0] += bflo(h.z); v1[1] += bfhi(h.z); v1[2] += bflo(h.w); v1[3] += bfhi(h.w);
                    const u32x4 w = pack8(v0, v1); *(u32x4*)(HB + r * D + col0 + bj * HALF) = w;
                    s += (bflo(w.x) * bflo(w.x) + bfhi(w.x) * bfhi(w.x)) + (bflo(w.y) * bflo(w.y) + bfhi(w.y) * bfhi(w.y)) + (bflo(w.z) * bflo(w.z) + bfhi(w.z) * bfhi(w.z)) + (bflo(w.w) * bflo(w.w) + bfhi(w.w) * bfhi(w.w)); }
                s += shx(s, 16, fq * 16 + fr); s += shx(s, 32, fq * 16 + fr);
                if (fq == 0) ssq16[r * 16 + 4 * u.pn + wc] = s; }
            EPI_FENCE();
        }
    }
};
template <bool MOE> struct EpiSwiGLU {
    static constexpr bool PERM = true, TWICE_OK = false;
    const float* rsrc; bf16* ACT; int nkt;
    DI void operator()(const f32x4 (&acc)[2][2][4][2], const Unit& u, int wr, int wc, int fr, int fq) const {
        const int row0 = u.pm * BM + wr * 64 + fr;
        bf16* abase = ACT + ((size_t)(u.pm * nkt + 2 * u.pn + (wc >> 1)) * 256 + (wr * 64 + fr)) * 64 + (wc & 1) * 32 + 8 * fq;
        f32x4 pp[2][4]; float rsv[2][4];
        if (MOE) {
#pragma unroll
            for (int ai = 0; ai < 2; ++ai)
#pragma unroll
                for (int m = 0; m < 4; ++m) rsv[ai][m] = rsrc[row0 + ai * HALF + m * 16];
        } else { rstd4_load(pp[0], rsrc, row0, fq); rstd4_load(pp[1], rsrc, row0 + HALF, fq); }
#pragma unroll
        for (int ai = 0; ai < 2; ++ai) {
#pragma unroll
            for (int m = 0; m < 4; ++m) { const int r = row0 + ai * HALF + m * 16;
                const float rs = MOE ? rsv[ai][m] : rstd_finish(pp[ai][m], fq * 16 + fr); const float rs2 = rs * rs, nsl2 = -rs * LOG2E;
                f32x4 o[2];
#pragma unroll
                for (int n = 0; n < 2; ++n) { const f32x4 gu = acc[ai][0][m][n] * acc[ai][1][m][n] * rs2;
#pragma unroll
                    for (int j = 0; j < 4; ++j) o[n][j] = gu[j] * sigmoid_scaled(acc[ai][0][m][n][j], nsl2); }
                *(u32x4*)(abase + (ai * HALF + m * 16) * 64) = pack8(o[0], o[1]); }
            EPI_FENCE();
        }
    }
};
struct EpiSwiGLU8 {
    static constexpr bool PERM = true, TWICE_OK = false;
    const float* slot_rs; unsigned char* ACT8;
    DI void operator()(const f32x4 (&acc)[2][2][4][2], const Unit& u, int wr, int wc, int fr, int fq) const {
        const int row0 = wr * 64 + fr;
        unsigned char* base = ACT8 + ((size_t)(u.pm * (DFE / 128) + u.pn) * 256 + row0) * 128 + wc * 32 + 8 * fq;
        float rsv[2][4];
#pragma unroll
        for (int ai = 0; ai < 2; ++ai)
#pragma unroll
            for (int m = 0; m < 4; ++m) rsv[ai][m] = slot_rs[u.pm * BM + row0 + ai * HALF + m * 16];
#pragma unroll
        for (int ai = 0; ai < 2; ++ai) {
#pragma unroll
            for (int m = 0; m < 4; ++m) { const float rs = rsv[ai][m] * (1.0f / W8_GU), rs2 = rs * rs, nsl2 = -rs * LOG2E;
                f32x4 o[2];
#pragma unroll
                for (int n = 0; n < 2; ++n) { const f32x4 gu = acc[ai][0][m][n] * acc[ai][1][m][n] * rs2;
#pragma unroll
                    for (int j = 0; j < 4; ++j) o[n][j] = gu[j] * sigmoid_scaled(acc[ai][0][m][n][j], nsl2); }
                u32x2 w; w.x = pk4_fp8(o[0][0], o[0][1], o[0][2], o[0][3]); w.y = pk4_fp8(o[1][0], o[1][1], o[1][2], o[1][3]);
                *(u32x2*)(base + (size_t)(ai * HALF + m * 16) * 128) = w; }
            EPI_FENCE();
        }
    }
};
struct EpiMoeDown {
    static constexpr bool PERM = true, TWICE_OK = false;
    const bf16* SRC; bf16* DST; const int* slot_tok; const float* slot_w; float scale;
    DI void operator()(const f32x4 (&acc)[2][2][4][2], const Unit& u, int wr, int wc, int fr, int fq) const {
        const int row0 = u.pm * BM + wr * 64 + fr, col0 = u.pn * BM + wc * 32 + 8 * fq;
        int tk[2][4]; float wk[2][4];
#pragma unroll
        for (int ai = 0; ai < 2; ++ai)
#pragma unroll
            for (int m = 0; m < 4; ++m) { tk[ai][m] = slot_tok[row0 + ai * HALF + m * 16]; wk[ai][m] = slot_w[row0 + ai * HALF + m * 16] * scale; }
#pragma unroll
        for (int ai = 0; ai < 2; ++ai) {
            u32x4 hv[4][2];
#pragma unroll
            for (int m = 0; m < 4; ++m) { const int tok = tk[ai][m] < 0 ? 0 : tk[ai][m];
#pragma unroll
                for (int bj = 0; bj < 2; ++bj) hv[m][bj] = *(const u32x4*)(SRC + (size_t)tok * D + col0 + bj * HALF); }
#pragma unroll
            for (int m = 0; m < 4; ++m) { const int tok = tk[ai][m]; const float w = wk[ai][m];
                if (tok >= 0) {
#pragma unroll
                    for (int bj = 0; bj < 2; ++bj) { const u32x4 h = hv[m][bj];
                        f32x4 v0 = acc[ai][bj][m][0] * w, v1 = acc[ai][bj][m][1] * w;
                        v0[0] += bflo(h.x); v0[1] += bfhi(h.x); v0[2] += bflo(h.y); v0[3] += bfhi(h.y); v1[0] += bflo(h.z); v1[1] += bfhi(h.z); v1[2] += bflo(h.w); v1[3] += bfhi(h.w);
                        *(u32x4*)(DST + (size_t)tok * D + col0 + bj * HALF) = pack8(v0, v1); } } }
            EPI_FENCE();
        }
    }
};
struct EpiSlab {
    static constexpr bool PERM = false, TWICE_OK = false;
    float* slab;
    DI void operator()(const f32x4 (&acc)[2][2][4][2], const Unit& u, int wr, int wc, int fr, int fq) const {
        float* base = slab + ((size_t)(u.pm * NQ + u.kq) * BM + wr * 64 + fr) * D + u.pn * BM + wc * 32 + 4 * fq;
#pragma unroll
        for (int ai = 0; ai < 2; ++ai)
#pragma unroll
            for (int m = 0; m < 4; ++m)
#pragma unroll
                for (int bj = 0; bj < 2; ++bj)
#pragma unroll
                    for (int n = 0; n < 2; ++n) *(f32x4*)(base + (size_t)(ai * HALF + m * 16) * D + bj * HALF + n * 16) = acc[ai][bj][m][n];
    }
};
}
namespace att {
constexpr int KS_OFF = 0, KROW = 144, VT_OFF = 36864, VROW = 520, KM_OFF = 70144, VTM_OFF = 74752, VMROW = 72, RAWK_OFF = 79872, RAWV_OFF = RAWK_OFF + 32768, LDS_END = RAWV_OFF + 32768;
static_assert(LDS_END <= RING_BYTES, "attention LDS");
DI int crow(int i, int h) { return (i & 3) + 8 * (i >> 2) + 4 * h; }
struct Args { const bf16 *Q, *K, *V, *U, *KM, *VM, *UM; const float* sinks; bf16 *O, *POOLED; };
#define MFMA32(a, b, c) __builtin_amdgcn_mfma_f32_32x32x16_bf16((a), (b), (c), 0, 0, 0)
template <int WIN> DI void pool_load(unsigned (&xs)[47], const bf16* U, unsigned urow0, int col) {
    const char* ub = (const char*)U; const unsigned off0 = ((urow0 - (unsigned)(WIN - 1)) * POOLW + (unsigned)col) * 2u;
#pragma unroll
    for (int i = 0; i < 31 + WIN; ++i) xs[i] = *(const unsigned*)(ub + (off0 + (unsigned)i * (POOLW * 2u)));
}
template <int WIN> DI void pool_store(const unsigned (&xs)[47], bf16* POOLED, unsigned prow0, int col) {
    float a0 = 0.f, a1 = 0.f; const float invw = 1.0f / (float)WIN;
#pragma unroll
    for (int j = 0; j < WIN - 1; ++j) { a0 += bflo(xs[j]); a1 += bfhi(xs[j]); }
#pragma unroll
    for (int t = 0; t < 32; ++t) { const float x0 = bflo(xs[WIN - 1 + t]), x1 = bfhi(xs[WIN - 1 + t]); a0 += x0; a1 += x1;
        *(unsigned*)((char*)POOLED + ((prow0 + (unsigned)t) * POOLW + (unsigned)col) * 2u) = pk2(a0 * invw - x0, a1 * invw - x1);
        a0 -= bflo(xs[t]); a1 -= bfhi(xs[t]); }
}
DI void phase(LAS unsigned char* lds, const Args& A, int c, int G, int tid0) {
    asm volatile("" : "+v"(tid0));
    const int wid = __builtin_amdgcn_readfirstlane(tid0 >> 6);
    constexpr int NUNIT = NB * 64 * NKV;
    if (c >= NUNIT) return;
    bf16x8 qa[4], qb[4];
#define ATT_DECODE(L_, b_, nb_, kh_) const int b_ = (L_) >> 7, nb_ = ((L_) >> 1) & 63, kh_ = (L_) & 1
#define ATT_LOAD_KV(L_) do { ATT_DECODE(L_, b2, nb2, kh2); const size_t rb2 = (size_t)b2 * SEQ; const int s02 = (nb2 - 1) * 128; \
        _Pragma("unroll") for (int pass = 0; pass < 4; ++pass) { const int s = s02 + (tid >> 3) + 64 * pass; \
            kv[pass] = *(const u32x4*)(A.K + (rb2 + (size_t)(s < 0 ? 0 : s)) * KVW + kh2 * 64 + 8 * (tid & 7)); } \
        _Pragma("unroll") for (int pass = 0; pass < 4; ++pass) { const int s = s02 + lane + 64 * pass; \
            vv[pass] = *(const u32x4*)(A.V + (rb2 + (size_t)(s < 0 ? 0 : s)) * KVW + kh2 * 64 + 8 * wid); } } while (0)
#define ATT_DMA_KV(L_) do { ATT_DECODE(L_, b2, nb2, kh2); const size_t rb2 = (size_t)b2 * SEQ; const int s02 = (nb2 - 1) * 128; \
        _Pragma("unroll") for (int pass = 0; pass < 4; ++pass) { const int s = s02 + (tid >> 3) + 64 * pass; const size_t go = (rb2 + (size_t)(s < 0 ? 0 : s)) * KVW + kh2 * 64 + 8 * (tid & 7); \
            __builtin_amdgcn_global_load_lds((const unsigned*)(A.K + go), (LAS unsigned*)(lds + RAWK_OFF + (pass * 512 + wid * 64) * 16), 16, 0, 0); \
            __builtin_amdgcn_global_load_lds((const unsigned*)(A.V + go), (LAS unsigned*)(lds + RAWV_OFF + (pass * 512 + wid * 64) * 16), 16, 0, 0); } } while (0)
#define ATT_RAW_KV() do { _Pragma("unroll") for (int pass = 0; pass < 4; ++pass) { kv[pass] = *(const LAS u32x4*)(lds + RAWK_OFF + (pass * 512 + tid) * 16); \
            vv[pass] = *(const LAS u32x4*)(lds + RAWV_OFF + ((lane + 64 * pass) * 8 + wid) * 16); } } while (0)
#define ATT_LOAD_Q(dst, L_, qs_) do { ATT_DECODE(L_, b2, nb2, kh2); const bf16* qp = A.Q + ((size_t)b2 * SEQ + (size_t)(nb2 * 128 + 32 * (qs_) + r)) * D + (kh2 * QG + wid) * HD + 8 * h; \
        _Pragma("unroll") for (int d0 = 0; d0 < 4; ++d0) dst[d0] = *(const bf16x8*)(qp + 16 * d0); } while (0)
    { const int tid = tid0, lane = tid & 63, r = lane & 31, h = lane >> 5; ATT_LOAD_Q(qa, c, 0); }
    for (int L = c; L < NUNIT; L += G) {
        int tid = tid0; asm volatile("" : "+v"(tid));
        const int lane = tid & 63, r = lane & 31, h = lane >> 5;
        ATT_DECODE(L, b, nb, kh);
        const size_t rowb = (size_t)b * SEQ;
        const int head = kh * QG + wid;
        const bool has_next = (L + G) < NUNIT;
        const float slope2 = __builtin_amdgcn_exp2f(-0.5f * (float)(head + 1)) * LOG2E, sink2 = A.sinks[head] * LOG2E;
        const int pg = 2 * kh + (wid & 1), pcol = 128 * pg + 2 * lane;
        const unsigned prow0 = (unsigned)(b * SEQ + nb * 128 + 32 * (wid >> 1)), urow0 = prow0 + (unsigned)(NMETA * (b + 1));
        unsigned xs[47];
        if (pg == 0) pool_load<2>(xs, A.U, urow0, pcol); else if (pg == 1) pool_load<4>(xs, A.U, urow0, pcol);
        else if (pg == 2) pool_load<8>(xs, A.U, urow0, pcol); else pool_load<16>(xs, A.U, urow0, pcol);
        __builtin_amdgcn_sched_barrier(0);
        u32x4 kv[4], vv[4];
        if (L == c) ATT_LOAD_KV(L); else ATT_RAW_KV();
#pragma unroll
        for (int pass = 0; pass < 4; ++pass) { const int j = (tid >> 3) + 64 * pass, cc = tid & 7; *(LAS u32x4*)(lds + KS_OFF + j * KROW + 16 * cc) = kv[pass]; }
#pragma unroll
        for (int pass = 0; pass < 4; ++pass) { const int j = lane + 64 * pass;
#pragma unroll
            for (int jj = 0; jj < 8; ++jj) { const unsigned w = vv[pass][jj >> 1]; ((LAS unsigned short*)(lds + VT_OFF + (8 * wid + jj) * VROW))[j] = (unsigned short)((jj & 1) ? (w >> 16) : (w & 0xffffu)); } }
        if (L == c) {
            u32x4 kmv = *(const u32x4*)(A.KM + (size_t)((tid >> 3) & (NMETA - 1)) * KVW + kh * 64 + 8 * (tid & 7));
            if (tid >= 8 * NMETA) kmv = (u32x4){0u, 0u, 0u, 0u};
            if (tid < 256) *(LAS u32x4*)(lds + KM_OFF + (tid >> 3) * KROW + 16 * (tid & 7)) = kmv;
            const int d = tid & 63, kg = tid >> 6;
#pragma unroll
            for (int kk = 0; kk < 4; ++kk) { const int key = 4 * kg + kk; unsigned short val = A.VM[(size_t)(key & (NMETA - 1)) * KVW + kh * 64 + d]; if (key >= NMETA) val = 0;
                ((LAS unsigned short*)(lds + VTM_OFF + d * VMROW))[key] = val; }
        }
        __syncthreads();
        if (pg == 0) pool_store<2>(xs, A.POOLED, prow0, pcol); else if (pg == 1) pool_store<4>(xs, A.POOLED, prow0, pcol);
        else if (pg == 2) pool_store<8>(xs, A.POOLED, prow0, pcol); else pool_store<16>(xs, A.POOLED, prow0, pcol);
        __builtin_amdgcn_sched_barrier(0);
        if (has_next) ATT_DMA_KV(L + G);
        __builtin_amdgcn_sched_barrier(0);
        f32x16 Bb;
#pragma unroll
        for (int i = 0; i < 16; ++i) Bb[i] = -slope2 * (float)(128 - crow(i, h) + r);
#define ATT_BB(i) Bb[i]
#pragma unroll
        for (int qs = 0; qs < 4; ++qs) {
            bf16x8 (&qr)[4] = (qs & 1) ? qb : qa;
            if (qs == 0) ATT_LOAD_Q(qb, L, 1); else if (qs == 1) ATT_LOAD_Q(qa, L, 2); else if (qs == 2) ATT_LOAD_Q(qb, L, 3); else if (has_next) ATT_LOAD_Q(qa, L + G, 0);
            __builtin_amdgcn_sched_barrier(0);
            const int qrow = nb * 128 + 32 * qs + r;
            float mx = sink2, lsum = 0.f;
            f32x16 o[2]; o[0] = (f32x16){}; o[1] = (f32x16){};
#define ATT_QK(S_, kt_) do { const LAS unsigned char* kp_ = lds + KS_OFF + (32 * (kt_) + r) * KROW + 16 * h; \
                _Pragma("unroll") for (int d0 = 0; d0 < 4; ++d0) S_ = MFMA32(*(const LAS bf16x8*)(kp_ + 32 * d0), qr[d0], S_); } while (0)
#define ATT_MAX16(S_) fmaxf(fmaxf(fmaxf(fmaxf(S_[0], S_[1]), fmaxf(S_[2], S_[3])), fmaxf(fmaxf(S_[4], S_[5]), fmaxf(S_[6], S_[7]))), fmaxf(fmaxf(fmaxf(S_[8], S_[9]), fmaxf(S_[10], S_[11])), fmaxf(fmaxf(S_[12], S_[13]), fmaxf(S_[14], S_[15]))))
#define ATT_RESCALE(tmax_) do { if ((tmax_) > mx) { const float alpha = __builtin_amdgcn_exp2f(mx - (tmax_)); mx = (tmax_); lsum *= alpha; \
                _Pragma("unroll") for (int i = 0; i < 16; ++i) { o[0][i] *= alpha; o[1][i] *= alpha; } } } while (0)
#define ATT_PV(P_, kt_, s_) do { u32x4 pw; pw.x = pk2(P_[8 * (s_)], P_[8 * (s_) + 1]); pw.y = pk2(P_[8 * (s_) + 2], P_[8 * (s_) + 3]); pw.z = pk2(P_[8 * (s_) + 4], P_[8 * (s_) + 5]); pw.w = pk2(P_[8 * (s_) + 6], P_[8 * (s_) + 7]); \
                const bf16x8 pf = __builtin_bit_cast(bf16x8, pw); \
                _Pragma("unroll") for (int db = 0; db < 2; ++db) { const LAS unsigned char* vp = lds + VT_OFF + (32 * db + r) * VROW + (32 * (kt_) + 16 * (s_) + 4 * h) * 2; \
                    const s16x4 lo = *(const LAS s16x4*)vp, hi = *(const LAS s16x4*)(vp + 16); o[db] = MFMA32(__builtin_shufflevector(lo, hi, 0, 1, 2, 3, 4, 5, 6, 7), pf, o[db]); } } while (0)
#pragma unroll
            for (int tt = 1; tt < 4; ++tt) {
                if (nb == 0 && qs + tt < 4) continue;
                f32x16 S;
#pragma unroll
                for (int i = 0; i < 16; ++i) S[i] = ATT_BB(i);
                ATT_QK(S, qs + tt);
                const float shift = (32.0f * (float)tt) * slope2;
                float tmax = ATT_MAX16(S); tmax = fmaxf(tmax, shx(tmax, 32, lane)) + shift;
                ATT_RESCALE(tmax);
                const float mxs = mx - shift;
#pragma unroll
                for (int i = 0; i < 16; ++i) { const float p = __builtin_amdgcn_exp2f(S[i] - mxs); S[i] = p; lsum += p; }
                ATT_PV(S, qs + tt, 0); ATT_PV(S, qs + tt, 1);
            }
            {
                const bool t0ok = !(nb == 0 && qs < 4);
                f32x16 S0, S4;
#pragma unroll
                for (int i = 0; i < 16; ++i) { S0[i] = ATT_BB(i); S4[i] = ATT_BB(i); }
                if (t0ok) ATT_QK(S0, qs);
                ATT_QK(S4, qs + 4);
                const float sh4 = 128.0f * slope2;
#pragma unroll
                for (int i = 0; i < 16; ++i) { const bool lo_ = crow(i, h) > r; S4[i] = lo_ ? (t0ok ? S0[i] : -1e30f) : S4[i] + sh4; }
                float tmax = ATT_MAX16(S4); tmax = fmaxf(tmax, shx(tmax, 32, lane));
                ATT_RESCALE(tmax);
#pragma unroll
                for (int i = 0; i < 16; ++i) { const float p = __builtin_amdgcn_exp2f(S4[i] - mx); lsum += p; const bool lo_ = crow(i, h) > r; S0[i] = lo_ ? p : 0.f; S4[i] = lo_ ? 0.f : p; }
                if (t0ok) { ATT_PV(S0, qs, 0); ATT_PV(S0, qs, 1); }
                ATT_PV(S4, qs + 4, 0); ATT_PV(S4, qs + 4, 1);
            }
            {
                f32x16 S;
#pragma unroll
                for (int i = 0; i < 16; ++i) S[i] = (i < 8) ? -slope2 * (float)(NMETA - crow(i, h)) : 0.f;
                { const LAS unsigned char* kp_ = lds + KM_OFF + r * KROW + 16 * h;
#pragma unroll
                  for (int d0 = 0; d0 < 4; ++d0) S = MFMA32(*(const LAS bf16x8*)(kp_ + 32 * d0), qr[d0], S); }
                const float shift = -slope2 * (float)qrow;
                float tmax = fmaxf(fmaxf(fmaxf(S[0], S[1]), fmaxf(S[2], S[3])), fmaxf(fmaxf(S[4], S[5]), fmaxf(S[6], S[7])));
                tmax = fmaxf(tmax, shx(tmax, 32, lane)) + shift;
                ATT_RESCALE(tmax);
                const float mxs = mx - shift;
#pragma unroll
                for (int i = 0; i < 8; ++i) { const float p = __builtin_amdgcn_exp2f(S[i] - mxs); S[i] = p; lsum += p; }
                u32x4 pw; pw.x = pk2(S[0], S[1]); pw.y = pk2(S[2], S[3]); pw.z = pk2(S[4], S[5]); pw.w = pk2(S[6], S[7]);
                const bf16x8 pf = __builtin_bit_cast(bf16x8, pw);
#pragma unroll
                for (int db = 0; db < 2; ++db) { const LAS unsigned char* vp = lds + VTM_OFF + (32 * db + r) * VMROW + (4 * h) * 2;
                    const s16x4 lo = *(const LAS s16x4*)vp, hi = *(const LAS s16x4*)(vp + 16); o[db] = MFMA32(__builtin_shufflevector(lo, hi, 0, 1, 2, 3, 4, 5, 6, 7), pf, o[db]); }
            }
#undef ATT_QK
#undef ATT_MAX16
#undef ATT_RESCALE
#undef ATT_PV
            lsum += shx(lsum, 32, lane);
            lsum += __builtin_amdgcn_exp2f(sink2 - mx);
            const float inv = 1.0f / lsum;
            bf16* op = A.O + (rowb + (size_t)qrow) * D + head * HD;
#pragma unroll
            for (int db = 0; db < 2; ++db)
#pragma unroll
                for (int j = 0; j < 2; ++j) { const int g0 = 2 * j, g1 = 2 * j + 1;
                    const unsigned w0x = pk2(o[db][4 * g0] * inv, o[db][4 * g0 + 1] * inv), w0y = pk2(o[db][4 * g0 + 2] * inv, o[db][4 * g0 + 3] * inv);
                    const unsigned w1x = pk2(o[db][4 * g1] * inv, o[db][4 * g1 + 1] * inv), w1y = pk2(o[db][4 * g1 + 2] * inv, o[db][4 * g1 + 3] * inv);
                    const auto rx = __builtin_amdgcn_permlane32_swap(w1x, w0x, false, false), ry = __builtin_amdgcn_permlane32_swap(w1y, w0y, false, false);
                    u32x4 w; w.x = rx[0]; w.y = ry[0]; w.z = rx[1]; w.w = ry[1];
                    *(u32x4*)(op + 32 * db + 8 * (h ? g0 : g1)) = w; }
        }
        asm volatile("s_waitcnt vmcnt(8)" ::: "memory");
        __syncthreads();
    }
#undef ATT_DECODE
#undef ATT_BB
#undef ATT_LOAD_KV
#undef ATT_DMA_KV
#undef ATT_RAW_KV
#undef ATT_LOAD_Q
}
}
constexpr int NWAVES = 8;
struct Args { const float* in[18]; float* out; unsigned char* ws; int ph_lo, ph_hi; };
struct Frame {
    LAS unsigned char* lds;
    int tid, lane, wave, vcu, G;
    float* out; unsigned char* ws;
};
#define WSP(T, off) ((T*)(F.ws + (off)))
#define METAP(T, off) ((T*)(F.ws + WS_META + (off)))
enum { I_X = 0, I_META, I_NORM_MIX, I_W_IN, I_SINKS, I_W_ATTN_BR, I_W_POOL, I_POOL_SCALE, I_W_OUT, I_NORM_FFN, I_DW_GATE, I_DW_UP, I_DW_DOWN, I_ROUTER, I_MW_GATE, I_MW_UP, I_MW_DOWN, I_NORM_FINAL };

DI void tr_item(const float* W, int N, bf16* WT, int ldw, int k0, int n0, int drow0, const float* kscale, const float* nscale, LAS float* scr, int lane, int tiled_nkt = 0) {
    float wv[32];
#pragma unroll
    for (int i = 0; i < 32; ++i) wv[i] = W[(size_t)(k0 + 2 * i + (lane >> 5)) * N + n0 + (lane & 31)];
    const float ns = nscale ? nscale[n0 + (lane & 31)] : 1.f;
#pragma unroll
    for (int i = 0; i < 32; ++i) { const int kk = 2 * i + (lane >> 5); float v = wv[i] * ns; if (kscale) v *= kscale[k0 + kk]; scr[kk * 33 + (lane & 31)] = v; }
    LDS_WAIT(); asm volatile("" ::: "memory");
    const int c = lane & 7;
#pragma unroll
    for (int j = 0; j < 4; ++j) { const int n = (lane >> 3) + 8 * j; const LAS float* s = scr + (8 * c) * 33 + n;
        u32x4 o; o.x = pk2(s[0 * 33], s[1 * 33]); o.y = pk2(s[2 * 33], s[3 * 33]); o.z = pk2(s[4 * 33], s[5 * 33]); o.w = pk2(s[6 * 33], s[7 * 33]);
        const int dr = drow0 + n;
        bf16* dst = tiled_nkt ? WT + ((size_t)((dr >> 8) * tiled_nkt + (k0 >> 6)) * 256 + (dr & 255)) * 64 + 8 * c
                              : WT + (size_t)dr * ldw + k0 + 8 * c;
        *(u32x4*)dst = o; }
    LDS_WAIT(); asm volatile("" ::: "memory");
}
DI void tr_item8(const float* W, int N, unsigned char* WT, int ldw, int k0, int n0, int drow0, const float* kscale, float scale, LAS float* scr, int lane, int tiled_nkt) {
    float wv[32];
#pragma unroll
    for (int i = 0; i < 32; ++i) wv[i] = W[(size_t)(k0 + 2 * i + (lane >> 5)) * N + n0 + (lane & 31)];
#pragma unroll
    for (int i = 0; i < 32; ++i) { const int kk = 2 * i + (lane >> 5); float v = wv[i] * scale; if (kscale) v *= kscale[k0 + kk]; scr[kk * 33 + (lane & 31)] = v; }
    LDS_WAIT(); asm volatile("" ::: "memory");
#pragma unroll
    for (int j = 0; j < 2; ++j) { const int o = lane + 64 * j, n = o >> 2, c = o & 3; const LAS float* s = scr + (16 * c) * 33 + n;
        u32x4 w; w.x = pk4_fp8(s[0 * 33], s[1 * 33], s[2 * 33], s[3 * 33]); w.y = pk4_fp8(s[4 * 33], s[5 * 33], s[6 * 33], s[7 * 33]);
        w.z = pk4_fp8(s[8 * 33], s[9 * 33], s[10 * 33], s[11 * 33]); w.w = pk4_fp8(s[12 * 33], s[13 * 33], s[14 * 33], s[15 * 33]);
        const int dr = drow0 + n;
        unsigned char* dst = tiled_nkt ? WT + ((size_t)((dr >> 8) * tiled_nkt + (k0 >> 7)) * 256 + (dr & 255)) * 128 + (k0 & 127) + 16 * c : WT + (size_t)dr * ldw + k0 + 16 * c;
        *(u32x4*)dst = w; }
    LDS_WAIT(); asm volatile("" ::: "memory");
}
DI void tr_plain(const float* W, int K, int N, bf16* WT, int ldw, int it, const float* kscale, const float* nscale, LAS float* scr, int lane, int tiled_nkt = 0) {
    const int nblk = N / 32, kb = it / nblk, nb = it % nblk; tr_item(W, N, WT, ldw, 64 * kb, 32 * nb, 32 * nb, kscale, nscale, scr, lane, tiled_nkt);
}
DI void tr_gu(const float* W, int N, bf16* WT, int it, int up, const float* kscale, LAS float* scr, int lane) {
    const int nblk = N / 32, kb = it / nblk, nb = it % nblk, n0 = 32 * nb; tr_item(W, N, WT, D, 64 * kb, n0, (n0 / 128) * 256 + up * 128 + (n0 % 128), kscale, nullptr, scr, lane);
}
DI void p0_prologue(Frame& F, const Args& A) {
    LAS float* scr = (LAS float*)(F.lds + RING_OFF + F.wave * 16384);
    const int gw = F.vcu * NWAVES + F.wave, NGW = F.G * NWAVES, lane = F.lane;
    constexpr int I_IN = 16 * (INW / 32), I_SQ = 16 * 32, I_PL = 2 * 8, I_DGU = 16 * (DFF / 32), I_DD = (DFF / 64) * 32, I_MGU = 16 * (DFE / 32), I_MD = (DFE / 64) * 32;
    constexpr int PER_LAYER = I_IN + I_SQ + 4 * I_PL + I_SQ, N_DENSE = 2 * I_DGU + I_DD, PER_EXP = 2 * I_MGU + I_MD;
    constexpr int NITEMS = 2 * PER_LAYER + N_DENSE + NE * PER_EXP;
    for (int it = gw; it < NITEMS; it += NGW) {
        int r = it;
        if (r < 2 * PER_LAYER) {
            const int l = r / PER_LAYER; r -= l * PER_LAYER;
            if (r < I_IN) { tr_plain(A.in[I_W_IN] + (size_t)l * D * INW, D, INW, WSP(bf16, WS_WIN) + (size_t)l * INW * D, D, r, A.in[I_NORM_MIX] + l * D, nullptr, scr, lane); continue; } r -= I_IN;
            if (r < I_SQ) { tr_plain(A.in[I_W_ATTN_BR] + (size_t)l * D * D, D, D, WSP(bf16, WS_WA) + (size_t)l * D * D, D, r, nullptr, nullptr, scr, lane); continue; } r -= I_SQ;
            if (r < 4 * I_PL) { const int g = r / I_PL; r -= g * I_PL;
                tr_plain(A.in[I_W_POOL] + ((size_t)l * 4 + g) * 128 * 256, 128, 256, WSP(bf16, WS_WP) + ((size_t)l * D + g * 256) * 256, 256, r, nullptr, A.in[I_POOL_SCALE] + l * D + g * 256, scr, lane); continue; } r -= 4 * I_PL;
            tr_plain(A.in[I_W_OUT] + (size_t)l * D * D, D, D, WSP(bf16, WS_WO) + (size_t)l * D * D, D, r, nullptr, nullptr, scr, lane); continue;
        }
        r -= 2 * PER_LAYER;
        if (r < N_DENSE) {
            if (r < I_DGU) { tr_gu(A.in[I_DW_GATE], DFF, WSP(bf16, WS_WGU), r, 0, A.in[I_NORM_FFN], scr, lane); continue; } r -= I_DGU;
            if (r < I_DGU) { tr_gu(A.in[I_DW_UP], DFF, WSP(bf16, WS_WGU), r, 1, A.in[I_NORM_FFN], scr, lane); continue; } r -= I_DGU;
            tr_plain(A.in[I_DW_DOWN], DFF, D, WSP(bf16, WS_WD), DFF, r, nullptr, nullptr, scr, lane, DFF / 64); continue;
        }
        r -= N_DENSE;
        { const int e = r / PER_EXP; r -= e * PER_EXP;
            unsigned char* gu8 = WSP(unsigned char, WS_MGU) + (size_t)e * 2 * DFE * D; unsigned char* dn8 = WSP(unsigned char, WS_MD) + (size_t)e * D * DFE;
            if (r < 2 * I_MGU) { const int up = r >= I_MGU ? 1 : 0; if (up) r -= I_MGU; const int nblk = DFE / 32, kb = r / nblk, nb = r % nblk, n0 = 32 * nb;
                tr_item8((up ? A.in[I_MW_UP] : A.in[I_MW_GATE]) + (size_t)e * D * DFE, DFE, gu8, D, 64 * kb, n0, (n0 / 128) * 256 + up * 128 + (n0 % 128), A.in[I_NORM_FFN] + D, W8_GU, scr, lane, 0); continue; }
            r -= 2 * I_MGU;
            { const int nblk = D / 32, kb = r / nblk, nb = r % nblk; tr_item8(A.in[I_MW_DOWN] + (size_t)e * DFE * D, D, dn8, 0, 64 * kb, 32 * nb, 32 * nb, nullptr, W8_DN, scr, lane, DFE / 128); } }
    }
    for (int rr = gw; rr < 2 * D; rr += NGW) *(unsigned*)(WSP(bf16, WS_WP) + (size_t)rr * 256 + 128 + 2 * lane) = 0u;
    const float* x = A.in[I_X]; bf16* HB = WSP(bf16, WS_HB); float* ssq = WSP(float, WS_SSQ);
    for (int m0 = gw * 4; m0 < M; m0 += NGW * 4) {
        f32x4 v[4][4];
#pragma unroll
        for (int q = 0; q < 4; ++q)
#pragma unroll
            for (int j = 0; j < 4; ++j) v[q][j] = *((const f32x4*)(x + (size_t)(m0 + q) * D) + lane + 64 * j);
#pragma unroll
        for (int q = 0; q < 4; ++q) { float s = 0.f; u32x2* o8 = (u32x2*)(HB + (size_t)(m0 + q) * D) + lane;
#pragma unroll
            for (int j = 0; j < 4; ++j) { s += (v[q][j][0] * v[q][j][0] + v[q][j][1] * v[q][j][1]) + (v[q][j][2] * v[q][j][2] + v[q][j][3] * v[q][j][3]); u32x2 w; w.x = pk2(v[q][j][0], v[q][j][1]); w.y = pk2(v[q][j][2], v[q][j][3]); o8[64 * j] = w; }
            s = wave_sum(s, lane);
            if (lane < 16) ssq[(size_t)(m0 + q) * 16 + lane] = lane == 0 ? s : 0.f; }
    }
    for (int m = gw; m < NMETA; m += NGW) {
        const f32x4* xr = (const f32x4*)(A.in[I_META] + (size_t)m * D) + lane; f32x4* ho = (f32x4*)(METAP(float, MO_HM) + (size_t)m * D) + lane; u32x2* o8 = (u32x2*)(METAP(bf16, MO_XM) + (size_t)m * D) + lane;
#pragma unroll
        for (int j = 0; j < 4; ++j) { const f32x4 v = xr[64 * j]; ho[64 * j] = v; u32x2 w; w.x = pk2(v[0], v[1]); w.y = pk2(v[2], v[3]); o8[64 * j] = w; }
    }
}

namespace meta {
DI f32x4 tile(const bf16* X, int ldx, const bf16* Wt, int ldw, int K, int lane) {
    const int i = lane & 15, q = lane >> 4; f32x4 acc = (f32x4){0.f, 0.f, 0.f, 0.f};
    const bf16* xp = X + (size_t)i * ldx + 8 * q; const bf16* wp = Wt + (size_t)i * ldw + 8 * q;
    for (int k0 = 0; k0 < K; k0 += 32) acc = __builtin_amdgcn_mfma_f32_16x16x32_bf16(*(const bf16x8*)(wp + k0), *(const bf16x8*)(xp + k0), acc, 0, 0, 0);
    return acc;
}
template <int NST, bool SSQ, int TILED_NKT = 0> DI f32x4 tile_split(const bf16* X, int ldx, const bf16* Wt, int ldw, int wave, int lane, LAS float* scr, float& ssq) {
    const int i = lane & 15, q = lane >> 4, ks = 32 * NST;
    const bf16* xp = X + (size_t)i * ldx + wave * ks + 8 * q; const bf16* wp = Wt + (size_t)i * ldw + wave * ks + 8 * q;
    bf16x8 a[NST], b[NST];
#pragma unroll
    for (int s = 0; s < NST; ++s) { const int kk = wave * ks + 32 * s + 8 * q, wr_ = ldw + i;
        a[s] = TILED_NKT ? *(const bf16x8*)(Wt + ((size_t)((wr_ >> 8) * TILED_NKT + (kk >> 6)) * 256 + (wr_ & 255)) * 64 + (kk & 63)) : *(const bf16x8*)(wp + 32 * s);
        b[s] = *(const bf16x8*)(xp + 32 * s); }
    f32x4 acc = (f32x4){0.f, 0.f, 0.f, 0.f}; float sq = 0.f;
#pragma unroll
    for (int s = 0; s < NST; ++s) { acc = __builtin_amdgcn_mfma_f32_16x16x32_bf16(a[s], b[s], acc, 0, 0, 0);
        if (SSQ) {
#pragma unroll
            for (int j = 0; j < 8; ++j) { const float x = bf2f((unsigned short)b[s][j]); sq += x * x; } } }
    __syncthreads();
    *(LAS f32x4*)(scr + (wave * 64 + lane) * 4) = acc;
    if (SSQ) { sq += shx(sq, 16, lane); sq += shx(sq, 32, lane); if (q == 0) scr[2048 + wave * 16 + i] = sq; }
    __syncthreads();
    f32x4 r = (f32x4){0.f, 0.f, 0.f, 0.f}; float t = 0.f;
#pragma unroll
    for (int w = 0; w < 8; ++w) { r += *(const LAS f32x4*)(scr + (w * 64 + lane) * 4); if (SSQ) t += scr[2048 + w * 16 + i]; }
    ssq = t; return r;
}
DI void inproj(Frame& F, LAS float* scr, int l, int col0) {
    const int lane = F.lane, i = lane & 15, q = lane >> 4; float ss;
    const f32x4 a = tile_split<4, true>(METAP(bf16, MO_XM), D, WSP(bf16, WS_WIN) + ((size_t)l * INW + col0) * D, D, F.wave, lane, scr, ss);
    if (F.wave != 0) return;
    const float rs = __builtin_amdgcn_rsqf(ss * (1.0f / D) + RMS_EPS);
    float* pr = METAP(float, MO_PROJ) + (size_t)i * INW + col0 + 4 * q;
#pragma unroll
    for (int j = 0; j < 4; ++j) { float v = a[j] * rs; const int c = col0 + 4 * q + j;
        if (c < D) v *= QSCALE; else if (c >= 1792) v = fast_sigmoid(v);
        pr[j] = v;
        if (c >= 1024 && c < 1152) METAP(bf16, MO_KM)[((size_t)l * NMETA + i) * KVW + (c - 1024)] = (bf16)f2bf(v);
        else if (c >= 1152 && c < 1280) METAP(bf16, MO_VM)[((size_t)l * NMETA + i) * KVW + (c - 1152)] = (bf16)f2bf(v);
        else if (c >= 1280 && c < 1792) { const bf16 ub = (bf16)f2bf(v);
#pragma unroll
            for (int b = 0; b < NB; ++b) WSP(bf16, WS_U)[((size_t)b * USEQ + i) * POOLW + (c - 1280)] = ub; } }
}
DI void attn_head(Frame& F, const Args& A, int l, int head) {
    const float* pr = METAP(float, MO_PROJ); const int t = F.tid, i = t >> 5, dl = t & 31, kvh = head / QG;
    const float slope2 = __builtin_amdgcn_exp2f(-0.5f * (float)(head + 1)) * LOG2E, sink2 = A.in[I_SINKS][l * NH + head] * LOG2E;
    const float q0 = pr[(size_t)i * INW + head * HD + dl], q1 = pr[(size_t)i * INW + head * HD + dl + 32];
    float k0[NMETA], k1[NMETA], v0[NMETA], v1[NMETA];
#pragma unroll
    for (int j = 0; j < NMETA; ++j) { const float* kp = pr + (size_t)j * INW + 1024 + kvh * HD + dl; k0[j] = kp[0]; k1[j] = kp[32]; v0[j] = kp[128]; v1[j] = kp[160]; }
    float lg[NMETA]; float mx = sink2;
#pragma unroll
    for (int j = 0; j < NMETA; ++j) { float s = q0 * k0[j] + q1 * k1[j];
#pragma unroll
        for (int o = 1; o < 32; o <<= 1) s += shx(s, o, F.lane);
        s = (j <= i) ? s - slope2 * (float)(i - j) : -1e30f; lg[j] = s; mx = fmaxf(mx, s); }
    float lsum = __builtin_amdgcn_exp2f(sink2 - mx), o0 = 0.f, o1 = 0.f;
#pragma unroll
    for (int j = 0; j < NMETA; ++j) { const float p = __builtin_amdgcn_exp2f(lg[j] - mx); lsum += p; o0 += p * v0[j]; o1 += p * v1[j]; }
    const float inv = 1.0f / lsum;
    bf16* op = METAP(bf16, MO_ATT) + (size_t)i * D + head * HD + dl;
    op[0] = (bf16)f2bf(o0 * inv); op[32] = (bf16)f2bf(o1 * inv);
}
DI void pool_rows(Frame& F) {
    const float* pr = METAP(float, MO_PROJ); const int col = F.tid, g = col >> 7, win = 2 << g;
    float u[NMETA];
#pragma unroll
    for (int tt = 0; tt < NMETA; ++tt) u[tt] = pr[(size_t)tt * INW + 1280 + col];
#pragma unroll
    for (int tt = 0; tt < NMETA; ++tt) { float s = 0.f; int cnt = 0;
#pragma unroll
        for (int j = 0; j < NMETA; ++j) if (j <= tt && j < win) { s += u[tt - j]; ++cnt; }
        METAP(bf16, MO_POOL)[(size_t)tt * POOLW + col] = (bf16)f2bf(s / (float)cnt - u[tt]); }
}
DI void merge(Frame& F, LAS float* scr, int l, int col0) {
    const int lane = F.lane, i = lane & 15, q = lane >> 4, g = col0 >> 8; float dummy;
    const f32x4 a = tile_split<4, false>(METAP(bf16, MO_ATT), D, WSP(bf16, WS_WA) + ((size_t)l * D + col0) * D, D, F.wave, lane, scr, dummy);
    if (F.wave != 0) return;
    const f32x4 p = tile(METAP(bf16, MO_POOL) + g * 128, POOLW, WSP(bf16, WS_WP) + ((size_t)l * D + col0) * 256, 256, 128, lane);
    const float* pr = METAP(float, MO_PROJ) + (size_t)i * INW;
#pragma unroll
    for (int j = 0; j < 4; ++j) { const int c = col0 + 4 * q + j; METAP(bf16, MO_MRG)[(size_t)i * D + c] = (bf16)f2bf(pr[1792 + c] * a[j] + pr[2816 + c] * p[j]); }
}
DI void resid(Frame& F, const f32x4 o, int col0) {
    const int lane = F.lane, i = lane & 15, q = lane >> 4;
    float* hp = METAP(float, MO_HM) + (size_t)i * D + col0 + 4 * q; const f32x4 h = *(const f32x4*)hp + o; *(f32x4*)hp = h;
    u32x2 w; w.x = pk2(h[0], h[1]); w.y = pk2(h[2], h[3]); *(u32x2*)(METAP(bf16, MO_XM) + (size_t)i * D + col0 + 4 * q) = w;
}
DI void outproj(Frame& F, LAS float* scr, int l, int col0) { float dummy;
    const f32x4 o = tile_split<4, false>(METAP(bf16, MO_MRG), D, WSP(bf16, WS_WO) + ((size_t)l * D + col0) * D, D, F.wave, F.lane, scr, dummy);
    if (F.wave == 0) resid(F, o, col0); }
DI void gu(Frame& F, LAS float* scr, int n0) {
    const int lane = F.lane, i = lane & 15, q = lane >> 4; float ss, dummy;
    const bf16* wg = WSP(bf16, WS_WGU) + (size_t)((n0 / 128) * 256 + (n0 % 128)) * D;
    const f32x4 ga = tile_split<4, true>(METAP(bf16, MO_XM), D, wg, D, F.wave, lane, scr, ss);
    const f32x4 ua = tile_split<4, false>(METAP(bf16, MO_XM), D, wg + (size_t)128 * D, D, F.wave, lane, scr, dummy);
    if (F.wave != 0) return;
    const float rs = __builtin_amdgcn_rsqf(ss * (1.0f / D) + RMS_EPS);
    f32x4 o;
#pragma unroll
    for (int j = 0; j < 4; ++j) { const float gg = ga[j] * rs; o[j] = gg * fast_sigmoid(gg) * (ua[j] * rs); }
    u32x2 w; w.x = pk2(o[0], o[1]); w.y = pk2(o[2], o[3]); *(u32x2*)(METAP(bf16, MO_ACT) + (size_t)i * DFF + n0 + 4 * q) = w;
}
DI void down(Frame& F, LAS float* scr, int col0) { float dummy;
    const f32x4 o = tile_split<DFF / 256, false, DFF / 64>(METAP(bf16, MO_ACT), DFF, WSP(bf16, WS_WD), col0, F.wave, F.lane, scr, dummy);
    if (F.wave == 0) resid(F, o, col0); }
}
DI void moe_route(Frame& F, const Args& A) {
    LAS float* rw = (LAS float*)(F.lds + RING_OFF);
    LAS unsigned* hist = (LAS unsigned*)(F.lds + XTRA_OFF);
    const float* router = A.in[I_ROUTER]; const float* gain = A.in[I_NORM_FFN] + D;
    for (int idx = F.tid; idx < NE * D; idx += NWAVES * 64) { const int k = idx >> 3, e = idx & 7; rw[e * D + k] = router[idx] * gain[k]; }
    unsigned char* hb8 = WSP(unsigned char, WS_POOLED);
    const bf16* h = WSP(bf16, WS_HB); float* ssq = WSP(float, WS_SSQ); unsigned* toke = WSP(unsigned, WS_TOKE); float* tokw = WSP(float, WS_TOKW); unsigned* wgcnt = WSP(unsigned, WS_WGCNT);
    const int lane = F.lane;
    for (int tile = F.vcu; tile < M / 256; tile += F.G) {
        if (F.tid < 16) hist[F.tid] = 0u;
        __syncthreads();
        for (int t4 = 0; t4 < 32; t4 += 4) {
            u32x2 hq[4][4];
#pragma unroll
            for (int t = 0; t < 4; ++t)
#pragma unroll
                for (int j = 0; j < 4; ++j) hq[t][j] = *((const u32x2*)(h + (size_t)(tile * 256 + F.wave * 32 + t4 + t) * D) + lane + 64 * j);
#pragma unroll
            for (int t = 0; t < 4; ++t) {
                const int tok = tile * 256 + F.wave * 32 + t4 + t;
                f32x4 v[4]; float s = 0.f;
#pragma unroll
                for (int j = 0; j < 4; ++j) { const u32x2 q = hq[t][j]; v[j] = (f32x4){bflo(q.x), bfhi(q.x), bflo(q.y), bfhi(q.y)}; s += (v[j][0] * v[j][0] + v[j][1] * v[j][1]) + (v[j][2] * v[j][2] + v[j][3] * v[j][3]); }
                float lg[NE];
#pragma unroll
                for (int e = 0; e < NE; ++e) { float a = 0.f;
#pragma unroll
                    for (int j = 0; j < 4; ++j) { const f32x4 w = *((const LAS f32x4*)(rw + e * D) + lane + 64 * j); a += (v[j][0] * w[0] + v[j][1] * w[1]) + (v[j][2] * w[2] + v[j][3] * w[3]); }
                    lg[e] = wave_sum(a, lane); }
                s = wave_sum(s, lane);
                const float rs = __builtin_amdgcn_rsqf(s * (1.0f / D) + RMS_EPS);
                int e0 = 0; float v0 = lg[0];
#pragma unroll
                for (int e = 1; e < NE; ++e) if (lg[e] > v0) { v0 = lg[e]; e0 = e; }
                int e1 = -1; float v1 = -INFINITY;
#pragma unroll
                for (int e = 0; e < NE; ++e) if (e != e0 && lg[e] > v1) { v1 = lg[e]; e1 = e; }
                const float w1 = 1.0f / (1.0f + __expf((v0 - v1) * rs)), w0 = 1.0f - w1;
                if (lane < 16) ssq[(size_t)tok * 16 + lane] = lane == 0 ? s : 0.f;
#pragma unroll
                for (int j = 0; j < 4; ++j) *((unsigned*)(hb8 + (size_t)tok * D) + lane + 64 * j) = pk4_fp8(v[j][0], v[j][1], v[j][2], v[j][3]);
                if (lane == 0) { toke[tok] = (unsigned)e0 | ((unsigned)e1 << 8); tokw[2 * tok] = w0; tokw[2 * tok + 1] = w1; __hip_atomic_fetch_add((unsigned*)&hist[e0], 1u, __ATOMIC_RELAXED, __HIP_MEMORY_SCOPE_WORKGROUP); __hip_atomic_fetch_add((unsigned*)&hist[8 + e1], 1u, __ATOMIC_RELAXED, __HIP_MEMORY_SCOPE_WORKGROUP); }
            }
        }
        __syncthreads();
        if (F.tid < 16) wgcnt[tile * 16 + F.tid] = hist[F.tid];
        __syncthreads();
    }
}
DI void moe_slots(Frame& F) {
    LAS unsigned* cnt = (LAS unsigned*)(F.lds + RING_OFF);
    LAS unsigned* tot = cnt + 4096;
    LAS unsigned* seg = tot + 16;
    LAS unsigned* pre = seg + 16;
    LAS unsigned char* es = (LAS unsigned char*)(pre + 16);
    const unsigned* wgcnt = WSP(unsigned, WS_WGCNT); const unsigned* toke = WSP(unsigned, WS_TOKE); const float* tokw = WSP(float, WS_TOKW);
    int* slot_tok = WSP(int, WS_SLOTTOK); float* slot_w = WSP(float, WS_SLOTW); float* slot_rs = WSP(float, WS_SLOTRS); const float* ssq = WSP(float, WS_SSQ); int* tab = WSP(int, WS_MOETAB);
    for (int i = F.tid; i < 4096; i += NWAVES * 64) cnt[i] = wgcnt[i];
    __syncthreads();
    { const int col = F.tid >> 5, pp = F.tid & 31; unsigned s = 0;
#pragma unroll
      for (int j = 0; j < 8; ++j) s += cnt[(pp * 8 + j) * 16 + col];
#pragma unroll
      for (int o = 1; o < 32; o <<= 1) s += (unsigned)__builtin_amdgcn_ds_bpermute((F.lane ^ o) << 2, (int)s);
      if (pp == 0) tot[col] = s; }
    __syncthreads();
    if (F.tid < 16) { const int k = F.tid >> 3, e = F.tid & 7; unsigned s = 0; for (int e2 = 0; e2 < e; ++e2) s += (tot[k * 8 + e2] + 255u) & ~255u; seg[F.tid] = s; }
    __syncthreads();
    if (F.vcu == 0) {
        if (F.tid < 16) tab[F.tid] = (int)seg[F.tid];
        if (F.tid < 2) { unsigned s = 0; for (int e = 0; e < NE; ++e) s += (tot[F.tid * 8 + e] + 255u) >> 8; tab[16 + F.tid] = (int)s; }
        for (int i = F.tid; i < 2 * MAXTILES; i += NWAVES * 64) { const int k = i / MAXTILES, t = i % MAXTILES; int e = NE - 1;
            for (int e2 = NE - 1; e2 >= 0; --e2) if ((unsigned)(t * 256) < seg[k * 8 + e2] + ((tot[k * 8 + e2] + 255u) & ~255u)) e = e2;
            tab[32 + i] = e; }
    }
    for (int sgi = F.vcu; sgi < 16; sgi += F.G) { const int k = sgi >> 3; const unsigned b0 = seg[sgi] + tot[sgi], b1 = seg[sgi] + ((tot[sgi] + 255u) & ~255u);
        for (unsigned p = b0 + F.tid; p < b1; p += NWAVES * 64) { slot_tok[k * NSLOT + p] = -1; slot_w[k * NSLOT + p] = 0.f; slot_rs[k * NSLOT + p] = 0.f; } }
    for (int tile = F.vcu; tile < M / 256; tile += F.G) {
        __syncthreads();
        { const int col = F.tid >> 5, pp = F.tid & 31; unsigned s = 0;
#pragma unroll
          for (int j = 0; j < 8; ++j) { const int t = pp * 8 + j; s += t < tile ? cnt[t * 16 + col] : 0u; }
#pragma unroll
          for (int o = 1; o < 32; o <<= 1) s += (unsigned)__builtin_amdgcn_ds_bpermute((F.lane ^ o) << 2, (int)s);
          if (pp == 0) pre[col] = s; }
        unsigned ee = 0u;
        if (F.tid < 256) ee = toke[tile * 256 + F.tid];
        LAS unsigned* wcnt = (LAS unsigned*)es;
        unsigned rk[2] = {0u, 0u};
        if (F.tid < 256) {
#pragma unroll
            for (int k = 0; k < 2; ++k) { const unsigned e = (ee >> (8 * k)) & 0xffu;
#pragma unroll
                for (int ex = 0; ex < NE; ++ex) { const unsigned long long b = __ballot(e == (unsigned)ex);
                    if (e == (unsigned)ex) rk[k] = (unsigned)__builtin_popcountll(b & ((1ull << F.lane) - 1ull));
                    if (F.lane == 0) wcnt[F.wave * 16 + k * 8 + ex] = (unsigned)__builtin_popcountll(b); } }
        }
        __syncthreads();
        if (F.tid < 256) {
            const int tok = tile * 256 + F.tid; const float rs = __builtin_amdgcn_rsqf(ssq[(size_t)tok * 16] * (1.0f / D) + RMS_EPS);
#pragma unroll
            for (int k = 0; k < 2; ++k) { const unsigned e = (ee >> (8 * k)) & 0xffu; unsigned rank = rk[k];
                for (int w = 0; w < F.wave; ++w) rank += wcnt[w * 16 + k * 8 + e];
                const unsigned p = seg[k * 8 + e] + pre[k * 8 + e] + rank; slot_tok[k * NSLOT + p] = tok; slot_w[k * NSLOT + p] = tokw[2 * tok + k]; slot_rs[k * NSLOT + p] = rs; }
        }
    }
    __syncthreads();
}
DI void moe_fix(Frame& F, int k, int ntail) {
    const int gw = F.vcu * NWAVES + F.wave, NGW = F.G * NWAVES, lane = F.lane;
    const int* slot_tok = WSP(int, WS_SLOTTOK) + k * NSLOT; const float* slot_w = WSP(float, WS_SLOTW) + k * NSLOT; const float* slab = WSP(float, WS_SLAB);
    const bf16* SRC = k == 0 ? WSP(bf16, WS_HB) : (const bf16*)F.out; bf16* DST = k == 0 ? (bf16*)F.out : WSP(bf16, WS_HB);
    for (int r = gw; r < ntail * 256; r += NGW) {
        const int tok = slot_tok[r]; if (tok < 0) continue;
        const float w = slot_w[r] * (1.0f / W8_DN); const int tile = r >> 8, row = r & 255;
#pragma unroll
        for (int j = 0; j < 4; ++j) {
            f32x4 s = (f32x4){0.f, 0.f, 0.f, 0.f};
#pragma unroll
            for (int kq = 0; kq < pg8::NQ; ++kq) s += *((const f32x4*)(slab + ((size_t)(tile * pg8::NQ + kq) * 256 + row) * D) + lane + 64 * j);
            const u32x2 h = *((const u32x2*)(SRC + (size_t)tok * D) + lane + 64 * j);
            u32x2 o; o.x = pk2(bflo(h.x) + w * s[0], bfhi(h.x) + w * s[1]); o.y = pk2(bflo(h.y) + w * s[2], bfhi(h.y) + w * s[3]);
            *((u32x2*)(DST + (size_t)tok * D) + lane + 64 * j) = o;
        }
    }
}
DI void final_norm(Frame& F, const Args& A) {
    const int gw = F.vcu * NWAVES + F.wave, NGW = F.G * NWAVES, lane = F.lane; const float* gain = A.in[I_NORM_FINAL]; const bf16* HB = WSP(bf16, WS_HB);
    f32x4 gv[4];
#pragma unroll
    for (int j = 0; j < 4; ++j) gv[j] = *((const f32x4*)gain + lane + 64 * j);
    for (int m0 = gw * 4; m0 < M; m0 += NGW * 4) {
        u32x2 q[4][4];
#pragma unroll
        for (int t = 0; t < 4; ++t)
#pragma unroll
            for (int j = 0; j < 4; ++j) q[t][j] = *((const u32x2*)(HB + (size_t)(m0 + t) * D) + lane + 64 * j);
#pragma unroll
        for (int t = 0; t < 4; ++t) { f32x4 v[4]; float s = 0.f; f32x4* xr = (f32x4*)(F.out + (size_t)(m0 + t) * D) + lane;
#pragma unroll
            for (int j = 0; j < 4; ++j) { v[j] = (f32x4){bflo(q[t][j].x), bfhi(q[t][j].x), bflo(q[t][j].y), bfhi(q[t][j].y)}; s += (v[j][0] * v[j][0] + v[j][1] * v[j][1]) + (v[j][2] * v[j][2] + v[j][3] * v[j][3]); }
            const float rs = __builtin_amdgcn_rsqf(wave_sum(s, lane) * (1.0f / D) + RMS_EPS);
#pragma unroll
            for (int j = 0; j < 4; ++j) xr[64 * j] = v[j] * rs * gv[j]; }
    }
}
#ifndef MK_PER_PHASE
#define MK_PER_PHASE 0
#endif
constexpr int NPHASES = 19;

DI void attn_phase(Frame& F, const Args& args, int l) {
    att::Args A{WSP(bf16, WS_Q), WSP(bf16, WS_K), WSP(bf16, WS_V), WSP(bf16, WS_U), METAP(bf16, MO_KM) + (size_t)l * NMETA * KVW, METAP(bf16, MO_VM) + (size_t)l * NMETA * KVW,
                METAP(bf16, MO_UM) + (size_t)l * NMETA * POOLW, args.in[I_SINKS] + l * NH, (bf16*)F.out, WSP(bf16, WS_POOLED)};
    att::phase(F.lds + RING_OFF, A, F.vcu, F.G, F.tid);
}

__global__ void __launch_bounds__(NWAVES * 64, 2) fwd(Args args) {
    extern __shared__ __attribute__((aligned(16))) unsigned char lds[];
    Frame F;
    F.lds = (LAS unsigned char*)lds;
    F.tid = threadIdx.x; F.lane = F.tid & 63; F.wave = __builtin_amdgcn_readfirstlane(F.tid >> 6);
    const int wave0 = F.wave;
    F.G = gridDim.x; { const int bx = blockIdx.x; F.vcu = (F.G % 8 == 0) ? (bx % 8) * (F.G / 8) + bx / 8 : bx; }
    F.out = args.out; F.ws = args.ws;
    for (int u = F.tid; u < (LDS_BYTES - LDSCTL_OFF) / 4; u += NWAVES * 64) ((LAS unsigned*)(F.lds + LDSCTL_OFF))[u] = 0u;
    __syncthreads();
    gu32* ctl = (gu32*)(F.ws + WS_CTL);
    XcdBarrier bar; bar.bar = (unsigned*)(ctl + CW_BAR); bar.x = 0; bar.st = nullptr;
    if (!MK_PER_PHASE) bar = xcd_barrier_post((unsigned*)(ctl + CW_BAR), (volatile LAS unsigned*)(F.lds + MISC_OFF) + 8, F.tid);
    const int lo = args.ph_lo, hi = args.ph_hi;
#define IN(k) (lo <= (k) && (k) < hi)
#define SEAM(k) do { if (IN(k) && IN((k) + 1)) xcd_barrier(bar, (wave0 << 6) | hw_lane()); } while (0)
#define LAUNDER() do { F.ws = args.ws; F.out = args.out; F.tid = (wave0 << 6) | hw_lane(); asm volatile("" : "+s"(F.ws), "+s"(F.out), "+v"(F.tid)); F.lane = F.tid & 63; F.wave = __builtin_amdgcn_readfirstlane(F.tid >> 6); ssq = WSP(float, WS_SSQ); } while (0)
#define META_TASK(n, call) do { LAS float* mscr = (LAS float*)(F.lds + RING_OFF); for (int task = F.vcu; task < (n); task += F.G) { call; } __syncthreads(); } while (0)

    float* ssq;
    if (IN(0)) { LAUNDER(); p0_prologue(F, args); } SEAM(0);

    for (int l = 0; l < 2; ++l) {
        const int pb = l * 6;
        if (IN(pb + 1)) { LAUNDER();
            if (l == 0) { META_TASK(INW / 16, meta::inproj(F, mscr, 0, 16 * task)); } else { META_TASK(768 / 16, meta::inproj(F, mscr, 1, 1024 + 16 * task)); }
            pg8::ProbPlain P{(const char*)WSP(bf16, WS_HB), (const char*)(WSP(bf16, WS_WIN) + (size_t)l * INW * D), D * 2, D * 2, D / 64, 0, 128, (size_t)256 * (D * 2)};
            pg8::StaticOrder S; S.init(M, INW, F.G, (int)blockIdx.x);
            pg8::EpiInProj E{ssq, WSP(bf16, WS_Q), WSP(bf16, WS_K), WSP(bf16, WS_V), WSP(bf16, WS_U), WSP(bf16, WS_G)};
            pg8::gemm_phase<pg8::ProbPlain, pg8::EpiInProj, pg8::StaticOrder, true>(F.lds + RING_OFF, P, S, E, F.tid);
        } SEAM(pb + 1);
        if (IN(pb + 2)) { LAUNDER();
            if (l == 0) { for (int hd = F.vcu; hd < NH + 1; hd += F.G) { if (hd < NH) meta::attn_head(F, args, 0, hd); else meta::pool_rows(F); } }
            attn_phase(F, args, l);
        } SEAM(pb + 2);
        if (IN(pb + 3)) { LAUNDER();
            if (l == 0) { META_TASK(D / 16, meta::merge(F, mscr, 0, 16 * task)); }
            { pg8::ProbPlain P{(const char*)WSP(bf16, WS_POOLED), (const char*)(WSP(bf16, WS_WP) + (size_t)l * D * 256), POOLW * 2, 256 * 2, 256 / 64, 128 * 2, 128, (size_t)256 * (POOLW * 2)};
              pg8::StaticOrder S; S.init(M, D, F.G, (int)blockIdx.x);
              pg8::EpiPoolLift E{WSP(bf16, WS_G), WSP(bf16, WS_Q)};
              pg8::gemm_phase<pg8::ProbPlain, pg8::EpiPoolLift, pg8::StaticOrder, true>(F.lds + RING_OFF, P, S, E, F.tid); }
            VM_WAIT(); __syncthreads();
            { pg8::ProbPlain P{(const char*)F.out, (const char*)(WSP(bf16, WS_WA) + (size_t)l * D * D), D * 2, D * 2, D / 64, 0, 128, (size_t)256 * (D * 2)};
              pg8::StaticOrder S; S.init(M, D, F.G, (int)blockIdx.x);
              pg8::EpiMerge E{WSP(bf16, WS_G), WSP(bf16, WS_Q)};
              pg8::gemm_phase<pg8::ProbPlain, pg8::EpiMerge, pg8::StaticOrder, true>(F.lds + RING_OFF, P, S, E, F.tid); }
        } SEAM(pb + 3);
        if (IN(pb + 4)) { LAUNDER();
            if (l == 0) { META_TASK(D / 16, meta::outproj(F, mscr, 0, 16 * task)); }
            pg8::ProbPlain P{(const char*)WSP(bf16, WS_Q), (const char*)(WSP(bf16, WS_WO) + (size_t)l * D * D), D * 2, D * 2, D / 64, 0, 128, (size_t)256 * (D * 2)};
            pg8::StaticOrder S; S.init(M, D, F.G, (int)blockIdx.x);
            pg8::EpiResid E{WSP(bf16, WS_HB), ssq};
            pg8::gemm_phase<pg8::ProbPlain, pg8::EpiResid, pg8::StaticOrder, true>(F.lds + RING_OFF, P, S, E, F.tid);
        } SEAM(pb + 4);
        if (l == 0) {
            if (IN(5)) { LAUNDER();
                META_TASK(DFF / 16, meta::gu(F, mscr, 16 * task));
                pg8::ProbPlain P{(const char*)WSP(bf16, WS_HB), (const char*)WSP(bf16, WS_WGU), D * 2, D * 2, D / 64, 0, 128, (size_t)256 * (D * 2)};
                pg8::StaticOrder S; S.init(M, 2 * DFF, F.G, (int)blockIdx.x);
                pg8::EpiSwiGLU<false> E{ssq, WSP(bf16, WS_ACT), DFF / 64};
                pg8::gemm_phase<pg8::ProbPlain, pg8::EpiSwiGLU<false>, pg8::StaticOrder, true>(F.lds + RING_OFF, P, S, E, F.tid);
            } SEAM(5);
            if (IN(6)) { LAUNDER();
                META_TASK(D / 16, meta::down(F, mscr, 16 * task));
                pg8::ProbPlain P{(const char*)WSP(bf16, WS_ACT), (const char*)WSP(bf16, WS_WD), 128, 128, DFF / 64, 0, 32768, (size_t)(DFF / 64) * 32768, 32768, (size_t)(DFF / 64) * 32768};
                pg8::StaticOrder S; S.init(M, D, F.G, (int)blockIdx.x); S.rev = true;
                pg8::EpiResid E{WSP(bf16, WS_HB), ssq};
                pg8::gemm_phase<pg8::ProbPlain, pg8::EpiResid, pg8::StaticOrder, true>(F.lds + RING_OFF, P, S, E, F.tid);
            } SEAM(6);
        }
    }
    if (IN(11)) { LAUNDER(); moe_route(F, args); } SEAM(11);
    if (IN(12)) { LAUNDER(); moe_slots(F); } SEAM(12);
    for (int k = 0; k < 2; ++k) {
        const int* tab = WSP(int, WS_MOETAB); const int* slot_tok = WSP(int, WS_SLOTTOK) + k * NSLOT; const float* slot_w = WSP(float, WS_SLOTW) + k * NSLOT;
        if (IN(13 + 2 * k)) { LAUNDER();
            if (k == 1) moe_fix(F, 0, __builtin_amdgcn_readfirstlane(tab[16]) - 256);
            const int ntile = __builtin_amdgcn_readfirstlane(tab[16 + k]);
            LAS int* etab = (LAS int*)(F.lds + XTRA_OFF + 1024);
            for (int i = F.tid; i < MAXTILES; i += NWAVES * 64) etab[i] = tab[32 + k * MAXTILES + i];
            __syncthreads();
            pg8::ProbMoeGU P{(const char*)WSP(unsigned char, WS_POOLED), (const char*)WSP(unsigned char, WS_MGU), D, D, D / 128, slot_tok, etab, (LAS int*)(F.lds + XTRA_OFF), (size_t)2 * DFE * D};
            pg8::LinearOrder S{ntile, 2 * DFE / 256, F.G, F.vcu, false};
            pg8::EpiSwiGLU8 E{WSP(float, WS_SLOTRS) + k * NSLOT, WSP(unsigned char, WS_ACT)};
            pg8::gemm_phase<pg8::ProbMoeGU, pg8::EpiSwiGLU8, pg8::LinearOrder, true, true>(F.lds + RING_OFF, P, S, E, F.tid);
        } SEAM(13 + 2 * k);
        if (IN(14 + 2 * k)) { LAUNDER();
            const int ntile = __builtin_amdgcn_readfirstlane(tab[16 + k]);
            LAS int* etab = (LAS int*)(F.lds + XTRA_OFF + 1024);
            for (int i = F.tid; i < MAXTILES; i += NWAVES * 64) etab[i] = tab[32 + k * MAXTILES + i];
            __syncthreads();
            { pg8::ProbMoeDown P{(const char*)WSP(unsigned char, WS_ACT), (const char*)WSP(unsigned char, WS_MD), 128, 128, DFE / 128, etab, 32768, (size_t)(DFE / 128) * 32768, 32768, (size_t)(DFE / 128) * 32768, (size_t)D * DFE};
              pg8::LinearOrder S{256, D / 256, F.G, F.vcu, true}; S.base = ntile - 256;
              pg8::EpiMoeDown E{k == 0 ? WSP(bf16, WS_HB) : (bf16*)F.out, k == 0 ? (bf16*)F.out : WSP(bf16, WS_HB), slot_tok, slot_w, 1.0f / W8_DN};
              pg8::gemm_phase<pg8::ProbMoeDown, pg8::EpiMoeDown, pg8::LinearOrder, true, true>(F.lds + RING_OFF, P, S, E, F.tid); }
            { pg8::ProbMoeDownQ P{(const char*)WSP(unsigned char, WS_ACT), (const char*)WSP(unsigned char, WS_MD), 128, 128, DFE / 128 / pg8::NQ, etab, (size_t)(DFE / 128) * 32768, (size_t)(DFE / 128) * 32768, (size_t)D * DFE};
              pg8::QuarterOrder S{ntile - 256, F.G, F.vcu};
              pg8::EpiSlab E{WSP(float, WS_SLAB)};
              pg8::gemm_phase<pg8::ProbMoeDownQ, pg8::EpiSlab, pg8::QuarterOrder, true, true>(F.lds + RING_OFF, P, S, E, F.tid); }
        } SEAM(14 + 2 * k);
    }
    if (IN(17)) { LAUNDER(); moe_fix(F, 1, __builtin_amdgcn_readfirstlane(WSP(int, WS_MOETAB)[17]) - 256); } SEAM(17);
    if (IN(18)) { LAUNDER(); final_norm(F, args); }
#undef IN
#undef SEAM
#undef META_TASK
#undef LAUNDER
}

extern "C" void kernel_launch(void* const* d_in, const int* in_sizes, int n_in, void* d_out, int out_size, void* d_ws, size_t ws_size, hipStream_t stream) {
    static int grid = 0;
    if (grid == 0) {
        if (n_in != 18 || in_sizes[0] != M * D || out_size != M * D || ws_size < WS_END) { fprintf(stderr, "kernel_launch: unexpected shapes (n_in %d, in0 %d, out %d, ws %zu); nothing launched\n", n_in, n_in > 0 ? in_sizes[0] : -1, out_size, ws_size); grid = -1; return; }
        int dev = 0, cus = 0, per_cu = 0;
        if (hipGetDevice(&dev) != hipSuccess || hipDeviceGetAttribute(&cus, hipDeviceAttributeMultiprocessorCount, dev) != hipSuccess) { grid = -1; return; }
        if (hipFuncSetAttribute((const void*)fwd, hipFuncAttributeMaxDynamicSharedMemorySize, LDS_BYTES) != hipSuccess) { fprintf(stderr, "kernel_launch: hipFuncSetAttribute failed\n"); grid = -1; return; }
        if (hipOccupancyMaxActiveBlocksPerMultiprocessor(&per_cu, (const void*)fwd, NWAVES * 64, LDS_BYTES) != hipSuccess || per_cu < 1) { fprintf(stderr, "kernel_launch: occupancy query reports %d workgroups per CU\n", per_cu); }
        (void)hipGetLastError();
        grid = cus;
    }
    if (grid < 0) return;
    if (hipMemsetAsync((char*)d_ws + WS_CTL, 0, CTL_ZERO_BYTES, stream) != hipSuccess) return;
    Args a{};
    for (int i = 0; i < 18; ++i) a.in[i] = (const float*)d_in[i];
    a.out = (float*)d_out; a.ws = (unsigned char*)d_ws;
#if MK_PER_PHASE
    for (int p = 0; p < NPHASES; ++p) { a.ph_lo = p; a.ph_hi = p + 1; hipLaunchKernelGGL(fwd, dim3(grid), dim3(NWAVES * 64), LDS_BYTES, stream, a); }
#else
    a.ph_lo = 0; a.ph_hi = NPHASES; hipLaunchKernelGGL(fwd, dim3(grid), dim3(NWAVES * 64), LDS_BYTES, stream, a);
#endif
}
```

```cpp
#include <hip/hip_runtime.h>
#include <cstdio>
#include <cstdint>

#define GAS __attribute__((address_space(1)))
#define LAS __attribute__((address_space(3)))
typedef unsigned short bf16;
typedef short bf16x8 __attribute__((ext_vector_type(8)));
typedef short s16x4 __attribute__((ext_vector_type(4)));
typedef float f32x2 __attribute__((ext_vector_type(2)));
typedef float f32x4 __attribute__((ext_vector_type(4)));
typedef float f32x16 __attribute__((ext_vector_type(16)));
typedef unsigned u32x2 __attribute__((ext_vector_type(2)));
typedef unsigned u32x4 __attribute__((ext_vector_type(4)));
typedef GAS unsigned gu32;
#define RLX_AGENT __ATOMIC_RELAXED, __HIP_MEMORY_SCOPE_AGENT
#define LDS_WAIT() asm volatile("s_waitcnt lgkmcnt(0)" ::: "memory")
#define VM_WAIT() asm volatile("s_waitcnt vmcnt(0)" ::: "memory")
#define DI __device__ __forceinline__
#define GLOBAL_AS __attribute__((address_space(1)))

constexpr int NB = 8, SEQ = 8192, D = 1024, M = NB * SEQ;
constexpr int NMETA = 16;
constexpr int NH = 16, HD = 64, NKV = 2, QG = 8, KVW = 128, POOLW = 512;
constexpr int USEQ = SEQ + NMETA;
constexpr int INW = 3840;
constexpr int DFF = 2816, NE = 8, DFE = 3584;
constexpr float RMS_EPS = 1e-5f;
constexpr float LOG2E = 1.4426950408889634f;
constexpr float QSCALE = 0.125f * LOG2E;
constexpr int NSLOT = M + NE * 256;
constexpr int MAXTILES = NSLOT / 256;

constexpr size_t MiB = 1u << 20;
constexpr size_t WS_CTL = 0, CTL_ZERO_BYTES = 1 * MiB;
constexpr size_t WS_SSQ = 1 * MiB;
constexpr size_t WS_TOKE = 5 * MiB;
constexpr size_t WS_TOKW = 5 * MiB + 512 * 1024;
constexpr size_t WS_SLOTTOK = 6 * MiB;
constexpr size_t WS_SLOTW = 7 * MiB;
constexpr size_t WS_WGCNT = 8 * MiB;
constexpr size_t WS_MOETAB = 8 * MiB + 64 * 1024;
constexpr size_t WS_SLOTRS = 8 * MiB + 128 * 1024;
constexpr size_t WS_META = 9 * MiB;
constexpr size_t WS_WIN = 16 * MiB;
constexpr size_t WS_WA = 31 * MiB;
constexpr size_t WS_WP = 35 * MiB;
constexpr size_t WS_WO = 36 * MiB;
constexpr size_t WS_WGU = 40 * MiB;
constexpr size_t WS_WD = 51 * MiB;
constexpr size_t WS_MGU = 57 * MiB;
constexpr size_t WS_MD = 169 * MiB;
constexpr size_t WS_HB = 225 * MiB;
constexpr size_t WS_POOLED = 353 * MiB;
constexpr size_t WS_Q = 417 * MiB;
constexpr size_t WS_K = 545 * MiB;
constexpr size_t WS_V = 561 * MiB;
constexpr size_t WS_U = 577 * MiB;
constexpr size_t WS_G = 642 * MiB;
constexpr size_t WS_ACT = 417 * MiB;
constexpr size_t WS_SLAB = 898 * MiB;
constexpr size_t WS_END = 930 * MiB;
static_assert(WS_ACT + (size_t)NSLOT * DFE * 2 <= WS_END && WS_ACT + (size_t)M * DFF * 2 <= WS_END, "act overlay");
constexpr size_t MO_HM = 0;
constexpr size_t MO_XM = 64 * 1024;
constexpr size_t MO_PROJ = 96 * 1024;
constexpr size_t MO_KM = 336 * 1024;
constexpr size_t MO_VM = 344 * 1024;
constexpr size_t MO_UM = 352 * 1024;
constexpr size_t MO_ATT = 384 * 1024;
constexpr size_t MO_POOL = 416 * 1024;
constexpr size_t MO_MRG = 432 * 1024;
constexpr size_t MO_ACT = 464 * 1024;
constexpr int CW_TMO = 0, CW_CODE = 1, CW_BAR = 4096;

constexpr int RING_OFF = 0, RING_BYTES = 147456;
constexpr int LDSCTL_OFF = RING_BYTES, MISC_OFF = LDSCTL_OFF + 320;
constexpr int XTRA_OFF = LDSCTL_OFF + 1024;
constexpr int LDS_BYTES = RING_BYTES + 4096;

DI unsigned f2bf(float f) { unsigned u = __builtin_bit_cast(unsigned, f); return (u + 0x7fffu + ((u >> 16) & 1u)) >> 16; }
DI unsigned pk2(float lo, float hi) { unsigned r; asm volatile("v_cvt_pk_bf16_f32 %0, %1, %2" : "=v"(r) : "v"(lo), "v"(hi)); return r; }
DI float sat8(float v) { return __builtin_amdgcn_fmed3f(v, -448.f, 448.f); }
DI unsigned pk4_fp8(float a, float b, float c, float d) { int w = __builtin_amdgcn_cvt_pk_fp8_f32(sat8(a), sat8(b), 0, false); w = __builtin_amdgcn_cvt_pk_fp8_f32(sat8(c), sat8(d), w, true); return (unsigned)w; }
constexpr float W8_GU = 64.f, W8_DN = 128.f;
DI float bf2f(unsigned short b) { return __builtin_bit_cast(float, (unsigned)b << 16); }
DI float bflo(unsigned w) { return __builtin_bit_cast(float, w << 16); }
DI float bfhi(unsigned w) { return __builtin_bit_cast(float, w & 0xffff0000u); }
DI int hw_lane() { int l; asm volatile("v_mbcnt_lo_u32_b32 %0, -1, 0\n\tv_mbcnt_hi_u32_b32 %0, -1, %0" : "=v"(l)); return l; }
DI float shx(float v, int mask, int lane) { return __builtin_bit_cast(float, __builtin_amdgcn_ds_bpermute((lane ^ mask) << 2, __builtin_bit_cast(int, v))); }
DI float wave_sum(float v, int lane) {
#pragma unroll
    for (int o = 1; o < 64; o <<= 1) v += shx(v, o, lane);
    return v;
}
DI float fast_sigmoid(float x) { return __builtin_amdgcn_rcpf(1.f + __builtin_amdgcn_exp2f(-x * LOG2E)); }
DI float sigmoid_scaled(float a, float nsl2) { return __builtin_amdgcn_rcpf(1.f + __builtin_amdgcn_exp2f(a * nsl2)); }

#define XB_TMO      128
#define XB_XCNT(j)  (256  + 64 * (j))
#define XB_XSUB(j)  (1280 + 64 * (j))
#define XB_XGEN(j)  (2304 + 64 * (j))
#define XB_TOP      3328
#define XB_TOPGEN   3392
#define XCD_BAR_WORDS 3456
#define XB_SPIN_CAP (1u << 18)
DI unsigned xb_ld(unsigned* p)              { return __hip_atomic_load(p, __ATOMIC_RELAXED, __HIP_MEMORY_SCOPE_AGENT); }
DI unsigned xb_add(unsigned* p, unsigned v) { return __hip_atomic_fetch_add(p, v, __ATOMIC_RELAXED, __HIP_MEMORY_SCOPE_AGENT); }
DI unsigned xb_xcc_id() { return (unsigned)__builtin_amdgcn_s_getreg((3 << 11) | 20) & 0xFu; }
#define XB_SPIN(cond, bar) do { unsigned _sp = 0; while (cond) { __builtin_amdgcn_s_sleep(1); \
    if ((++_sp & 255u) == 0u) { if (xb_ld(&(bar)[XB_TMO])) break; if (_sp > XB_SPIN_CAP) { atomicAdd(&(bar)[XB_TMO], 1u); break; } } } } while (0)
struct XcdBarrier { unsigned* bar; unsigned x; volatile LAS unsigned* st; };
DI XcdBarrier xcd_barrier_post(unsigned* bar, volatile LAS unsigned* st, int tid) {
    XcdBarrier b; b.bar = bar; b.x = xb_xcc_id(); b.st = st;
    if (tid == 0) (void)xb_add(&bar[XB_XCNT(b.x)], 1u);
    return b;
}
DI void xcd_barrier_complete(unsigned* bar, unsigned x, unsigned& nloc, unsigned& nx) {
    const unsigned G = gridDim.x * gridDim.y * gridDim.z;
    unsigned sum, cnt, mine, sp = 0u;
    for (;;) {
        sum = 0u; cnt = 0u; mine = 0u;
#pragma unroll
        for (unsigned j = 0; j < 16; ++j) { const unsigned c = xb_ld(&bar[XB_XCNT(j)]); sum += c; cnt += (c > 0u) ? 1u : 0u; mine = (j == x) ? c : mine; }
        if (sum == G) break;
        __builtin_amdgcn_s_sleep(1);
        if ((++sp & 255u) == 0u) { if (xb_ld(&bar[XB_TMO])) break; if (sp > XB_SPIN_CAP) { atomicAdd(&bar[XB_TMO], 1u); break; } }
    }
    nloc = mine > 0u ? mine : 1u; nx = cnt > 0u ? cnt : 1u;
}
DI void xcd_barrier(const XcdBarrier& b, int tid) {
    asm volatile("s_waitcnt vmcnt(0)" ::: "memory");
    __syncthreads();
    if (tid == 0) {
        unsigned* bar = b.bar;
        __builtin_amdgcn_s_waitcnt(0);
        unsigned nloc = b.st[0], nx = b.st[1];
        if (nloc == 0u) { xcd_barrier_complete(bar, b.x, nloc, nx); b.st[0] = nloc; b.st[1] = nx; }
        const unsigned old = xb_add(&bar[XB_XSUB(b.x)], 1u);
        const unsigned gen = old / nloc;
        if (old + 1u == (gen + 1u) * nloc) {
            __builtin_amdgcn_fence(__ATOMIC_RELEASE, "agent");
            asm volatile("s_waitcnt vmcnt(0)" ::: "memory");
            const unsigned og = xb_add(&bar[XB_TOP], 1u);
            const unsigned tg = og / nx;
            if (og + 1u == (tg + 1u) * nx) xb_add(&bar[XB_TOPGEN], 1u);
            else XB_SPIN(xb_ld(&bar[XB_TOPGEN]) == tg, bar);
            __builtin_amdgcn_fence(__ATOMIC_ACQUIRE, "agent");
            xb_add(&bar[XB_XGEN(b.x)], 1u);
            asm volatile("s_waitcnt vmcnt(0)" ::: "memory");
        } else {
            XB_SPIN(xb_ld(&bar[XB_XGEN(b.x)]) == gen, bar);
            __builtin_amdgcn_fence(__ATOMIC_ACQUIRE, "agent");
            asm volatile("s_waitcnt vmcnt(0)" ::: "memory");
        }
    }
    __syncthreads();
}
namespace pg8 {
constexpr int BM = 256, BK = 64, HALF = 128, HTB = HALF * BK * 2, STAGE_BYTES = 8 * HTB, NXCD = 8, WGM = 8;
__host__ __device__ __forceinline__ int lds_byte(int r, int c) { const int st = (r >> 4) * 2 + (c >> 5), rr = r & 15, cc = c & 31, ob = rr * 64 + cc * 2; return st * 1024 + (ob ^ (((ob >> 9) & 1) << 5)); }
__host__ __device__ __forceinline__ void stage_rc(int b, int& R, int& C) { const int st = b / 1024, sb = b % 1024, swz = sb ^ (((sb >> 9) & 1) << 5); R = (st >> 1) * 16 + swz / 64; C = (st & 1) * 32 + (swz % 64) / 2; }
__host__ __device__ __forceinline__ int perm32(int rho) { const int n = rho >> 4, i = rho & 15; return 8 * (i >> 2) + 4 * n + (i & 3); }

struct Unit { int pm, pn; int kq = 0; };

struct StaticOrder {
    int nM, nN, nwg, G, c; bool rev = false;
    DI void init(int M_, int N_, int G_, int c_) { nM = M_ / BM; nN = N_ / BM; nwg = nM * nN; G = G_; c = c_; }
    DI bool next(int i, Unit& u) const {
        const long L = (long)i * G + c; if (L >= nwg) return false;
        int wgid = (int)L; { const int q = nwg / NXCD, r = nwg % NXCD, xcd = wgid % NXCD, off = wgid / NXCD; wgid = (xcd < r ? xcd * (q + 1) : r * (q + 1) + (xcd - r) * q) + off; }
        const int nig = WGM * nN, gid = wgid / nig, fm = gid * WGM, gsz = (nM - fm) < WGM ? (nM - fm) : WGM;
        u.pm = fm + ((wgid % nig) % gsz); u.pn = (wgid % nig) / gsz; if (rev) u.pm = nM - 1 - u.pm; return true;
    }
};
struct LinearOrder {
    int ntile, nN, G, c; bool rev; int base = 0;
    DI bool next(int i, Unit& u) const {
        const long L = (long)i * G + c; if (L >= (long)ntile * nN) return false;
        constexpr int gt = 8; const int per8 = gt * nN, g = (int)(L / per8), w = (int)(L % per8), gsz = (ntile - gt * g) < gt ? (ntile - gt * g) : gt;
        u.pm = gt * g + w % gsz; u.pn = w / gsz; if (rev) u.pm = ntile - 1 - u.pm; u.pm += base; return true; }
};
constexpr int NQ = 2;
struct QuarterOrder {
    int ntail, G, c;
    DI bool next(int i, Unit& u) const { const long L = (long)i * G + c; if (L >= (long)ntail * 4 * NQ) return false; u.pm = (int)(L / (4 * NQ)); u.pn = (int)((L / NQ) & 3); u.kq = (int)(L % NQ); return true; }
};

struct ProbPlain {
    static constexpr bool GATHER = false;
    const char* A; const char* Bt; unsigned lda2, ldb2; int nt; unsigned acol2;
    unsigned kstepA; size_t panelA;
    unsigned kstepB = 128; size_t panelB = 0;
    DI unsigned a_base(const Unit& u) const { return (unsigned)((size_t)u.pm * panelA + (size_t)u.pn * acol2); }
    DI unsigned b_base(const Unit& u) const { return (unsigned)((size_t)u.pn * (panelB ? panelB : (size_t)BM * ldb2)); }
    DI unsigned a_row(const Unit&, int r) const { return (unsigned)r * lda2; }
};
struct ProbMoeGU {
    static constexpr bool GATHER = true;
    static constexpr unsigned kstepA = 128, kstepB = 128;
    const char* A; const char* Bt; unsigned lda2, ldb2; int nt; const int* slot_tok; const LAS int* tile_e; LAS int* gtab; size_t estride;
    DI unsigned a_base(const Unit&) const { return 0u; }
    DI unsigned a_row_lds(int r) const { int t = gtab[r]; t = t < 0 ? 0 : t; return (unsigned)t * lda2; }
    DI void prefetch_rows(const Unit& u, int wid, int lane) const { if (wid < 4) __builtin_amdgcn_global_load_lds((const unsigned*)(slot_tok + u.pm * BM + wid * 64 + lane), (LAS unsigned*)(gtab + wid * 64), 4, 0, 0); }
    DI unsigned b_base(const Unit& u) const { return (unsigned)((size_t)tile_e[u.pm] * estride + (size_t)u.pn * BM * ldb2); }
    DI unsigned a_row(const Unit& u, int r) const { int t = slot_tok[u.pm * BM + r]; t = t < 0 ? 0 : t; return (unsigned)t * lda2; }
};
struct ProbMoeDown {
    static constexpr bool GATHER = false;
    const char* A; const char* Bt; unsigned lda2, ldb2; int nt; const LAS int* tile_e; unsigned kstepA; size_t panelA; unsigned kstepB; size_t panelB; size_t estride;
    DI unsigned a_base(const Unit& u) const { return (unsigned)((size_t)u.pm * panelA); }
    DI unsigned b_base(const Unit& u) const { return (unsigned)((size_t)tile_e[u.pm] * estride + (size_t)u.pn * panelB); }
    DI unsigned a_row(const Unit&, int r) const { return (unsigned)r * lda2; }
};

struct ProbMoeDownQ {
    static constexpr bool GATHER = false; static constexpr unsigned kstepA = 32768, kstepB = 32768;
    const char* A; const char* Bt; unsigned lda2, ldb2; int nt; const LAS int* tile_e; size_t panelA, panelB, estride;
    DI unsigned a_base(const Unit& u) const { return (unsigned)((size_t)u.pm * panelA + (size_t)u.kq * nt * 32768); }
    DI unsigned b_base(const Unit& u) const { return (unsigned)((size_t)tile_e[u.pm] * estride + (size_t)u.pn * panelB + (size_t)u.kq * nt * 32768); }
    DI unsigned a_row(const Unit&, int r) const { return (unsigned)r * lda2; }
};

template <class Prob, class Epi, class Sched, bool ALIGN_EPI, bool FP8 = false>
DI void gemm_phase(LAS unsigned char* lds, const Prob& P, const Sched& S, const Epi& E, int tid) {
    asm volatile("" : "+v"(tid));
    const int wid = __builtin_amdgcn_readfirstlane(tid >> 6), lane = tid & 63, wr = wid >> 2, wc = wid & 3, fr = lane & 15, fq = lane >> 4;
    const int nt = P.nt;
    int R0, C0, R1, C1; stage_rc(tid * 16, R0, C0); stage_rc(tid * 16 + 8192, R1, C1);
    const int Rb0 = Epi::PERM ? ((R0 & ~31) + perm32(R0 & 31)) : R0, Rb1 = Epi::PERM ? ((R1 & ~31) + perm32(R1 & 31)) : R1;
    const unsigned voffB0 = (unsigned)Rb0 * P.ldb2 + (unsigned)C0 * 2u, voffB1 = (unsigned)Rb1 * P.ldb2 + (unsigned)C1 * 2u;
    const unsigned kstep = P.kstepB, kstepA = P.kstepA;
    const unsigned hstepB = (unsigned)HALF * P.ldb2;
    const __amdgpu_buffer_rsrc_t rsA = __builtin_amdgcn_make_buffer_rsrc((void*)P.A, 0, -1, 0x00020000), rsB = __builtin_amdgcn_make_buffer_rsrc((void*)P.Bt, 0, -1, 0x00020000);
    const unsigned ldsw = (unsigned)wid * 1024u;
    const int aoff = lds_byte(wr * 64 + fr, fq * 8), boff = lds_byte(wc * 32 + fr, fq * 8);
#define PG8_SA(b, h) (((b) * 2 + (h)) * HTB)
#define PG8_SB(b, h) ((4 + (b) * 2 + (h)) * HTB)
#define PG8_STGX(rs, bufoff, soff, v0, v1) do { \
        __builtin_amdgcn_raw_ptr_buffer_load_lds(rs, (LAS unsigned*)(lds + (bufoff) + ldsw), 16, (int)(v0), (int)(soff), 0, 0); \
        __builtin_amdgcn_raw_ptr_buffer_load_lds(rs, (LAS unsigned*)(lds + (bufoff) + ldsw + 8192), 16, (int)(v1), (int)(soff), 0, 0); } while (0)
#define PG8_STG(bufoff, soff, v0, v1) PG8_STGX(rsA, bufoff, soff, v0, v1)
#define PG8_STGB(bufoff, soff) PG8_STGX(rsB, bufoff, soff, voffB0, voffB1)
#define PG8_LDA(dst, b, h) do { if constexpr (FP8) { _Pragma("unroll") for (int m = 0; m < 4; ++m) { const i32x4_ lo_ = *(const LAS i32x4_*)(lds + PG8_SA(b, h) + aoff + m * 2048), hi_ = *(const LAS i32x4_*)(lds + PG8_SA(b, h) + aoff + m * 2048 + 1024); dst##8[m] = __builtin_shufflevector(lo_, hi_, 0, 1, 2, 3, 4, 5, 6, 7); } } \
        else { _Pragma("unroll") for (int m = 0; m < 4; ++m) _Pragma("unroll") for (int k = 0; k < 2; ++k) dst[m][k] = *(const LAS bf16x8*)(lds + PG8_SA(b, h) + aoff + m * 2048 + k * 1024); } } while (0)
#define PG8_LDB(dst, b, h) do { if constexpr (FP8) { _Pragma("unroll") for (int n = 0; n < 2; ++n) { const i32x4_ lo_ = *(const LAS i32x4_*)(lds + PG8_SB(b, h) + boff + n * 2048), hi_ = *(const LAS i32x4_*)(lds + PG8_SB(b, h) + boff + n * 2048 + 1024); dst##8[n] = __builtin_shufflevector(lo_, hi_, 0, 1, 2, 3, 4, 5, 6, 7); } } \
        else { _Pragma("unroll") for (int n = 0; n < 2; ++n) _Pragma("unroll") for (int k = 0; k < 2; ++k) dst[n][k] = *(const LAS bf16x8*)(lds + PG8_SB(b, h) + boff + n * 2048 + k * 1024); } } while (0)
#define PG8_MMA(ai, bj, At, Bt) do { __builtin_amdgcn_s_setprio(1); _Pragma("unroll") for (int m = 0; m < 4; ++m) _Pragma("unroll") for (int n = 0; n < 2; ++n) { \
        if constexpr (FP8) { acc[ai][bj][m][n] = __builtin_amdgcn_mfma_scale_f32_16x16x128_f8f6f4(Bt##8[n], At##8[m], acc[ai][bj][m][n], 0, 0, 0, 0x7f7f7f7f, 0, 0x7f7f7f7f); } \
        else { _Pragma("unroll") for (int k = 0; k < 2; ++k) acc[ai][bj][m][n] = __builtin_amdgcn_mfma_f32_16x16x32_bf16(Bt[n][k], At[m][k], acc[ai][bj][m][n], 0, 0, 0); } } \
        __builtin_amdgcn_s_setprio(0); } while (0)
#define PG8_WAIT_V(n) asm volatile("s_waitcnt vmcnt(" #n ")" ::: "memory")
#define PG8_WAIT_L(n) asm volatile("s_waitcnt lgkmcnt(" #n ")" ::: "memory")
#define PG8_BAR __builtin_amdgcn_s_barrier()
#define PG8_SCHED __builtin_amdgcn_sched_barrier(0)
    Unit cur, nxt; int ui = 0;
    if (!S.next(0, cur)) return;
    f32x4 acc[2][2][4][2];
#pragma unroll
    for (int a = 0; a < 2; ++a)
#pragma unroll
        for (int b = 0; b < 2; ++b)
#pragma unroll
            for (int m = 0; m < 4; ++m)
#pragma unroll
                for (int n = 0; n < 2; ++n) acc[a][b][m][n] = (f32x4){0.f, 0.f, 0.f, 0.f};
    bf16x8 At[4][2], B0[2][2], B1[2][2];
    typedef int i32x8_ __attribute__((ext_vector_type(8))); typedef int i32x4_ __attribute__((ext_vector_type(4)));
    i32x8_ At8[4], B08[2], B18[2];
    unsigned vc00, vc01, vc10, vc11;
#define PG8_AOFF(u, o00, o01, o10, o11) do { o00 = P.a_row(u, R0) + (unsigned)C0 * 2u; o01 = P.a_row(u, R1) + (unsigned)C1 * 2u; \
        o10 = P.a_row(u, HALF + R0) + (unsigned)C0 * 2u; o11 = P.a_row(u, HALF + R1) + (unsigned)C1 * 2u; } while (0)
    PG8_AOFF(cur, vc00, vc01, vc10, vc11);
    unsigned cA = P.a_base(cur), cB = P.b_base(cur);
    PG8_STGB(PG8_SB(0, 0), cB); PG8_STGB(PG8_SB(0, 1), cB + hstepB); PG8_STG(PG8_SA(0, 0), cA, vc00, vc01); PG8_STG(PG8_SA(0, 1), cA, vc10, vc11);
    if (wr == 1) PG8_BAR;
    PG8_WAIT_V(2); PG8_BAR;
    PG8_STGB(PG8_SB(1, 0), cB + kstep); PG8_STG(PG8_SA(1, 0), cA + kstepA, vc00, vc01); PG8_STGB(PG8_SB(1, 1), cB + hstepB + kstep);
    PG8_WAIT_V(6); PG8_BAR;
    for (;;) {
        const bool has_next = S.next(ui + 1, nxt);
        unsigned nA = cA, nB = cB;
        if (has_next) { nA = P.a_base(nxt); nB = P.b_base(nxt); if constexpr (Prob::GATHER) { P.prefetch_rows(nxt, wid, lane); } }
        for (int t = 0; t < nt; t += 2) {
            const bool last = (t == nt - 2);
            const unsigned a1 = cA + (unsigned)(t + 1) * kstepA;
            const unsigned a2 = last ? nA : cA + (unsigned)(t + 2) * kstepA, b2 = last ? nB : cB + (unsigned)(t + 2) * kstep;
            const unsigned a3 = a2 + kstepA, b3 = b2 + kstep;
            PG8_LDB(B0, 0, 0); PG8_LDB(B1, 0, 1); PG8_SCHED; PG8_LDA(At, 0, 0); PG8_STG(PG8_SA(1, 1), a1, vc10, vc11);
            if constexpr (Prob::GATHER) { if (last && has_next) {
                vc00 = P.a_row_lds(R0) + (unsigned)C0 * 2u; vc01 = P.a_row_lds(R1) + (unsigned)C1 * 2u; vc10 = P.a_row_lds(HALF + R0) + (unsigned)C0 * 2u; vc11 = P.a_row_lds(HALF + R1) + (unsigned)C1 * 2u; } }
            PG8_WAIT_V(8); PG8_WAIT_L(0); PG8_BAR; PG8_MMA(0, 0, At, B0); PG8_MMA(0, 1, At, B1); PG8_BAR; PG8_SCHED;
            PG8_LDA(At, 0, 1); PG8_STGB(PG8_SB(0, 0), b2); PG8_STGB(PG8_SB(0, 1), b2 + hstepB); PG8_STG(PG8_SA(0, 0), a2, vc00, vc01);
            PG8_WAIT_V(8); PG8_WAIT_L(0); PG8_BAR; PG8_MMA(1, 0, At, B0); PG8_MMA(1, 1, At, B1); PG8_BAR; PG8_SCHED;
            PG8_LDB(B0, 1, 0); PG8_LDB(B1, 1, 1); PG8_SCHED; PG8_LDA(At, 1, 0); PG8_STG(PG8_SA(0, 1), a2, vc10, vc11);
            PG8_WAIT_V(8); PG8_WAIT_L(0); PG8_BAR; PG8_MMA(0, 0, At, B0); PG8_MMA(0, 1, At, B1); PG8_BAR; PG8_SCHED;
            PG8_LDA(At, 1, 1); PG8_STGB(PG8_SB(1, 0), b3); PG8_STGB(PG8_SB(1, 1), b3 + hstepB); PG8_STG(PG8_SA(1, 0), a3, vc00, vc01);
            PG8_WAIT_V(8); PG8_WAIT_L(0); PG8_BAR; PG8_MMA(1, 0, At, B0); PG8_MMA(1, 1, At, B1); PG8_BAR; PG8_SCHED;
        }
#ifdef PROBE_EPI
        const unsigned te_ = (unsigned)__builtin_amdgcn_s_memrealtime();
#endif
        if constexpr (ALIGN_EPI) { if (wr == 0) PG8_BAR; }
        PG8_SCHED; E(acc, cur, wr, wc, fr, fq); PG8_SCHED;
#ifdef PROBE_EPI
        if (tid == 0) { volatile LAS unsigned* pw_ = (volatile LAS unsigned*)(lds - RING_OFF + MISC_OFF) + 32; if (pw_[0]) pw_[1] += (unsigned)__builtin_amdgcn_s_memrealtime() - te_; }
#endif
        if (!has_next) break;
#pragma unroll
        for (int a = 0; a < 2; ++a)
#pragma unroll
            for (int b = 0; b < 2; ++b)
#pragma unroll
                for (int m = 0; m < 4; ++m)
#pragma unroll
                    for (int n = 0; n < 2; ++n) acc[a][b][m][n] = (f32x4){0.f, 0.f, 0.f, 0.f};
        cur = nxt; cA = nA; cB = nB; ++ui;
        if constexpr (ALIGN_EPI) { if (wr == 1) PG8_BAR; }
    }
    PG8_WAIT_V(0);
    if constexpr (!ALIGN_EPI) { if (wr == 0) PG8_BAR; }
    PG8_BAR;
#undef PG8_SA
#undef PG8_SB
#undef PG8_STG
#undef PG8_STGX
#undef PG8_STGB
#undef PG8_LDA
#undef PG8_LDB
#undef PG8_MMA
#undef PG8_WAIT_V
#undef PG8_WAIT_L
#undef PG8_BAR
#undef PG8_SCHED
#undef PG8_AOFF
}
}
namespace pg8 {
DI u32x4 pack8(const f32x4 v0, const f32x4 v1) { u32x4 w; w.x = pk2(v0[0], v0[1]); w.y = pk2(v0[2], v0[3]); w.z = pk2(v1[0], v1[1]); w.w = pk2(v1[2], v1[3]); return w; }

DI void rstd4_load(f32x4 (&p)[4], const float* ssq16, int row0, int fq) {
#pragma unroll
    for (int m = 0; m < 4; ++m) p[m] = *(const f32x4*)(ssq16 + (size_t)(row0 + m * 16) * 16 + 4 * fq);
}
DI float rstd_finish(const f32x4 p, int lane) { float s = (p[0] + p[1]) + (p[2] + p[3]); s += shx(s, 16, lane); s += shx(s, 32, lane); return __builtin_amdgcn_rsqf(s * (1.0f / D) + RMS_EPS); }
#define EPI_FENCE() asm volatile("" ::: "memory")

struct EpiInProj {
    static constexpr bool PERM = true, TWICE_OK = true;
    const float* ssq16; bf16 *Q, *K, *V, *U, *G;
    DI void operator()(const f32x4 (&acc)[2][2][4][2], const Unit& u, int wr, int wc, int fr, int fq) const {
        const int row0 = u.pm * BM + wr * 64 + fr, cw = wc * 32 + 8 * fq;
        const int pn = u.pn;
        bf16* base0; bf16* base1; int ldc, col0, col1, mode;
        if (pn < 4) { base0 = base1 = Q; ldc = D; col0 = pn * 256 + cw; col1 = col0 + HALF; mode = 1; }
        else if (pn == 4) { base0 = K; base1 = V; ldc = KVW; col0 = col1 = cw; mode = 0; }
        else if (pn < 7) { base0 = base1 = U + (size_t)(NMETA * ((u.pm >> 5) + 1)) * POOLW; ldc = POOLW; col0 = (pn - 5) * 256 + cw; col1 = col0 + HALF; mode = 0; }
        else { base0 = base1 = G; ldc = 2 * D; col0 = (pn - 7) * 256 + cw; col1 = col0 + HALF; mode = 2; }
        f32x4 pp[2][4]; rstd4_load(pp[0], ssq16, row0, fq); rstd4_load(pp[1], ssq16, row0 + HALF, fq);
#pragma unroll
        for (int ai = 0; ai < 2; ++ai) {
#pragma unroll
            for (int m = 0; m < 4; ++m) {
                const int row = row0 + ai * HALF + m * 16;
                const float sc = rstd_finish(pp[ai][m], fq * 16 + fr) * (mode == 1 ? QSCALE : 1.f);
#pragma unroll
                for (int bj = 0; bj < 2; ++bj) {
                    f32x4 v0, v1;
                    if (mode == 2) { const float nsl2 = -sc * LOG2E;
#pragma unroll
                        for (int j = 0; j < 4; ++j) { v0[j] = sigmoid_scaled(acc[ai][bj][m][0][j], nsl2); v1[j] = sigmoid_scaled(acc[ai][bj][m][1][j], nsl2); }
                    } else { v0 = acc[ai][bj][m][0] * sc; v1 = acc[ai][bj][m][1] * sc; }
                    *(u32x4*)((bj ? base1 : base0) + (size_t)row * ldc + (bj ? col1 : col0)) = pack8(v0, v1);
                }
            }
            EPI_FENCE();
        }
    }
};
struct EpiPoolLift {
    static constexpr bool PERM = true, TWICE_OK = false;
    const bf16* G; bf16* MRG;
    DI void operator()(const f32x4 (&acc)[2][2][4][2], const Unit& u, int wr, int wc, int fr, int fq) const {
        const int row0 = u.pm * BM + wr * 64 + fr, col0 = u.pn * BM + wc * 32 + 8 * fq;
#pragma unroll
        for (int ai = 0; ai < 2; ++ai) {
            u32x4 g[4][2];
#pragma unroll
            for (int m = 0; m < 4; ++m)
#pragma unroll
                for (int bj = 0; bj < 2; ++bj) g[m][bj] = *(const u32x4*)(G + (size_t)(row0 + ai * HALF + m * 16) * (2 * D) + D + col0 + bj * HALF);
#pragma unroll
            for (int m = 0; m < 4; ++m) { const size_t r = (size_t)(row0 + ai * HALF + m * 16);
#pragma unroll
                for (int bj = 0; bj < 2; ++bj) { const u32x4 gg = g[m][bj];
                    f32x4 v0 = acc[ai][bj][m][0], v1 = acc[ai][bj][m][1];
                    v0[0] *= bflo(gg.x); v0[1] *= bfhi(gg.x); v0[2] *= bflo(gg.y); v0[3] *= bfhi(gg.y);
                    v1[0] *= bflo(gg.z); v1[1] *= bfhi(gg.z); v1[2] *= bflo(gg.w); v1[3] *= bfhi(gg.w);
                    *(u32x4*)(MRG + r * D + col0 + bj * HALF) = pack8(v0, v1); } }
            EPI_FENCE();
        }
    }
};
struct EpiMerge {
    static constexpr bool PERM = true, TWICE_OK = false;
    const bf16* G; bf16* MRG;
    DI void operator()(const f32x4 (&acc)[2][2][4][2], const Unit& u, int wr, int wc, int fr, int fq) const {
        const int row0 = u.pm * BM + wr * 64 + fr, col0 = u.pn * BM + wc * 32 + 8 * fq;
#pragma unroll
        for (int ai = 0; ai < 2; ++ai) {
            u32x4 g[4][2], pv[4][2];
#pragma unroll
            for (int m = 0; m < 4; ++m)
#pragma unroll
                for (int bj = 0; bj < 2; ++bj) { const size_t r = (size_t)(row0 + ai * HALF + m * 16); g[m][bj] = *(const u32x4*)(G + r * (2 * D) + col0 + bj * HALF); pv[m][bj] = *(const u32x4*)(MRG + r * D + col0 + bj * HALF); }
#pragma unroll
            for (int m = 0; m < 4; ++m) { const size_t r = (size_t)(row0 + ai * HALF + m * 16);
#pragma unroll
                for (int bj = 0; bj < 2; ++bj) { const u32x4 gg = g[m][bj], p = pv[m][bj];
                    f32x4 v0 = acc[ai][bj][m][0], v1 = acc[ai][bj][m][1];
                    v0[0] = v0[0] * bflo(gg.x) + bflo(p.x); v0[1] = v0[1] * bfhi(gg.x) + bfhi(p.x); v0[2] = v0[2] * bflo(gg.y) + bflo(p.y); v0[3] = v0[3] * bfhi(gg.y) + bfhi(p.y);
                    v1[0] = v1[0] * bflo(gg.z) + bflo(p.z); v1[1] = v1[1] * bfhi(gg.z) + bfhi(p.z); v1[2] = v1[2] * bflo(gg.w) + bflo(p.w); v1[3] = v1[3] * bfhi(gg.w) + bfhi(p.w);
                    *(u32x4*)(MRG + r * D + col0 + bj * HALF) = pack8(v0, v1); } }
            EPI_FENCE();
        }
    }
};
struct EpiResid {
    static constexpr bool PERM = true, TWICE_OK = false;
    bf16* HB; float* ssq16;
    DI void operator()(const f32x4 (&acc)[2][2][4][2], const Unit& u, int wr, int wc, int fr, int fq) const {
        const int row0 = u.pm * BM + wr * 64 + fr, col0 = u.pn * BM + wc * 32 + 8 * fq;
#pragma unroll
        for (int ai = 0; ai < 2; ++ai) {
            u32x4 hv[4][2];
#pragma unroll
            for (int m = 0; m < 4; ++m)
#pragma unroll
                for (int bj = 0; bj < 2; ++bj) hv[m][bj] = *(const u32x4*)(HB + (size_t)(row0 + ai * HALF + m * 16) * D + col0 + bj * HALF);
#pragma unroll
            for (int m = 0; m < 4; ++m) { const size_t r = (size_t)(row0 + ai * HALF + m * 16); float s = 0.f;
#pragma unroll
                for (int bj = 0; bj < 2; ++bj) { const u32x4 h = hv[m][bj];
                    f32x4 v0 = acc[ai][bj][m][0], v1 = acc[ai][bj][m][1];
                    v0[0] += bflo(h.x); v0[1] += bfhi(h.x); v0[2] += bflo(h.y); v0[3] += bfhi(h.y); v1[0] += bflo(h.z); v1[1] += bfhi(h.z); v1[2] += bflo(h.w); v1[3] += bfhi(h.w);
                    const u32x4 w = pack8(v0, v1); *(u32x4*)(HB + r * D + col0 + bj * HALF) = w;
                    s += (bflo(w.x) * bflo(w.x) + bfhi(w.x) * bfhi(w.x)) + (bflo(w.y) * bflo(w.y) + bfhi(w.y) * bfhi(w.y)) + (bflo(w.z) * bflo(w.z) + bfhi(w.z) * bfhi(w.z)) + (bflo(w.w) * bflo(w.w) + bfhi(w.w) * bfhi(w.w)); }
                s += shx(s, 16, fq * 16 + fr); s += shx(s, 32, fq * 16 + fr);
                if (fq == 0) ssq16[r * 16 + 4 * u.pn + wc] = s; }
            EPI_FENCE();
        }
    }
};
template <bool MOE> struct EpiSwiGLU {
    static constexpr bool PERM = true, TWICE_OK = false;
    const float* rsrc; bf16* ACT; int nkt;
    DI void operator()(const f32x4 (&acc)[2][2][4][2], const Unit& u, int wr, int wc, int fr, int fq) const {
        const int row0 = u.pm * BM + wr * 64 + fr;
        bf16* abase = ACT + ((size_t)(u.pm * nkt + 2 * u.pn + (wc >> 1)) * 256 + (wr * 64 + fr)) * 64 + (wc & 1) * 32 + 8 * fq;
        f32x4 pp[2][4]; float rsv[2][4];
        if (MOE) {
#pragma unroll
            for (int ai = 0; ai < 2; ++ai)
#pragma unroll
                for (int m = 0; m < 4; ++m) rsv[ai][m] = rsrc[row0 + ai * HALF + m * 16];
        } else { rstd4_load(pp[0], rsrc, row0, fq); rstd4_load(pp[1], rsrc, row0 + HALF, fq); }
#pragma unroll
        for (int ai = 0; ai < 2; ++ai) {
#pragma unroll
            for (int m = 0; m < 4; ++m) { const int r = row0 + ai * HALF + m * 16;
                const float rs = MOE ? rsv[ai][m] : rstd_finish(pp[ai][m], fq * 16 + fr); const float rs2 = rs * rs, nsl2 = -rs * LOG2E;
                f32x4 o[2];
#pragma unroll
                for (int n = 0; n < 2; ++n) { const f32x4 gu = acc[ai][0][m][n] * acc[ai][1][m][n] * rs2;
#pragma unroll
                    for (int j = 0; j < 4; ++j) o[n][j] = gu[j] * sigmoid_scaled(acc[ai][0][m][n][j], nsl2); }
                *(u32x4*)(abase + (ai * HALF + m * 16) * 64) = pack8(o[0], o[1]); }
            EPI_FENCE();
        }
    }
};
struct EpiSwiGLU8 {
    static constexpr bool PERM = true, TWICE_OK = false;
    const float* slot_rs; unsigned char* ACT8;
    DI void operator()(const f32x4 (&acc)[2][2][4][2], const Unit& u, int wr, int wc, int fr, int fq) const {
        const int row0 = wr * 64 + fr;
        unsigned char* base = ACT8 + ((size_t)(u.pm * (DFE / 128) + u.pn) * 256 + row0) * 128 + wc * 32 + 8 * fq;
        float rsv[2][4];
#pragma unroll
        for (int ai = 0; ai < 2; ++ai)
#pragma unroll
            for (int m = 0; m < 4; ++m) rsv[ai][m] = slot_rs[u.pm * BM + row0 + ai * HALF + m * 16];
#pragma unroll
        for (int ai = 0; ai < 2; ++ai) {
#pragma unroll
            for (int m = 0; m < 4; ++m) { const float rs = rsv[ai][m] * (1.0f / W8_GU), rs2 = rs * rs, nsl2 = -rs * LOG2E;
                f32x4 o[2];
#pragma unroll
                for (int n = 0; n < 2; ++n) { const f32x4 gu = acc[ai][0][m][n] * acc[ai][1][m][n] * rs2;
#pragma unroll
                    for (int j = 0; j < 4; ++j) o[n][j] = gu[j] * sigmoid_scaled(acc[ai][0][m][n][j], nsl2); }
                u32x2 w; w.x = pk4_fp8(o[0][0], o[0][1], o[0][2], o[0][3]); w.y = pk4_fp8(o[1][0], o[1][1], o[1][2], o[1][3]);
                *(u32x2*)(base + (size_t)(ai * HALF + m * 16) * 128) = w; }
            EPI_FENCE();
        }
    }
};
struct EpiMoeDown {
    static constexpr bool PERM = true, TWICE_OK = false;
    const bf16* SRC; bf16* DST; const int* slot_tok; const float* slot_w; float scale;
    DI void operator()(const f32x4 (&acc)[2][2][4][2], const Unit& u, int wr, int wc, int fr, int fq) const {
        const int row0 = u.pm * BM + wr * 64 + fr, col0 = u.pn * BM + wc * 32 + 8 * fq;
        int tk[2][4]; float wk[2][4];
#pragma unroll
        for (int ai = 0; ai < 2; ++ai)
#pragma unroll
            for (int m = 0; m < 4; ++m) { tk[ai][m] = slot_tok[row0 + ai * HALF + m * 16]; wk[ai][m] = slot_w[row0 + ai * HALF + m * 16] * scale; }
#pragma unroll
        for (int ai = 0; ai < 2; ++ai) {
            u32x4 hv[4][2];
#pragma unroll
            for (int m = 0; m < 4; ++m) { const int tok = tk[ai][m] < 0 ? 0 : tk[ai][m];
#pragma unroll
                for (int bj = 0; bj < 2; ++bj) hv[m][bj] = *(const u32x4*)(SRC + (size_t)tok * D + col0 + bj * HALF); }
#pragma unroll
            for (int m = 0; m < 4; ++m) { const int tok = tk[ai][m]; const float w = wk[ai][m];
                if (tok >= 0) {
#pragma unroll
                    for (int bj = 0; bj < 2; ++bj) { const u32x4 h = hv[m][bj];
                        f32x4 v0 = acc[ai][bj][m][0] * w, v1 = acc[ai][bj][m][1] * w;
                        v0[0] += bflo(h.x); v0[1] += bfhi(h.x); v0[2] += bflo(h.y); v0[3] += bfhi(h.y); v1[0] += bflo(h.z); v1[1] += bfhi(h.z); v1[2] += bflo(h.w); v1[3] += bfhi(h.w);
                        *(u32x4*)(DST + (size_t)tok * D + col0 + bj * HALF) = pack8(v0, v1); } } }
            EPI_FENCE();
        }
    }
};
struct EpiSlab {
    static constexpr bool PERM = false, TWICE_OK = false;
    float* slab;
    DI void operator()(const f32x4 (&acc)[2][2][4][2], const Unit& u, int wr, int wc, int fr, int fq) const {
        float* base = slab + ((size_t)(u.pm * NQ + u.kq) * BM + wr * 64 + fr) * D + u.pn * BM + wc * 32 + 4 * fq;
#pragma unroll
        for (int ai = 0; ai < 2; ++ai)
#pragma unroll
            for (int m = 0; m < 4; ++m)
#pragma unroll
                for (int bj = 0; bj < 2; ++bj)
#pragma unroll
                    for (int n = 0; n < 2; ++n) *(f32x4*)(base + (size_t)(ai * HALF + m * 16) * D + bj * HALF + n * 16) = acc[ai][bj][m][n];
    }
};
}
namespace att {
constexpr int KS_OFF = 0, KROW = 144, VT_OFF = 36864, VROW = 520, KM_OFF = 70144, VTM_OFF = 74752, VMROW = 72, RAWK_OFF = 79872, RAWV_OFF = RAWK_OFF + 32768, LDS_END = RAWV_OFF + 32768;
static_assert(LDS_END <= RING_BYTES, "attention LDS");
DI int crow(int i, int h) { return (i & 3) + 8 * (i >> 2) + 4 * h; }
struct Args { const bf16 *Q, *K, *V, *U, *KM, *VM, *UM; const float* sinks; bf16 *O, *POOLED; };
#define MFMA32(a, b, c) __builtin_amdgcn_mfma_f32_32x32x16_bf16((a), (b), (c), 0, 0, 0)
template <int WIN> DI void pool_load(unsigned (&xs)[47], const bf16* U, unsigned urow0, int col) {
    const char* ub = (const char*)U; const unsigned off0 = ((urow0 - (unsigned)(WIN - 1)) * POOLW + (unsigned)col) * 2u;
#pragma unroll
    for (int i = 0; i < 31 + WIN; ++i) xs[i] = *(const unsigned*)(ub + (off0 + (unsigned)i * (POOLW * 2u)));
}
template <int WIN> DI void pool_store(const unsigned (&xs)[47], bf16* POOLED, unsigned prow0, int col) {
    float a0 = 0.f, a1 = 0.f; const float invw = 1.0f / (float)WIN;
#pragma unroll
    for (int j = 0; j < WIN - 1; ++j) { a0 += bflo(xs[j]); a1 += bfhi(xs[j]); }
#pragma unroll
    for (int t = 0; t < 32; ++t) { const float x0 = bflo(xs[WIN - 1 + t]), x1 = bfhi(xs[WIN - 1 + t]); a0 += x0; a1 += x1;
        *(unsigned*)((char*)POOLED + ((prow0 + (unsigned)t) * POOLW + (unsigned)col) * 2u) = pk2(a0 * invw - x0, a1 * invw - x1);
        a0 -= bflo(xs[t]); a1 -= bfhi(xs[t]); }
}
DI void phase(LAS unsigned char* lds, const Args& A, int c, int G, int tid0) {
    asm volatile("" : "+v"(tid0));
    const int wid = __builtin_amdgcn_readfirstlane(tid0 >> 6);
    constexpr int NUNIT = NB * 64 * NKV;
    if (c >= NUNIT) return;
    bf16x8 qa[4], qb[4];
#define ATT_DECODE(L_, b_, nb_, kh_) const int b_ = (L_) >> 7, nb_ = ((L_) >> 1) & 63, kh_ = (L_) & 1
#define ATT_LOAD_KV(L_) do { ATT_DECODE(L_, b2, nb2, kh2); const size_t rb2 = (size_t)b2 * SEQ; const int s02 = (nb2 - 1) * 128; \
        _Pragma("unroll") for (int pass = 0; pass < 4; ++pass) { const int s = s02 + (tid >> 3) + 64 * pass; \
            kv[pass] = *(const u32x4*)(A.K + (rb2 + (size_t)(s < 0 ? 0 : s)) * KVW + kh2 * 64 + 8 * (tid & 7)); } \
        _Pragma("unroll") for (int pass = 0; pass < 4; ++pass) { const int s = s02 + lane + 64 * pass; \
            vv[pass] = *(const u32x4*)(A.V + (rb2 + (size_t)(s < 0 ? 0 : s)) * KVW + kh2 * 64 + 8 * wid); } } while (0)
#define ATT_DMA_KV(L_) do { ATT_DECODE(L_, b2, nb2, kh2); const size_t rb2 = (size_t)b2 * SEQ; const int s02 = (nb2 - 1) * 128; \
        _Pragma("unroll") for (int pass = 0; pass < 4; ++pass) { const int s = s02 + (tid >> 3) + 64 * pass; const size_t go = (rb2 + (size_t)(s < 0 ? 0 : s)) * KVW + kh2 * 64 + 8 * (tid & 7); \
            __builtin_amdgcn_global_load_lds((const unsigned*)(A.K + go), (LAS unsigned*)(lds + RAWK_OFF + (pass * 512 + wid * 64) * 16), 16, 0, 0); \
            __builtin_amdgcn_global_load_lds((const unsigned*)(A.V + go), (LAS unsigned*)(lds + RAWV_OFF + (pass * 512 + wid * 64) * 16), 16, 0, 0); } } while (0)
#define ATT_RAW_KV() do { _Pragma("unroll") for (int pass = 0; pass < 4; ++pass) { kv[pass] = *(const LAS u32x4*)(lds + RAWK_OFF + (pass * 512 + tid) * 16); \
            vv[pass] = *(const LAS u32x4*)(lds + RAWV_OFF + ((lane + 64 * pass) * 8 + wid) * 16); } } while (0)
#define ATT_LOAD_Q(dst, L_, qs_) do { ATT_DECODE(L_, b2, nb2, kh2); const bf16* qp = A.Q + ((size_t)b2 * SEQ + (size_t)(nb2 * 128 + 32 * (qs_) + r)) * D + (kh2 * QG + wid) * HD + 8 * h; \
        _Pragma("unroll") for (int d0 = 0; d0 < 4; ++d0) dst[d0] = *(const bf16x8*)(qp + 16 * d0); } while (0)
    { const int tid = tid0, lane = tid & 63, r = lane & 31, h = lane >> 5; ATT_LOAD_Q(qa, c, 0); }
    for (int L = c; L < NUNIT; L += G) {
        int tid = tid0; asm volatile("" : "+v"(tid));
        const int lane = tid & 63, r = lane & 31, h = lane >> 5;
        ATT_DECODE(L, b, nb, kh);
        const size_t rowb = (size_t)b * SEQ;
        const int head = kh * QG + wid;
        const bool has_next = (L + G) < NUNIT;
        const float slope2 = __builtin_amdgcn_exp2f(-0.5f * (float)(head + 1)) * LOG2E, sink2 = A.sinks[head] * LOG2E;
        const int pg = 2 * kh + (wid & 1), pcol = 128 * pg + 2 * lane;
        const unsigned prow0 = (unsigned)(b * SEQ + nb * 128 + 32 * (wid >> 1)), urow0 = prow0 + (unsigned)(NMETA * (b + 1));
        unsigned xs[47];
        if (pg == 0) pool_load<2>(xs, A.U, urow0, pcol); else if (pg == 1) pool_load<4>(xs, A.U, urow0, pcol);
        else if (pg == 2) pool_load<8>(xs, A.U, urow0, pcol); else pool_load<16>(xs, A.U, urow0, pcol);
        __builtin_amdgcn_sched_barrier(0);
        u32x4 kv[4], vv[4];
        if (L == c) ATT_LOAD_KV(L); else ATT_RAW_KV();
#pragma unroll
        for (int pass = 0; pass < 4; ++pass) { const int j = (tid >> 3) + 64 * pass, cc = tid & 7; *(LAS u32x4*)(lds + KS_OFF + j * KROW + 16 * cc) = kv[pass]; }
#pragma unroll
        for (int pass = 0; pass < 4; ++pass) { const int j = lane + 64 * pass;
#pragma unroll
            for (int jj = 0; jj < 8; ++jj) { const unsigned w = vv[pass][jj >> 1]; ((LAS unsigned short*)(lds + VT_OFF + (8 * wid + jj) * VROW))[j] = (unsigned short)((jj & 1) ? (w >> 16) : (w & 0xffffu)); } }
        if (L == c) {
            u32x4 kmv = *(const u32x4*)(A.KM + (size_t)((tid >> 3) & (NMETA - 1)) * KVW + kh * 64 + 8 * (tid & 7));
            if (tid >= 8 * NMETA) kmv = (u32x4){0u, 0u, 0u, 0u};
            if (tid < 256) *(LAS u32x4*)(lds + KM_OFF + (tid >> 3) * KROW + 16 * (tid & 7)) = kmv;
            const int d = tid & 63, kg = tid >> 6;
#pragma unroll
            for (int kk = 0; kk < 4; ++kk) { const int key = 4 * kg + kk; unsigned short val = A.VM[(size_t)(key & (NMETA - 1)) * KVW + kh * 64 + d]; if (key >= NMETA) val = 0;
                ((LAS unsigned short*)(lds + VTM_OFF + d * VMROW))[key] = val; }
        }
        __syncthreads();
        if (pg == 0) pool_store<2>(xs, A.POOLED, prow0, pcol); else if (pg == 1) pool_store<4>(xs, A.POOLED, prow0, pcol);
        else if (pg == 2) pool_store<8>(xs, A.POOLED, prow0, pcol); else pool_store<16>(xs, A.POOLED, prow0, pcol);
        __builtin_amdgcn_sched_barrier(0);
        if (has_next) ATT_DMA_KV(L + G);
        __builtin_amdgcn_sched_barrier(0);
        f32x16 Bb;
#pragma unroll
        for (int i = 0; i < 16; ++i) Bb[i] = -slope2 * (float)(128 - crow(i, h) + r);
#define ATT_BB(i) Bb[i]
#pragma unroll
        for (int qs = 0; qs < 4; ++qs) {
            bf16x8 (&qr)[4] = (qs & 1) ? qb : qa;
            if (qs == 0) ATT_LOAD_Q(qb, L, 1); else if (qs == 1) ATT_LOAD_Q(qa, L, 2); else if (qs == 2) ATT_LOAD_Q(qb, L, 3); else if (has_next) ATT_LOAD_Q(qa, L + G, 0);
            __builtin_amdgcn_sched_barrier(0);
            const int qrow = nb * 128 + 32 * qs + r;
            float mx = sink2, lsum = 0.f;
            f32x16 o[2]; o[0] = (f32x16){}; o[1] = (f32x16){};
#define ATT_QK(S_, kt_) do { const LAS unsigned char* kp_ = lds + KS_OFF + (32 * (kt_) + r) * KROW + 16 * h; \
                _Pragma("unroll") for (int d0 = 0; d0 < 4; ++d0) S_ = MFMA32(*(const LAS bf16x8*)(kp_ + 32 * d0), qr[d0], S_); } while (0)
#define ATT_MAX16(S_) fmaxf(fmaxf(fmaxf(fmaxf(S_[0], S_[1]), fmaxf(S_[2], S_[3])), fmaxf(fmaxf(S_[4], S_[5]), fmaxf(S_[6], S_[7]))), fmaxf(fmaxf(fmaxf(S_[8], S_[9]), fmaxf(S_[10], S_[11])), fmaxf(fmaxf(S_[12], S_[13]), fmaxf(S_[14], S_[15]))))
#define ATT_RESCALE(tmax_) do { if ((tmax_) > mx) { const float alpha = __builtin_amdgcn_exp2f(mx - (tmax_)); mx = (tmax_); lsum *= alpha; \
                _Pragma("unroll") for (int i = 0; i < 16; ++i) { o[0][i] *= alpha; o[1][i] *= alpha; } } } while (0)
#define ATT_PV(P_, kt_, s_) do { u32x4 pw; pw.x = pk2(P_[8 * (s_)], P_[8 * (s_) + 1]); pw.y = pk2(P_[8 * (s_) + 2], P_[8 * (s_) + 3]); pw.z = pk2(P_[8 * (s_) + 4], P_[8 * (s_) + 5]); pw.w = pk2(P_[8 * (s_) + 6], P_[8 * (s_) + 7]); \
                const bf16x8 pf = __builtin_bit_cast(bf16x8, pw); \
                _Pragma("unroll") for (int db = 0; db < 2; ++db) { const LAS unsigned char* vp = lds + VT_OFF + (32 * db + r) * VROW + (32 * (kt_) + 16 * (s_) + 4 * h) * 2; \
                    const s16x4 lo = *(const LAS s16x4*)vp, hi = *(const LAS s16x4*)(vp + 16); o[db] = MFMA32(__builtin_shufflevector(lo, hi, 0, 1, 2, 3, 4, 5, 6, 7), pf, o[db]); } } while (0)
#pragma unroll
            for (int tt = 1; tt < 4; ++tt) {
                if (nb == 0 && qs + tt < 4) continue;
                f32x16 S;
#pragma unroll
                for (int i = 0; i < 16; ++i) S[i] = ATT_BB(i);
                ATT_QK(S, qs + tt);
                const float shift = (32.0f * (float)tt) * slope2;
                float tmax = ATT_MAX16(S); tmax = fmaxf(tmax, shx(tmax, 32, lane)) + shift;
                ATT_RESCALE(tmax);
                const float mxs = mx - shift;
#pragma unroll
                for (int i = 0; i < 16; ++i) { const float p = __builtin_amdgcn_exp2f(S[i] - mxs); S[i] = p; lsum += p; }
                ATT_PV(S, qs + tt, 0); ATT_PV(S, qs + tt, 1);
            }
            {
                const bool t0ok = !(nb == 0 && qs < 4);
                f32x16 S0, S4;
#pragma unroll
                for (int i = 0; i < 16; ++i) { S0[i] = ATT_BB(i); S4[i] = ATT_BB(i); }
                if (t0ok) ATT_QK(S0, qs);
                ATT_QK(S4, qs + 4);
                const float sh4 = 128.0f * slope2;
#pragma unroll
                for (int i = 0; i < 16; ++i) { const bool lo_ = crow(i, h) > r; S4[i] = lo_ ? (t0ok ? S0[i] : -1e30f) : S4[i] + sh4; }
                float tmax = ATT_MAX16(S4); tmax = fmaxf(tmax, shx(tmax, 32, lane));
                ATT_RESCALE(tmax);
#pragma unroll
                for (int i = 0; i < 16; ++i) { const float p = __builtin_amdgcn_exp2f(S4[i] - mx); lsum += p; const bool lo_ = crow(i, h) > r; S0[i] = lo_ ? p : 0.f; S4[i] = lo_ ? 0.f : p; }
                if (t0ok) { ATT_PV(S0, qs, 0); ATT_PV(S0, qs, 1); }
                ATT_PV(S4, qs + 4, 0); ATT_PV(S4, qs + 4, 1);
            }
            {
                f32x16 S;
#pragma unroll
                for (int i = 0; i < 16; ++i) S[i] = (i < 8) ? -slope2 * (float)(NMETA - crow(i, h)) : 0.f;
                { const LAS unsigned char* kp_ = lds + KM_OFF + r * KROW + 16 * h;
#pragma unroll
                  for (int d0 = 0; d0 < 4; ++d0) S = MFMA32(*(const LAS bf16x8*)(kp_ + 32 * d0), qr[d0], S); }
                const float shift = -slope2 * (float)qrow;
                float tmax = fmaxf(fmaxf(fmaxf(S[0], S[1]), fmaxf(S[2], S[3])), fmaxf(fmaxf(S[4], S[5]), fmaxf(S[6], S[7])));
                tmax = fmaxf(tmax, shx(tmax, 32, lane)) + shift;
                ATT_RESCALE(tmax);
                const float mxs = mx - shift;
#pragma unroll
                for (int i = 0; i < 8; ++i) { const float p = __builtin_amdgcn_exp2f(S[i] - mxs); S[i] = p; lsum += p; }
                u32x4 pw; pw.x = pk2(S[0], S[1]); pw.y = pk2(S[2], S[3]); pw.z = pk2(S[4], S[5]); pw.w = pk2(S[6], S[7]);
                const bf16x8 pf = __builtin_bit_cast(bf16x8, pw);
#pragma unroll
                for (int db = 0; db < 2; ++db) { const LAS unsigned char* vp = lds + VTM_OFF + (32 * db + r) * VMROW + (4 * h) * 2;
                    const s16x4 lo = *(const LAS s16x4*)vp, hi = *(const LAS s16x4*)(vp + 16); o[db] = MFMA32(__builtin_shufflevector(lo, hi, 0, 1, 2, 3, 4, 5, 6, 7), pf, o[db]); }
            }
#undef ATT_QK
#undef ATT_MAX16
#undef ATT_RESCALE
#undef ATT_PV
            lsum += shx(lsum, 32, lane);
            lsum += __builtin_amdgcn_exp2f(sink2 - mx);
            const float inv = 1.0f / lsum;
            bf16* op = A.O + (rowb + (size_t)qrow) * D + head * HD;
#pragma unroll
            for (int db = 0; db < 2; ++db)
#pragma unroll
                for (int j = 0; j < 2; ++j) { const int g0 = 2 * j, g1 = 2 * j + 1;
                    const unsigned w0x = pk2(o[db][4 * g0] * inv, o[db][4 * g0 + 1] * inv), w0y = pk2(o[db][4 * g0 + 2] * inv, o[db][4 * g0 + 3] * inv);
                    const unsigned w1x = pk2(o[db][4 * g1] * inv, o[db][4 * g1 + 1] * inv), w1y = pk2(o[db][4 * g1 + 2] * inv, o[db][4 * g1 + 3] * inv);
                    const auto rx = __builtin_amdgcn_permlane32_swap(w1x, w0x, false, false), ry = __builtin_amdgcn_permlane32_swap(w1y, w0y, false, false);
                    u32x4 w; w.x = rx[0]; w.y = ry[0]; w.z = rx[1]; w.w = ry[1];
                    *(u32x4*)(op + 32 * db + 8 * (h ? g0 : g1)) = w; }
        }
        asm volatile("s_waitcnt vmcnt(8)" ::: "memory");
        __syncthreads();
    }
#undef ATT_DECODE
#undef ATT_BB
#undef ATT_LOAD_KV
#undef ATT_DMA_KV
#undef ATT_RAW_KV
#undef ATT_LOAD_Q
}
}
constexpr int NWAVES = 8;
struct Args { const float* in[18]; float* out; unsigned char* ws; int ph_lo, ph_hi; };
struct Frame {
    LAS unsigned char* lds;
    int tid, lane, wave, vcu, G;
    float* out; unsigned char* ws;
};
#define WSP(T, off) ((T*)(F.ws + (off)))
#define METAP(T, off) ((T*)(F.ws + WS_META + (off)))
enum { I_X = 0, I_META, I_NORM_MIX, I_W_IN, I_SINKS, I_W_ATTN_BR, I_W_POOL, I_POOL_SCALE, I_W_OUT, I_NORM_FFN, I_DW_GATE, I_DW_UP, I_DW_DOWN, I_ROUTER, I_MW_GATE, I_MW_UP, I_MW_DOWN, I_NORM_FINAL };

struct TrD { const float* W; unsigned char* WT; const float* kscale; const float* nscale; float scale; int N, ldw, k0, n0, drow0, tiled_nkt, fp8; };
DI void tr_set(TrD& d, const float* W, int N, void* WT, int ldw, int it, const float* kscale, const float* nscale, int tiled_nkt) {
    const int nblk = N / 32, kb = it / nblk, nb = it % nblk;
    d.W = W; d.N = N; d.WT = (unsigned char*)WT; d.ldw = ldw; d.k0 = 64 * kb; d.n0 = 32 * nb; d.drow0 = 32 * nb; d.kscale = kscale; d.nscale = nscale; d.scale = 1.f; d.tiled_nkt = tiled_nkt; d.fp8 = 0;
}
DI void tr_set_gu(TrD& d, const float* W, int N, void* WT, int it, int up, const float* kscale) {
    tr_set(d, W, N, WT, D, it, kscale, nullptr, 0); d.drow0 = (d.n0 / 128) * 256 + up * 128 + (d.n0 % 128);
}
DI void tr_decode(TrD& d, Frame& F, const Args& A, int it) {
    constexpr int I_IN = 16 * (INW / 32), I_SQ = 16 * 32, I_PL = 2 * 8, I_DGU = 16 * (DFF / 32), I_DD = (DFF / 64) * 32, I_MGU = 16 * (DFE / 32), I_MD = (DFE / 64) * 32;
    constexpr int PER_LAYER = I_IN + I_SQ + 4 * I_PL + I_SQ, N_DENSE = 2 * I_DGU + I_DD, PER_EXP = 2 * I_MGU + I_MD;
    int r = it;
    if (r < 2 * PER_LAYER) {
        const int l = r / PER_LAYER; r -= l * PER_LAYER;
        if (r < I_IN) { tr_set(d, A.in[I_W_IN] + (size_t)l * D * INW, INW, WSP(bf16, WS_WIN) + (size_t)l * INW * D, D, r, A.in[I_NORM_MIX] + l * D, nullptr, 0); return; } r -= I_IN;
        if (r < I_SQ) { tr_set(d, A.in[I_W_ATTN_BR] + (size_t)l * D * D, D, WSP(bf16, WS_WA) + (size_t)l * D * D, D, r, nullptr, nullptr, 0); return; } r -= I_SQ;
        if (r < 4 * I_PL) { const int g = r / I_PL; r -= g * I_PL;
            tr_set(d, A.in[I_W_POOL] + ((size_t)l * 4 + g) * 128 * 256, 256, WSP(bf16, WS_WP) + ((size_t)l * D + g * 256) * 256, 256, r, nullptr, A.in[I_POOL_SCALE] + l * D + g * 256, 0); return; } r -= 4 * I_PL;
        tr_set(d, A.in[I_W_OUT] + (size_t)l * D * D, D, WSP(bf16, WS_WO) + (size_t)l * D * D, D, r, nullptr, nullptr, 0); return;
    }
    r -= 2 * PER_LAYER;
    if (r < N_DENSE) {
        if (r < I_DGU) { tr_set_gu(d, A.in[I_DW_GATE], DFF, WSP(bf16, WS_WGU), r, 0, A.in[I_NORM_FFN]); return; } r -= I_DGU;
        if (r < I_DGU) { tr_set_gu(d, A.in[I_DW_UP], DFF, WSP(bf16, WS_WGU), r, 1, A.in[I_NORM_FFN]); return; } r -= I_DGU;
        tr_set(d, A.in[I_DW_DOWN], D, WSP(bf16, WS_WD), DFF, r, nullptr, nullptr, DFF / 64); return;
    }
    r -= N_DENSE;
    { const int e = r / PER_EXP; r -= e * PER_EXP;
        unsigned char* gu8 = WSP(unsigned char, WS_MGU) + (size_t)e * 2 * DFE * D; unsigned char* dn8 = WSP(unsigned char, WS_MD) + (size_t)e * D * DFE;
        if (r < 2 * I_MGU) { const int up = r >= I_MGU ? 1 : 0; if (up) r -= I_MGU;
            tr_set_gu(d, (up ? A.in[I_MW_UP] : A.in[I_MW_GATE]) + (size_t)e * D * DFE, DFE, gu8, r, up, A.in[I_NORM_FFN] + D); d.scale = W8_GU; d.fp8 = 1; return; }
        r -= 2 * I_MGU;
        tr_set(d, A.in[I_MW_DOWN] + (size_t)e * DFE * D, D, dn8, 0, r, nullptr, nullptr, DFE / 128); d.scale = W8_DN; d.fp8 = 1; }
}
DI void tr_load(const TrD& d, f32x2 (&wv)[16], f32x4 (&ks)[4], f32x2& nraw, int lane) {
    const float* wp = d.W + (unsigned)((d.k0 + (lane >> 4)) * d.N + d.n0 + 2 * (lane & 15));
#pragma unroll
    for (int i = 0; i < 16; ++i) wv[i] = *(const f32x2*)(wp + (unsigned)(4 * i * d.N));
    const bool hk = d.kscale != nullptr, hn = d.nscale != nullptr;
    const float* kp = (hk ? d.kscale + d.k0 : d.W) + (d.fp8 ? 16 * (lane & 3) : 8 * (lane & 7));
#pragma unroll
    for (int q = 0; q < 4; ++q) ks[q] = *(const f32x4*)(kp + ((d.fp8 || q < 2) ? 4 * q : 0));
    nraw = *(const f32x2*)((hn ? d.nscale : d.W) + d.n0 + 2 * (lane & 15));
}
DI void tr_finish(const TrD& d, const f32x2 (&wv)[16], const f32x4 (&ksr)[4], f32x2 nraw, LAS float* scr, int lane) {
    const bool hk = d.kscale != nullptr, hn = d.nscale != nullptr;
    const float ns0 = hn ? nraw[0] * d.scale : d.scale, ns1 = hn ? nraw[1] * d.scale : d.scale;
    f32x4 ks[4];
#pragma unroll
    for (int q = 0; q < 4; ++q) ks[q] = hk ? ksr[q] : (f32x4){1.f, 1.f, 1.f, 1.f};
#pragma unroll
    for (int i = 0; i < 16; ++i) { LAS float* sp = scr + (4 * i + (lane >> 4)) * 33 + 2 * (lane & 15); sp[0] = wv[i][0] * ns0; sp[1] = wv[i][1] * ns1; }
    LDS_WAIT(); asm volatile("" ::: "memory");
    if (d.fp8) {
        const int c = lane & 3;
#pragma unroll
        for (int j = 0; j < 2; ++j) { const int n = (lane + 64 * j) >> 2; const LAS float* s = scr + (16 * c) * 33 + n;
            u32x4 w; w.x = pk4_fp8(s[0 * 33] * ks[0][0], s[1 * 33] * ks[0][1], s[2 * 33] * ks[0][2], s[3 * 33] * ks[0][3]); w.y = pk4_fp8(s[4 * 33] * ks[1][0], s[5 * 33] * ks[1][1], s[6 * 33] * ks[1][2], s[7 * 33] * ks[1][3]);
            w.z = pk4_fp8(s[8 * 33] * ks[2][0], s[9 * 33] * ks[2][1], s[10 * 33] * ks[2][2], s[11 * 33] * ks[2][3]); w.w = pk4_fp8(s[12 * 33] * ks[3][0], s[13 * 33] * ks[3][1], s[14 * 33] * ks[3][2], s[15 * 33] * ks[3][3]);
            const int dr = d.drow0 + n;
            unsigned char* dst = d.tiled_nkt ? d.WT + ((size_t)((dr >> 8) * d.tiled_nkt + (d.k0 >> 7)) * 256 + (dr & 255)) * 128 + (d.k0 & 127) + 16 * c : d.WT + (size_t)dr * d.ldw + d.k0 + 16 * c;
            *(u32x4*)dst = w; }
    } else {
        const int c = lane & 7;
#pragma unroll
        for (int j = 0; j < 4; ++j) { const int n = (lane >> 3) + 8 * j; const LAS float* s = scr + (8 * c) * 33 + n;
            u32x4 o; o.x = pk2(s[0 * 33] * ks[0][0], s[1 * 33] * ks[0][1]); o.y = pk2(s[2 * 33] * ks[0][2], s[3 * 33] * ks[0][3]); o.z = pk2(s[4 * 33] * ks[1][0], s[5 * 33] * ks[1][1]); o.w = pk2(s[6 * 33] * ks[1][2], s[7 * 33] * ks[1][3]);
            const int dr = d.drow0 + n;
            bf16* dst = d.tiled_nkt ? (bf16*)d.WT + ((size_t)((dr >> 8) * d.tiled_nkt + (d.k0 >> 6)) * 256 + (dr & 255)) * 64 + 8 * c : (bf16*)d.WT + (size_t)dr * d.ldw + d.k0 + 8 * c;
            *(u32x4*)dst = o; }
    }
    LDS_WAIT(); asm volatile("" ::: "memory");
}
DI void p0_prologue(Frame& F, const Args& A) {
    LAS float* scr = (LAS float*)(F.lds + RING_OFF + F.wave * 16384);
    const int gw = F.vcu * NWAVES + F.wave, NGW = F.G * NWAVES, lane = F.lane;
    constexpr int NITEMS = 2 * (16 * (INW / 32) + 16 * 32 + 4 * 2 * 8 + 16 * 32) + (2 * 16 * (DFF / 32) + (DFF / 64) * 32) + NE * (2 * 16 * (DFE / 32) + (DFE / 64) * 32);
    if (gw < NITEMS) {
        TrD dA, dB; f32x2 wA[16], wB[16]; f32x4 kA[4], kB[4]; f32x2 nA, nB;
        int it = gw;
        tr_decode(dA, F, A, it); tr_load(dA, wA, kA, nA, lane);
#define TR_TOUCH(wc, kc, nc) { _Pragma("unroll") for (int i_ = 0; i_ < 16; ++i_) asm volatile("" : "+v"(wc[i_])); _Pragma("unroll") for (int q_ = 0; q_ < 4; ++q_) asm volatile("" : "+v"(kc[q_])); asm volatile("" : "+v"(nc)); }
#define TR_STEP(dc, wc, kc, nc, dn, wn, kn, nn) { const int itn = it + NGW; const bool more = itn < NITEMS; tr_decode(dn, F, A, more ? itn : it); tr_load(dn, wn, kn, nn, lane); __builtin_amdgcn_sched_barrier(0); TR_TOUCH(wc, kc, nc) tr_finish(dc, wc, kc, nc, scr, lane); __builtin_amdgcn_sched_barrier(0); if (!more) break; it = itn; }
        for (;;) { TR_STEP(dA, wA, kA, nA, dB, wB, kB, nB) TR_STEP(dB, wB, kB, nB, dA, wA, kA, nA) }
#undef TR_STEP
#undef TR_TOUCH
    }
    for (int rr = gw; rr < 2 * D; rr += NGW) *(unsigned*)(WSP(bf16, WS_WP) + (size_t)rr * 256 + 128 + 2 * lane) = 0u;
    const float* x = A.in[I_X]; bf16* HB = WSP(bf16, WS_HB); float* ssq = WSP(float, WS_SSQ);
    if (gw * 4 < M) {
        f32x4 va[4][4], vb[4][4];
        int m0 = gw * 4;
#define X_LOAD(v, mm) { _Pragma("unroll") for (int q = 0; q < 4; ++q) _Pragma("unroll") for (int j = 0; j < 4; ++j) v[q][j] = *((const f32x4*)(x + (size_t)((mm) + q) * D) + lane + 64 * j); }
#define X_STEP(v, vn) { const int mn = m0 + NGW * 4; const bool more = mn < M; X_LOAD(vn, more ? mn : m0) __builtin_amdgcn_sched_barrier(0); \
            _Pragma("unroll") for (int q = 0; q < 4; ++q) { float s = 0.f; u32x2* o8 = (u32x2*)(HB + (size_t)(m0 + q) * D) + lane; \
                _Pragma("unroll") for (int j = 0; j < 4; ++j) { s += (v[q][j][0] * v[q][j][0] + v[q][j][1] * v[q][j][1]) + (v[q][j][2] * v[q][j][2] + v[q][j][3] * v[q][j][3]); u32x2 w; w.x = pk2(v[q][j][0], v[q][j][1]); w.y = pk2(v[q][j][2], v[q][j][3]); o8[64 * j] = w; } \
                s = wave_sum(s, lane); \
                if (lane < 16) ssq[(size_t)(m0 + q) * 16 + lane] = lane == 0 ? s : 0.f; } \
            if (!more) break; m0 = mn; }
        X_LOAD(va, m0)
        for (;;) { X_STEP(va, vb) X_STEP(vb, va) }
#undef X_LOAD
#undef X_STEP
    }
    for (int m = gw; m < NMETA; m += NGW) {
        const f32x4* xr = (const f32x4*)(A.in[I_META] + (size_t)m * D) + lane; f32x4* ho = (f32x4*)(METAP(float, MO_HM) + (size_t)m * D) + lane; u32x2* o8 = (u32x2*)(METAP(bf16, MO_XM) + (size_t)m * D) + lane;
#pragma unroll
        for (int j = 0; j < 4; ++j) { const f32x4 v = xr[64 * j]; ho[64 * j] = v; u32x2 w; w.x = pk2(v[0], v[1]); w.y = pk2(v[2], v[3]); o8[64 * j] = w; }
    }
}

namespace meta {
DI f32x4 tile(const bf16* X, int ldx, const bf16* Wt, int ldw, int K, int lane) {
    const int i = lane & 15, q = lane >> 4; f32x4 acc = (f32x4){0.f, 0.f, 0.f, 0.f};
    const bf16* xp = X + (size_t)i * ldx + 8 * q; const bf16* wp = Wt + (size_t)i * ldw + 8 * q;
    for (int k0 = 0; k0 < K; k0 += 32) acc = __builtin_amdgcn_mfma_f32_16x16x32_bf16(*(const bf16x8*)(wp + k0), *(const bf16x8*)(xp + k0), acc, 0, 0, 0);
    return acc;
}
template <int NST, bool SSQ, int TILED_NKT = 0> DI f32x4 tile_split(const bf16* X, int ldx, const bf16* Wt, int ldw, int wave, int lane, LAS float* scr, float& ssq) {
    const int i = lane & 15, q = lane >> 4, ks = 32 * NST;
    const bf16* xp = X + (size_t)i * ldx + wave * ks + 8 * q; const bf16* wp = Wt + (size_t)i * ldw + wave * ks + 8 * q;
    bf16x8 a[NST], b[NST];
#pragma unroll
    for (int s = 0; s < NST; ++s) { const int kk = wave * ks + 32 * s + 8 * q, wr_ = ldw + i;
        a[s] = TILED_NKT ? *(const bf16x8*)(Wt + ((size_t)((wr_ >> 8) * TILED_NKT + (kk >> 6)) * 256 + (wr_ & 255)) * 64 + (kk & 63)) : *(const bf16x8*)(wp + 32 * s);
        b[s] = *(const bf16x8*)(xp + 32 * s); }
    f32x4 acc = (f32x4){0.f, 0.f, 0.f, 0.f}; float sq = 0.f;
#pragma unroll
    for (int s = 0; s < NST; ++s) { acc = __builtin_amdgcn_mfma_f32_16x16x32_bf16(a[s], b[s], acc, 0, 0, 0);
        if (SSQ) {
#pragma unroll
            for (int j = 0; j < 8; ++j) { const float x = bf2f((unsigned short)b[s][j]); sq += x * x; } } }
    __syncthreads();
    *(LAS f32x4*)(scr + (wave * 64 + lane) * 4) = acc;
    if (SSQ) { sq += shx(sq, 16, lane); sq += shx(sq, 32, lane); if (q == 0) scr[2048 + wave * 16 + i] = sq; }
    __syncthreads();
    f32x4 r = (f32x4){0.f, 0.f, 0.f, 0.f}; float t = 0.f;
#pragma unroll
    for (int w = 0; w < 8; ++w) { r += *(const LAS f32x4*)(scr + (w * 64 + lane) * 4); if (SSQ) t += scr[2048 + w * 16 + i]; }
    ssq = t; return r;
}
DI void inproj(Frame& F, LAS float* scr, int l, int col0) {
    const int lane = F.lane, i = lane & 15, q = lane >> 4; float ss;
    const f32x4 a = tile_split<4, true>(METAP(bf16, MO_XM), D, WSP(bf16, WS_WIN) + ((size_t)l * INW + col0) * D, D, F.wave, lane, scr, ss);
    if (F.wave != 0) return;
    const float rs = __builtin_amdgcn_rsqf(ss * (1.0f / D) + RMS_EPS);
    float* pr = METAP(float, MO_PROJ) + (size_t)i * INW + col0 + 4 * q;
#pragma unroll
    for (int j = 0; j < 4; ++j) { float v = a[j] * rs; const int c = col0 + 4 * q + j;
        if (c < D) v *= QSCALE; else if (c >= 1792) v = fast_sigmoid(v);
        pr[j] = v;
        if (c >= 1024 && c < 1152) METAP(bf16, MO_KM)[((size_t)l * NMETA + i) * KVW + (c - 1024)] = (bf16)f2bf(v);
        else if (c >= 1152 && c < 1280) METAP(bf16, MO_VM)[((size_t)l * NMETA + i) * KVW + (c - 1152)] = (bf16)f2bf(v);
        else if (c >= 1280 && c < 1792) { const bf16 ub = (bf16)f2bf(v);
#pragma unroll
            for (int b = 0; b < NB; ++b) WSP(bf16, WS_U)[((size_t)b * USEQ + i) * POOLW + (c - 1280)] = ub; } }
}
DI void attn_head(Frame& F, const Args& A, int l, int head) {
    const float* pr = METAP(float, MO_PROJ); const int t = F.tid, i = t >> 5, dl = t & 31, kvh = head / QG;
    const float slope2 = __builtin_amdgcn_exp2f(-0.5f * (float)(head + 1)) * LOG2E, sink2 = A.in[I_SINKS][l * NH + head] * LOG2E;
    const float q0 = pr[(size_t)i * INW + head * HD + dl], q1 = pr[(size_t)i * INW + head * HD + dl + 32];
    float k0[NMETA], k1[NMETA], v0[NMETA], v1[NMETA];
#pragma unroll
    for (int j = 0; j < NMETA; ++j) { const float* kp = pr + (size_t)j * INW + 1024 + kvh * HD + dl; k0[j] = kp[0]; k1[j] = kp[32]; v0[j] = kp[128]; v1[j] = kp[160]; }
    float lg[NMETA]; float mx = sink2;
#pragma unroll
    for (int j = 0; j < NMETA; ++j) { float s = q0 * k0[j] + q1 * k1[j];
#pragma unroll
        for (int o = 1; o < 32; o <<= 1) s += shx(s, o, F.lane);
        s = (j <= i) ? s - slope2 * (float)(i - j) : -1e30f; lg[j] = s; mx = fmaxf(mx, s); }
    float lsum = __builtin_amdgcn_exp2f(sink2 - mx), o0 = 0.f, o1 = 0.f;
#pragma unroll
    for (int j = 0; j < NMETA; ++j) { const float p = __builtin_amdgcn_exp2f(lg[j] - mx); lsum += p; o0 += p * v0[j]; o1 += p * v1[j]; }
    const float inv = 1.0f / lsum;
    bf16* op = METAP(bf16, MO_ATT) + (size_t)i * D + head * HD + dl;
    op[0] = (bf16)f2bf(o0 * inv); op[32] = (bf16)f2bf(o1 * inv);
}
DI void pool_rows(Frame& F) {
    const float* pr = METAP(float, MO_PROJ); const int col = F.tid, g = col >> 7, win = 2 << g;
    float u[NMETA];
#pragma unroll
    for (int tt = 0; tt < NMETA; ++tt) u[tt] = pr[(size_t)tt * INW + 1280 + col];
#pragma unroll
    for (int tt = 0; tt < NMETA; ++tt) { float s = 0.f; int cnt = 0;
#pragma unroll
        for (int j = 0; j < NMETA; ++j) if (j <= tt && j < win) { s += u[tt - j]; ++cnt; }
        METAP(bf16, MO_POOL)[(size_t)tt * POOLW + col] = (bf16)f2bf(s / (float)cnt - u[tt]); }
}
DI void merge(Frame& F, LAS float* scr, int l, int col0) {
    const int lane = F.lane, i = lane & 15, q = lane >> 4, g = col0 >> 8; float dummy;
    const f32x4 a = tile_split<4, false>(METAP(bf16, MO_ATT), D, WSP(bf16, WS_WA) + ((size_t)l * D + col0) * D, D, F.wave, lane, scr, dummy);
    if (F.wave != 0) return;
    const f32x4 p = tile(METAP(bf16, MO_POOL) + g * 128, POOLW, WSP(bf16, WS_WP) + ((size_t)l * D + col0) * 256, 256, 128, lane);
    const float* pr = METAP(float, MO_PROJ) + (size_t)i * INW;
#pragma unroll
    for (int j = 0; j < 4; ++j) { const int c = col0 + 4 * q + j; METAP(bf16, MO_MRG)[(size_t)i * D + c] = (bf16)f2bf(pr[1792 + c] * a[j] + pr[2816 + c] * p[j]); }
}
DI void resid(Frame& F, const f32x4 o, int col0) {
    const int lane = F.lane, i = lane & 15, q = lane >> 4;
    float* hp = METAP(float, MO_HM) + (size_t)i * D + col0 + 4 * q; const f32x4 h = *(const f32x4*)hp + o; *(f32x4*)hp = h;
    u32x2 w; w.x = pk2(h[0], h[1]); w.y = pk2(h[2], h[3]); *(u32x2*)(METAP(bf16, MO_XM) + (size_t)i * D + col0 + 4 * q) = w;
}
DI void outproj(Frame& F, LAS float* scr, int l, int col0) { float dummy;
    const f32x4 o = tile_split<4, false>(METAP(bf16, MO_MRG), D, WSP(bf16, WS_WO) + ((size_t)l * D + col0) * D, D, F.wave, F.lane, scr, dummy);
    if (F.wave == 0) resid(F, o, col0); }
DI void gu(Frame& F, LAS float* scr, int n0) {
    const int lane = F.lane, i = lane & 15, q = lane >> 4; float ss, dummy;
    const bf16* wg = WSP(bf16, WS_WGU) + (size_t)((n0 / 128) * 256 + (n0 % 128)) * D;
    const f32x4 ga = tile_split<4, true>(METAP(bf16, MO_XM), D, wg, D, F.wave, lane, scr, ss);
    const f32x4 ua = tile_split<4, false>(METAP(bf16, MO_XM), D, wg + (size_t)128 * D, D, F.wave, lane, scr, dummy);
    if (F.wave != 0) return;
    const float rs = __builtin_amdgcn_rsqf(ss * (1.0f / D) + RMS_EPS);
    f32x4 o;
#pragma unroll
    for (int j = 0; j < 4; ++j) { const float gg = ga[j] * rs; o[j] = gg * fast_sigmoid(gg) * (ua[j] * rs); }
    u32x2 w; w.x = pk2(o[0], o[1]); w.y = pk2(o[2], o[3]); *(u32x2*)(METAP(bf16, MO_ACT) + (size_t)i * DFF + n0 + 4 * q) = w;
}
DI void down(Frame& F, LAS float* scr, int col0) { float dummy;
    const f32x4 o = tile_split<DFF / 256, false, DFF / 64>(METAP(bf16, MO_ACT), DFF, WSP(bf16, WS_WD), col0, F.wave, F.lane, scr, dummy);
    if (F.wave == 0) resid(F, o, col0); }
}
DI void moe_route(Frame& F, const Args& A) {
    LAS unsigned char* rwb = F.lds + RING_OFF;
    LAS unsigned* hist = (LAS unsigned*)(F.lds + XTRA_OFF);
    const float* router = A.in[I_ROUTER]; const float* gain = A.in[I_NORM_FFN] + D;
    for (int it = F.tid; it < 32 * 64; it += NWAVES * 64) {
        const int m = it >> 6, l = it & 63, r = l & 15, q = l >> 4, e = (r & 3) + 4 * ((r >> 2) & 1), lo = r >> 3, k0 = 64 * (m >> 1) + 16 * q + 8 * (m & 1);
        unsigned w[4];
#pragma unroll
        for (int p = 0; p < 4; ++p) {
            float x0 = router[(k0 + 2 * p) * NE + e] * gain[k0 + 2 * p], x1 = router[(k0 + 2 * p + 1) * NE + e] * gain[k0 + 2 * p + 1];
            if (lo) { const unsigned hh = pk2(x0, x1); x0 -= bflo(hh); x1 -= bfhi(hh); }
            w[p] = pk2(x0, x1); }
        *(LAS u32x4*)(rwb + m * 1024 + ((r * 64 + q * 16) ^ ((r & 8) ? 32 : 0))) = (u32x4){w[0], w[1], w[2], w[3]};
    }
    unsigned char* hb8 = WSP(unsigned char, WS_POOLED);
    const bf16* h = WSP(bf16, WS_HB); float* ssq = WSP(float, WS_SSQ); unsigned* toke = WSP(unsigned, WS_TOKE); float* tokw = WSP(float, WS_TOKW); unsigned* wgcnt = WSP(unsigned, WS_WGCNT);
    const int lane = F.lane, i = lane & 15, q = lane >> 4;
    const int boff = (i * 64 + q * 16) ^ ((i & 8) ? 32 : 0);
    for (int tile = F.vcu; tile < M / 256; tile += F.G) {
        if (F.tid < 16) hist[F.tid] = 0u;
        __syncthreads();
        const int tok0 = tile * 256 + F.wave * 32 + i;
        u32x4 ba[4][2], bb[4][2];
        f32x4 acc = (f32x4){0.f, 0.f, 0.f, 0.f}; float s = 0.f;
#define RT_LOAD(buf, c) { const bf16* hp_ = h + (size_t)(tok0 + 16 * ((c) >> 2)) * D + 256 * ((c) & 3) + 16 * q; \
            _Pragma("unroll") for (int u = 0; u < 4; ++u) { buf[u][0] = *(const u32x4*)(hp_ + 64 * u); buf[u][1] = *(const u32x4*)(hp_ + 64 * u + 8); } }
#define RT_PROC(buf, c) { unsigned char* o8_ = hb8 + (size_t)(tok0 + 16 * ((c) >> 2)) * D + 256 * ((c) & 3) + 16 * q; \
            _Pragma("unroll") for (int u = 0; u < 4; ++u) { unsigned o_[4]; \
                _Pragma("unroll") for (int hh = 0; hh < 2; ++hh) { const u32x4 a_ = buf[u][hh]; \
                    const bf16x8 wf_ = *(const LAS bf16x8*)(rwb + (2 * (4 * ((c) & 3) + u) + hh) * 1024 + boff); \
                    acc = __builtin_amdgcn_mfma_f32_16x16x32_bf16(wf_, __builtin_bit_cast(bf16x8, a_), acc, 0, 0, 0); \
                    const float f0 = bflo(a_[0]), f1 = bfhi(a_[0]), f2 = bflo(a_[1]), f3 = bfhi(a_[1]), f4 = bflo(a_[2]), f5 = bfhi(a_[2]), f6 = bflo(a_[3]), f7 = bfhi(a_[3]); \
                    s += ((f0 * f0 + f1 * f1) + (f2 * f2 + f3 * f3)) + ((f4 * f4 + f5 * f5) + (f6 * f6 + f7 * f7)); \
                    o_[2 * hh] = pk4_fp8(f0, f1, f2, f3); o_[2 * hh + 1] = pk4_fp8(f4, f5, f6, f7); } \
                *(u32x4*)(o8_ + 64 * u) = (u32x4){o_[0], o_[1], o_[2], o_[3]}; } }
        RT_LOAD(ba, 0)
        for (int c = 0; c < 8; c += 2) {
            RT_LOAD(bb, c + 1) __builtin_amdgcn_sched_barrier(0);
            RT_PROC(ba, c)
            RT_LOAD(ba, c + 2 < 8 ? c + 2 : c + 1) __builtin_amdgcn_sched_barrier(0);
            RT_PROC(bb, c + 1)
            if (c & 2) {
                const int tok = tok0 + 16 * (c >> 2);
                f32x4 x;
#pragma unroll
                for (int j = 0; j < 4; ++j) x[j] = acc[j] + shx(acc[j], 32, lane);
                s += shx(s, 16, lane); s += shx(s, 32, lane);
                int i1 = 0; float v1 = x[0];
#pragma unroll
                for (int j = 1; j < 4; ++j) if (x[j] > v1) { v1 = x[j]; i1 = j; }
                int i2 = -1; float v2 = -INFINITY;
#pragma unroll
                for (int j = 0; j < 4; ++j) if (j != i1 && x[j] > v2) { v2 = x[j]; i2 = j; }
                i1 += 4 * (q & 1); i2 += 4 * (q & 1);
                const float pv1 = shx(v1, 16, lane), pv2 = shx(v2, 16, lane);
                const int pi = __builtin_amdgcn_ds_bpermute((lane ^ 16) << 2, i1 | (i2 << 8)), pi1 = pi & 255, pi2 = pi >> 8;
                const bool mine = v1 > pv1 || (v1 == pv1 && i1 < pi1);
                const int e0 = mine ? i1 : pi1; const float t0 = mine ? v1 : pv1;
                const float ca = mine ? v2 : v1, cb = mine ? pv1 : pv2; const int cia = mine ? i2 : i1, cib = mine ? pi1 : pi2;
                const bool m2 = ca > cb || (ca == cb && cia < cib);
                const int e1 = m2 ? cia : cib; const float t1 = m2 ? ca : cb;
                const float rs = __builtin_amdgcn_rsqf(s * (1.0f / D) + RMS_EPS);
                const float w1 = 1.0f / (1.0f + __expf((t0 - t1) * rs)), w0 = 1.0f - w1;
                *(f32x4*)(ssq + (size_t)tok * 16 + 4 * q) = (f32x4){q == 0 ? s : 0.f, 0.f, 0.f, 0.f};
                if (q == 0) { toke[tok] = (unsigned)e0 | ((unsigned)e1 << 8); *(f32x2*)(tokw + 2 * tok) = (f32x2){w0, w1};
                    __hip_atomic_fetch_add((unsigned*)&hist[e0], 1u, __ATOMIC_RELAXED, __HIP_MEMORY_SCOPE_WORKGROUP); __hip_atomic_fetch_add((unsigned*)&hist[8 + e1], 1u, __ATOMIC_RELAXED, __HIP_MEMORY_SCOPE_WORKGROUP); }
                acc = (f32x4){0.f, 0.f, 0.f, 0.f}; s = 0.f;
            }
        }
#undef RT_LOAD
#undef RT_PROC
        __syncthreads();
        if (F.tid < 16) wgcnt[tile * 16 + F.tid] = hist[F.tid];
        __syncthreads();
    }
}
DI void moe_slots(Frame& F) {
    LAS unsigned* cnt = (LAS unsigned*)(F.lds + RING_OFF);
    LAS unsigned* tot = cnt + 4096;
    LAS unsigned* seg = tot + 16;
    LAS unsigned* pre = seg + 16;
    LAS unsigned char* es = (LAS unsigned char*)(pre + 16);
    const unsigned* wgcnt = WSP(unsigned, WS_WGCNT); const unsigned* toke = WSP(unsigned, WS_TOKE); const float* tokw = WSP(float, WS_TOKW);
    int* slot_tok = WSP(int, WS_SLOTTOK); float* slot_w = WSP(float, WS_SLOTW); float* slot_rs = WSP(float, WS_SLOTRS); const float* ssq = WSP(float, WS_SSQ); int* tab = WSP(int, WS_MOETAB);
    for (int i = F.tid; i < 4096; i += NWAVES * 64) cnt[i] = wgcnt[i];
    __syncthreads();
    { const int col = F.tid >> 5, pp = F.tid & 31; unsigned s = 0;
#pragma unroll
      for (int j = 0; j < 8; ++j) s += cnt[(pp * 8 + j) * 16 + col];
#pragma unroll
      for (int o = 1; o < 32; o <<= 1) s += (unsigned)__builtin_amdgcn_ds_bpermute((F.lane ^ o) << 2, (int)s);
      if (pp == 0) tot[col] = s; }
    __syncthreads();
    if (F.tid < 16) { const int k = F.tid >> 3, e = F.tid & 7; unsigned s = 0; for (int e2 = 0; e2 < e; ++e2) s += (tot[k * 8 + e2] + 255u) & ~255u; seg[F.tid] = s; }
    __syncthreads();
    if (F.vcu == 0) {
        if (F.tid < 16) tab[F.tid] = (int)seg[F.tid];
        if (F.tid < 2) { unsigned s = 0; for (int e = 0; e < NE; ++e) s += (tot[F.tid * 8 + e] + 255u) >> 8; tab[16 + F.tid] = (int)s; }
        for (int i = F.tid; i < 2 * MAXTILES; i += NWAVES * 64) { const int k = i / MAXTILES, t = i % MAXTILES; int e = NE - 1;
            for (int e2 = NE - 1; e2 >= 0; --e2) if ((unsigned)(t * 256) < seg[k * 8 + e2] + ((tot[k * 8 + e2] + 255u) & ~255u)) e = e2;
            tab[32 + i] = e; }
    }
    for (int sgi = F.vcu; sgi < 16; sgi += F.G) { const int k = sgi >> 3; const unsigned b0 = seg[sgi] + tot[sgi], b1 = seg[sgi] + ((tot[sgi] + 255u) & ~255u);
        for (unsigned p = b0 + F.tid; p < b1; p += NWAVES * 64) { slot_tok[k * NSLOT + p] = -1; slot_w[k * NSLOT + p] = 0.f; slot_rs[k * NSLOT + p] = 0.f; } }
    for (int tile = F.vcu; tile < M / 256; tile += F.G) {
        __syncthreads();
        { const int col = F.tid >> 5, pp = F.tid & 31; unsigned s = 0;
#pragma unroll
          for (int j = 0; j < 8; ++j) { const int t = pp * 8 + j; s += t < tile ? cnt[t * 16 + col] : 0u; }
#pragma unroll
          for (int o = 1; o < 32; o <<= 1) s += (unsigned)__builtin_amdgcn_ds_bpermute((F.lane ^ o) << 2, (int)s);
          if (pp == 0) pre[col] = s; }
        unsigned ee = 0u;
        if (F.tid < 256) ee = toke[tile * 256 + F.tid];
        LAS unsigned* wcnt = (LAS unsigned*)es;
        unsigned rk[2] = {0u, 0u};
        if (F.tid < 256) {
#pragma unroll
            for (int k = 0; k < 2; ++k) { const unsigned e = (ee >> (8 * k)) & 0xffu;
#pragma unroll
                for (int ex = 0; ex < NE; ++ex) { const unsigned long long b = __ballot(e == (unsigned)ex);
                    if (e == (unsigned)ex) rk[k] = (unsigned)__builtin_popcountll(b & ((1ull << F.lane) - 1ull));
                    if (F.lane == 0) wcnt[F.wave * 16 + k * 8 + ex] = (unsigned)__builtin_popcountll(b); } }
        }
        __syncthreads();
        if (F.tid < 256) {
            const int tok = tile * 256 + F.tid; const float rs = __builtin_amdgcn_rsqf(ssq[(size_t)tok * 16] * (1.0f / D) + RMS_EPS);
#pragma unroll
            for (int k = 0; k < 2; ++k) { const unsigned e = (ee >> (8 * k)) & 0xffu; unsigned rank = rk[k];
                for (int w = 0; w < F.wave; ++w) rank += wcnt[w * 16 + k * 8 + e];
                const unsigned p = seg[k * 8 + e] + pre[k * 8 + e] + rank; slot_tok[k * NSLOT + p] = tok; slot_w[k * NSLOT + p] = tokw[2 * tok + k]; slot_rs[k * NSLOT + p] = rs; }
        }
    }
    __syncthreads();
}
DI void moe_fix(Frame& F, int k, int ntail) {
    const int gw = F.vcu * NWAVES + F.wave, NGW = F.G * NWAVES, lane = F.lane;
    const int* slot_tok = WSP(int, WS_SLOTTOK) + k * NSLOT; const float* slot_w = WSP(float, WS_SLOTW) + k * NSLOT; const float* slab = WSP(float, WS_SLAB);
    const bf16* SRC = k == 0 ? WSP(bf16, WS_HB) : (const bf16*)F.out; bf16* DST = k == 0 ? (bf16*)F.out : WSP(bf16, WS_HB);
    for (int r = gw; r < ntail * 256; r += NGW) {
        const int tok = slot_tok[r]; if (tok < 0) continue;
        const float w = slot_w[r] * (1.0f / W8_DN); const int tile = r >> 8, row = r & 255;
#pragma unroll
        for (int j = 0; j < 4; ++j) {
            f32x4 s = (f32x4){0.f, 0.f, 0.f, 0.f};
#pragma unroll
            for (int kq = 0; kq < pg8::NQ; ++kq) s += *((const f32x4*)(slab + ((size_t)(tile * pg8::NQ + kq) * 256 + row) * D) + lane + 64 * j);
            const u32x2 h = *((const u32x2*)(SRC + (size_t)tok * D) + lane + 64 * j);
            u32x2 o; o.x = pk2(bflo(h.x) + w * s[0], bfhi(h.x) + w * s[1]); o.y = pk2(bflo(h.y) + w * s[2], bfhi(h.y) + w * s[3]);
            *((u32x2*)(DST + (size_t)tok * D) + lane + 64 * j) = o;
        }
    }
}
DI void final_norm(Frame& F, const Args& A) {
    const int gw = F.vcu * NWAVES + F.wave, NGW = F.G * NWAVES, lane = F.lane; const float* gain = A.in[I_NORM_FINAL]; const bf16* HB = WSP(bf16, WS_HB);
    f32x4 gv[4];
#pragma unroll
    for (int j = 0; j < 4; ++j) gv[j] = *((const f32x4*)gain + lane + 64 * j);
    for (int m0 = gw * 4; m0 < M; m0 += NGW * 4) {
        u32x2 q[4][4];
#pragma unroll
        for (int t = 0; t < 4; ++t)
#pragma unroll
            for (int j = 0; j < 4; ++j) q[t][j] = *((const u32x2*)(HB + (size_t)(m0 + t) * D) + lane + 64 * j);
#pragma unroll
        for (int t = 0; t < 4; ++t) { f32x4 v[4]; float s = 0.f; f32x4* xr = (f32x4*)(F.out + (size_t)(m0 + t) * D) + lane;
#pragma unroll
            for (int j = 0; j < 4; ++j) { v[j] = (f32x4){bflo(q[t][j].x), bfhi(q[t][j].x), bflo(q[t][j].y), bfhi(q[t][j].y)}; s += (v[j][0] * v[j][0] + v[j][1] * v[j][1]) + (v[j][2] * v[j][2] + v[j][3] * v[j][3]); }
            const float rs = __builtin_amdgcn_rsqf(wave_sum(s, lane) * (1.0f / D) + RMS_EPS);
#pragma unroll
            for (int j = 0; j < 4; ++j) xr[64 * j] = v[j] * rs * gv[j]; }
    }
}
#ifndef MK_PER_PHASE
#define MK_PER_PHASE 0
#endif
constexpr int NPHASES = 19;

DI void attn_phase(Frame& F, const Args& args, int l) {
    att::Args A{WSP(bf16, WS_Q), WSP(bf16, WS_K), WSP(bf16, WS_V), WSP(bf16, WS_U), METAP(bf16, MO_KM) + (size_t)l * NMETA * KVW, METAP(bf16, MO_VM) + (size_t)l * NMETA * KVW,
                METAP(bf16, MO_UM) + (size_t)l * NMETA * POOLW, args.in[I_SINKS] + l * NH, (bf16*)F.out, WSP(bf16, WS_POOLED)};
    att::phase(F.lds + RING_OFF, A, F.vcu, F.G, F.tid);
}

__global__ void __launch_bounds__(NWAVES * 64, 2) fwd(Args args) {
    extern __shared__ __attribute__((aligned(16))) unsigned char lds[];
    Frame F;
    F.lds = (LAS unsigned char*)lds;
    F.tid = threadIdx.x; F.lane = F.tid & 63; F.wave = __builtin_amdgcn_readfirstlane(F.tid >> 6);
    const int wave0 = F.wave;
    F.G = gridDim.x; { const int bx = blockIdx.x; F.vcu = (F.G % 8 == 0) ? (bx % 8) * (F.G / 8) + bx / 8 : bx; }
    F.out = args.out; F.ws = args.ws;
    for (int u = F.tid; u < (LDS_BYTES - LDSCTL_OFF) / 4; u += NWAVES * 64) ((LAS unsigned*)(F.lds + LDSCTL_OFF))[u] = 0u;
    __syncthreads();
    gu32* ctl = (gu32*)(F.ws + WS_CTL);
    XcdBarrier bar; bar.bar = (unsigned*)(ctl + CW_BAR); bar.x = 0; bar.st = nullptr;
    if (!MK_PER_PHASE) bar = xcd_barrier_post((unsigned*)(ctl + CW_BAR), (volatile LAS unsigned*)(F.lds + MISC_OFF) + 8, F.tid);
    const int lo = args.ph_lo, hi = args.ph_hi;
#ifdef PROBE_MASK
    unsigned long long pacc = 0, pt0 = __builtin_amdgcn_s_memrealtime();
#define PROBE_SEAM(k) do { const unsigned long long t_ = __builtin_amdgcn_s_memrealtime(); if ((PROBE_MASK >> (k)) & 1) pacc += t_ - pt0; pt0 = t_; } while (0)
#ifdef PROBE_CLK
    unsigned long long cacc = 0, ct0 = __builtin_amdgcn_s_memtime();
#undef PROBE_SEAM
#define PROBE_SEAM(k) do { const unsigned long long t_ = __builtin_amdgcn_s_memrealtime(), c_ = __builtin_amdgcn_s_memtime(); if ((PROBE_MASK >> (k)) & 1) { pacc += t_ - pt0; cacc += c_ - ct0; } pt0 = t_; ct0 = c_; } while (0)
#endif
#ifdef PROBE_EPI
#undef PROBE_SEAM
#define PROBE_SEAM(k) do { if (threadIdx.x == 0) ((volatile LAS unsigned*)(F.lds + MISC_OFF))[32] = (PROBE_MASK >> ((k) + 1)) & 1; __syncthreads(); } while (0)
#endif
#else
#define PROBE_SEAM(k) do { } while (0)
#endif
#define IN(k) (lo <= (k) && (k) < hi)
#define SEAM(k) do { if (IN(k) && IN((k) + 1)) xcd_barrier(bar, (wave0 << 6) | hw_lane()); PROBE_SEAM(k); } while (0)
#define LAUNDER() do { GLOBAL_AS unsigned char* ws_g = (GLOBAL_AS unsigned char*)args.ws; GLOBAL_AS float* out_g = (GLOBAL_AS float*)args.out; F.tid = (wave0 << 6) | hw_lane(); asm volatile("" : "+s"(ws_g), "+s"(out_g), "+v"(F.tid)); F.ws = (unsigned char*)ws_g; F.out = (float*)out_g; F.lane = F.tid & 63; F.wave = __builtin_amdgcn_readfirstlane(F.tid >> 6); ssq = WSP(float, WS_SSQ); } while (0)
#define META_TASK(n, call) do { LAS float* mscr = (LAS float*)(F.lds + RING_OFF); for (int task = F.vcu; task < (n); task += F.G) { call; } __syncthreads(); } while (0)

    float* ssq;
    if (IN(0)) { LAUNDER(); p0_prologue(F, args); } SEAM(0);

    for (int l = 0; l < 2; ++l) {
        const int pb = l * 6;
        if (IN(pb + 1)) { LAUNDER();
            if (l == 0) { META_TASK(INW / 16, meta::inproj(F, mscr, 0, 16 * task)); } else { META_TASK(768 / 16, meta::inproj(F, mscr, 1, 1024 + 16 * task)); }
            pg8::ProbPlain P{(const char*)WSP(bf16, WS_HB), (const char*)(WSP(bf16, WS_WIN) + (size_t)l * INW * D), D * 2, D * 2, D / 64, 0, 128, (size_t)256 * (D * 2)};
            pg8::StaticOrder S; S.init(M, INW, F.G, (int)blockIdx.x);
            pg8::EpiInProj E{ssq, WSP(bf16, WS_Q), WSP(bf16, WS_K), WSP(bf16, WS_V), WSP(bf16, WS_U), WSP(bf16, WS_G)};
            pg8::gemm_phase<pg8::ProbPlain, pg8::EpiInProj, pg8::StaticOrder, true>(F.lds + RING_OFF, P, S, E, F.tid);
        } SEAM(pb + 1);
        if (IN(pb + 2)) { LAUNDER();
            if (l == 0) { for (int hd = F.vcu; hd < NH + 1; hd += F.G) { if (hd < NH) meta::attn_head(F, args, 0, hd); else meta::pool_rows(F); } }
            attn_phase(F, args, l);
        } SEAM(pb + 2);
        if (IN(pb + 3)) { LAUNDER();
            if (l == 0) { META_TASK(D / 16, meta::merge(F, mscr, 0, 16 * task)); }
            { pg8::ProbPlain P{(const char*)WSP(bf16, WS_POOLED), (const char*)(WSP(bf16, WS_WP) + (size_t)l * D * 256), POOLW * 2, 256 * 2, 256 / 64, 128 * 2, 128, (size_t)256 * (POOLW * 2)};
              pg8::StaticOrder S; S.init(M, D, F.G, (int)blockIdx.x);
              pg8::EpiPoolLift E{WSP(bf16, WS_G), WSP(bf16, WS_Q)};
              pg8::gemm_phase<pg8::ProbPlain, pg8::EpiPoolLift, pg8::StaticOrder, true>(F.lds + RING_OFF, P, S, E, F.tid); }
            VM_WAIT(); __syncthreads();
            { pg8::ProbPlain P{(const char*)F.out, (const char*)(WSP(bf16, WS_WA) + (size_t)l * D * D), D * 2, D * 2, D / 64, 0, 128, (size_t)256 * (D * 2)};
              pg8::StaticOrder S; S.init(M, D, F.G, (int)blockIdx.x);
              pg8::EpiMerge E{WSP(bf16, WS_G), WSP(bf16, WS_Q)};
              pg8::gemm_phase<pg8::ProbPlain, pg8::EpiMerge, pg8::StaticOrder, true>(F.lds + RING_OFF, P, S, E, F.tid); }
        } SEAM(pb + 3);
        if (IN(pb + 4)) { LAUNDER();
            if (l == 0) { META_TASK(D / 16, meta::outproj(F, mscr, 0, 16 * task)); }
            pg8::ProbPlain P{(const char*)WSP(bf16, WS_Q), (const char*)(WSP(bf16, WS_WO) + (size_t)l * D * D), D * 2, D * 2, D / 64, 0, 128, (size_t)256 * (D * 2)};
            pg8::StaticOrder S; S.init(M, D, F.G, (int)blockIdx.x);
            pg8::EpiResid E{WSP(bf16, WS_HB), ssq};
            pg8::gemm_phase<pg8::ProbPlain, pg8::EpiResid, pg8::StaticOrder, true>(F.lds + RING_OFF, P, S, E, F.tid);
        } SEAM(pb + 4);
        if (l == 0) {
            if (IN(5)) { LAUNDER();
                META_TASK(DFF / 16, meta::gu(F, mscr, 16 * task));
                pg8::ProbPlain P{(const char*)WSP(bf16, WS_HB), (const char*)WSP(bf16, WS_WGU), D * 2, D * 2, D / 64, 0, 128, (size_t)256 * (D * 2)};
                pg8::StaticOrder S; S.init(M, 2 * DFF, F.G, (int)blockIdx.x);
                pg8::EpiSwiGLU<false> E{ssq, WSP(bf16, WS_ACT), DFF / 64};
                pg8::gemm_phase<pg8::ProbPlain, pg8::EpiSwiGLU<false>, pg8::StaticOrder, true>(F.lds + RING_OFF, P, S, E, F.tid);
            } SEAM(5);
            if (IN(6)) { LAUNDER();
                META_TASK(D / 16, meta::down(F, mscr, 16 * task));
                pg8::ProbPlain P{(const char*)WSP(bf16, WS_ACT), (const char*)WSP(bf16, WS_WD), 128, 128, DFF / 64, 0, 32768, (size_t)(DFF / 64) * 32768, 32768, (size_t)(DFF / 64) * 32768};
                pg8::StaticOrder S; S.init(M, D, F.G, (int)blockIdx.x); S.rev = true;
                pg8::EpiResid E{WSP(bf16, WS_HB), ssq};
                pg8::gemm_phase<pg8::ProbPlain, pg8::EpiResid, pg8::StaticOrder, true>(F.lds + RING_OFF, P, S, E, F.tid);
            } SEAM(6);
        }
    }
    if (IN(11)) { LAUNDER(); moe_route(F, args); } SEAM(11);
    if (IN(12)) { LAUNDER(); moe_slots(F); } SEAM(12);
    for (int k = 0; k < 2; ++k) {
        const int* tab = WSP(int, WS_MOETAB); const int* slot_tok = WSP(int, WS_SLOTTOK) + k * NSLOT; const float* slot_w = WSP(float, WS_SLOTW) + k * NSLOT;
        if (IN(13 + 2 * k)) { LAUNDER();
            if (k == 1) moe_fix(F, 0, __builtin_amdgcn_readfirstlane(tab[16]) - 256);
            const int ntile = __builtin_amdgcn_readfirstlane(tab[16 + k]);
            LAS int* etab = (LAS int*)(F.lds + XTRA_OFF + 1024);
            for (int i = F.tid; i < MAXTILES; i += NWAVES * 64) etab[i] = tab[32 + k * MAXTILES + i];
            __syncthreads();
            pg8::ProbMoeGU P{(const char*)WSP(unsigned char, WS_POOLED), (const char*)WSP(unsigned char, WS_MGU), D, D, D / 128, slot_tok, etab, (LAS int*)(F.lds + XTRA_OFF), (size_t)2 * DFE * D};
            pg8::LinearOrder S{ntile, 2 * DFE / 256, F.G, F.vcu, false};
            pg8::EpiSwiGLU8 E{WSP(float, WS_SLOTRS) + k * NSLOT, WSP(unsigned char, WS_ACT)};
            pg8::gemm_phase<pg8::ProbMoeGU, pg8::EpiSwiGLU8, pg8::LinearOrder, true, true>(F.lds + RING_OFF, P, S, E, F.tid);
        } SEAM(13 + 2 * k);
        if (IN(14 + 2 * k)) { LAUNDER();
            const int ntile = __builtin_amdgcn_readfirstlane(tab[16 + k]);
            LAS int* etab = (LAS int*)(F.lds + XTRA_OFF + 1024);
            for (int i = F.tid; i < MAXTILES; i += NWAVES * 64) etab[i] = tab[32 + k * MAXTILES + i];
            __syncthreads();
            { pg8::ProbMoeDown P{(const char*)WSP(unsigned char, WS_ACT), (const char*)WSP(unsigned char, WS_MD), 128, 128, DFE / 128, etab, 32768, (size_t)(DFE / 128) * 32768, 32768, (size_t)(DFE / 128) * 32768, (size_t)D * DFE};
              pg8::LinearOrder S{256, D / 256, F.G, F.vcu, true}; S.base = ntile - 256;
              pg8::EpiMoeDown E{k == 0 ? WSP(bf16, WS_HB) : (bf16*)F.out, k == 0 ? (bf16*)F.out : WSP(bf16, WS_HB), slot_tok, slot_w, 1.0f / W8_DN};
              pg8::gemm_phase<pg8::ProbMoeDown, pg8::EpiMoeDown, pg8::LinearOrder, true, true>(F.lds + RING_OFF, P, S, E, F.tid); }
            { pg8::ProbMoeDownQ P{(const char*)WSP(unsigned char, WS_ACT), (const char*)WSP(unsigned char, WS_MD), 128, 128, DFE / 128 / pg8::NQ, etab, (size_t)(DFE / 128) * 32768, (size_t)(DFE / 128) * 32768, (size_t)D * DFE};
              pg8::QuarterOrder S{ntile - 256, F.G, F.vcu};
              pg8::EpiSlab E{WSP(float, WS_SLAB)};
              pg8::gemm_phase<pg8::ProbMoeDownQ, pg8::EpiSlab, pg8::QuarterOrder, true, true>(F.lds + RING_OFF, P, S, E, F.tid); }
        } SEAM(14 + 2 * k);
    }
    if (IN(17)) { LAUNDER(); moe_fix(F, 1, __builtin_amdgcn_readfirstlane(WSP(int, WS_MOETAB)[17]) - 256); } SEAM(17);
    if (IN(18)) { LAUNDER(); final_norm(F, args); }
#ifdef PROBE_MASK
    PROBE_SEAM(18);
#ifdef PROBE_EPI
    pacc = ((volatile LAS unsigned*)(F.lds + MISC_OFF))[33];
#endif
#ifdef PROBE_CLK
    pacc = (cacc * 100ull / (pacc ? pacc : 1ull)) * 100ull / 8ull;
#endif
    if (blockIdx.x == 0) { const unsigned long long t_ = __builtin_amdgcn_s_memrealtime(); while (__builtin_amdgcn_s_memrealtime() - t_ < 8ull * pacc) __builtin_amdgcn_s_sleep(32); }
#endif
#undef IN
#undef SEAM
#undef PROBE_SEAM
#undef META_TASK
#undef LAUNDER
}

extern "C" void kernel_launch(void* const* d_in, const int* in_sizes, int n_in, void* d_out, int out_size, void* d_ws, size_t ws_size, hipStream_t stream) {
    static int grid = 0;
    if (grid == 0) {
        if (n_in != 18 || in_sizes[0] != M * D || out_size != M * D || ws_size < WS_END) { fprintf(stderr, "kernel_launch: unexpected shapes (n_in %d, in0 %d, out %d, ws %zu); nothing launched\n", n_in, n_in > 0 ? in_sizes[0] : -1, out_size, ws_size); grid = -1; return; }
        int dev = 0, cus = 0, per_cu = 0;
        if (hipGetDevice(&dev) != hipSuccess || hipDeviceGetAttribute(&cus, hipDeviceAttributeMultiprocessorCount, dev) != hipSuccess) { grid = -1; return; }
        if (hipFuncSetAttribute((const void*)fwd, hipFuncAttributeMaxDynamicSharedMemorySize, LDS_BYTES) != hipSuccess) { fprintf(stderr, "kernel_launch: hipFuncSetAttribute failed\n"); grid = -1; return; }
        if (hipOccupancyMaxActiveBlocksPerMultiprocessor(&per_cu, (const void*)fwd, NWAVES * 64, LDS_BYTES) != hipSuccess || per_cu < 1) { fprintf(stderr, "kernel_launch: occupancy query reports %d workgroups per CU\n", per_cu); }
        (void)hipGetLastError();
        grid = cus;
    }
    if (grid < 0) return;
    if (hipMemsetAsync((char*)d_ws + WS_CTL, 0, CTL_ZERO_BYTES, stream) != hipSuccess) return;
    Args a{};
    for (int i = 0; i < 18; ++i) a.in[i] = (const float*)d_in[i];
    a.out = (float*)d_out; a.ws = (unsigned char*)d_ws;
#if MK_PER_PHASE
    for (int p = 0; p < NPHASES; ++p) { a.ph_lo = p; a.ph_hi = p + 1; hipLaunchKernelGGL(fwd, dim3(grid), dim3(NWAVES * 64), LDS_BYTES, stream, a); }
#else
    a.ph_lo = 0; a.ph_hi = NPHASES; hipLaunchKernelGGL(fwd, dim3(grid), dim3(NWAVES * 64), LDS_BYTES, stream, a);
#endif
}
```

```cpp
#include <hip/hip_runtime.h>
#include <cstdio>
#include <cstdint>

#define GAS __attribute__((address_space(1)))
#define LAS __attribute__((address_space(3)))
typedef unsigned short bf16;
typedef short bf16x8 __attribute__((ext_vector_type(8)));
typedef short s16x4 __attribute__((ext_vector_type(4)));
typedef float f32x2 __attribute__((ext_vector_type(2)));
typedef float f32x4 __attribute__((ext_vector_type(4)));
typedef float f32x16 __attribute__((ext_vector_type(16)));
typedef unsigned u32x2 __attribute__((ext_vector_type(2)));
typedef unsigned u32x4 __attribute__((ext_vector_type(4)));
typedef GAS unsigned gu32;
#define RLX_AGENT __ATOMIC_RELAXED, __HIP_MEMORY_SCOPE_AGENT
#define LDS_WAIT() asm volatile("s_waitcnt lgkmcnt(0)" ::: "memory")
#define VM_WAIT() asm volatile("s_waitcnt vmcnt(0)" ::: "memory")
#define DI __device__ __forceinline__
#define GLOBAL_AS __attribute__((address_space(1)))

constexpr int NB = 8, SEQ = 8192, D = 1024, M = NB * SEQ;
constexpr int NMETA = 16;
constexpr int NH = 16, HD = 64, NKV = 2, QG = 8, KVW = 128, POOLW = 512;
constexpr int USEQ = SEQ + NMETA;
constexpr int INW = 3840;
constexpr int DFF = 2816, NE = 8, DFE = 3584;
constexpr float RMS_EPS = 1e-5f;
constexpr float LOG2E = 1.4426950408889634f;
constexpr float QSCALE = 0.125f * LOG2E;
constexpr int NSLOT = M + NE * 256;
constexpr int MAXTILES = NSLOT / 256;

constexpr size_t MiB = 1u << 20;
constexpr size_t WS_CTL = 0, CTL_ZERO_BYTES = 1 * MiB;
constexpr size_t WS_SSQ = 1 * MiB;
constexpr size_t WS_TOKE = 5 * MiB;
constexpr size_t WS_TOKW = 5 * MiB + 512 * 1024;
constexpr size_t WS_SLOTTOK = 6 * MiB;
constexpr size_t WS_SLOTW = 7 * MiB;
constexpr size_t WS_WGCNT = 8 * MiB;
constexpr size_t WS_MOETAB = 8 * MiB + 64 * 1024;
constexpr size_t WS_SLOTRS = 8 * MiB + 128 * 1024;
constexpr size_t WS_META = 9 * MiB;
constexpr size_t WS_WIN = 16 * MiB;
constexpr size_t WS_WA = 31 * MiB;
constexpr int MRGK = 128 + 1024;
constexpr size_t WS_WP = 35 * MiB;
constexpr size_t WS_WO = 36 * MiB;
constexpr size_t WS_WGU = 40 * MiB;
constexpr size_t WS_WD = 51 * MiB;
constexpr size_t WS_MGU = 57 * MiB;
constexpr size_t WS_MD = 169 * MiB;
constexpr size_t WS_HB = 225 * MiB;
constexpr size_t WS_POOLED = 353 * MiB;
constexpr size_t WS_Q = 417 * MiB;
constexpr size_t WS_K = 545 * MiB;
constexpr size_t WS_V = 561 * MiB;
constexpr size_t WS_U = 577 * MiB;
constexpr size_t WS_G = 642 * MiB;
constexpr size_t WS_ACT = 417 * MiB;
constexpr size_t WS_SLAB = 898 * MiB;
constexpr size_t WS_END = 930 * MiB;
static_assert(WS_ACT + (size_t)NSLOT * DFE * 2 <= WS_END && WS_ACT + (size_t)M * DFF * 2 <= WS_END, "act overlay");
constexpr size_t MO_HM = 0;
constexpr size_t MO_XM = 64 * 1024;
constexpr size_t MO_PROJ = 96 * 1024;
constexpr size_t MO_KM = 336 * 1024;
constexpr size_t MO_VM = 344 * 1024;
constexpr size_t MO_UM = 352 * 1024;
constexpr size_t MO_ATT = 384 * 1024;
constexpr size_t MO_POOL = 416 * 1024;
constexpr size_t MO_MRG = 432 * 1024;
constexpr size_t MO_ACT = 464 * 1024;
constexpr int CW_TMO = 0, CW_CODE = 1, CW_BAR = 4096;

constexpr int RING_OFF = 0, RING_BYTES = 147456;
constexpr int LDSCTL_OFF = RING_BYTES, MISC_OFF = LDSCTL_OFF + 320;
constexpr int XTRA_OFF = LDSCTL_OFF + 1024;
constexpr int LDS_BYTES = RING_BYTES + 4096;

DI unsigned f2bf(float f) { unsigned u = __builtin_bit_cast(unsigned, f); return (u + 0x7fffu + ((u >> 16) & 1u)) >> 16; }
DI unsigned pk2(float lo, float hi) { unsigned r; asm volatile("v_cvt_pk_bf16_f32 %0, %1, %2" : "=v"(r) : "v"(lo), "v"(hi)); return r; }
DI float sat8(float v) { return __builtin_amdgcn_fmed3f(v, -448.f, 448.f); }
DI unsigned pk4_fp8(float a, float b, float c, float d) { int w = __builtin_amdgcn_cvt_pk_fp8_f32(sat8(a), sat8(b), 0, false); w = __builtin_amdgcn_cvt_pk_fp8_f32(sat8(c), sat8(d), w, true); return (unsigned)w; }
constexpr float W8_GU = 64.f, W8_DN = 128.f;
DI float bf2f(unsigned short b) { return __builtin_bit_cast(float, (unsigned)b << 16); }
DI float bflo(unsigned w) { return __builtin_bit_cast(float, w << 16); }
DI float bfhi(unsigned w) { return __builtin_bit_cast(float, w & 0xffff0000u); }
DI int hw_lane() { int l; asm volatile("v_mbcnt_lo_u32_b32 %0, -1, 0\n\tv_mbcnt_hi_u32_b32 %0, -1, %0" : "=v"(l)); return l; }
DI float shx(float v, int mask, int lane) { return __builtin_bit_cast(float, __builtin_amdgcn_ds_bpermute((lane ^ mask) << 2, __builtin_bit_cast(int, v))); }
DI float wave_sum(float v, int lane) {
#pragma unroll
    for (int o = 1; o < 64; o <<= 1) v += shx(v, o, lane);
    return v;
}
DI float fast_sigmoid(float x) { return __builtin_amdgcn_rcpf(1.f + __builtin_amdgcn_exp2f(-x * LOG2E)); }
DI float sigmoid_scaled(float a, float nsl2) { return __builtin_amdgcn_rcpf(1.f + __builtin_amdgcn_exp2f(a * nsl2)); }

#define XB_TMO      128
#define XB_XCNT(j)  (256  + 64 * (j))
#define XB_XSUB(j)  (1280 + 64 * (j))
#define XB_XGEN(j)  (2304 + 64 * (j))
#define XB_TOP      3328
#define XB_TOPGEN   3392
#define XCD_BAR_WORDS 3456
#define XB_SPIN_CAP (1u << 18)
DI unsigned xb_ld(unsigned* p)              { return __hip_atomic_load(p, __ATOMIC_RELAXED, __HIP_MEMORY_SCOPE_AGENT); }
DI unsigned xb_add(unsigned* p, unsigned v) { return __hip_atomic_fetch_add(p, v, __ATOMIC_RELAXED, __HIP_MEMORY_SCOPE_AGENT); }
DI unsigned xb_xcc_id() { return (unsigned)__builtin_amdgcn_s_getreg((3 << 11) | 20) & 0xFu; }
#define XB_SPIN(cond, bar) do { unsigned _sp = 0; while (cond) { __builtin_amdgcn_s_sleep(1); \
    if ((++_sp & 255u) == 0u) { if (xb_ld(&(bar)[XB_TMO])) break; if (_sp > XB_SPIN_CAP) { atomicAdd(&(bar)[XB_TMO], 1u); break; } } } } while (0)
struct XcdBarrier { unsigned* bar; unsigned x; volatile LAS unsigned* st; };
DI XcdBarrier xcd_barrier_post(unsigned* bar, volatile LAS unsigned* st, int tid) {
    XcdBarrier b; b.bar = bar; b.x = xb_xcc_id(); b.st = st;
    if (tid == 0) (void)xb_add(&bar[XB_XCNT(b.x)], 1u);
    return b;
}
DI void xcd_barrier_complete(unsigned* bar, unsigned x, unsigned& nloc, unsigned& nx) {
    const unsigned G = gridDim.x * gridDim.y * gridDim.z;
    unsigned sum, cnt, mine, sp = 0u;
    for (;;) {
        sum = 0u; cnt = 0u; mine = 0u;
#pragma unroll
        for (unsigned j = 0; j < 16; ++j) { const unsigned c = xb_ld(&bar[XB_XCNT(j)]); sum += c; cnt += (c > 0u) ? 1u : 0u; mine = (j == x) ? c : mine; }
        if (sum == G) break;
        __builtin_amdgcn_s_sleep(1);
        if ((++sp & 255u) == 0u) { if (xb_ld(&bar[XB_TMO])) break; if (sp > XB_SPIN_CAP) { atomicAdd(&bar[XB_TMO], 1u); break; } }
    }
    nloc = mine > 0u ? mine : 1u; nx = cnt > 0u ? cnt : 1u;
}
DI void xcd_barrier(const XcdBarrier& b, int tid) {
    asm volatile("s_waitcnt vmcnt(0)" ::: "memory");
    __syncthreads();
    if (tid == 0) {
        unsigned* bar = b.bar;
        __builtin_amdgcn_s_waitcnt(0);
        unsigned nloc = b.st[0], nx = b.st[1];
        if (nloc == 0u) { xcd_barrier_complete(bar, b.x, nloc, nx); b.st[0] = nloc; b.st[1] = nx; }
        const unsigned old = xb_add(&bar[XB_XSUB(b.x)], 1u);
        const unsigned gen = old / nloc;
        if (old + 1u == (gen + 1u) * nloc) {
            __builtin_amdgcn_fence(__ATOMIC_RELEASE, "agent");
            asm volatile("s_waitcnt vmcnt(0)" ::: "memory");
            const unsigned og = xb_add(&bar[XB_TOP], 1u);
            const unsigned tg = og / nx;
            if (og + 1u == (tg + 1u) * nx) xb_add(&bar[XB_TOPGEN], 1u);
            else XB_SPIN(xb_ld(&bar[XB_TOPGEN]) == tg, bar);
            __builtin_amdgcn_fence(__ATOMIC_ACQUIRE, "agent");
            xb_add(&bar[XB_XGEN(b.x)], 1u);
            asm volatile("s_waitcnt vmcnt(0)" ::: "memory");
        } else {
            XB_SPIN(xb_ld(&bar[XB_XGEN(b.x)]) == gen, bar);
            __builtin_amdgcn_fence(__ATOMIC_ACQUIRE, "agent");
            asm volatile("s_waitcnt vmcnt(0)" ::: "memory");
        }
    }
    __syncthreads();
}
namespace pg8 {
constexpr int BM = 256, BK = 64, HALF = 128, HTB = HALF * BK * 2, STAGE_BYTES = 8 * HTB, NXCD = 8, WGM = 8;
__host__ __device__ __forceinline__ int lds_byte(int r, int c) { const int st = (r >> 4) * 2 + (c >> 5), rr = r & 15, cc = c & 31, ob = rr * 64 + cc * 2; return st * 1024 + (ob ^ (((ob >> 9) & 1) << 5)); }
__host__ __device__ __forceinline__ void stage_rc(int b, int& R, int& C) { const int st = b / 1024, sb = b % 1024, swz = sb ^ (((sb >> 9) & 1) << 5); R = (st >> 1) * 16 + swz / 64; C = (st & 1) * 32 + (swz % 64) / 2; }
__host__ __device__ __forceinline__ int perm32(int rho) { const int n = rho >> 4, i = rho & 15; return 8 * (i >> 2) + 4 * n + (i & 3); }

struct Unit { int pm, pn; int kq = 0; };

struct StaticOrder {
    int nM, nN, nwg, G, c; bool rev = false;
    DI void init(int M_, int N_, int G_, int c_) { nM = M_ / BM; nN = N_ / BM; nwg = nM * nN; G = G_; c = c_; }
    DI bool next(int i, Unit& u) const {
        const long L = (long)i * G + c; if (L >= nwg) return false;
        int wgid = (int)L; { const int q = nwg / NXCD, r = nwg % NXCD, xcd = wgid % NXCD, off = wgid / NXCD; wgid = (xcd < r ? xcd * (q + 1) : r * (q + 1) + (xcd - r) * q) + off; }
        const int nig = WGM * nN, gid = wgid / nig, fm = gid * WGM, gsz = (nM - fm) < WGM ? (nM - fm) : WGM;
        u.pm = fm + ((wgid % nig) % gsz); u.pn = (wgid % nig) / gsz; if (rev) u.pm = nM - 1 - u.pm; return true;
    }
};
struct LinearOrder {
    int ntile, nN, G, c; bool rev; int base = 0;
    DI bool next(int i, Unit& u) const {
        const long L = (long)i * G + c; if (L >= (long)ntile * nN) return false;
        constexpr int gt = 8; const int per8 = gt * nN, g = (int)(L / per8), w = (int)(L % per8), gsz = (ntile - gt * g) < gt ? (ntile - gt * g) : gt;
        u.pm = gt * g + w % gsz; u.pn = w / gsz; if (rev) u.pm = ntile - 1 - u.pm; u.pm += base; return true; }
};
constexpr int NQ = 2;
struct QuarterOrder {
    int ntail, G, c;
    DI bool next(int i, Unit& u) const { const long L = (long)i * G + c; if (L >= (long)ntail * 4 * NQ) return false; u.pm = (int)(L / (4 * NQ)); u.pn = (int)((L / NQ) & 3); u.kq = (int)(L % NQ); return true; }
};

struct ProbPlain {
    static constexpr bool GATHER = false;
    const char* A; const char* Bt; unsigned lda2, ldb2; int nt; unsigned acol2;
    unsigned kstepA; size_t panelA;
    unsigned kstepB = 128; size_t panelB = 0;
    DI unsigned a_base(const Unit& u) const { return (unsigned)((size_t)u.pm * panelA + (size_t)u.pn * acol2); }
    DI unsigned b_base(const Unit& u) const { return (unsigned)((size_t)u.pn * (panelB ? panelB : (size_t)BM * ldb2)); }
    DI unsigned a_row(const Unit&, int r) const { return (unsigned)r * lda2; }
    DI unsigned ak(const Unit&, int t) const { return (unsigned)t * kstepA; }
};
struct ProbMoeGU {
    static constexpr bool GATHER = true;
    static constexpr unsigned kstepA = 128, kstepB = 128;
    const char* A; const char* Bt; unsigned lda2, ldb2; int nt; const int* slot_tok; const LAS int* tile_e; LAS int* gtab; size_t estride;
    DI unsigned a_base(const Unit&) const { return 0u; }
    DI unsigned a_row_lds(int r) const { int t = gtab[r]; t = t < 0 ? 0 : t; return (unsigned)t * lda2; }
    DI void prefetch_rows(const Unit& u, int wid, int lane) const { if (wid < 4) __builtin_amdgcn_global_load_lds((const unsigned*)(slot_tok + u.pm * BM + wid * 64 + lane), (LAS unsigned*)(gtab + wid * 64), 4, 0, 0); }
    DI unsigned b_base(const Unit& u) const { return (unsigned)((size_t)tile_e[u.pm] * estride + (size_t)u.pn * BM * ldb2); }
    DI unsigned a_row(const Unit& u, int r) const { int t = slot_tok[u.pm * BM + r]; t = t < 0 ? 0 : t; return (unsigned)t * lda2; }
    DI unsigned ak(const Unit&, int t) const { return (unsigned)t * kstepA; }
};
struct ProbMoeDown {
    static constexpr bool GATHER = false;
    const char* A; const char* Bt; unsigned lda2, ldb2; int nt; const LAS int* tile_e; unsigned kstepA; size_t panelA; unsigned kstepB; size_t panelB; size_t estride;
    DI unsigned a_base(const Unit& u) const { return (unsigned)((size_t)u.pm * panelA); }
    DI unsigned b_base(const Unit& u) const { return (unsigned)((size_t)tile_e[u.pm] * estride + (size_t)u.pn * panelB); }
    DI unsigned a_row(const Unit&, int r) const { return (unsigned)r * lda2; }
    DI unsigned ak(const Unit&, int t) const { return (unsigned)t * kstepA; }
};

struct ProbMoeDownQ {
    static constexpr bool GATHER = false; static constexpr unsigned kstepA = 32768, kstepB = 32768;
    const char* A; const char* Bt; unsigned lda2, ldb2; int nt; const LAS int* tile_e; size_t panelA, panelB, estride;
    DI unsigned a_base(const Unit& u) const { return (unsigned)((size_t)u.pm * panelA + (size_t)u.kq * nt * 32768); }
    DI unsigned b_base(const Unit& u) const { return (unsigned)((size_t)tile_e[u.pm] * estride + (size_t)u.pn * panelB + (size_t)u.kq * nt * 32768); }
    DI unsigned a_row(const Unit&, int r) const { return (unsigned)r * lda2; }
    DI unsigned ak(const Unit&, int t) const { return (unsigned)t * kstepA; }
};
struct ProbMerge {
    static constexpr bool GATHER = false; static constexpr unsigned kstepB = 128;
    const char* A; const char* Bt; unsigned ldb2; int nt;
    DI unsigned a_base(const Unit& u) const { return (unsigned)u.pm * (24u * 32768u); }
    DI unsigned b_base(const Unit& u) const { return (unsigned)u.pn * (unsigned)BM * ldb2; }
    DI unsigned a_row(const Unit&, int r) const { return (unsigned)r * 128u; }
    DI unsigned ak(const Unit& u, int t) const { return (unsigned)(t < 2 ? 2 * u.pn + t : 6 + t) * 32768u; }
};

template <class Prob, class Epi, class Sched, bool ALIGN_EPI, bool FP8 = false>
DI void gemm_phase(LAS unsigned char* lds, const Prob& P, const Sched& S, const Epi& E, int tid) {
    asm volatile("" : "+v"(tid));
    const int wid = __builtin_amdgcn_readfirstlane(tid >> 6), lane = tid & 63, wr = wid >> 2, wc = wid & 3, fr = lane & 15, fq = lane >> 4;
    const int nt = P.nt;
    int R0, C0, R1, C1; stage_rc(tid * 16, R0, C0); stage_rc(tid * 16 + 8192, R1, C1);
    const int Rb0 = Epi::PERM ? ((R0 & ~31) + perm32(R0 & 31)) : R0, Rb1 = Epi::PERM ? ((R1 & ~31) + perm32(R1 & 31)) : R1;
    const unsigned voffB0 = (unsigned)Rb0 * P.ldb2 + (unsigned)C0 * 2u, voffB1 = (unsigned)Rb1 * P.ldb2 + (unsigned)C1 * 2u;
    const unsigned kstep = P.kstepB;
    const unsigned hstepB = (unsigned)HALF * P.ldb2;
    const __amdgpu_buffer_rsrc_t rsA = __builtin_amdgcn_make_buffer_rsrc((void*)P.A, 0, -1, 0x00020000), rsB = __builtin_amdgcn_make_buffer_rsrc((void*)P.Bt, 0, -1, 0x00020000);
    const unsigned ldsw = (unsigned)wid * 1024u;
    const int aoff = lds_byte(wr * 64 + fr, fq * 8), boff = lds_byte(wc * 32 + fr, fq * 8);
#define PG8_SA(b, h) (((b) * 2 + (h)) * HTB)
#define PG8_SB(b, h) ((4 + (b) * 2 + (h)) * HTB)
#define PG8_STGX(rs, bufoff, soff, v0, v1) do { \
        __builtin_amdgcn_raw_ptr_buffer_load_lds(rs, (LAS unsigned*)(lds + (bufoff) + ldsw), 16, (int)(v0), (int)(soff), 0, 0); \
        __builtin_amdgcn_raw_ptr_buffer_load_lds(rs, (LAS unsigned*)(lds + (bufoff) + ldsw + 8192), 16, (int)(v1), (int)(soff), 0, 0); } while (0)
#define PG8_STG(bufoff, soff, v0, v1) PG8_STGX(rsA, bufoff, soff, v0, v1)
#define PG8_STGB(bufoff, soff) PG8_STGX(rsB, bufoff, soff, voffB0, voffB1)
#define PG8_LDA(dst, b, h) do { if constexpr (FP8) { _Pragma("unroll") for (int m = 0; m < 4; ++m) { const i32x4_ lo_ = *(const LAS i32x4_*)(lds + PG8_SA(b, h) + aoff + m * 2048), hi_ = *(const LAS i32x4_*)(lds + PG8_SA(b, h) + aoff + m * 2048 + 1024); dst##8[m] = __builtin_shufflevector(lo_, hi_, 0, 1, 2, 3, 4, 5, 6, 7); } } \
        else { _Pragma("unroll") for (int m = 0; m < 4; ++m) _Pragma("unroll") for (int k = 0; k < 2; ++k) dst[m][k] = *(const LAS bf16x8*)(lds + PG8_SA(b, h) + aoff + m * 2048 + k * 1024); } } while (0)
#define PG8_LDB(dst, b, h) do { if constexpr (FP8) { _Pragma("unroll") for (int n = 0; n < 2; ++n) { const i32x4_ lo_ = *(const LAS i32x4_*)(lds + PG8_SB(b, h) + boff + n * 2048), hi_ = *(const LAS i32x4_*)(lds + PG8_SB(b, h) + boff + n * 2048 + 1024); dst##8[n] = __builtin_shufflevector(lo_, hi_, 0, 1, 2, 3, 4, 5, 6, 7); } } \
        else { _Pragma("unroll") for (int n = 0; n < 2; ++n) _Pragma("unroll") for (int k = 0; k < 2; ++k) dst[n][k] = *(const LAS bf16x8*)(lds + PG8_SB(b, h) + boff + n * 2048 + k * 1024); } } while (0)
#define PG8_MMA(ai, bj, At, Bt) do { __builtin_amdgcn_s_setprio(1); _Pragma("unroll") for (int m = 0; m < 4; ++m) _Pragma("unroll") for (int n = 0; n < 2; ++n) { \
        if constexpr (FP8) { acc[ai][bj][m][n] = __builtin_amdgcn_mfma_scale_f32_16x16x128_f8f6f4(Bt##8[n], At##8[m], acc[ai][bj][m][n], 0, 0, 0, 0x7f7f7f7f, 0, 0x7f7f7f7f); } \
        else { _Pragma("unroll") for (int k = 0; k < 2; ++k) acc[ai][bj][m][n] = __builtin_amdgcn_mfma_f32_16x16x32_bf16(Bt[n][k], At[m][k], acc[ai][bj][m][n], 0, 0, 0); } } \
        __builtin_amdgcn_s_setprio(0); } while (0)
#define PG8_WAIT_V(n) asm volatile("s_waitcnt vmcnt(" #n ")" ::: "memory")
#define PG8_WAIT_L(n) asm volatile("s_waitcnt lgkmcnt(" #n ")" ::: "memory")
#define PG8_BAR __builtin_amdgcn_s_barrier()
#define PG8_SCHED __builtin_amdgcn_sched_barrier(0)
    Unit cur, nxt; int ui = 0;
    if (!S.next(0, cur)) return;
    f32x4 acc[2][2][4][2];
#pragma unroll
    for (int a = 0; a < 2; ++a)
#pragma unroll
        for (int b = 0; b < 2; ++b)
#pragma unroll
            for (int m = 0; m < 4; ++m)
#pragma unroll
                for (int n = 0; n < 2; ++n) acc[a][b][m][n] = (f32x4){0.f, 0.f, 0.f, 0.f};
    bf16x8 At[4][2], B0[2][2], B1[2][2];
    typedef int i32x8_ __attribute__((ext_vector_type(8))); typedef int i32x4_ __attribute__((ext_vector_type(4)));
    i32x8_ At8[4], B08[2], B18[2];
    unsigned vc00, vc01, vc10, vc11;
#define PG8_AOFF(u, o00, o01, o10, o11) do { o00 = P.a_row(u, R0) + (unsigned)C0 * 2u; o01 = P.a_row(u, R1) + (unsigned)C1 * 2u; \
        o10 = P.a_row(u, HALF + R0) + (unsigned)C0 * 2u; o11 = P.a_row(u, HALF + R1) + (unsigned)C1 * 2u; } while (0)
    PG8_AOFF(cur, vc00, vc01, vc10, vc11);
    unsigned cA = P.a_base(cur), cB = P.b_base(cur);
    PG8_STGB(PG8_SB(0, 0), cB); PG8_STGB(PG8_SB(0, 1), cB + hstepB); PG8_STG(PG8_SA(0, 0), cA + P.ak(cur, 0), vc00, vc01); PG8_STG(PG8_SA(0, 1), cA + P.ak(cur, 0), vc10, vc11);
    if (wr == 1) PG8_BAR;
    PG8_WAIT_V(2); PG8_BAR;
    PG8_STGB(PG8_SB(1, 0), cB + kstep); PG8_STG(PG8_SA(1, 0), cA + P.ak(cur, 1), vc00, vc01); PG8_STGB(PG8_SB(1, 1), cB + hstepB + kstep);
    PG8_WAIT_V(6); PG8_BAR;
    for (;;) {
        const bool has_next = S.next(ui + 1, nxt);
        unsigned nA = cA, nB = cB;
        if (has_next) { nA = P.a_base(nxt); nB = P.b_base(nxt); if constexpr (Prob::GATHER) { P.prefetch_rows(nxt, wid, lane); } }
        const Unit nu = has_next ? nxt : cur;
        for (int t = 0; t < nt; t += 2) {
            const bool last = (t == nt - 2);
            const unsigned a1 = cA + P.ak(cur, t + 1);
            const unsigned a2 = last ? nA + P.ak(nu, 0) : cA + P.ak(cur, t + 2), b2 = last ? nB : cB + (unsigned)(t + 2) * kstep;
            const unsigned a3 = last ? nA + P.ak(nu, 1) : cA + P.ak(cur, t + 3), b3 = b2 + kstep;
            PG8_LDB(B0, 0, 0); PG8_LDB(B1, 0, 1); PG8_SCHED; PG8_LDA(At, 0, 0); PG8_STG(PG8_SA(1, 1), a1, vc10, vc11);
            if constexpr (Prob::GATHER) { if (last && has_next) {
                vc00 = P.a_row_lds(R0) + (unsigned)C0 * 2u; vc01 = P.a_row_lds(R1) + (unsigned)C1 * 2u; vc10 = P.a_row_lds(HALF + R0) + (unsigned)C0 * 2u; vc11 = P.a_row_lds(HALF + R1) + (unsigned)C1 * 2u; } }
            PG8_WAIT_V(8); PG8_WAIT_L(0); PG8_BAR; PG8_MMA(0, 0, At, B0); PG8_MMA(0, 1, At, B1); PG8_BAR; PG8_SCHED;
            PG8_LDA(At, 0, 1); PG8_STGB(PG8_SB(0, 0), b2); PG8_STGB(PG8_SB(0, 1), b2 + hstepB); PG8_STG(PG8_SA(0, 0), a2, vc00, vc01);
            PG8_WAIT_V(8); PG8_WAIT_L(0); PG8_BAR; PG8_MMA(1, 0, At, B0); PG8_MMA(1, 1, At, B1); PG8_BAR; PG8_SCHED;
            PG8_LDB(B0, 1, 0); PG8_LDB(B1, 1, 1); PG8_SCHED; PG8_LDA(At, 1, 0); PG8_STG(PG8_SA(0, 1), a2, vc10, vc11);
            PG8_WAIT_V(8); PG8_WAIT_L(0); PG8_BAR; PG8_MMA(0, 0, At, B0); PG8_MMA(0, 1, At, B1); PG8_BAR; PG8_SCHED;
            PG8_LDA(At, 1, 1); PG8_STGB(PG8_SB(1, 0), b3); PG8_STGB(PG8_SB(1, 1), b3 + hstepB); PG8_STG(PG8_SA(1, 0), a3, vc00, vc01);
            PG8_WAIT_V(8); PG8_WAIT_L(0); PG8_BAR; PG8_MMA(1, 0, At, B0); PG8_MMA(1, 1, At, B1); PG8_BAR; PG8_SCHED;
            if constexpr (Epi::HAS_MID) { if (t == 0) { E.mid(acc, cur, wr, wc, fr, fq); PG8_SCHED; } }
        }
#ifdef PROBE_EPI
        const unsigned te_ = (unsigned)__builtin_amdgcn_s_memrealtime();
#endif
        if constexpr (ALIGN_EPI) { if (wr == 0) PG8_BAR; }
        PG8_SCHED; E(acc, cur, wr, wc, fr, fq); PG8_SCHED;
#ifdef PROBE_EPI
        if (tid == 0) { volatile LAS unsigned* pw_ = (volatile LAS unsigned*)(lds - RING_OFF + MISC_OFF) + 32; if (pw_[0]) pw_[1] += (unsigned)__builtin_amdgcn_s_memrealtime() - te_; }
#endif
        if (!has_next) break;
#pragma unroll
        for (int a = 0; a < 2; ++a)
#pragma unroll
            for (int b = 0; b < 2; ++b)
#pragma unroll
                for (int m = 0; m < 4; ++m)
#pragma unroll
                    for (int n = 0; n < 2; ++n) acc[a][b][m][n] = (f32x4){0.f, 0.f, 0.f, 0.f};
        cur = nxt; cA = nA; cB = nB; ++ui;
        if constexpr (ALIGN_EPI) { if (wr == 1) PG8_BAR; }
    }
    PG8_WAIT_V(0);
    if constexpr (!ALIGN_EPI) { if (wr == 0) PG8_BAR; }
    PG8_BAR;
#undef PG8_SA
#undef PG8_SB
#undef PG8_STG
#undef PG8_STGX
#undef PG8_STGB
#undef PG8_LDA
#undef PG8_LDB
#undef PG8_MMA
#undef PG8_WAIT_V
#undef PG8_WAIT_L
#undef PG8_BAR
#undef PG8_SCHED
#undef PG8_AOFF
}
}
namespace pg8 {
DI u32x4 pack8(const f32x4 v0, const f32x4 v1) { u32x4 w; w.x = pk2(v0[0], v0[1]); w.y = pk2(v0[2], v0[3]); w.z = pk2(v1[0], v1[1]); w.w = pk2(v1[2], v1[3]); return w; }

DI void rstd4_load(f32x4 (&p)[4], const float* ssq16, int row0, int fq) {
#pragma unroll
    for (int m = 0; m < 4; ++m) p[m] = *(const f32x4*)(ssq16 + (size_t)(row0 + m * 16) * 16 + 4 * fq);
}
DI float rstd_finish(const f32x4 p, int lane) { float s = (p[0] + p[1]) + (p[2] + p[3]); s += shx(s, 16, lane); s += shx(s, 32, lane); return __builtin_amdgcn_rsqf(s * (1.0f / D) + RMS_EPS); }
#define EPI_FENCE() asm volatile("" ::: "memory")

struct EpiInProj {
    static constexpr bool PERM = true, TWICE_OK = true, HAS_MID = false;
    const float* ssq16; bf16 *Q, *K, *V, *U, *G;
    DI void operator()(const f32x4 (&acc)[2][2][4][2], const Unit& u, int wr, int wc, int fr, int fq) const {
        const int row0 = u.pm * BM + wr * 64 + fr, cw = wc * 32 + 8 * fq;
        const int pn = u.pn;
        bf16* base0; bf16* base1; int ldc, col0, col1, mode;
        if (pn < 4) { base0 = base1 = Q; ldc = D; col0 = pn * 256 + cw; col1 = col0 + HALF; mode = 1; }
        else if (pn == 4) { base0 = K; base1 = V; ldc = KVW; col0 = col1 = cw; mode = 0; }
        else if (pn < 7) { base0 = base1 = U + (size_t)(NMETA * ((u.pm >> 5) + 1)) * POOLW; ldc = POOLW; col0 = (pn - 5) * 256 + cw; col1 = col0 + HALF; mode = 0; }
        else { base0 = base1 = G; ldc = 2 * D; col0 = (pn - 7) * 256 + cw; col1 = col0 + HALF; mode = 2; }
        f32x4 pp[2][4]; rstd4_load(pp[0], ssq16, row0, fq); rstd4_load(pp[1], ssq16, row0 + HALF, fq);
#pragma unroll
        for (int ai = 0; ai < 2; ++ai) {
#pragma unroll
            for (int m = 0; m < 4; ++m) {
                const int row = row0 + ai * HALF + m * 16;
                const float sc = rstd_finish(pp[ai][m], fq * 16 + fr) * (mode == 1 ? QSCALE : 1.f);
#pragma unroll
                for (int bj = 0; bj < 2; ++bj) {
                    f32x4 v0, v1;
                    if (mode == 2) { const float nsl2 = -sc * LOG2E;
#pragma unroll
                        for (int j = 0; j < 4; ++j) { v0[j] = sigmoid_scaled(acc[ai][bj][m][0][j], nsl2); v1[j] = sigmoid_scaled(acc[ai][bj][m][1][j], nsl2); }
                    } else { v0 = acc[ai][bj][m][0] * sc; v1 = acc[ai][bj][m][1] * sc; }
                    *(u32x4*)((bj ? base1 : base0) + (size_t)row * ldc + (bj ? col1 : col0)) = pack8(v0, v1);
                }
            }
            EPI_FENCE();
        }
    }
};
struct EpiMerge {
    static constexpr bool PERM = true, TWICE_OK = false, HAS_MID = true;
    const bf16* G; bf16* MRG;
    DI void mid(f32x4 (&acc)[2][2][4][2], const Unit& u, int wr, int wc, int fr, int fq) const {
        const int row0 = u.pm * BM + wr * 64 + fr, col0 = u.pn * BM + wc * 32 + 8 * fq;
#pragma unroll
        for (int ai = 0; ai < 2; ++ai) {
            u32x4 g0[4][2], g1[4][2];
#pragma unroll
            for (int m = 0; m < 4; ++m)
#pragma unroll
                for (int bj = 0; bj < 2; ++bj) { const bf16* gp = G + (size_t)(row0 + ai * HALF + m * 16) * (2 * D) + col0 + bj * HALF; g0[m][bj] = *(const u32x4*)gp; g1[m][bj] = *(const u32x4*)(gp + D); }
#pragma unroll
            for (int m = 0; m < 4; ++m)
#pragma unroll
                for (int bj = 0; bj < 2; ++bj) { const u32x4 a = g0[m][bj], b = g1[m][bj];
#define MRG_R(x, y, lohi) (lohi(y) * __builtin_amdgcn_rcpf(__builtin_fmaxf(lohi(x), 1e-30f)))
                    acc[ai][bj][m][0][0] *= MRG_R(a.x, b.x, bflo); acc[ai][bj][m][0][1] *= MRG_R(a.x, b.x, bfhi); acc[ai][bj][m][0][2] *= MRG_R(a.y, b.y, bflo); acc[ai][bj][m][0][3] *= MRG_R(a.y, b.y, bfhi);
                    acc[ai][bj][m][1][0] *= MRG_R(a.z, b.z, bflo); acc[ai][bj][m][1][1] *= MRG_R(a.z, b.z, bfhi); acc[ai][bj][m][1][2] *= MRG_R(a.w, b.w, bflo); acc[ai][bj][m][1][3] *= MRG_R(a.w, b.w, bfhi);
#undef MRG_R
                }
            EPI_FENCE();
        }
    }
    DI void operator()(const f32x4 (&acc)[2][2][4][2], const Unit& u, int wr, int wc, int fr, int fq) const {
        const int row0 = u.pm * BM + wr * 64 + fr, col0 = u.pn * BM + wc * 32 + 8 * fq;
#pragma unroll
        for (int ai = 0; ai < 2; ++ai) {
            u32x4 g[4][2];
#pragma unroll
            for (int m = 0; m < 4; ++m)
#pragma unroll
                for (int bj = 0; bj < 2; ++bj) g[m][bj] = *(const u32x4*)(G + (size_t)(row0 + ai * HALF + m * 16) * (2 * D) + col0 + bj * HALF);
#pragma unroll
            for (int m = 0; m < 4; ++m) { const size_t r = (size_t)(row0 + ai * HALF + m * 16);
#pragma unroll
                for (int bj = 0; bj < 2; ++bj) { const u32x4 gg = g[m][bj];
                    f32x4 v0 = acc[ai][bj][m][0], v1 = acc[ai][bj][m][1];
#define MRG_G(x, lohi) __builtin_fmaxf(lohi(x), 1e-30f)
                    v0[0] *= MRG_G(gg.x, bflo); v0[1] *= MRG_G(gg.x, bfhi); v0[2] *= MRG_G(gg.y, bflo); v0[3] *= MRG_G(gg.y, bfhi);
                    v1[0] *= MRG_G(gg.z, bflo); v1[1] *= MRG_G(gg.z, bfhi); v1[2] *= MRG_G(gg.w, bflo); v1[3] *= MRG_G(gg.w, bfhi);
#undef MRG_G
                    *(u32x4*)(MRG + r * D + col0 + bj * HALF) = pack8(v0, v1); } }
            EPI_FENCE();
        }
    }
};
struct EpiResid {
    static constexpr bool PERM = true, TWICE_OK = false, HAS_MID = false;
    bf16* HB; float* ssq16;
    DI void operator()(const f32x4 (&acc)[2][2][4][2], const Unit& u, int wr, int wc, int fr, int fq) const {
        const int row0 = u.pm * BM + wr * 64 + fr, col0 = u.pn * BM + wc * 32 + 8 * fq;
#pragma unroll
        for (int ai = 0; ai < 2; ++ai) {
            u32x4 hv[4][2];
#pragma unroll
            for (int m = 0; m < 4; ++m)
#pragma unroll
                for (int bj = 0; bj < 2; ++bj) hv[m][bj] = *(const u32x4*)(HB + (size_t)(row0 + ai * HALF + m * 16) * D + col0 + bj * HALF);
#pragma unroll
            for (int m = 0; m < 4; ++m) { const size_t r = (size_t)(row0 + ai * HALF + m * 16); float s = 0.f;
#pragma unroll
                for (int bj = 0; bj < 2; ++bj) { const u32x4 h = hv[m][bj];
                    f32x4 v0 = acc[ai][bj][m][0], v1 = acc[ai][bj][m][1];
                    v0[0] += bflo(h.x); v0[1] += bfhi(h.x); v0[2] += bflo(h.y); v0[3] += bfhi(h.y); v1[0] += bflo(h.z); v1[1] += bfhi(h.z); v1[2] += bflo(h.w); v1[3] += bfhi(h.w);
                    const u32x4 w = pack8(v0, v1); *(u32x4*)(HB + r * D + col0 + bj * HALF) = w;
                    s += (bflo(w.x) * bflo(w.x) + bfhi(w.x) * bfhi(w.x)) + (bflo(w.y) * bflo(w.y) + bfhi(w.y) * bfhi(w.y)) + (bflo(w.z) * bflo(w.z) + bfhi(w.z) * bfhi(w.z)) + (bflo(w.w) * bflo(w.w) + bfhi(w.w) * bfhi(w.w)); }
                s += shx(s, 16, fq * 16 + fr); s += shx(s, 32, fq * 16 + fr);
                if (fq == 0) ssq16[r * 16 + 4 * u.pn + wc] = s; }
            EPI_FENCE();
        }
    }
};
template <bool MOE> struct EpiSwiGLU {
    static constexpr bool PERM = true, TWICE_OK = false, HAS_MID = false;
    const float* rsrc; bf16* ACT; int nkt;
    DI void operator()(const f32x4 (&acc)[2][2][4][2], const Unit& u, int wr, int wc, int fr, int fq) const {
        const int row0 = u.pm * BM + wr * 64 + fr;
        bf16* abase = ACT + ((size_t)(u.pm * nkt + 2 * u.pn + (wc >> 1)) * 256 + (wr * 64 + fr)) * 64 + (wc & 1) * 32 + 8 * fq;
        f32x4 pp[2][4]; float rsv[2][4];
        if (MOE) {
#pragma unroll
            for (int ai = 0; ai < 2; ++ai)
#pragma unroll
                for (int m = 0; m < 4; ++m) rsv[ai][m] = rsrc[row0 + ai * HALF + m * 16];
        } else { rstd4_load(pp[0], rsrc, row0, fq); rstd4_load(pp[1], rsrc, row0 + HALF, fq); }
#pragma unroll
        for (int ai = 0; ai < 2; ++ai) {
#pragma unroll
            for (int m = 0; m < 4; ++m) { const int r = row0 + ai * HALF + m * 16;
                const float rs = MOE ? rsv[ai][m] : rstd_finish(pp[ai][m], fq * 16 + fr); const float rs2 = rs * rs, nsl2 = -rs * LOG2E;
                f32x4 o[2];
#pragma unroll
                for (int n = 0; n < 2; ++n) { const f32x4 gu = acc[ai][0][m][n] * acc[ai][1][m][n] * rs2;
#pragma unroll
                    for (int j = 0; j < 4; ++j) o[n][j] = gu[j] * sigmoid_scaled(acc[ai][0][m][n][j], nsl2); }
                *(u32x4*)(abase + (ai * HALF + m * 16) * 64) = pack8(o[0], o[1]); }
            EPI_FENCE();
        }
    }
};
struct EpiSwiGLU8 {
    static constexpr bool PERM = true, TWICE_OK = false, HAS_MID = false;
    const float* slot_rs; unsigned char* ACT8;
    DI void operator()(const f32x4 (&acc)[2][2][4][2], const Unit& u, int wr, int wc, int fr, int fq) const {
        const int row0 = wr * 64 + fr;
        unsigned char* base = ACT8 + ((size_t)(u.pm * (DFE / 128) + u.pn) * 256 + row0) * 128 + wc * 32 + 8 * fq;
        float rsv[2][4];
#pragma unroll
        for (int ai = 0; ai < 2; ++ai)
#pragma unroll
            for (int m = 0; m < 4; ++m) rsv[ai][m] = slot_rs[u.pm * BM + row0 + ai * HALF + m * 16];
#pragma unroll
        for (int ai = 0; ai < 2; ++ai) {
#pragma unroll
            for (int m = 0; m < 4; ++m) { const float rs = rsv[ai][m] * (1.0f / W8_GU), rs2 = rs * rs, nsl2 = -rs * LOG2E;
                f32x4 o[2];
#pragma unroll
                for (int n = 0; n < 2; ++n) { const f32x4 gu = acc[ai][0][m][n] * acc[ai][1][m][n] * rs2;
#pragma unroll
                    for (int j = 0; j < 4; ++j) o[n][j] = gu[j] * sigmoid_scaled(acc[ai][0][m][n][j], nsl2); }
                u32x2 w; w.x = pk4_fp8(o[0][0], o[0][1], o[0][2], o[0][3]); w.y = pk4_fp8(o[1][0], o[1][1], o[1][2], o[1][3]);
                *(u32x2*)(base + (size_t)(ai * HALF + m * 16) * 128) = w; }
            EPI_FENCE();
        }
    }
};
struct EpiMoeDown {
    static constexpr bool PERM = true, TWICE_OK = false, HAS_MID = false;
    const bf16* SRC; bf16* DST; const int* slot_tok; const float* slot_w; float scale;
    DI void operator()(const f32x4 (&acc)[2][2][4][2], const Unit& u, int wr, int wc, int fr, int fq) const {
        const int row0 = u.pm * BM + wr * 64 + fr, col0 = u.pn * BM + wc * 32 + 8 * fq;
        int tk[2][4]; float wk[2][4];
#pragma unroll
        for (int ai = 0; ai < 2; ++ai)
#pragma unroll
            for (int m = 0; m < 4; ++m) { tk[ai][m] = slot_tok[row0 + ai * HALF + m * 16]; wk[ai][m] = slot_w[row0 + ai * HALF + m * 16] * scale; }
#pragma unroll
        for (int ai = 0; ai < 2; ++ai) {
            u32x4 hv[4][2];
#pragma unroll
            for (int m = 0; m < 4; ++m) { const int tok = tk[ai][m] < 0 ? 0 : tk[ai][m];
#pragma unroll
                for (int bj = 0; bj < 2; ++bj) hv[m][bj] = *(const u32x4*)(SRC + (size_t)tok * D + col0 + bj * HALF); }
#pragma unroll
            for (int m = 0; m < 4; ++m) { const int tok = tk[ai][m]; const float w = wk[ai][m];
                if (tok >= 0) {
#pragma unroll
                    for (int bj = 0; bj < 2; ++bj) { const u32x4 h = hv[m][bj];
                        f32x4 v0 = acc[ai][bj][m][0] * w, v1 = acc[ai][bj][m][1] * w;
                        v0[0] += bflo(h.x); v0[1] += bfhi(h.x); v0[2] += bflo(h.y); v0[3] += bfhi(h.y); v1[0] += bflo(h.z); v1[1] += bfhi(h.z); v1[2] += bflo(h.w); v1[3] += bfhi(h.w);
                        *(u32x4*)(DST + (size_t)tok * D + col0 + bj * HALF) = pack8(v0, v1); } } }
            EPI_FENCE();
        }
    }
};
struct EpiSlab {
    static constexpr bool PERM = false, TWICE_OK = false, HAS_MID = false;
    float* slab;
    DI void operator()(const f32x4 (&acc)[2][2][4][2], const Unit& u, int wr, int wc, int fr, int fq) const {
        float* base = slab + ((size_t)(u.pm * NQ + u.kq) * BM + wr * 64 + fr) * D + u.pn * BM + wc * 32 + 4 * fq;
#pragma unroll
        for (int ai = 0; ai < 2; ++ai)
#pragma unroll
            for (int m = 0; m < 4; ++m)
#pragma unroll
                for (int bj = 0; bj < 2; ++bj)
#pragma unroll
                    for (int n = 0; n < 2; ++n) *(f32x4*)(base + (size_t)(ai * HALF + m * 16) * D + bj * HALF + n * 16) = acc[ai][bj][m][n];
    }
};
}
namespace att {
constexpr int KS_OFF = 0, KROW = 144, VT_OFF = 36864, VROW = 520, KM_OFF = 70144, VTM_OFF = 74752, VMROW = 72, RAWK_OFF = 79872, RAWV_OFF = RAWK_OFF + 32768, LDS_END = RAWV_OFF + 32768;
static_assert(LDS_END <= RING_BYTES, "attention LDS");
DI int crow(int i, int h) { return (i & 3) + 8 * (i >> 2) + 4 * h; }
struct Args { const bf16 *Q, *K, *V, *U, *KM, *VM, *UM; const float* sinks; bf16* O; };
#define MFMA32(a, b, c) __builtin_amdgcn_mfma_f32_32x32x16_bf16((a), (b), (c), 0, 0, 0)
template <int WIN> DI void pool_load(unsigned (&xs)[47], const bf16* U, unsigned urow0, int col) {
    const char* ub = (const char*)U; const unsigned off0 = ((urow0 - (unsigned)(WIN - 1)) * POOLW + (unsigned)col) * 2u;
#pragma unroll
    for (int i = 0; i < 31 + WIN; ++i) xs[i] = *(const unsigned*)(ub + (off0 + (unsigned)i * (POOLW * 2u)));
}
template <int WIN> DI void pool_store(const unsigned (&xs)[47], bf16* OP, unsigned prow0, int col) {
    char* pb = (char*)OP + ((size_t)(((prow0 >> 8) * 24u + (unsigned)(col >> 6)) * 256u + (prow0 & 255u)) * 128u + (unsigned)(col & 63) * 2u);
    float a0 = 0.f, a1 = 0.f; const float invw = 1.0f / (float)WIN;
#pragma unroll
    for (int j = 0; j < WIN - 1; ++j) { a0 += bflo(xs[j]); a1 += bfhi(xs[j]); }
#pragma unroll
    for (int t = 0; t < 32; ++t) { const float x0 = bflo(xs[WIN - 1 + t]), x1 = bfhi(xs[WIN - 1 + t]); a0 += x0; a1 += x1;
        *(unsigned*)(pb + t * 128) = pk2(a0 * invw - x0, a1 * invw - x1);
        a0 -= bflo(xs[t]); a1 -= bfhi(xs[t]); }
}
DI void phase(LAS unsigned char* lds, const Args& A, int c, int G, int tid0) {
    asm volatile("" : "+v"(tid0));
    const int wid = __builtin_amdgcn_readfirstlane(tid0 >> 6);
    constexpr int NUNIT = NB * 64 * NKV;
    if (c >= NUNIT) return;
    bf16x8 qa[4], qb[4];
#define ATT_DECODE(L_, b_, nb_, kh_) const int b_ = (L_) >> 7, nb_ = ((L_) >> 1) & 63, kh_ = (L_) & 1
#define ATT_LOAD_KV(L_) do { ATT_DECODE(L_, b2, nb2, kh2); const size_t rb2 = (size_t)b2 * SEQ; const int s02 = (nb2 - 1) * 128; \
        _Pragma("unroll") for (int pass = 0; pass < 4; ++pass) { const int s = s02 + (tid >> 3) + 64 * pass; \
            kv[pass] = *(const u32x4*)(A.K + (rb2 + (size_t)(s < 0 ? 0 : s)) * KVW + kh2 * 64 + 8 * (tid & 7)); } \
        _Pragma("unroll") for (int pass = 0; pass < 4; ++pass) { const int s = s02 + lane + 64 * pass; \
            vv[pass] = *(const u32x4*)(A.V + (rb2 + (size_t)(s < 0 ? 0 : s)) * KVW + kh2 * 64 + 8 * wid); } } while (0)
#define ATT_DMA_KV(L_) do { ATT_DECODE(L_, b2, nb2, kh2); const size_t rb2 = (size_t)b2 * SEQ; const int s02 = (nb2 - 1) * 128; \
        _Pragma("unroll") for (int pass = 0; pass < 4; ++pass) { const int s = s02 + (tid >> 3) + 64 * pass; const size_t go = (rb2 + (size_t)(s < 0 ? 0 : s)) * KVW + kh2 * 64 + 8 * (tid & 7); \
            __builtin_amdgcn_global_load_lds((const unsigned*)(A.K + go), (LAS unsigned*)(lds + RAWK_OFF + (pass * 512 + wid * 64) * 16), 16, 0, 0); \
            __builtin_amdgcn_global_load_lds((const unsigned*)(A.V + go), (LAS unsigned*)(lds + RAWV_OFF + (pass * 512 + wid * 64) * 16), 16, 0, 0); } } while (0)
#define ATT_RAW_KV() do { _Pragma("unroll") for (int pass = 0; pass < 4; ++pass) { kv[pass] = *(const LAS u32x4*)(lds + RAWK_OFF + (pass * 512 + tid) * 16); \
            vv[pass] = *(const LAS u32x4*)(lds + RAWV_OFF + ((lane + 64 * pass) * 8 + wid) * 16); } } while (0)
#define ATT_LOAD_Q(dst, L_, qs_) do { ATT_DECODE(L_, b2, nb2, kh2); const bf16* qp = A.Q + ((size_t)b2 * SEQ + (size_t)(nb2 * 128 + 32 * (qs_) + r)) * D + (kh2 * QG + wid) * HD + 8 * h; \
        _Pragma("unroll") for (int d0 = 0; d0 < 4; ++d0) dst[d0] = *(const bf16x8*)(qp + 16 * d0); } while (0)
    { const int tid = tid0, lane = tid & 63, r = lane & 31, h = lane >> 5; ATT_LOAD_Q(qa, c, 0); }
    for (int L = c; L < NUNIT; L += G) {
        int tid = tid0; asm volatile("" : "+v"(tid));
        const int lane = tid & 63, r = lane & 31, h = lane >> 5;
        ATT_DECODE(L, b, nb, kh);
        const size_t rowb = (size_t)b * SEQ;
        const int head = kh * QG + wid;
        const bool has_next = (L + G) < NUNIT;
        const float slope2 = __builtin_amdgcn_exp2f(-0.5f * (float)(head + 1)) * LOG2E, sink2 = A.sinks[head] * LOG2E;
        const int pg = 2 * kh + (wid & 1), pcol = 128 * pg + 2 * lane;
        const unsigned prow0 = (unsigned)(b * SEQ + nb * 128 + 32 * (wid >> 1)), urow0 = prow0 + (unsigned)(NMETA * (b + 1));
        unsigned xs[47];
        if (pg == 0) pool_load<2>(xs, A.U, urow0, pcol); else if (pg == 1) pool_load<4>(xs, A.U, urow0, pcol);
        else if (pg == 2) pool_load<8>(xs, A.U, urow0, pcol); else pool_load<16>(xs, A.U, urow0, pcol);
        __builtin_amdgcn_sched_barrier(0);
        u32x4 kv[4], vv[4];
        if (L == c) ATT_LOAD_KV(L); else ATT_RAW_KV();
#pragma unroll
        for (int pass = 0; pass < 4; ++pass) { const int j = (tid >> 3) + 64 * pass, cc = tid & 7; *(LAS u32x4*)(lds + KS_OFF + j * KROW + 16 * cc) = kv[pass]; }
#pragma unroll
        for (int pass = 0; pass < 4; ++pass) { const int j = lane + 64 * pass;
#pragma unroll
            for (int jj = 0; jj < 8; ++jj) { const unsigned w = vv[pass][jj >> 1]; ((LAS unsigned short*)(lds + VT_OFF + (8 * wid + jj) * VROW))[j] = (unsigned short)((jj & 1) ? (w >> 16) : (w & 0xffffu)); } }
        if (L == c) {
            u32x4 kmv = *(const u32x4*)(A.KM + (size_t)((tid >> 3) & (NMETA - 1)) * KVW + kh * 64 + 8 * (tid & 7));
            if (tid >= 8 * NMETA) kmv = (u32x4){0u, 0u, 0u, 0u};
            if (tid < 256) *(LAS u32x4*)(lds + KM_OFF + (tid >> 3) * KROW + 16 * (tid & 7)) = kmv;
            const int d = tid & 63, kg = tid >> 6;
#pragma unroll
            for (int kk = 0; kk < 4; ++kk) { const int key = 4 * kg + kk; unsigned short val = A.VM[(size_t)(key & (NMETA - 1)) * KVW + kh * 64 + d]; if (key >= NMETA) val = 0;
                ((LAS unsigned short*)(lds + VTM_OFF + d * VMROW))[key] = val; }
        }
        __syncthreads();
        if (pg == 0) pool_store<2>(xs, A.O, prow0, pcol); else if (pg == 1) pool_store<4>(xs, A.O, prow0, pcol);
        else if (pg == 2) pool_store<8>(xs, A.O, prow0, pcol); else pool_store<16>(xs, A.O, prow0, pcol);
        __builtin_amdgcn_sched_barrier(0);
        if (has_next) ATT_DMA_KV(L + G);
        __builtin_amdgcn_sched_barrier(0);
        f32x16 Bb;
#pragma unroll
        for (int i = 0; i < 16; ++i) Bb[i] = -slope2 * (float)(128 - crow(i, h) + r);
#define ATT_BB(i) Bb[i]
#pragma unroll
        for (int qs = 0; qs < 4; ++qs) {
            bf16x8 (&qr)[4] = (qs & 1) ? qb : qa;
            if (qs == 0) ATT_LOAD_Q(qb, L, 1); else if (qs == 1) ATT_LOAD_Q(qa, L, 2); else if (qs == 2) ATT_LOAD_Q(qb, L, 3); else if (has_next) ATT_LOAD_Q(qa, L + G, 0);
            __builtin_amdgcn_sched_barrier(0);
            const int qrow = nb * 128 + 32 * qs + r;
            float mx = sink2, lsum = 0.f;
            f32x16 o[2]; o[0] = (f32x16){}; o[1] = (f32x16){};
#define ATT_QK(S_, kt_) do { const LAS unsigned char* kp_ = lds + KS_OFF + (32 * (kt_) + r) * KROW + 16 * h; \
                _Pragma("unroll") for (int d0 = 0; d0 < 4; ++d0) S_ = MFMA32(*(const LAS bf16x8*)(kp_ + 32 * d0), qr[d0], S_); } while (0)
#define ATT_MAX16(S_) fmaxf(fmaxf(fmaxf(fmaxf(S_[0], S_[1]), fmaxf(S_[2], S_[3])), fmaxf(fmaxf(S_[4], S_[5]), fmaxf(S_[6], S_[7]))), fmaxf(fmaxf(fmaxf(S_[8], S_[9]), fmaxf(S_[10], S_[11])), fmaxf(fmaxf(S_[12], S_[13]), fmaxf(S_[14], S_[15]))))
#define ATT_RESCALE(tmax_) do { if ((tmax_) > mx) { const float alpha = __builtin_amdgcn_exp2f(mx - (tmax_)); mx = (tmax_); lsum *= alpha; \
                _Pragma("unroll") for (int i = 0; i < 16; ++i) { o[0][i] *= alpha; o[1][i] *= alpha; } } } while (0)
#define ATT_PV(P_, kt_, s_) do { u32x4 pw; pw.x = pk2(P_[8 * (s_)], P_[8 * (s_) + 1]); pw.y = pk2(P_[8 * (s_) + 2], P_[8 * (s_) + 3]); pw.z = pk2(P_[8 * (s_) + 4], P_[8 * (s_) + 5]); pw.w = pk2(P_[8 * (s_) + 6], P_[8 * (s_) + 7]); \
                const bf16x8 pf = __builtin_bit_cast(bf16x8, pw); \
                _Pragma("unroll") for (int db = 0; db < 2; ++db) { const LAS unsigned char* vp = lds + VT_OFF + (32 * db + r) * VROW + (32 * (kt_) + 16 * (s_) + 4 * h) * 2; \
                    const s16x4 lo = *(const LAS s16x4*)vp, hi = *(const LAS s16x4*)(vp + 16); o[db] = MFMA32(__builtin_shufflevector(lo, hi, 0, 1, 2, 3, 4, 5, 6, 7), pf, o[db]); } } while (0)
#pragma unroll
            for (int tt = 1; tt < 4; ++tt) {
                if (nb == 0 && qs + tt < 4) continue;
                f32x16 S;
#pragma unroll
                for (int i = 0; i < 16; ++i) S[i] = ATT_BB(i);
                ATT_QK(S, qs + tt);
                const float shift = (32.0f * (float)tt) * slope2;
                float tmax = ATT_MAX16(S); tmax = fmaxf(tmax, shx(tmax, 32, lane)) + shift;
                ATT_RESCALE(tmax);
                const float mxs = mx - shift;
#pragma unroll
                for (int i = 0; i < 16; ++i) { const float p = __builtin_amdgcn_exp2f(S[i] - mxs); S[i] = p; lsum += p; }
                ATT_PV(S, qs + tt, 0); ATT_PV(S, qs + tt, 1);
            }
            {
                const bool t0ok = !(nb == 0 && qs < 4);
                f32x16 S0, S4;
#pragma unroll
                for (int i = 0; i < 16; ++i) { S0[i] = ATT_BB(i); S4[i] = ATT_BB(i); }
                if (t0ok) ATT_QK(S0, qs);
                ATT_QK(S4, qs + 4);
                const float sh4 = 128.0f * slope2;
#pragma unroll
                for (int i = 0; i < 16; ++i) { const bool lo_ = crow(i, h) > r; S4[i] = lo_ ? (t0ok ? S0[i] : -1e30f) : S4[i] + sh4; }
                float tmax = ATT_MAX16(S4); tmax = fmaxf(tmax, shx(tmax, 32, lane));
                ATT_RESCALE(tmax);
#pragma unroll
                for (int i = 0; i < 16; ++i) { const float p = __builtin_amdgcn_exp2f(S4[i] - mx); lsum += p; const bool lo_ = crow(i, h) > r; S0[i] = lo_ ? p : 0.f; S4[i] = lo_ ? 0.f : p; }
                if (t0ok) { ATT_PV(S0, qs, 0); ATT_PV(S0, qs, 1); }
                ATT_PV(S4, qs + 4, 0); ATT_PV(S4, qs + 4, 1);
            }
            {
                f32x16 S;
#pragma unroll
                for (int i = 0; i < 16; ++i) S[i] = (i < 8) ? -slope2 * (float)(NMETA - crow(i, h)) : 0.f;
                { const LAS unsigned char* kp_ = lds + KM_OFF + r * KROW + 16 * h;
#pragma unroll
                  for (int d0 = 0; d0 < 4; ++d0) S = MFMA32(*(const LAS bf16x8*)(kp_ + 32 * d0), qr[d0], S); }
                const float shift = -slope2 * (float)qrow;
                float tmax = fmaxf(fmaxf(fmaxf(S[0], S[1]), fmaxf(S[2], S[3])), fmaxf(fmaxf(S[4], S[5]), fmaxf(S[6], S[7])));
                tmax = fmaxf(tmax, shx(tmax, 32, lane)) + shift;
                ATT_RESCALE(tmax);
                const float mxs = mx - shift;
#pragma unroll
                for (int i = 0; i < 8; ++i) { const float p = __builtin_amdgcn_exp2f(S[i] - mxs); S[i] = p; lsum += p; }
                u32x4 pw; pw.x = pk2(S[0], S[1]); pw.y = pk2(S[2], S[3]); pw.z = pk2(S[4], S[5]); pw.w = pk2(S[6], S[7]);
                const bf16x8 pf = __builtin_bit_cast(bf16x8, pw);
#pragma unroll
                for (int db = 0; db < 2; ++db) { const LAS unsigned char* vp = lds + VTM_OFF + (32 * db + r) * VMROW + (4 * h) * 2;
                    const s16x4 lo = *(const LAS s16x4*)vp, hi = *(const LAS s16x4*)(vp + 16); o[db] = MFMA32(__builtin_shufflevector(lo, hi, 0, 1, 2, 3, 4, 5, 6, 7), pf, o[db]); }
            }
#undef ATT_QK
#undef ATT_MAX16
#undef ATT_RESCALE
#undef ATT_PV
            lsum += shx(lsum, 32, lane);
            lsum += __builtin_amdgcn_exp2f(sink2 - mx);
            const float inv = 1.0f / lsum;
            const unsigned orow = (unsigned)rowb + (unsigned)qrow;
            bf16* op = A.O + ((size_t)(((orow >> 8) * 24u + 8u + (unsigned)head) * 256u + (orow & 255u))) * 64;
#pragma unroll
            for (int db = 0; db < 2; ++db)
#pragma unroll
                for (int j = 0; j < 2; ++j) { const int g0 = 2 * j, g1 = 2 * j + 1;
                    const unsigned w0x = pk2(o[db][4 * g0] * inv, o[db][4 * g0 + 1] * inv), w0y = pk2(o[db][4 * g0 + 2] * inv, o[db][4 * g0 + 3] * inv);
                    const unsigned w1x = pk2(o[db][4 * g1] * inv, o[db][4 * g1 + 1] * inv), w1y = pk2(o[db][4 * g1 + 2] * inv, o[db][4 * g1 + 3] * inv);
                    const auto rx = __builtin_amdgcn_permlane32_swap(w1x, w0x, false, false), ry = __builtin_amdgcn_permlane32_swap(w1y, w0y, false, false);
                    u32x4 w; w.x = rx[0]; w.y = ry[0]; w.z = rx[1]; w.w = ry[1];
                    *(u32x4*)(op + 32 * db + 8 * (h ? g0 : g1)) = w; }
        }
        asm volatile("s_waitcnt vmcnt(8)" ::: "memory");
        __syncthreads();
    }
#undef ATT_DECODE
#undef ATT_BB
#undef ATT_LOAD_KV
#undef ATT_DMA_KV
#undef ATT_RAW_KV
#undef ATT_LOAD_Q
}
}
constexpr int NWAVES = 8;
struct Args { const float* in[18]; float* out; unsigned char* ws; int ph_lo, ph_hi; };
struct Frame {
    LAS unsigned char* lds;
    int tid, lane, wave, vcu, G;
    float* out; unsigned char* ws;
};
#define WSP(T, off) ((T*)(F.ws + (off)))
#define METAP(T, off) ((T*)(F.ws + WS_META + (off)))
enum { I_X = 0, I_META, I_NORM_MIX, I_W_IN, I_SINKS, I_W_ATTN_BR, I_W_POOL, I_POOL_SCALE, I_W_OUT, I_NORM_FFN, I_DW_GATE, I_DW_UP, I_DW_DOWN, I_ROUTER, I_MW_GATE, I_MW_UP, I_MW_DOWN, I_NORM_FINAL };

struct TrD { const float* W; unsigned char* WT; const float* kscale; const float* nscale; float scale; int N, ldw, k0, n0, drow0, tiled_nkt, fp8; };
DI void tr_set(TrD& d, const float* W, int N, void* WT, int ldw, int it, const float* kscale, const float* nscale, int tiled_nkt) {
    const int nblk = N / 32, kb = it / nblk, nb = it % nblk;
    d.W = W; d.N = N; d.WT = (unsigned char*)WT; d.ldw = ldw; d.k0 = 64 * kb; d.n0 = 32 * nb; d.drow0 = 32 * nb; d.kscale = kscale; d.nscale = nscale; d.scale = 1.f; d.tiled_nkt = tiled_nkt; d.fp8 = 0;
}
DI void tr_set_gu(TrD& d, const float* W, int N, void* WT, int it, int up, const float* kscale) {
    tr_set(d, W, N, WT, D, it, kscale, nullptr, 0); d.drow0 = (d.n0 / 128) * 256 + up * 128 + (d.n0 % 128);
}
DI void tr_decode(TrD& d, Frame& F, const Args& A, int it) {
    constexpr int I_IN = 16 * (INW / 32), I_SQ = 16 * 32, I_PL = 2 * 8, I_DGU = 16 * (DFF / 32), I_DD = (DFF / 64) * 32, I_MGU = 16 * (DFE / 32), I_MD = (DFE / 64) * 32;
    constexpr int PER_LAYER = I_IN + I_SQ + 4 * I_PL + I_SQ, N_DENSE = 2 * I_DGU + I_DD, PER_EXP = 2 * I_MGU + I_MD;
    int r = it;
    if (r < 2 * PER_LAYER) {
        const int l = r / PER_LAYER; r -= l * PER_LAYER;
        if (r < I_IN) { tr_set(d, A.in[I_W_IN] + (size_t)l * D * INW, INW, WSP(bf16, WS_WIN) + (size_t)l * INW * D, D, r, A.in[I_NORM_MIX] + l * D, nullptr, 0); return; } r -= I_IN;
        if (r < I_SQ) { tr_set(d, A.in[I_W_ATTN_BR] + (size_t)l * D * D, D, WSP(bf16, WS_WA) + (size_t)l * D * MRGK + 128, MRGK, r, nullptr, nullptr, 0); return; } r -= I_SQ;
        if (r < 4 * I_PL) { const int g = r / I_PL; r -= g * I_PL;
            tr_set(d, A.in[I_W_POOL] + ((size_t)l * 4 + g) * 128 * 256, 256, WSP(bf16, WS_WA) + ((size_t)l * D + g * 256) * MRGK, MRGK, r, nullptr, A.in[I_POOL_SCALE] + l * D + g * 256, 0); return; } r -= 4 * I_PL;
        tr_set(d, A.in[I_W_OUT] + (size_t)l * D * D, D, WSP(bf16, WS_WO) + (size_t)l * D * D, D, r, nullptr, nullptr, 0); return;
    }
    r -= 2 * PER_LAYER;
    if (r < N_DENSE) {
        if (r < I_DGU) { tr_set_gu(d, A.in[I_DW_GATE], DFF, WSP(bf16, WS_WGU), r, 0, A.in[I_NORM_FFN]); return; } r -= I_DGU;
        if (r < I_DGU) { tr_set_gu(d, A.in[I_DW_UP], DFF, WSP(bf16, WS_WGU), r, 1, A.in[I_NORM_FFN]); return; } r -= I_DGU;
        tr_set(d, A.in[I_DW_DOWN], D, WSP(bf16, WS_WD), DFF, r, nullptr, nullptr, DFF / 64); return;
    }
    r -= N_DENSE;
    { const int e = r / PER_EXP; r -= e * PER_EXP;
        unsigned char* gu8 = WSP(unsigned char, WS_MGU) + (size_t)e * 2 * DFE * D; unsigned char* dn8 = WSP(unsigned char, WS_MD) + (size_t)e * D * DFE;
        if (r < 2 * I_MGU) { const int up = r >= I_MGU ? 1 : 0; if (up) r -= I_MGU;
            tr_set_gu(d, (up ? A.in[I_MW_UP] : A.in[I_MW_GATE]) + (size_t)e * D * DFE, DFE, gu8, r, up, A.in[I_NORM_FFN] + D); d.scale = W8_GU; d.fp8 = 1; return; }
        r -= 2 * I_MGU;
        tr_set(d, A.in[I_MW_DOWN] + (size_t)e * DFE * D, D, dn8, 0, r, nullptr, nullptr, DFE / 128); d.scale = W8_DN; d.fp8 = 1; }
}
DI void tr_load(const TrD& d, f32x2 (&wv)[16], f32x4 (&ks)[4], f32x2& nraw, int lane) {
    const float* wp = d.W + (unsigned)((d.k0 + (lane >> 4)) * d.N + d.n0 + 2 * (lane & 15));
#pragma unroll
    for (int i = 0; i < 16; ++i) wv[i] = *(const f32x2*)(wp + (unsigned)(4 * i * d.N));
    const bool hk = d.kscale != nullptr, hn = d.nscale != nullptr;
    const float* kp = (hk ? d.kscale + d.k0 : d.W) + (d.fp8 ? 16 * (lane & 3) : 8 * (lane & 7));
#pragma unroll
    for (int q = 0; q < 4; ++q) ks[q] = *(const f32x4*)(kp + ((d.fp8 || q < 2) ? 4 * q : 0));
    nraw = *(const f32x2*)((hn ? d.nscale : d.W) + d.n0 + 2 * (lane & 15));
}
DI void tr_finish(const TrD& d, const f32x2 (&wv)[16], const f32x4 (&ksr)[4], f32x2 nraw, LAS float* scr, int lane) {
    const bool hk = d.kscale != nullptr, hn = d.nscale != nullptr;
    const float ns0 = hn ? nraw[0] * d.scale : d.scale, ns1 = hn ? nraw[1] * d.scale : d.scale;
    f32x4 ks[4];
#pragma unroll
    for (int q = 0; q < 4; ++q) ks[q] = hk ? ksr[q] : (f32x4){1.f, 1.f, 1.f, 1.f};
#pragma unroll
    for (int i = 0; i < 16; ++i) { LAS float* sp = scr + (4 * i + (lane >> 4)) * 33 + 2 * (lane & 15); sp[0] = wv[i][0] * ns0; sp[1] = wv[i][1] * ns1; }
    LDS_WAIT(); asm volatile("" ::: "memory");
    if (d.fp8) {
        const int c = lane & 3;
#pragma unroll
        for (int j = 0; j < 2; ++j) { const int n = (lane + 64 * j) >> 2; const LAS float* s = scr + (16 * c) * 33 + n;
            u32x4 w; w.x = pk4_fp8(s[0 * 33] * ks[0][0], s[1 * 33] * ks[0][1], s[2 * 33] * ks[0][2], s[3 * 33] * ks[0][3]); w.y = pk4_fp8(s[4 * 33] * ks[1][0], s[5 * 33] * ks[1][1], s[6 * 33] * ks[1][2], s[7 * 33] * ks[1][3]);
            w.z = pk4_fp8(s[8 * 33] * ks[2][0], s[9 * 33] * ks[2][1], s[10 * 33] * ks[2][2], s[11 * 33] * ks[2][3]); w.w = pk4_fp8(s[12 * 33] * ks[3][0], s[13 * 33] * ks[3][1], s[14 * 33] * ks[3][2], s[15 * 33] * ks[3][3]);
            const int dr = d.drow0 + n;
            unsigned char* dst = d.tiled_nkt ? d.WT + ((size_t)((dr >> 8) * d.tiled_nkt + (d.k0 >> 7)) * 256 + (dr & 255)) * 128 + (d.k0 & 127) + 16 * c : d.WT + (size_t)dr * d.ldw + d.k0 + 16 * c;
            *(u32x4*)dst = w; }
    } else {
        const int c = lane & 7;
#pragma unroll
        for (int j = 0; j < 4; ++j) { const int n = (lane >> 3) + 8 * j; const LAS float* s = scr + (8 * c) * 33 + n;
            u32x4 o; o.x = pk2(s[0 * 33] * ks[0][0], s[1 * 33] * ks[0][1]); o.y = pk2(s[2 * 33] * ks[0][2], s[3 * 33] * ks[0][3]); o.z = pk2(s[4 * 33] * ks[1][0], s[5 * 33] * ks[1][1]); o.w = pk2(s[6 * 33] * ks[1][2], s[7 * 33] * ks[1][3]);
            const int dr = d.drow0 + n;
            bf16* dst = d.tiled_nkt ? (bf16*)d.WT + ((size_t)((dr >> 8) * d.tiled_nkt + (d.k0 >> 6)) * 256 + (dr & 255)) * 64 + 8 * c : (bf16*)d.WT + (size_t)dr * d.ldw + d.k0 + 8 * c;
            *(u32x4*)dst = o; }
    }
    LDS_WAIT(); asm volatile("" ::: "memory");
}
DI void p0_prologue(Frame& F, const Args& A) {
    LAS float* scr = (LAS float*)(F.lds + RING_OFF + F.wave * 16384);
    const int gw = F.vcu * NWAVES + F.wave, NGW = F.G * NWAVES, lane = F.lane;
    constexpr int NITEMS = 2 * (16 * (INW / 32) + 16 * 32 + 4 * 2 * 8 + 16 * 32) + (2 * 16 * (DFF / 32) + (DFF / 64) * 32) + NE * (2 * 16 * (DFE / 32) + (DFE / 64) * 32);
    if (gw < NITEMS) {
        TrD dA, dB; f32x2 wA[16], wB[16]; f32x4 kA[4], kB[4]; f32x2 nA, nB;
        int it = gw;
        tr_decode(dA, F, A, it); tr_load(dA, wA, kA, nA, lane);
#define TR_TOUCH(wc, kc, nc) { _Pragma("unroll") for (int i_ = 0; i_ < 16; ++i_) asm volatile("" : "+v"(wc[i_])); _Pragma("unroll") for (int q_ = 0; q_ < 4; ++q_) asm volatile("" : "+v"(kc[q_])); asm volatile("" : "+v"(nc)); }
#define TR_STEP(dc, wc, kc, nc, dn, wn, kn, nn) { const int itn = it + NGW; const bool more = itn < NITEMS; tr_decode(dn, F, A, more ? itn : it); tr_load(dn, wn, kn, nn, lane); __builtin_amdgcn_sched_barrier(0); TR_TOUCH(wc, kc, nc) tr_finish(dc, wc, kc, nc, scr, lane); __builtin_amdgcn_sched_barrier(0); if (!more) break; it = itn; }
        for (;;) { TR_STEP(dA, wA, kA, nA, dB, wB, kB, nB) TR_STEP(dB, wB, kB, nB, dA, wA, kA, nA) }
#undef TR_STEP
#undef TR_TOUCH
    }
    const float* x = A.in[I_X]; bf16* HB = WSP(bf16, WS_HB); float* ssq = WSP(float, WS_SSQ);
    if (gw * 4 < M) {
        f32x4 va[4][4], vb[4][4];
        int m0 = gw * 4;
#define X_LOAD(v, mm) { _Pragma("unroll") for (int q = 0; q < 4; ++q) _Pragma("unroll") for (int j = 0; j < 4; ++j) v[q][j] = *((const f32x4*)(x + (size_t)((mm) + q) * D) + lane + 64 * j); }
#define X_STEP(v, vn) { const int mn = m0 + NGW * 4; const bool more = mn < M; X_LOAD(vn, more ? mn : m0) __builtin_amdgcn_sched_barrier(0); \
            _Pragma("unroll") for (int q = 0; q < 4; ++q) { float s = 0.f; u32x2* o8 = (u32x2*)(HB + (size_t)(m0 + q) * D) + lane; \
                _Pragma("unroll") for (int j = 0; j < 4; ++j) { s += (v[q][j][0] * v[q][j][0] + v[q][j][1] * v[q][j][1]) + (v[q][j][2] * v[q][j][2] + v[q][j][3] * v[q][j][3]); u32x2 w; w.x = pk2(v[q][j][0], v[q][j][1]); w.y = pk2(v[q][j][2], v[q][j][3]); o8[64 * j] = w; } \
                s = wave_sum(s, lane); \
                if (lane < 16) ssq[(size_t)(m0 + q) * 16 + lane] = lane == 0 ? s : 0.f; } \
            if (!more) break; m0 = mn; }
        X_LOAD(va, m0)
        for (;;) { X_STEP(va, vb) X_STEP(vb, va) }
#undef X_LOAD
#undef X_STEP
    }
    for (int m = gw; m < NMETA; m += NGW) {
        const f32x4* xr = (const f32x4*)(A.in[I_META] + (size_t)m * D) + lane; f32x4* ho = (f32x4*)(METAP(float, MO_HM) + (size_t)m * D) + lane; u32x2* o8 = (u32x2*)(METAP(bf16, MO_XM) + (size_t)m * D) + lane;
#pragma unroll
        for (int j = 0; j < 4; ++j) { const f32x4 v = xr[64 * j]; ho[64 * j] = v; u32x2 w; w.x = pk2(v[0], v[1]); w.y = pk2(v[2], v[3]); o8[64 * j] = w; }
    }
}

namespace meta {
DI f32x4 tile(const bf16* X, int ldx, const bf16* Wt, int ldw, int K, int lane) {
    const int i = lane & 15, q = lane >> 4; f32x4 acc = (f32x4){0.f, 0.f, 0.f, 0.f};
    const bf16* xp = X + (size_t)i * ldx + 8 * q; const bf16* wp = Wt + (size_t)i * ldw + 8 * q;
    for (int k0 = 0; k0 < K; k0 += 32) acc = __builtin_amdgcn_mfma_f32_16x16x32_bf16(*(const bf16x8*)(wp + k0), *(const bf16x8*)(xp + k0), acc, 0, 0, 0);
    return acc;
}
template <int NST, bool SSQ, int TILED_NKT = 0> DI f32x4 tile_split(const bf16* X, int ldx, const bf16* Wt, int ldw, int wave, int lane, LAS float* scr, float& ssq) {
    const int i = lane & 15, q = lane >> 4, ks = 32 * NST;
    const bf16* xp = X + (size_t)i * ldx + wave * ks + 8 * q; const bf16* wp = Wt + (size_t)i * ldw + wave * ks + 8 * q;
    bf16x8 a[NST], b[NST];
#pragma unroll
    for (int s = 0; s < NST; ++s) { const int kk = wave * ks + 32 * s + 8 * q, wr_ = ldw + i;
        a[s] = TILED_NKT ? *(const bf16x8*)(Wt + ((size_t)((wr_ >> 8) * TILED_NKT + (kk >> 6)) * 256 + (wr_ & 255)) * 64 + (kk & 63)) : *(const bf16x8*)(wp + 32 * s);
        b[s] = *(const bf16x8*)(xp + 32 * s); }
    f32x4 acc = (f32x4){0.f, 0.f, 0.f, 0.f}; float sq = 0.f;
#pragma unroll
    for (int s = 0; s < NST; ++s) { acc = __builtin_amdgcn_mfma_f32_16x16x32_bf16(a[s], b[s], acc, 0, 0, 0);
        if (SSQ) {
#pragma unroll
            for (int j = 0; j < 8; ++j) { const float x = bf2f((unsigned short)b[s][j]); sq += x * x; } } }
    __syncthreads();
    *(LAS f32x4*)(scr + (wave * 64 + lane) * 4) = acc;
    if (SSQ) { sq += shx(sq, 16, lane); sq += shx(sq, 32, lane); if (q == 0) scr[2048 + wave * 16 + i] = sq; }
    __syncthreads();
    f32x4 r = (f32x4){0.f, 0.f, 0.f, 0.f}; float t = 0.f;
#pragma unroll
    for (int w = 0; w < 8; ++w) { r += *(const LAS f32x4*)(scr + (w * 64 + lane) * 4); if (SSQ) t += scr[2048 + w * 16 + i]; }
    ssq = t; return r;
}
DI void inproj(Frame& F, LAS float* scr, int l, int col0) {
    const int lane = F.lane, i = lane & 15, q = lane >> 4; float ss;
    const f32x4 a = tile_split<4, true>(METAP(bf16, MO_XM), D, WSP(bf16, WS_WIN) + ((size_t)l * INW + col0) * D, D, F.wave, lane, scr, ss);
    if (F.wave != 0) return;
    const float rs = __builtin_amdgcn_rsqf(ss * (1.0f / D) + RMS_EPS);
    float* pr = METAP(float, MO_PROJ) + (size_t)i * INW + col0 + 4 * q;
#pragma unroll
    for (int j = 0; j < 4; ++j) { float v = a[j] * rs; const int c = col0 + 4 * q + j;
        if (c < D) v *= QSCALE; else if (c >= 1792) v = fast_sigmoid(v);
        pr[j] = v;
        if (c >= 1024 && c < 1152) METAP(bf16, MO_KM)[((size_t)l * NMETA + i) * KVW + (c - 1024)] = (bf16)f2bf(v);
        else if (c >= 1152 && c < 1280) METAP(bf16, MO_VM)[((size_t)l * NMETA + i) * KVW + (c - 1152)] = (bf16)f2bf(v);
        else if (c >= 1280 && c < 1792) { const bf16 ub = (bf16)f2bf(v);
#pragma unroll
            for (int b = 0; b < NB; ++b) WSP(bf16, WS_U)[((size_t)b * USEQ + i) * POOLW + (c - 1280)] = ub; } }
}
DI void attn_head(Frame& F, const Args& A, int l, int head) {
    const float* pr = METAP(float, MO_PROJ); const int t = F.tid, i = t >> 5, dl = t & 31, kvh = head / QG;
    const float slope2 = __builtin_amdgcn_exp2f(-0.5f * (float)(head + 1)) * LOG2E, sink2 = A.in[I_SINKS][l * NH + head] * LOG2E;
    const float q0 = pr[(size_t)i * INW + head * HD + dl], q1 = pr[(size_t)i * INW + head * HD + dl + 32];
    float k0[NMETA], k1[NMETA], v0[NMETA], v1[NMETA];
#pragma unroll
    for (int j = 0; j < NMETA; ++j) { const float* kp = pr + (size_t)j * INW + 1024 + kvh * HD + dl; k0[j] = kp[0]; k1[j] = kp[32]; v0[j] = kp[128]; v1[j] = kp[160]; }
    float lg[NMETA]; float mx = sink2;
#pragma unroll
    for (int j = 0; j < NMETA; ++j) { float s = q0 * k0[j] + q1 * k1[j];
#pragma unroll
        for (int o = 1; o < 32; o <<= 1) s += shx(s, o, F.lane);
        s = (j <= i) ? s - slope2 * (float)(i - j) : -1e30f; lg[j] = s; mx = fmaxf(mx, s); }
    float lsum = __builtin_amdgcn_exp2f(sink2 - mx), o0 = 0.f, o1 = 0.f;
#pragma unroll
    for (int j = 0; j < NMETA; ++j) { const float p = __builtin_amdgcn_exp2f(lg[j] - mx); lsum += p; o0 += p * v0[j]; o1 += p * v1[j]; }
    const float inv = 1.0f / lsum;
    bf16* op = METAP(bf16, MO_ATT) + (size_t)i * D + head * HD + dl;
    op[0] = (bf16)f2bf(o0 * inv); op[32] = (bf16)f2bf(o1 * inv);
}
DI void pool_rows(Frame& F) {
    const float* pr = METAP(float, MO_PROJ); const int col = F.tid, g = col >> 7, win = 2 << g;
    float u[NMETA];
#pragma unroll
    for (int tt = 0; tt < NMETA; ++tt) u[tt] = pr[(size_t)tt * INW + 1280 + col];
#pragma unroll
    for (int tt = 0; tt < NMETA; ++tt) { float s = 0.f; int cnt = 0;
#pragma unroll
        for (int j = 0; j < NMETA; ++j) if (j <= tt && j < win) { s += u[tt - j]; ++cnt; }
        METAP(bf16, MO_POOL)[(size_t)tt * POOLW + col] = (bf16)f2bf(s / (float)cnt - u[tt]); }
}
DI void merge(Frame& F, LAS float* scr, int l, int col0) {
    const int lane = F.lane, i = lane & 15, q = lane >> 4, g = col0 >> 8; float dummy;
    const f32x4 a = tile_split<4, false>(METAP(bf16, MO_ATT), D, WSP(bf16, WS_WA) + ((size_t)l * D + col0) * MRGK + 128, MRGK, F.wave, lane, scr, dummy);
    if (F.wave != 0) return;
    const f32x4 p = tile(METAP(bf16, MO_POOL) + g * 128, POOLW, WSP(bf16, WS_WA) + ((size_t)l * D + col0) * MRGK, MRGK, 128, lane);
    const float* pr = METAP(float, MO_PROJ) + (size_t)i * INW;
#pragma unroll
    for (int j = 0; j < 4; ++j) { const int c = col0 + 4 * q + j; METAP(bf16, MO_MRG)[(size_t)i * D + c] = (bf16)f2bf(pr[1792 + c] * a[j] + pr[2816 + c] * p[j]); }
}
DI void resid(Frame& F, const f32x4 o, int col0) {
    const int lane = F.lane, i = lane & 15, q = lane >> 4;
    float* hp = METAP(float, MO_HM) + (size_t)i * D + col0 + 4 * q; const f32x4 h = *(const f32x4*)hp + o; *(f32x4*)hp = h;
    u32x2 w; w.x = pk2(h[0], h[1]); w.y = pk2(h[2], h[3]); *(u32x2*)(METAP(bf16, MO_XM) + (size_t)i * D + col0 + 4 * q) = w;
}
DI void outproj(Frame& F, LAS float* scr, int l, int col0) { float dummy;
    const f32x4 o = tile_split<4, false>(METAP(bf16, MO_MRG), D, WSP(bf16, WS_WO) + ((size_t)l * D + col0) * D, D, F.wave, F.lane, scr, dummy);
    if (F.wave == 0) resid(F, o, col0); }
DI void gu(Frame& F, LAS float* scr, int n0) {
    const int lane = F.lane, i = lane & 15, q = lane >> 4; float ss, dummy;
    const bf16* wg = WSP(bf16, WS_WGU) + (size_t)((n0 / 128) * 256 + (n0 % 128)) * D;
    const f32x4 ga = tile_split<4, true>(METAP(bf16, MO_XM), D, wg, D, F.wave, lane, scr, ss);
    const f32x4 ua = tile_split<4, false>(METAP(bf16, MO_XM), D, wg + (size_t)128 * D, D, F.wave, lane, scr, dummy);
    if (F.wave != 0) return;
    const float rs = __builtin_amdgcn_rsqf(ss * (1.0f / D) + RMS_EPS);
    f32x4 o;
#pragma unroll
    for (int j = 0; j < 4; ++j) { const float gg = ga[j] * rs; o[j] = gg * fast_sigmoid(gg) * (ua[j] * rs); }
    u32x2 w; w.x = pk2(o[0], o[1]); w.y = pk2(o[2], o[3]); *(u32x2*)(METAP(bf16, MO_ACT) + (size_t)i * DFF + n0 + 4 * q) = w;
}
DI void down(Frame& F, LAS float* scr, int col0) { float dummy;
    const f32x4 o = tile_split<DFF / 256, false, DFF / 64>(METAP(bf16, MO_ACT), DFF, WSP(bf16, WS_WD), col0, F.wave, F.lane, scr, dummy);
    if (F.wave == 0) resid(F, o, col0); }
}
DI void moe_route(Frame& F, const Args& A) {
    LAS unsigned char* rwb = F.lds + RING_OFF;
    LAS unsigned* hist = (LAS unsigned*)(F.lds + XTRA_OFF);
    const float* router = A.in[I_ROUTER]; const float* gain = A.in[I_NORM_FFN] + D;
    for (int it = F.tid; it < 32 * 64; it += NWAVES * 64) {
        const int m = it >> 6, l = it & 63, r = l & 15, q = l >> 4, e = (r & 3) + 4 * ((r >> 2) & 1), lo = r >> 3, k0 = 64 * (m >> 1) + 16 * q + 8 * (m & 1);
        unsigned w[4];
#pragma unroll
        for (int p = 0; p < 4; ++p) {
            float x0 = router[(k0 + 2 * p) * NE + e] * gain[k0 + 2 * p], x1 = router[(k0 + 2 * p + 1) * NE + e] * gain[k0 + 2 * p + 1];
            if (lo) { const unsigned hh = pk2(x0, x1); x0 -= bflo(hh); x1 -= bfhi(hh); }
            w[p] = pk2(x0, x1); }
        *(LAS u32x4*)(rwb + m * 1024 + ((r * 64 + q * 16) ^ ((r & 8) ? 32 : 0))) = (u32x4){w[0], w[1], w[2], w[3]};
    }
    unsigned char* hb8 = WSP(unsigned char, WS_POOLED);
    const bf16* h = WSP(bf16, WS_HB); float* ssq = WSP(float, WS_SSQ); unsigned* toke = WSP(unsigned, WS_TOKE); float* tokw = WSP(float, WS_TOKW); unsigned* wgcnt = WSP(unsigned, WS_WGCNT);
    const int lane = F.lane, i = lane & 15, q = lane >> 4;
    const int boff = (i * 64 + q * 16) ^ ((i & 8) ? 32 : 0);
    for (int tile = F.vcu; tile < M / 256; tile += F.G) {
        if (F.tid < 16) hist[F.tid] = 0u;
        __syncthreads();
        const int tok0 = tile * 256 + F.wave * 32 + i;
        u32x4 ba[4][2], bb[4][2];
        f32x4 acc = (f32x4){0.f, 0.f, 0.f, 0.f}; float s = 0.f;
#define RT_LOAD(buf, c) { const bf16* hp_ = h + (size_t)(tok0 + 16 * ((c) >> 2)) * D + 256 * ((c) & 3) + 16 * q; \
            _Pragma("unroll") for (int u = 0; u < 4; ++u) { buf[u][0] = *(const u32x4*)(hp_ + 64 * u); buf[u][1] = *(const u32x4*)(hp_ + 64 * u + 8); } }
#define RT_PROC(buf, c) { unsigned char* o8_ = hb8 + (size_t)(tok0 + 16 * ((c) >> 2)) * D + 256 * ((c) & 3) + 16 * q; \
            _Pragma("unroll") for (int u = 0; u < 4; ++u) { unsigned o_[4]; \
                _Pragma("unroll") for (int hh = 0; hh < 2; ++hh) { const u32x4 a_ = buf[u][hh]; \
                    const bf16x8 wf_ = *(const LAS bf16x8*)(rwb + (2 * (4 * ((c) & 3) + u) + hh) * 1024 + boff); \
                    acc = __builtin_amdgcn_mfma_f32_16x16x32_bf16(wf_, __builtin_bit_cast(bf16x8, a_), acc, 0, 0, 0); \
                    const float f0 = bflo(a_[0]), f1 = bfhi(a_[0]), f2 = bflo(a_[1]), f3 = bfhi(a_[1]), f4 = bflo(a_[2]), f5 = bfhi(a_[2]), f6 = bflo(a_[3]), f7 = bfhi(a_[3]); \
                    s += ((f0 * f0 + f1 * f1) + (f2 * f2 + f3 * f3)) + ((f4 * f4 + f5 * f5) + (f6 * f6 + f7 * f7)); \
                    o_[2 * hh] = pk4_fp8(f0, f1, f2, f3); o_[2 * hh + 1] = pk4_fp8(f4, f5, f6, f7); } \
                *(u32x4*)(o8_ + 64 * u) = (u32x4){o_[0], o_[1], o_[2], o_[3]}; } }
        RT_LOAD(ba, 0)
        for (int c = 0; c < 8; c += 2) {
            RT_LOAD(bb, c + 1) __builtin_amdgcn_sched_barrier(0);
            RT_PROC(ba, c)
            RT_LOAD(ba, c + 2 < 8 ? c + 2 : c + 1) __builtin_amdgcn_sched_barrier(0);
            RT_PROC(bb, c + 1)
            if (c & 2) {
                const int tok = tok0 + 16 * (c >> 2);
                f32x4 x;
#pragma unroll
                for (int j = 0; j < 4; ++j) x[j] = acc[j] + shx(acc[j], 32, lane);
                s += shx(s, 16, lane); s += shx(s, 32, lane);
                int i1 = 0; float v1 = x[0];
#pragma unroll
                for (int j = 1; j < 4; ++j) if (x[j] > v1) { v1 = x[j]; i1 = j; }
                int i2 = -1; float v2 = -INFINITY;
#pragma unroll
                for (int j = 0; j < 4; ++j) if (j != i1 && x[j] > v2) { v2 = x[j]; i2 = j; }
                i1 += 4 * (q & 1); i2 += 4 * (q & 1);
                const float pv1 = shx(v1, 16, lane), pv2 = shx(v2, 16, lane);
                const int pi = __builtin_amdgcn_ds_bpermute((lane ^ 16) << 2, i1 | (i2 << 8)), pi1 = pi & 255, pi2 = pi >> 8;
                const bool mine = v1 > pv1 || (v1 == pv1 && i1 < pi1);
                const int e0 = mine ? i1 : pi1; const float t0 = mine ? v1 : pv1;
                const float ca = mine ? v2 : v1, cb = mine ? pv1 : pv2; const int cia = mine ? i2 : i1, cib = mine ? pi1 : pi2;
                const bool m2 = ca > cb || (ca == cb && cia < cib);
                const int e1 = m2 ? cia : cib; const float t1 = m2 ? ca : cb;
                const float rs = __builtin_amdgcn_rsqf(s * (1.0f / D) + RMS_EPS);
                const float w1 = 1.0f / (1.0f + __expf((t0 - t1) * rs)), w0 = 1.0f - w1;
                *(f32x4*)(ssq + (size_t)tok * 16 + 4 * q) = (f32x4){q == 0 ? s : 0.f, 0.f, 0.f, 0.f};
                if (q == 0) { toke[tok] = (unsigned)e0 | ((unsigned)e1 << 8); *(f32x2*)(tokw + 2 * tok) = (f32x2){w0, w1};
                    __hip_atomic_fetch_add((unsigned*)&hist[e0], 1u, __ATOMIC_RELAXED, __HIP_MEMORY_SCOPE_WORKGROUP); __hip_atomic_fetch_add((unsigned*)&hist[8 + e1], 1u, __ATOMIC_RELAXED, __HIP_MEMORY_SCOPE_WORKGROUP); }
                acc = (f32x4){0.f, 0.f, 0.f, 0.f}; s = 0.f;
            }
        }
#undef RT_LOAD
#undef RT_PROC
        __syncthreads();
        if (F.tid < 16) wgcnt[tile * 16 + F.tid] = hist[F.tid];
        __syncthreads();
    }
}
DI void moe_slots(Frame& F) {
    LAS unsigned* cnt = (LAS unsigned*)(F.lds + RING_OFF);
    LAS unsigned* tot = cnt + 4096;
    LAS unsigned* seg = tot + 16;
    LAS unsigned* pre = seg + 16;
    LAS unsigned char* es = (LAS unsigned char*)(pre + 16);
    const unsigned* wgcnt = WSP(unsigned, WS_WGCNT); const unsigned* toke = WSP(unsigned, WS_TOKE); const float* tokw = WSP(float, WS_TOKW);
    int* slot_tok = WSP(int, WS_SLOTTOK); float* slot_w = WSP(float, WS_SLOTW); float* slot_rs = WSP(float, WS_SLOTRS); const float* ssq = WSP(float, WS_SSQ); int* tab = WSP(int, WS_MOETAB);
    for (int i = F.tid; i < 4096; i += NWAVES * 64) cnt[i] = wgcnt[i];
    __syncthreads();
    { const int col = F.tid >> 5, pp = F.tid & 31; unsigned s = 0;
#pragma unroll
      for (int j = 0; j < 8; ++j) s += cnt[(pp * 8 + j) * 16 + col];
#pragma unroll
      for (int o = 1; o < 32; o <<= 1) s += (unsigned)__builtin_amdgcn_ds_bpermute((F.lane ^ o) << 2, (int)s);
      if (pp == 0) tot[col] = s; }
    __syncthreads();
    if (F.tid < 16) { const int k = F.tid >> 3, e = F.tid & 7; unsigned s = 0; for (int e2 = 0; e2 < e; ++e2) s += (tot[k * 8 + e2] + 255u) & ~255u; seg[F.tid] = s; }
    __syncthreads();
    if (F.vcu == 0) {
        if (F.tid < 16) tab[F.tid] = (int)seg[F.tid];
        if (F.tid < 2) { unsigned s = 0; for (int e = 0; e < NE; ++e) s += (tot[F.tid * 8 + e] + 255u) >> 8; tab[16 + F.tid] = (int)s; }
        for (int i = F.tid; i < 2 * MAXTILES; i += NWAVES * 64) { const int k = i / MAXTILES, t = i % MAXTILES; int e = NE - 1;
            for (int e2 = NE - 1; e2 >= 0; --e2) if ((unsigned)(t * 256) < seg[k * 8 + e2] + ((tot[k * 8 + e2] + 255u) & ~255u)) e = e2;
            tab[32 + i] = e; }
    }
    for (int sgi = F.vcu; sgi < 16; sgi += F.G) { const int k = sgi >> 3; const unsigned b0 = seg[sgi] + tot[sgi], b1 = seg[sgi] + ((tot[sgi] + 255u) & ~255u);
        for (unsigned p = b0 + F.tid; p < b1; p += NWAVES * 64) { slot_tok[k * NSLOT + p] = -1; slot_w[k * NSLOT + p] = 0.f; slot_rs[k * NSLOT + p] = 0.f; } }
    for (int tile = F.vcu; tile < M / 256; tile += F.G) {
        __syncthreads();
        { const int col = F.tid >> 5, pp = F.tid & 31; unsigned s = 0;
#pragma unroll
          for (int j = 0; j < 8; ++j) { const int t = pp * 8 + j; s += t < tile ? cnt[t * 16 + col] : 0u; }
#pragma unroll
          for (int o = 1; o < 32; o <<= 1) s += (unsigned)__builtin_amdgcn_ds_bpermute((F.lane ^ o) << 2, (int)s);
          if (pp == 0) pre[col] = s; }
        unsigned ee = 0u;
        if (F.tid < 256) ee = toke[tile * 256 + F.tid];
        LAS unsigned* wcnt = (LAS unsigned*)es;
        unsigned rk[2] = {0u, 0u};
        if (F.tid < 256) {
#pragma unroll
            for (int k = 0; k < 2; ++k) { const unsigned e = (ee >> (8 * k)) & 0xffu;
#pragma unroll
                for (int ex = 0; ex < NE; ++ex) { const unsigned long long b = __ballot(e == (unsigned)ex);
                    if (e == (unsigned)ex) rk[k] = (unsigned)__builtin_popcountll(b & ((1ull << F.lane) - 1ull));
                    if (F.lane == 0) wcnt[F.wave * 16 + k * 8 + ex] = (unsigned)__builtin_popcountll(b); } }
        }
        __syncthreads();
        if (F.tid < 256) {
            const int tok = tile * 256 + F.tid; const float rs = __builtin_amdgcn_rsqf(ssq[(size_t)tok * 16] * (1.0f / D) + RMS_EPS);
#pragma unroll
            for (int k = 0; k < 2; ++k) { const unsigned e = (ee >> (8 * k)) & 0xffu; unsigned rank = rk[k];
                for (int w = 0; w < F.wave; ++w) rank += wcnt[w * 16 + k * 8 + e];
                const unsigned p = seg[k * 8 + e] + pre[k * 8 + e] + rank; slot_tok[k * NSLOT + p] = tok; slot_w[k * NSLOT + p] = tokw[2 * tok + k]; slot_rs[k * NSLOT + p] = rs; }
        }
    }
    __syncthreads();
}
DI void moe_fix(Frame& F, int k, int ntail) {
    const int gw = F.vcu * NWAVES + F.wave, NGW = F.G * NWAVES, lane = F.lane;
    const int* slot_tok = WSP(int, WS_SLOTTOK) + k * NSLOT; const float* slot_w = WSP(float, WS_SLOTW) + k * NSLOT; const float* slab = WSP(float, WS_SLAB);
    const bf16* SRC = k == 0 ? WSP(bf16, WS_HB) : (const bf16*)F.out; bf16* DST = k == 0 ? (bf16*)F.out : WSP(bf16, WS_HB);
    for (int r = gw; r < ntail * 256; r += NGW) {
        const int tok = slot_tok[r]; if (tok < 0) continue;
        const float w = slot_w[r] * (1.0f / W8_DN); const int tile = r >> 8, row = r & 255;
#pragma unroll
        for (int j = 0; j < 4; ++j) {
            f32x4 s = (f32x4){0.f, 0.f, 0.f, 0.f};
#pragma unroll
            for (int kq = 0; kq < pg8::NQ; ++kq) s += *((const f32x4*)(slab + ((size_t)(tile * pg8::NQ + kq) * 256 + row) * D) + lane + 64 * j);
            const u32x2 h = *((const u32x2*)(SRC + (size_t)tok * D) + lane + 64 * j);
            u32x2 o; o.x = pk2(bflo(h.x) + w * s[0], bfhi(h.x) + w * s[1]); o.y = pk2(bflo(h.y) + w * s[2], bfhi(h.y) + w * s[3]);
            *((u32x2*)(DST + (size_t)tok * D) + lane + 64 * j) = o;
        }
    }
}
DI void final_norm(Frame& F, const Args& A) {
    const int gw = F.vcu * NWAVES + F.wave, NGW = F.G * NWAVES, lane = F.lane; const float* gain = A.in[I_NORM_FINAL]; const bf16* HB = WSP(bf16, WS_HB);
    f32x4 gv[4];
#pragma unroll
    for (int j = 0; j < 4; ++j) gv[j] = *((const f32x4*)gain + lane + 64 * j);
    for (int m0 = gw * 4; m0 < M; m0 += NGW * 4) {
        u32x2 q[4][4];
#pragma unroll
        for (int t = 0; t < 4; ++t)
#pragma unroll
            for (int j = 0; j < 4; ++j) q[t][j] = *((const u32x2*)(HB + (size_t)(m0 + t) * D) + lane + 64 * j);
#pragma unroll
        for (int t = 0; t < 4; ++t) { f32x4 v[4]; float s = 0.f; f32x4* xr = (f32x4*)(F.out + (size_t)(m0 + t) * D) + lane;
#pragma unroll
            for (int j = 0; j < 4; ++j) { v[j] = (f32x4){bflo(q[t][j].x), bfhi(q[t][j].x), bflo(q[t][j].y), bfhi(q[t][j].y)}; s += (v[j][0] * v[j][0] + v[j][1] * v[j][1]) + (v[j][2] * v[j][2] + v[j][3] * v[j][3]); }
            const float rs = __builtin_amdgcn_rsqf(wave_sum(s, lane) * (1.0f / D) + RMS_EPS);
#pragma unroll
            for (int j = 0; j < 4; ++j) xr[64 * j] = v[j] * rs * gv[j]; }
    }
}
#ifndef MK_PER_PHASE
#define MK_PER_PHASE 0
#endif
constexpr int NPHASES = 19;

DI void attn_phase(Frame& F, const Args& args, int l) {
    att::Args A{WSP(bf16, WS_Q), WSP(bf16, WS_K), WSP(bf16, WS_V), WSP(bf16, WS_U), METAP(bf16, MO_KM) + (size_t)l * NMETA * KVW, METAP(bf16, MO_VM) + (size_t)l * NMETA * KVW,
                METAP(bf16, MO_UM) + (size_t)l * NMETA * POOLW, args.in[I_SINKS] + l * NH, (bf16*)F.out};
    att::phase(F.lds + RING_OFF, A, F.vcu, F.G, F.tid);
}

__global__ void __launch_bounds__(NWAVES * 64, 2) fwd(Args args) {
    extern __shared__ __attribute__((aligned(16))) unsigned char lds[];
    Frame F;
    F.lds = (LAS unsigned char*)lds;
    F.tid = threadIdx.x; F.lane = F.tid & 63; F.wave = __builtin_amdgcn_readfirstlane(F.tid >> 6);
    const int wave0 = F.wave;
    F.G = gridDim.x; { const int bx = blockIdx.x; F.vcu = (F.G % 8 == 0) ? (bx % 8) * (F.G / 8) + bx / 8 : bx; }
    F.out = args.out; F.ws = args.ws;
    for (int u = F.tid; u < (LDS_BYTES - LDSCTL_OFF) / 4; u += NWAVES * 64) ((LAS unsigned*)(F.lds + LDSCTL_OFF))[u] = 0u;
    __syncthreads();
    gu32* ctl = (gu32*)(F.ws + WS_CTL);
    XcdBarrier bar; bar.bar = (unsigned*)(ctl + CW_BAR); bar.x = 0; bar.st = nullptr;
    if (!MK_PER_PHASE) bar = xcd_barrier_post((unsigned*)(ctl + CW_BAR), (volatile LAS unsigned*)(F.lds + MISC_OFF) + 8, F.tid);
    const int lo = args.ph_lo, hi = args.ph_hi;
#ifdef PROBE_MASK
    unsigned long long pacc = 0, pt0 = __builtin_amdgcn_s_memrealtime();
#define PROBE_SEAM(k) do { const unsigned long long t_ = __builtin_amdgcn_s_memrealtime(); if ((PROBE_MASK >> (k)) & 1) pacc += t_ - pt0; pt0 = t_; } while (0)
#ifdef PROBE_CLK
    unsigned long long cacc = 0, ct0 = __builtin_amdgcn_s_memtime();
#undef PROBE_SEAM
#define PROBE_SEAM(k) do { const unsigned long long t_ = __builtin_amdgcn_s_memrealtime(), c_ = __builtin_amdgcn_s_memtime(); if ((PROBE_MASK >> (k)) & 1) { pacc += t_ - pt0; cacc += c_ - ct0; } pt0 = t_; ct0 = c_; } while (0)
#endif
#ifdef PROBE_EPI
#undef PROBE_SEAM
#define PROBE_SEAM(k) do { if (threadIdx.x == 0) ((volatile LAS unsigned*)(F.lds + MISC_OFF))[32] = (PROBE_MASK >> ((k) + 1)) & 1; __syncthreads(); } while (0)
#endif
#else
#define PROBE_SEAM(k) do { } while (0)
#endif
#define IN(k) (lo <= (k) && (k) < hi)
#define SEAM(k) do { if (IN(k) && IN((k) + 1)) xcd_barrier(bar, (wave0 << 6) | hw_lane()); PROBE_SEAM(k); } while (0)
#define LAUNDER() do { GLOBAL_AS unsigned char* ws_g = (GLOBAL_AS unsigned char*)args.ws; GLOBAL_AS float* out_g = (GLOBAL_AS float*)args.out; F.tid = (wave0 << 6) | hw_lane(); asm volatile("" : "+s"(ws_g), "+s"(out_g), "+v"(F.tid)); F.ws = (unsigned char*)ws_g; F.out = (float*)out_g; F.lane = F.tid & 63; F.wave = __builtin_amdgcn_readfirstlane(F.tid >> 6); ssq = WSP(float, WS_SSQ); } while (0)
#define META_TASK(n, call) do { LAS float* mscr = (LAS float*)(F.lds + RING_OFF); for (int task = F.vcu; task < (n); task += F.G) { call; } __syncthreads(); } while (0)

    float* ssq;
    if (IN(0)) { LAUNDER(); p0_prologue(F, args); } SEAM(0);

    for (int l = 0; l < 2; ++l) {
        const int pb = l * 6;
        if (IN(pb + 1)) { LAUNDER();
            if (l == 0) { META_TASK(INW / 16, meta::inproj(F, mscr, 0, 16 * task)); } else { META_TASK(768 / 16, meta::inproj(F, mscr, 1, 1024 + 16 * task)); }
            pg8::ProbPlain P{(const char*)WSP(bf16, WS_HB), (const char*)(WSP(bf16, WS_WIN) + (size_t)l * INW * D), D * 2, D * 2, D / 64, 0, 128, (size_t)256 * (D * 2)};
            pg8::StaticOrder S; S.init(M, INW, F.G, (int)blockIdx.x);
            pg8::EpiInProj E{ssq, WSP(bf16, WS_Q), WSP(bf16, WS_K), WSP(bf16, WS_V), WSP(bf16, WS_U), WSP(bf16, WS_G)};
            pg8::gemm_phase<pg8::ProbPlain, pg8::EpiInProj, pg8::StaticOrder, true>(F.lds + RING_OFF, P, S, E, F.tid);
        } SEAM(pb + 1);
        if (IN(pb + 2)) { LAUNDER();
            if (l == 0) { for (int hd = F.vcu; hd < NH + 1; hd += F.G) { if (hd < NH) meta::attn_head(F, args, 0, hd); else meta::pool_rows(F); } }
            attn_phase(F, args, l);
        } SEAM(pb + 2);
        if (IN(pb + 3)) { LAUNDER();
            if (l == 0) { META_TASK(D / 16, meta::merge(F, mscr, 0, 16 * task)); }
            pg8::ProbMerge P{(const char*)F.out, (const char*)(WSP(bf16, WS_WA) + (size_t)l * D * MRGK), MRGK * 2, MRGK / 64};
            pg8::StaticOrder S; S.init(M, D, F.G, (int)blockIdx.x);
            pg8::EpiMerge E{WSP(bf16, WS_G), WSP(bf16, WS_Q)};
            pg8::gemm_phase<pg8::ProbMerge, pg8::EpiMerge, pg8::StaticOrder, true>(F.lds + RING_OFF, P, S, E, F.tid);
        } SEAM(pb + 3);
        if (IN(pb + 4)) { LAUNDER();
            if (l == 0) { META_TASK(D / 16, meta::outproj(F, mscr, 0, 16 * task)); }
            pg8::ProbPlain P{(const char*)WSP(bf16, WS_Q), (const char*)(WSP(bf16, WS_WO) + (size_t)l * D * D), D * 2, D * 2, D / 64, 0, 128, (size_t)256 * (D * 2)};
            pg8::StaticOrder S; S.init(M, D, F.G, (int)blockIdx.x);
            pg8::EpiResid E{WSP(bf16, WS_HB), ssq};
            pg8::gemm_phase<pg8::ProbPlain, pg8::EpiResid, pg8::StaticOrder, true>(F.lds + RING_OFF, P, S, E, F.tid);
        } SEAM(pb + 4);
        if (l == 0) {
            if (IN(5)) { LAUNDER();
                META_TASK(DFF / 16, meta::gu(F, mscr, 16 * task));
                pg8::ProbPlain P{(const char*)WSP(bf16, WS_HB), (const char*)WSP(bf16, WS_WGU), D * 2, D * 2, D / 64, 0, 128, (size_t)256 * (D * 2)};
                pg8::StaticOrder S; S.init(M, 2 * DFF, F.G, (int)blockIdx.x);
                pg8::EpiSwiGLU<false> E{ssq, WSP(bf16, WS_ACT), DFF / 64};
                pg8::gemm_phase<pg8::ProbPlain, pg8::EpiSwiGLU<false>, pg8::StaticOrder, true>(F.lds + RING_OFF, P, S, E, F.tid);
            } SEAM(5);
            if (IN(6)) { LAUNDER();
                META_TASK(D / 16, meta::down(F, mscr, 16 * task));
                pg8::ProbPlain P{(const char*)WSP(bf16, WS_ACT), (const char*)WSP(bf16, WS_WD), 128, 128, DFF / 64, 0, 32768, (size_t)(DFF / 64) * 32768, 32768, (size_t)(DFF / 64) * 32768};
                pg8::StaticOrder S; S.init(M, D, F.G, (int)blockIdx.x); S.rev = true;
                pg8::EpiResid E{WSP(bf16, WS_HB), ssq};
                pg8::gemm_phase<pg8::ProbPlain, pg8::EpiResid, pg8::StaticOrder, true>(F.lds + RING_OFF, P, S, E, F.tid);
            } SEAM(6);
        }
    }
    if (IN(11)) { LAUNDER(); moe_route(F, args); } SEAM(11);
    if (IN(12)) { LAUNDER(); moe_slots(F); } SEAM(12);
    for (int k = 0; k < 2; ++k) {
        const int* tab = WSP(int, WS_MOETAB); const int* slot_tok = WSP(int, WS_SLOTTOK) + k * NSLOT; const float* slot_w = WSP(float, WS_SLOTW) + k * NSLOT;
        if (IN(13 + 2 * k)) { LAUNDER();
            if (k == 1) moe_fix(F, 0, __builtin_amdgcn_readfirstlane(tab[16]) - 256);
            const int ntile = __builtin_amdgcn_readfirstlane(tab[16 + k]);
            LAS int* etab = (LAS int*)(F.lds + XTRA_OFF + 1024);
            for (int i = F.tid; i < MAXTILES; i += NWAVES * 64) etab[i] = tab[32 + k * MAXTILES + i];
            __syncthreads();
            pg8::ProbMoeGU P{(const char*)WSP(unsigned char, WS_POOLED), (const char*)WSP(unsigned char, WS_MGU), D, D, D / 128, slot_tok, etab, (LAS int*)(F.lds + XTRA_OFF), (size_t)2 * DFE * D};
            pg8::LinearOrder S{ntile, 2 * DFE / 256, F.G, F.vcu, false};
            pg8::EpiSwiGLU8 E{WSP(float, WS_SLOTRS) + k * NSLOT, WSP(unsigned char, WS_ACT)};
            pg8::gemm_phase<pg8::ProbMoeGU, pg8::EpiSwiGLU8, pg8::LinearOrder, true, true>(F.lds + RING_OFF, P, S, E, F.tid);
        } SEAM(13 + 2 * k);
        if (IN(14 + 2 * k)) { LAUNDER();
            const int ntile = __builtin_amdgcn_readfirstlane(tab[16 + k]);
            LAS int* etab = (LAS int*)(F.lds + XTRA_OFF + 1024);
            for (int i = F.tid; i < MAXTILES; i += NWAVES * 64) etab[i] = tab[32 + k * MAXTILES + i];
            __syncthreads();
            { pg8::ProbMoeDown P{(const char*)WSP(unsigned char, WS_ACT), (const char*)WSP(unsigned char, WS_MD), 128, 128, DFE / 128, etab, 32768, (size_t)(DFE / 128) * 32768, 32768, (size_t)(DFE / 128) * 32768, (size_t)D * DFE};
              pg8::LinearOrder S{256, D / 256, F.G, F.vcu, true}; S.base = ntile - 256;
              pg8::EpiMoeDown E{k == 0 ? WSP(bf16, WS_HB) : (bf16*)F.out, k == 0 ? (bf16*)F.out : WSP(bf16, WS_HB), slot_tok, slot_w, 1.0f / W8_DN};
              pg8::gemm_phase<pg8::ProbMoeDown, pg8::EpiMoeDown, pg8::LinearOrder, true, true>(F.lds + RING_OFF, P, S, E, F.tid); }
            { pg8::ProbMoeDownQ P{(const char*)WSP(unsigned char, WS_ACT), (const char*)WSP(unsigned char, WS_MD), 128, 128, DFE / 128 / pg8::NQ, etab, (size_t)(DFE / 128) * 32768, (size_t)(DFE / 128) * 32768, (size_t)D * DFE};
              pg8::QuarterOrder S{ntile - 256, F.G, F.vcu};
              pg8::EpiSlab E{WSP(float, WS_SLAB)};
              pg8::gemm_phase<pg8::ProbMoeDownQ, pg8::EpiSlab, pg8::QuarterOrder, true, true>(F.lds + RING_OFF, P, S, E, F.tid); }
        } SEAM(14 + 2 * k);
    }
    if (IN(17)) { LAUNDER(); moe_fix(F, 1, __builtin_amdgcn_readfirstlane(WSP(int, WS_MOETAB)[17]) - 256); } SEAM(17);
    if (IN(18)) { LAUNDER(); final_norm(F, args); }
#ifdef PROBE_MASK
    PROBE_SEAM(18);
#ifdef PROBE_EPI
    pacc = ((volatile LAS unsigned*)(F.lds + MISC_OFF))[33];
#endif
#ifdef PROBE_CLK
    pacc = (cacc * 100ull / (pacc ? pacc : 1ull)) * 100ull / 8ull;
#endif
    if (blockIdx.x == 0) { const unsigned long long t_ = __builtin_amdgcn_s_memrealtime(); while (__builtin_amdgcn_s_memrealtime() - t_ < 8ull * pacc) __builtin_amdgcn_s_sleep(32); }
#endif
#undef IN
#undef SEAM
#undef PROBE_SEAM
#undef META_TASK
#undef LAUNDER
}

extern "C" void kernel_launch(void* const* d_in, const int* in_sizes, int n_in, void* d_out, int out_size, void* d_ws, size_t ws_size, hipStream_t stream) {
    static int grid = 0;
    if (grid == 0) {
        if (n_in != 18 || in_sizes[0] != M * D || out_size != M * D || ws_size < WS_END) { fprintf(stderr, "kernel_launch: unexpected shapes (n_in %d, in0 %d, out %d, ws %zu); nothing launched\n", n_in, n_in > 0 ? in_sizes[0] : -1, out_size, ws_size); grid = -1; return; }
        int dev = 0, cus = 0, per_cu = 0;
        if (hipGetDevice(&dev) != hipSuccess || hipDeviceGetAttribute(&cus, hipDeviceAttributeMultiprocessorCount, dev) != hipSuccess) { grid = -1; return; }
        if (hipFuncSetAttribute((const void*)fwd, hipFuncAttributeMaxDynamicSharedMemorySize, LDS_BYTES) != hipSuccess) { fprintf(stderr, "kernel_launch: hipFuncSetAttribute failed\n"); grid = -1; return; }
        if (hipOccupancyMaxActiveBlocksPerMultiprocessor(&per_cu, (const void*)fwd, NWAVES * 64, LDS_BYTES) != hipSuccess || per_cu < 1) { fprintf(stderr, "kernel_launch: occupancy query reports %d workgroups per CU\n", per_cu); }
        (void)hipGetLastError();
        grid = cus;
    }
    if (grid < 0) return;
    if (hipMemsetAsync((char*)d_ws + WS_CTL, 0, CTL_ZERO_BYTES, stream) != hipSuccess) return;
    Args a{};
    for (int i = 0; i < 18; ++i) a.in[i] = (const float*)d_in[i];
    a.out = (float*)d_out; a.ws = (unsigned char*)d_ws;
#if MK_PER_PHASE
    for (int p = 0; p < NPHASES; ++p) { a.ph_lo = p; a.ph_hi = p + 1; hipLaunchKernelGGL(fwd, dim3(grid), dim3(NWAVES * 64), LDS_BYTES, stream, a); }
#else
    a.ph_lo = 0; a.ph_hi = NPHASES; hipLaunchKernelGGL(fwd, dim3(grid), dim3(NWAVES * 64), LDS_BYTES, stream, a);
#endif
}
```

```cpp
#include <hip/hip_runtime.h>
#include <cstdio>
#include <cstdint>

#define GAS __attribute__((address_space(1)))
#define LAS __attribute__((address_space(3)))
typedef unsigned short bf16;
typedef short bf16x8 __attribute__((ext_vector_type(8)));
typedef short s16x4 __attribute__((ext_vector_type(4)));
typedef float f32x2 __attribute__((ext_vector_type(2)));
typedef float f32x4 __attribute__((ext_vector_type(4)));
typedef float f32x16 __attribute__((ext_vector_type(16)));
typedef unsigned u32x2 __attribute__((ext_vector_type(2)));
typedef unsigned u32x4 __attribute__((ext_vector_type(4)));
typedef GAS unsigned gu32;
#define RLX_AGENT __ATOMIC_RELAXED, __HIP_MEMORY_SCOPE_AGENT
#define LDS_WAIT() asm volatile("s_waitcnt lgkmcnt(0)" ::: "memory")
#define VM_WAIT() asm volatile("s_waitcnt vmcnt(0)" ::: "memory")
#define DI __device__ __forceinline__
#define GLOBAL_AS __attribute__((address_space(1)))

constexpr int NB = 8, SEQ = 8192, D = 1024, M = NB * SEQ;
constexpr int NMETA = 16;
constexpr int NH = 16, HD = 64, NKV = 2, QG = 8, KVW = 128, POOLW = 512;
constexpr int USEQ = SEQ + NMETA;
constexpr int INW = 3840;
constexpr int DFF = 2816, NE = 8, DFE = 3584;
constexpr float RMS_EPS = 1e-5f;
constexpr float LOG2E = 1.4426950408889634f;
constexpr float QSCALE = 0.125f * LOG2E;
constexpr int NSLOT = M + NE * 256;
constexpr int MAXTILES = NSLOT / 256;

constexpr size_t MiB = 1u << 20;
constexpr size_t WS_CTL = 0, CTL_ZERO_BYTES = 1 * MiB;
constexpr size_t WS_SSQ = 1 * MiB;
constexpr size_t WS_TOKE = 5 * MiB;
constexpr size_t WS_TOKW = 5 * MiB + 512 * 1024;
constexpr size_t WS_SLOTTOK = 6 * MiB;
constexpr size_t WS_SLOTW = 7 * MiB;
constexpr size_t WS_WGCNT = 8 * MiB;
constexpr size_t WS_MOETAB = 8 * MiB + 64 * 1024;
constexpr size_t WS_SLOTRS = 8 * MiB + 128 * 1024;
constexpr size_t WS_META = 9 * MiB;
constexpr size_t WS_WIN = 16 * MiB;
constexpr size_t WS_WA = 31 * MiB;
constexpr int MRGK = 128 + 1024;
constexpr size_t WS_WO = 36 * MiB;
constexpr size_t WS_WGU = 40 * MiB;
constexpr size_t WS_WD = 51 * MiB;
constexpr size_t WS_MGU = 57 * MiB;
constexpr size_t WS_MD = 169 * MiB;
constexpr size_t WS_HB = 225 * MiB;
constexpr size_t WS_POOLED = 353 * MiB;
constexpr size_t WS_Q = 417 * MiB;
constexpr size_t WS_K = 545 * MiB;
constexpr size_t WS_V = 561 * MiB;
constexpr size_t WS_U = 577 * MiB;
constexpr size_t WS_G = 642 * MiB;
constexpr size_t WS_ACT = 417 * MiB;
constexpr size_t WS_SLAB = 898 * MiB;
constexpr size_t WS_END = 930 * MiB;
static_assert(WS_ACT + (size_t)NSLOT * DFE * 2 <= WS_END && WS_ACT + (size_t)M * DFF * 2 <= WS_END, "act overlay");
constexpr size_t MO_HM = 0;
constexpr size_t MO_XM = 64 * 1024;
constexpr size_t MO_PROJ = 96 * 1024;
constexpr size_t MO_KM = 336 * 1024;
constexpr size_t MO_VM = 344 * 1024;
constexpr size_t MO_UM = 352 * 1024;
constexpr size_t MO_ATT = 384 * 1024;
constexpr size_t MO_POOL = 416 * 1024;
constexpr size_t MO_MRG = 432 * 1024;
constexpr size_t MO_ACT = 464 * 1024;
constexpr int CW_TMO = 0, CW_CODE = 1, CW_BAR = 4096;

constexpr int RING_OFF = 0, RING_BYTES = 147456;
constexpr int LDSCTL_OFF = RING_BYTES, MISC_OFF = LDSCTL_OFF + 320;
constexpr int XTRA_OFF = LDSCTL_OFF + 1024;
constexpr int LDS_BYTES = RING_BYTES + 4096;

DI unsigned f2bf(float f) { unsigned u = __builtin_bit_cast(unsigned, f); return (u + 0x7fffu + ((u >> 16) & 1u)) >> 16; }
DI unsigned pk2(float lo, float hi) { unsigned r; asm volatile("v_cvt_pk_bf16_f32 %0, %1, %2" : "=v"(r) : "v"(lo), "v"(hi)); return r; }
DI float sat8(float v) { return __builtin_amdgcn_fmed3f(v, -448.f, 448.f); }
DI unsigned pk4_fp8(float a, float b, float c, float d) { int w = __builtin_amdgcn_cvt_pk_fp8_f32(sat8(a), sat8(b), 0, false); w = __builtin_amdgcn_cvt_pk_fp8_f32(sat8(c), sat8(d), w, true); return (unsigned)w; }
constexpr float W8_GU = 64.f, W8_DN = 128.f;
DI float bf2f(unsigned short b) { return __builtin_bit_cast(float, (unsigned)b << 16); }
DI float bflo(unsigned w) { return __builtin_bit_cast(float, w << 16); }
DI float bfhi(unsigned w) { return __builtin_bit_cast(float, w & 0xffff0000u); }
DI int hw_lane() { int l; asm volatile("v_mbcnt_lo_u32_b32 %0, -1, 0\n\tv_mbcnt_hi_u32_b32 %0, -1, %0" : "=v"(l)); return l; }
DI float shx(float v, int mask, int lane) { return __builtin_bit_cast(float, __builtin_amdgcn_ds_bpermute((lane ^ mask) << 2, __builtin_bit_cast(int, v))); }
DI float wave_sum(float v, int lane) {
#pragma unroll
    for (int o = 1; o < 64; o <<= 1) v += shx(v, o, lane);
    return v;
}
DI float fast_sigmoid(float x) { return __builtin_amdgcn_rcpf(1.f + __builtin_amdgcn_exp2f(-x * LOG2E)); }
DI float sigmoid_scaled(float a, float nsl2) { return __builtin_amdgcn_rcpf(1.f + __builtin_amdgcn_exp2f(a * nsl2)); }

#define XB_TMO      128
#define XB_XCNT(j)  (256  + 64 * (j))
#define XB_XSUB(j)  (1280 + 64 * (j))
#define XB_XGEN(j)  (2304 + 64 * (j))
#define XB_TOP      3328
#define XB_TOPGEN   3392
#define XCD_BAR_WORDS 3456
#define XB_SPIN_CAP (1u << 18)
DI unsigned xb_ld(unsigned* p)              { return __hip_atomic_load(p, __ATOMIC_RELAXED, __HIP_MEMORY_SCOPE_AGENT); }
DI unsigned xb_add(unsigned* p, unsigned v) { return __hip_atomic_fetch_add(p, v, __ATOMIC_RELAXED, __HIP_MEMORY_SCOPE_AGENT); }
DI unsigned xb_xcc_id() { return (unsigned)__builtin_amdgcn_s_getreg((3 << 11) | 20) & 0xFu; }
#define XB_SPIN(cond, bar) do { unsigned _sp = 0; while (cond) { __builtin_amdgcn_s_sleep(1); \
    if ((++_sp & 255u) == 0u) { if (xb_ld(&(bar)[XB_TMO])) break; if (_sp > XB_SPIN_CAP) { atomicAdd(&(bar)[XB_TMO], 1u); break; } } } } while (0)
struct XcdBarrier { unsigned* bar; unsigned x; volatile LAS unsigned* st; };
DI XcdBarrier xcd_barrier_post(unsigned* bar, volatile LAS unsigned* st, int tid) {
    XcdBarrier b; b.bar = bar; b.x = xb_xcc_id(); b.st = st;
    if (tid == 0) (void)xb_add(&bar[XB_XCNT(b.x)], 1u);
    return b;
}
DI void xcd_barrier_complete(unsigned* bar, unsigned x, unsigned& nloc, unsigned& nx) {
    const unsigned G = gridDim.x * gridDim.y * gridDim.z;
    unsigned sum, cnt, mine, sp = 0u;
    for (;;) {
        sum = 0u; cnt = 0u; mine = 0u;
#pragma unroll
        for (unsigned j = 0; j < 16; ++j) { const unsigned c = xb_ld(&bar[XB_XCNT(j)]); sum += c; cnt += (c > 0u) ? 1u : 0u; mine = (j == x) ? c : mine; }
        if (sum == G) break;
        __builtin_amdgcn_s_sleep(1);
        if ((++sp & 255u) == 0u) { if (xb_ld(&bar[XB_TMO])) break; if (sp > XB_SPIN_CAP) { atomicAdd(&bar[XB_TMO], 1u); break; } }
    }
    nloc = mine > 0u ? mine : 1u; nx = cnt > 0u ? cnt : 1u;
}
DI void xcd_barrier(const XcdBarrier& b, int tid) {
    asm volatile("s_waitcnt vmcnt(0)" ::: "memory");
    __syncthreads();
    if (tid == 0) {
        unsigned* bar = b.bar;
        __builtin_amdgcn_s_waitcnt(0);
        unsigned nloc = b.st[0], nx = b.st[1];
        if (nloc == 0u) { xcd_barrier_complete(bar, b.x, nloc, nx); b.st[0] = nloc; b.st[1] = nx; }
        const unsigned old = xb_add(&bar[XB_XSUB(b.x)], 1u);
        const unsigned gen = old / nloc;
        if (old + 1u == (gen + 1u) * nloc) {
            __builtin_amdgcn_fence(__ATOMIC_RELEASE, "agent");
            asm volatile("s_waitcnt vmcnt(0)" ::: "memory");
            const unsigned og = xb_add(&bar[XB_TOP], 1u);
            const unsigned tg = og / nx;
            if (og + 1u == (tg + 1u) * nx) xb_add(&bar[XB_TOPGEN], 1u);
            else XB_SPIN(xb_ld(&bar[XB_TOPGEN]) == tg, bar);
            __builtin_amdgcn_fence(__ATOMIC_ACQUIRE, "agent");
            xb_add(&bar[XB_XGEN(b.x)], 1u);
            asm volatile("s_waitcnt vmcnt(0)" ::: "memory");
        } else {
            XB_SPIN(xb_ld(&bar[XB_XGEN(b.x)]) == gen, bar);
            __builtin_amdgcn_fence(__ATOMIC_ACQUIRE, "agent");
            asm volatile("s_waitcnt vmcnt(0)" ::: "memory");
        }
    }
    __syncthreads();
}
namespace pg8 {
constexpr int BM = 256, BK = 64, HALF = 128, HTB = HALF * BK * 2, STAGE_BYTES = 8 * HTB, NXCD = 8, WGM = 8;
__host__ __device__ __forceinline__ int lds_byte(int r, int c) { const int st = (r >> 4) * 2 + (c >> 5), rr = r & 15, cc = c & 31, ob = rr * 64 + cc * 2; return st * 1024 + (ob ^ (((ob >> 9) & 1) << 5)); }
__host__ __device__ __forceinline__ void stage_rc(int b, int& R, int& C) { const int st = b / 1024, sb = b % 1024, swz = sb ^ (((sb >> 9) & 1) << 5); R = (st >> 1) * 16 + swz / 64; C = (st & 1) * 32 + (swz % 64) / 2; }
__host__ __device__ __forceinline__ int perm32(int rho) { const int n = rho >> 4, i = rho & 15; return 8 * (i >> 2) + 4 * n + (i & 3); }

struct Unit { int pm, pn; int kq = 0; };

struct StaticOrder {
    int nM, nN, nwg, G, c; bool rev = false;
    DI void init(int M_, int N_, int G_, int c_) { nM = M_ / BM; nN = N_ / BM; nwg = nM * nN; G = G_; c = c_; }
    DI bool next(int i, Unit& u) const {
        const long L = (long)i * G + c; if (L >= nwg) return false;
        int wgid = (int)L; { const int q = nwg / NXCD, r = nwg % NXCD, xcd = wgid % NXCD, off = wgid / NXCD; wgid = (xcd < r ? xcd * (q + 1) : r * (q + 1) + (xcd - r) * q) + off; }
        const int nig = WGM * nN, gid = wgid / nig, fm = gid * WGM, gsz = (nM - fm) < WGM ? (nM - fm) : WGM;
        u.pm = fm + ((wgid % nig) % gsz); u.pn = (wgid % nig) / gsz;
        if (rev) { const int span = nM / NXCD; if (span * NXCD == nM) { const int base = (u.pm / span) * span; u.pm = base + span - 1 - (u.pm - base); } else u.pm = nM - 1 - u.pm; }
        return true;
    }
};
struct LinearOrder {
    int ntile, nN, G, c; bool rev; int base = 0;
    DI bool next(int i, Unit& u) const {
        const long L = (long)i * G + c; if (L >= (long)ntile * nN) return false;
        constexpr int gt = 8; const int per8 = gt * nN, g = (int)(L / per8), w = (int)(L % per8), gsz = (ntile - gt * g) < gt ? (ntile - gt * g) : gt;
        u.pm = gt * g + w % gsz; u.pn = w / gsz; if (rev) u.pm = ntile - 1 - u.pm; u.pm += base; return true; }
};
constexpr int NQ = 2, NSL = 4;
struct QuarterOrder {
    int ntail, G, c;
    DI bool next(int i, Unit& u) const { const long L = (long)i * G + c; if (L >= (long)ntail * 4 * NQ) return false; u.pm = (int)(L / (4 * NQ)); u.pn = (int)((L / NQ) & 3); u.kq = (int)(L % NQ); return true; }
};

struct ProbPlain {
    static constexpr bool GATHER = false;
    const char* A; const char* Bt; unsigned lda2, ldb2; int nt; unsigned acol2;
    unsigned kstepA; size_t panelA;
    unsigned kstepB = 128; size_t panelB = 0;
    DI unsigned a_base(const Unit& u) const { return (unsigned)((size_t)u.pm * panelA + (size_t)u.pn * acol2); }
    DI unsigned b_base(const Unit& u) const { return (unsigned)((size_t)u.pn * (panelB ? panelB : (size_t)BM * ldb2)); }
    DI unsigned a_row(const Unit&, int r) const { return (unsigned)r * lda2; }
    DI unsigned ak(const Unit&, int t) const { return (unsigned)t * kstepA; }
};
struct ProbMoeGU {
    static constexpr bool GATHER = true;
    static constexpr unsigned kstepA = 128, kstepB = 128;
    const char* A; const char* Bt; unsigned lda2, ldb2; int nt; const int* slot_tok; const LAS int* tile_e; LAS int* gtab; size_t estride;
    DI unsigned a_base(const Unit&) const { return 0u; }
    DI unsigned a_row_lds(int r) const { int t = gtab[r]; t = t < 0 ? 0 : t; return (unsigned)t * lda2; }
    DI void prefetch_rows(const Unit& u, int wid, int lane) const { if (wid < 4) __builtin_amdgcn_global_load_lds((const unsigned*)(slot_tok + u.pm * BM + wid * 64 + lane), (LAS unsigned*)(gtab + wid * 64), 4, 0, 0); }
    DI unsigned b_base(const Unit& u) const { return (unsigned)((size_t)tile_e[u.pm] * estride + (size_t)u.pn * BM * ldb2); }
    DI unsigned a_row(const Unit& u, int r) const { int t = slot_tok[u.pm * BM + r]; t = t < 0 ? 0 : t; return (unsigned)t * lda2; }
    DI unsigned ak(const Unit&, int t) const { return (unsigned)t * kstepA; }
};
struct ProbMoeDown {
    static constexpr bool GATHER = false;
    const char* A; const char* Bt; unsigned lda2, ldb2; int nt; const LAS int* tile_e; unsigned kstepA; size_t panelA; unsigned kstepB; size_t panelB; size_t estride;
    DI unsigned a_base(const Unit& u) const { return (unsigned)((size_t)u.pm * panelA); }
    DI unsigned b_base(const Unit& u) const { return (unsigned)((size_t)tile_e[u.pm] * estride + (size_t)u.pn * panelB); }
    DI unsigned a_row(const Unit&, int r) const { return (unsigned)r * lda2; }
    DI unsigned ak(const Unit&, int t) const { return (unsigned)t * kstepA; }
};

struct ProbMoeDownQ {
    static constexpr bool GATHER = false; static constexpr unsigned kstepA = 32768, kstepB = 32768;
    const char* A; const char* Bt; unsigned lda2, ldb2; int nt; const LAS int* tile_e; size_t panelA, panelB, estride; int kst0, kst1;
    DI unsigned a_base(const Unit& u) const { return (unsigned)((size_t)u.pm * panelA + (size_t)(u.kq ? kst1 : kst0) * 32768); }
    DI unsigned b_base(const Unit& u) const { return (unsigned)((size_t)tile_e[u.pm] * estride + (size_t)u.pn * panelB + (size_t)(u.kq ? kst1 : kst0) * 32768); }
    DI unsigned a_row(const Unit&, int r) const { return (unsigned)r * lda2; }
    DI unsigned ak(const Unit&, int t) const { return (unsigned)t * kstepA; }
};
struct ProbMerge {
    static constexpr bool GATHER = false; static constexpr unsigned kstepB = 128;
    const char* A; const char* Bt; unsigned ldb2; int nt;
    DI unsigned a_base(const Unit& u) const { return (unsigned)u.pm * (24u * 32768u); }
    DI unsigned b_base(const Unit& u) const { return (unsigned)u.pn * (unsigned)BM * ldb2; }
    DI unsigned a_row(const Unit&, int r) const { return (unsigned)r * 128u; }
    DI unsigned ak(const Unit& u, int t) const { return (unsigned)(t < 2 ? 2 * u.pn + t : 6 + t) * 32768u; }
};

template <class Prob, class Epi, class Sched, bool ALIGN_EPI, bool FP8 = false>
DI void gemm_phase(LAS unsigned char* lds, const Prob& P, const Sched& S, const Epi& E, int tid) {
    asm volatile("" : "+v"(tid));
    const int wid = __builtin_amdgcn_readfirstlane(tid >> 6), lane = tid & 63, wr = wid >> 2, wc = wid & 3, fr = lane & 15, fq = lane >> 4;
    const int nt = P.nt;
    int R0, C0, R1, C1; stage_rc(tid * 16, R0, C0); stage_rc(tid * 16 + 8192, R1, C1);
    const int Rb0 = Epi::PERM ? ((R0 & ~31) + perm32(R0 & 31)) : R0, Rb1 = Epi::PERM ? ((R1 & ~31) + perm32(R1 & 31)) : R1;
    const unsigned voffB0 = (unsigned)Rb0 * P.ldb2 + (unsigned)C0 * 2u, voffB1 = (unsigned)Rb1 * P.ldb2 + (unsigned)C1 * 2u;
    const unsigned kstep = P.kstepB;
    const unsigned hstepB = (unsigned)HALF * P.ldb2;
    const __amdgpu_buffer_rsrc_t rsA = __builtin_amdgcn_make_buffer_rsrc((void*)P.A, 0, -1, 0x00020000), rsB = __builtin_amdgcn_make_buffer_rsrc((void*)P.Bt, 0, -1, 0x00020000);
    const unsigned ldsw = (unsigned)wid * 1024u;
    const int aoff = lds_byte(wr * 64 + fr, fq * 8), boff = lds_byte(wc * 32 + fr, fq * 8);
#define PG8_SA(b, h) (((b) * 2 + (h)) * HTB)
#define PG8_SB(b, h) ((4 + (b) * 2 + (h)) * HTB)
#define PG8_STGX(rs, bufoff, soff, v0, v1) do { \
        __builtin_amdgcn_raw_ptr_buffer_load_lds(rs, (LAS unsigned*)(lds + (bufoff) + ldsw), 16, (int)(v0), (int)(soff), 0, 0); \
        __builtin_amdgcn_raw_ptr_buffer_load_lds(rs, (LAS unsigned*)(lds + (bufoff) + ldsw + 8192), 16, (int)(v1), (int)(soff), 0, 0); } while (0)
#define PG8_STG(bufoff, soff, v0, v1) PG8_STGX(rsA, bufoff, soff, v0, v1)
#define PG8_STGB(bufoff, soff) PG8_STGX(rsB, bufoff, soff, voffB0, voffB1)
#define PG8_LDA(dst, b, h) do { if constexpr (FP8) { _Pragma("unroll") for (int m = 0; m < 4; ++m) { const i32x4_ lo_ = *(const LAS i32x4_*)(lds + PG8_SA(b, h) + aoff + m * 2048), hi_ = *(const LAS i32x4_*)(lds + PG8_SA(b, h) + aoff + m * 2048 + 1024); dst##8[m] = __builtin_shufflevector(lo_, hi_, 0, 1, 2, 3, 4, 5, 6, 7); } } \
        else { _Pragma("unroll") for (int m = 0; m < 4; ++m) _Pragma("unroll") for (int k = 0; k < 2; ++k) dst[m][k] = *(const LAS bf16x8*)(lds + PG8_SA(b, h) + aoff + m * 2048 + k * 1024); } } while (0)
#define PG8_LDB(dst, b, h) do { if constexpr (FP8) { _Pragma("unroll") for (int n = 0; n < 2; ++n) { const i32x4_ lo_ = *(const LAS i32x4_*)(lds + PG8_SB(b, h) + boff + n * 2048), hi_ = *(const LAS i32x4_*)(lds + PG8_SB(b, h) + boff + n * 2048 + 1024); dst##8[n] = __builtin_shufflevector(lo_, hi_, 0, 1, 2, 3, 4, 5, 6, 7); } } \
        else { _Pragma("unroll") for (int n = 0; n < 2; ++n) _Pragma("unroll") for (int k = 0; k < 2; ++k) dst[n][k] = *(const LAS bf16x8*)(lds + PG8_SB(b, h) + boff + n * 2048 + k * 1024); } } while (0)
#define PG8_MMA(ai, bj, At, Bt) do { __builtin_amdgcn_s_setprio(1); _Pragma("unroll") for (int m = 0; m < 4; ++m) _Pragma("unroll") for (int n = 0; n < 2; ++n) { \
        if constexpr (FP8) { acc[ai][bj][m][n] = __builtin_amdgcn_mfma_scale_f32_16x16x128_f8f6f4(Bt##8[n], At##8[m], acc[ai][bj][m][n], 0, 0, 0, 0x7f7f7f7f, 0, 0x7f7f7f7f); } \
        else { _Pragma("unroll") for (int k = 0; k < 2; ++k) acc[ai][bj][m][n] = __builtin_amdgcn_mfma_f32_16x16x32_bf16(Bt[n][k], At[m][k], acc[ai][bj][m][n], 0, 0, 0); } } \
        __builtin_amdgcn_s_setprio(0); } while (0)
#define PG8_WAIT_V(n) asm volatile("s_waitcnt vmcnt(" #n ")" ::: "memory")
#define PG8_WAIT_L(n) asm volatile("s_waitcnt lgkmcnt(" #n ")" ::: "memory")
#define PG8_BAR __builtin_amdgcn_s_barrier()
#define PG8_SCHED __builtin_amdgcn_sched_barrier(0)
    Unit cur, nxt; int ui = 0;
    if (!S.next(0, cur)) return;
    f32x4 acc[2][2][4][2];
#pragma unroll
    for (int a = 0; a < 2; ++a)
#pragma unroll
        for (int b = 0; b < 2; ++b)
#pragma unroll
            for (int m = 0; m < 4; ++m)
#pragma unroll
                for (int n = 0; n < 2; ++n) acc[a][b][m][n] = (f32x4){0.f, 0.f, 0.f, 0.f};
    bf16x8 At[4][2], B0[2][2], B1[2][2];
    typedef int i32x8_ __attribute__((ext_vector_type(8))); typedef int i32x4_ __attribute__((ext_vector_type(4)));
    i32x8_ At8[4], B08[2], B18[2];
    unsigned vc00, vc01, vc10, vc11;
#define PG8_AOFF(u, o00, o01, o10, o11) do { o00 = P.a_row(u, R0) + (unsigned)C0 * 2u; o01 = P.a_row(u, R1) + (unsigned)C1 * 2u; \
        o10 = P.a_row(u, HALF + R0) + (unsigned)C0 * 2u; o11 = P.a_row(u, HALF + R1) + (unsigned)C1 * 2u; } while (0)
    PG8_AOFF(cur, vc00, vc01, vc10, vc11);
    unsigned cA = P.a_base(cur), cB = P.b_base(cur);
    PG8_STGB(PG8_SB(0, 0), cB); PG8_STGB(PG8_SB(0, 1), cB + hstepB); PG8_STG(PG8_SA(0, 0), cA + P.ak(cur, 0), vc00, vc01); PG8_STG(PG8_SA(0, 1), cA + P.ak(cur, 0), vc10, vc11);
    if (wr == 1) PG8_BAR;
    PG8_WAIT_V(2); PG8_BAR;
    PG8_STGB(PG8_SB(1, 0), cB + kstep); PG8_STG(PG8_SA(1, 0), cA + P.ak(cur, 1), vc00, vc01); PG8_STGB(PG8_SB(1, 1), cB + hstepB + kstep);
    PG8_WAIT_V(6); PG8_BAR;
    for (;;) {
        const bool has_next = S.next(ui + 1, nxt);
        unsigned nA = cA, nB = cB;
        if (has_next) { nA = P.a_base(nxt); nB = P.b_base(nxt); if constexpr (Prob::GATHER) { P.prefetch_rows(nxt, wid, lane); } }
        const Unit nu = has_next ? nxt : cur;
        for (int t = 0; t < nt; t += 2) {
            const bool last = (t == nt - 2);
            const unsigned a1 = cA + P.ak(cur, t + 1);
            const unsigned a2 = last ? nA + P.ak(nu, 0) : cA + P.ak(cur, t + 2), b2 = last ? nB : cB + (unsigned)(t + 2) * kstep;
            const unsigned a3 = last ? nA + P.ak(nu, 1) : cA + P.ak(cur, t + 3), b3 = b2 + kstep;
            PG8_LDB(B0, 0, 0); PG8_LDB(B1, 0, 1); PG8_SCHED; PG8_LDA(At, 0, 0); PG8_STG(PG8_SA(1, 1), a1, vc10, vc11);
            if constexpr (Prob::GATHER) { if (last && has_next) {
                vc00 = P.a_row_lds(R0) + (unsigned)C0 * 2u; vc01 = P.a_row_lds(R1) + (unsigned)C1 * 2u; vc10 = P.a_row_lds(HALF + R0) + (unsigned)C0 * 2u; vc11 = P.a_row_lds(HALF + R1) + (unsigned)C1 * 2u; } }
            PG8_WAIT_V(8); PG8_WAIT_L(0); PG8_BAR; PG8_MMA(0, 0, At, B0); PG8_MMA(0, 1, At, B1); PG8_BAR; PG8_SCHED;
            PG8_LDA(At, 0, 1); PG8_STGB(PG8_SB(0, 0), b2); PG8_STGB(PG8_SB(0, 1), b2 + hstepB); PG8_STG(PG8_SA(0, 0), a2, vc00, vc01);
            PG8_WAIT_V(8); PG8_WAIT_L(0); PG8_BAR; PG8_MMA(1, 0, At, B0); PG8_MMA(1, 1, At, B1); PG8_BAR; PG8_SCHED;
            PG8_LDB(B0, 1, 0); PG8_LDB(B1, 1, 1); PG8_SCHED; PG8_LDA(At, 1, 0); PG8_STG(PG8_SA(0, 1), a2, vc10, vc11);
            PG8_WAIT_V(8); PG8_WAIT_L(0); PG8_BAR; PG8_MMA(0, 0, At, B0); PG8_MMA(0, 1, At, B1); PG8_BAR; PG8_SCHED;
            PG8_LDA(At, 1, 1); PG8_STGB(PG8_SB(1, 0), b3); PG8_STGB(PG8_SB(1, 1), b3 + hstepB); PG8_STG(PG8_SA(1, 0), a3, vc00, vc01);
            PG8_WAIT_V(8); PG8_WAIT_L(0); PG8_BAR; PG8_MMA(1, 0, At, B0); PG8_MMA(1, 1, At, B1); PG8_BAR; PG8_SCHED;
            if constexpr (Epi::HAS_MID) { if (t == 0) { E.mid(acc, cur, wr, wc, fr, fq); PG8_SCHED; } }
        }
        if constexpr (ALIGN_EPI) { if (wr == 0) PG8_BAR; }
        PG8_SCHED; E(acc, cur, wr, wc, fr, fq); PG8_SCHED;
        if (!has_next) break;
#pragma unroll
        for (int a = 0; a < 2; ++a)
#pragma unroll
            for (int b = 0; b < 2; ++b)
#pragma unroll
                for (int m = 0; m < 4; ++m)
#pragma unroll
                    for (int n = 0; n < 2; ++n) acc[a][b][m][n] = (f32x4){0.f, 0.f, 0.f, 0.f};
        cur = nxt; cA = nA; cB = nB; ++ui;
        if constexpr (ALIGN_EPI) { if (wr == 1) PG8_BAR; }
    }
    PG8_WAIT_V(0);
    if constexpr (!ALIGN_EPI) { if (wr == 0) PG8_BAR; }
    PG8_BAR;
#undef PG8_SA
#undef PG8_SB
#undef PG8_STG
#undef PG8_STGX
#undef PG8_STGB
#undef PG8_LDA
#undef PG8_LDB
#undef PG8_MMA
#undef PG8_WAIT_V
#undef PG8_WAIT_L
#undef PG8_BAR
#undef PG8_SCHED
#undef PG8_AOFF
}
}
namespace pg8 {
DI u32x4 pack8(const f32x4 v0, const f32x4 v1) { u32x4 w; w.x = pk2(v0[0], v0[1]); w.y = pk2(v0[2], v0[3]); w.z = pk2(v1[0], v1[1]); w.w = pk2(v1[2], v1[3]); return w; }

DI void rstd4_load(f32x4 (&p)[4], const float* ssq16, int row0, int fq) {
#pragma unroll
    for (int m = 0; m < 4; ++m) p[m] = *(const f32x4*)(ssq16 + (size_t)(row0 + m * 16) * 16 + 4 * fq);
}
DI float rstd_finish(const f32x4 p, int lane) { float s = (p[0] + p[1]) + (p[2] + p[3]); s += shx(s, 16, lane); s += shx(s, 32, lane); return __builtin_amdgcn_rsqf(s * (1.0f / D) + RMS_EPS); }
#define EPI_FENCE() asm volatile("" ::: "memory")

struct EpiInProj {
    static constexpr bool PERM = true, TWICE_OK = true, HAS_MID = false;
    const float* ssq16; bf16 *Q, *K, *V, *U, *G;
    DI void operator()(const f32x4 (&acc)[2][2][4][2], const Unit& u, int wr, int wc, int fr, int fq) const {
        const int row0 = u.pm * BM + wr * 64 + fr, cw = wc * 32 + 8 * fq;
        const int pn = u.pn;
        bf16* base0; bf16* base1; int ldc, col0, col1, mode;
        if (pn < 4) { base0 = base1 = Q; ldc = D; col0 = pn * 256 + cw; col1 = col0 + HALF; mode = 1; }
        else if (pn == 4) { base0 = K; base1 = V; ldc = KVW; col0 = col1 = cw; mode = 0; }
        else if (pn < 7) { base0 = base1 = U + (size_t)(NMETA * ((u.pm >> 5) + 1)) * POOLW; ldc = POOLW; col0 = (pn - 5) * 256 + cw; col1 = col0 + HALF; mode = 0; }
        else { base0 = base1 = G; ldc = 2 * D; col0 = (pn - 7) * 256 + cw; col1 = col0 + HALF; mode = 2; }
        f32x4 pp[2][4]; rstd4_load(pp[0], ssq16, row0, fq); rstd4_load(pp[1], ssq16, row0 + HALF, fq);
#pragma unroll
        for (int ai = 0; ai < 2; ++ai) {
#pragma unroll
            for (int m = 0; m < 4; ++m) {
                const int row = row0 + ai * HALF + m * 16;
                const float sc = rstd_finish(pp[ai][m], fq * 16 + fr) * (mode == 1 ? QSCALE : 1.f);
#pragma unroll
                for (int bj = 0; bj < 2; ++bj) {
                    f32x4 v0, v1;
                    if (mode == 2) { const float nsl2 = -sc * LOG2E;
#pragma unroll
                        for (int j = 0; j < 4; ++j) { v0[j] = 0.f; v1[j] = 0.f; }
                        f32x4 t0 = acc[ai][bj][m][0] * nsl2, t1 = acc[ai][bj][m][1] * nsl2;
#pragma unroll
                        for (int j = 0; j < 4; ++j) { t0[j] = __builtin_amdgcn_exp2f(t0[j]); t1[j] = __builtin_amdgcn_exp2f(t1[j]); }
                        { float one_ = 1.0f; asm volatile("" : "+s"(one_)); t0 = t0 + one_; t1 = t1 + one_; }
#pragma unroll
                        for (int j = 0; j < 4; ++j) { v0[j] = __builtin_amdgcn_rcpf(t0[j]); v1[j] = __builtin_amdgcn_rcpf(t1[j]); }
                    } else { v0 = acc[ai][bj][m][0] * sc; v1 = acc[ai][bj][m][1] * sc; }
                    *(u32x4*)((bj ? base1 : base0) + (size_t)row * ldc + (bj ? col1 : col0)) = pack8(v0, v1);
                }
            }
            EPI_FENCE();
        }
    }
};
struct EpiMerge {
    static constexpr bool PERM = true, TWICE_OK = false, HAS_MID = true;
    const bf16* G; bf16* MRG;
    DI void mid(f32x4 (&acc)[2][2][4][2], const Unit& u, int wr, int wc, int fr, int fq) const {
        const int row0 = u.pm * BM + wr * 64 + fr, col0 = u.pn * BM + wc * 32 + 8 * fq;
#pragma unroll
        for (int ai = 0; ai < 2; ++ai) {
            u32x4 g0[4][2], g1[4][2];
#pragma unroll
            for (int m = 0; m < 4; ++m)
#pragma unroll
                for (int bj = 0; bj < 2; ++bj) { const bf16* gp = G + (size_t)(row0 + ai * HALF + m * 16) * (2 * D) + col0 + bj * HALF; g0[m][bj] = *(const u32x4*)gp; g1[m][bj] = *(const u32x4*)(gp + D); }
#pragma unroll
            for (int m = 0; m < 4; ++m)
#pragma unroll
                for (int bj = 0; bj < 2; ++bj) { const u32x4 a = g0[m][bj], b = g1[m][bj];
#define MRG_RC(x, lohi) __builtin_amdgcn_rcpf(__builtin_fmaxf(lohi(x), 1e-30f))
                    const f32x4 r0 = {MRG_RC(a.x, bflo), MRG_RC(a.x, bfhi), MRG_RC(a.y, bflo), MRG_RC(a.y, bfhi)}, r1 = {MRG_RC(a.z, bflo), MRG_RC(a.z, bfhi), MRG_RC(a.w, bflo), MRG_RC(a.w, bfhi)};
                    const f32x4 h0 = {bflo(b.x), bfhi(b.x), bflo(b.y), bfhi(b.y)}, h1 = {bflo(b.z), bfhi(b.z), bflo(b.w), bfhi(b.w)};
                    acc[ai][bj][m][0] = acc[ai][bj][m][0] * (h0 * r0); acc[ai][bj][m][1] = acc[ai][bj][m][1] * (h1 * r1);
#undef MRG_RC
                }
            EPI_FENCE();
        }
    }
    DI void operator()(const f32x4 (&acc)[2][2][4][2], const Unit& u, int wr, int wc, int fr, int fq) const {
        const int row0 = u.pm * BM + wr * 64 + fr, col0 = u.pn * BM + wc * 32 + 8 * fq;
        u32x4 ga[2][4][2];
#pragma unroll
        for (int ai = 0; ai < 2; ++ai)
#pragma unroll
            for (int m = 0; m < 4; ++m)
#pragma unroll
                for (int bj = 0; bj < 2; ++bj) ga[ai][m][bj] = *(const u32x4*)(G + (size_t)(row0 + ai * HALF + m * 16) * (2 * D) + col0 + bj * HALF);
        EPI_FENCE();
#pragma unroll
        for (int ai = 0; ai < 2; ++ai) {
#pragma unroll
            for (int m = 0; m < 4; ++m) { const size_t r = (size_t)(row0 + ai * HALF + m * 16);
#pragma unroll
                for (int bj = 0; bj < 2; ++bj) { const u32x4 gg = ga[ai][m][bj];
                    f32x4 v0 = acc[ai][bj][m][0], v1 = acc[ai][bj][m][1];
#define MRG_G(x, lohi) __builtin_fmaxf(lohi(x), 1e-30f)
                    const f32x4 q0 = {MRG_G(gg.x, bflo), MRG_G(gg.x, bfhi), MRG_G(gg.y, bflo), MRG_G(gg.y, bfhi)}, q1 = {MRG_G(gg.z, bflo), MRG_G(gg.z, bfhi), MRG_G(gg.w, bflo), MRG_G(gg.w, bfhi)};
                    v0 = v0 * q0; v1 = v1 * q1;
#undef MRG_G
                    *(u32x4*)(MRG + r * D + col0 + bj * HALF) = pack8(v0, v1); } }
            EPI_FENCE();
        }
    }
};
struct EpiResid {
    static constexpr bool PERM = true, TWICE_OK = false, HAS_MID = false;
    bf16* HB; float* ssq16;
    DI void operator()(const f32x4 (&acc)[2][2][4][2], const Unit& u, int wr, int wc, int fr, int fq) const {
        const int row0 = u.pm * BM + wr * 64 + fr, col0 = u.pn * BM + wc * 32 + 8 * fq;
        u32x4 hva[2][4][2];
#pragma unroll
        for (int ai = 0; ai < 2; ++ai)
#pragma unroll
            for (int m = 0; m < 4; ++m)
#pragma unroll
                for (int bj = 0; bj < 2; ++bj) hva[ai][m][bj] = *(const u32x4*)(HB + (size_t)(row0 + ai * HALF + m * 16) * D + col0 + bj * HALF);
        EPI_FENCE();
#pragma unroll
        for (int ai = 0; ai < 2; ++ai) {
#pragma unroll
            for (int m = 0; m < 4; ++m) { const size_t r = (size_t)(row0 + ai * HALF + m * 16); float s = 0.f;
#pragma unroll
                for (int bj = 0; bj < 2; ++bj) { const u32x4 h = hva[ai][m][bj];
                    const f32x4 h0 = {bflo(h.x), bfhi(h.x), bflo(h.y), bfhi(h.y)}, h1 = {bflo(h.z), bfhi(h.z), bflo(h.w), bfhi(h.w)};
                    const f32x4 v0 = acc[ai][bj][m][0] + h0, v1 = acc[ai][bj][m][1] + h1;
                    const u32x4 w = pack8(v0, v1); *(u32x4*)(HB + r * D + col0 + bj * HALF) = w;
                    const f32x4 q0 = {bflo(w.x), bfhi(w.x), bflo(w.y), bfhi(w.y)}, q1 = {bflo(w.z), bfhi(w.z), bflo(w.w), bfhi(w.w)};
                    const f32x4 qq = q0 * q0 + q1 * q1; s += (qq[0] + qq[1]) + (qq[2] + qq[3]); }
                s += shx(s, 16, fq * 16 + fr); s += shx(s, 32, fq * 16 + fr);
                if (fq == 0) ssq16[r * 16 + 4 * u.pn + wc] = s; }
            EPI_FENCE();
        }
    }
};
template <bool MOE> struct EpiSwiGLU {
    static constexpr bool PERM = true, TWICE_OK = false, HAS_MID = false;
    const float* rsrc; bf16* ACT; int nkt;
    DI void operator()(const f32x4 (&acc)[2][2][4][2], const Unit& u, int wr, int wc, int fr, int fq) const {
        const int row0 = u.pm * BM + wr * 64 + fr;
        bf16* abase = ACT + ((size_t)(u.pm * nkt + 2 * u.pn + (wc >> 1)) * 256 + (wr * 64 + fr)) * 64 + (wc & 1) * 32 + 8 * fq;
        f32x4 pp[2][4]; float rsv[2][4];
        if (MOE) {
#pragma unroll
            for (int ai = 0; ai < 2; ++ai)
#pragma unroll
                for (int m = 0; m < 4; ++m) rsv[ai][m] = rsrc[row0 + ai * HALF + m * 16];
        } else { rstd4_load(pp[0], rsrc, row0, fq); rstd4_load(pp[1], rsrc, row0 + HALF, fq); }
#pragma unroll
        for (int ai = 0; ai < 2; ++ai) {
#pragma unroll
            for (int m = 0; m < 4; ++m) { const int r = row0 + ai * HALF + m * 16;
                const float rs = MOE ? rsv[ai][m] : rstd_finish(pp[ai][m], fq * 16 + fr); const float rs2 = rs * rs, nsl2 = -rs * LOG2E;
                f32x4 o[2];
#pragma unroll
                for (int n = 0; n < 2; ++n) { const f32x4 g = acc[ai][0][m][n], u = acc[ai][1][m][n];
                    f32x4 t = g * nsl2, r;
#pragma unroll
                    for (int j = 0; j < 4; ++j) t[j] = __builtin_amdgcn_exp2f(t[j]);
                    { float one_ = 1.0f; asm volatile("" : "+s"(one_)); t = t + one_; }
#pragma unroll
                    for (int j = 0; j < 4; ++j) r[j] = __builtin_amdgcn_rcpf(t[j]);
                    o[n] = (g * u) * (r * rs2); }
                *(u32x4*)(abase + (ai * HALF + m * 16) * 64) = pack8(o[0], o[1]); }
            EPI_FENCE();
        }
    }
};
struct EpiSwiGLU8 {
    static constexpr bool PERM = true, TWICE_OK = false, HAS_MID = false;
    const float* slot_rs; unsigned char* ACT8;
    DI void operator()(const f32x4 (&acc)[2][2][4][2], const Unit& u, int wr, int wc, int fr, int fq) const {
        const int row0 = wr * 64 + fr;
        unsigned char* base = ACT8 + ((size_t)(u.pm * (DFE / 128) + u.pn) * 256 + row0) * 128 + wc * 32 + 8 * fq;
        float rsv[2][4];
#pragma unroll
        for (int ai = 0; ai < 2; ++ai)
#pragma unroll
            for (int m = 0; m < 4; ++m) rsv[ai][m] = slot_rs[u.pm * BM + row0 + ai * HALF + m * 16];
#pragma unroll
        for (int ai = 0; ai < 2; ++ai) {
#pragma unroll
            for (int m = 0; m < 4; ++m) { const float rs = rsv[ai][m] * (1.0f / W8_GU), rs2 = rs * rs, nsl2 = -rs * LOG2E;
                f32x4 o[2];
#pragma unroll
                for (int n = 0; n < 2; ++n) { const f32x4 g = acc[ai][0][m][n], u = acc[ai][1][m][n];
                    f32x4 t = g * nsl2, r;
#pragma unroll
                    for (int j = 0; j < 4; ++j) t[j] = __builtin_amdgcn_exp2f(t[j]);
                    { float one_ = 1.0f; asm volatile("" : "+s"(one_)); t = t + one_; }
#pragma unroll
                    for (int j = 0; j < 4; ++j) r[j] = __builtin_amdgcn_rcpf(t[j]);
                    o[n] = (g * u) * (r * rs2); }
                u32x2 w; w.x = pk4_fp8(o[0][0], o[0][1], o[0][2], o[0][3]); w.y = pk4_fp8(o[1][0], o[1][1], o[1][2], o[1][3]);
                *(u32x2*)(base + (size_t)(ai * HALF + m * 16) * 128) = w; }
            EPI_FENCE();
        }
    }
};
struct EpiMoeDown {
    static constexpr bool PERM = true, TWICE_OK = false, HAS_MID = false;
    const bf16* SRC; bf16* DST; const int* slot_tok; const float* slot_w; float scale;
    DI void operator()(const f32x4 (&acc)[2][2][4][2], const Unit& u, int wr, int wc, int fr, int fq) const {
        const int row0 = u.pm * BM + wr * 64 + fr, col0 = u.pn * BM + wc * 32 + 8 * fq;
        int tk[2][4]; float wk[2][4];
#pragma unroll
        for (int ai = 0; ai < 2; ++ai)
#pragma unroll
            for (int m = 0; m < 4; ++m) { tk[ai][m] = slot_tok[row0 + ai * HALF + m * 16]; wk[ai][m] = slot_w[row0 + ai * HALF + m * 16] * scale; }
        u32x4 hva[2][4][2];
#pragma unroll
        for (int ai = 0; ai < 2; ++ai)
#pragma unroll
            for (int m = 0; m < 4; ++m) { const int tok = tk[ai][m] < 0 ? 0 : tk[ai][m];
#pragma unroll
                for (int bj = 0; bj < 2; ++bj) hva[ai][m][bj] = *(const u32x4*)(SRC + (size_t)tok * D + col0 + bj * HALF); }
        EPI_FENCE();
#pragma unroll
        for (int ai = 0; ai < 2; ++ai) {
#pragma unroll
            for (int m = 0; m < 4; ++m) { const int tok = tk[ai][m]; const float w = wk[ai][m];
                if (tok >= 0) {
#pragma unroll
                    for (int bj = 0; bj < 2; ++bj) { const u32x4 h = hva[ai][m][bj];
                        const f32x4 h0 = {bflo(h.x), bfhi(h.x), bflo(h.y), bfhi(h.y)}, h1 = {bflo(h.z), bfhi(h.z), bflo(h.w), bfhi(h.w)};
                        const f32x4 v0 = acc[ai][bj][m][0] * w + h0, v1 = acc[ai][bj][m][1] * w + h1;
                        *(u32x4*)(DST + (size_t)tok * D + col0 + bj * HALF) = pack8(v0, v1); } } }
            EPI_FENCE();
        }
    }
};
struct EpiSlab {
    static constexpr bool PERM = false, TWICE_OK = false, HAS_MID = false;
    float* slab; int pass;
    DI void operator()(const f32x4 (&acc)[2][2][4][2], const Unit& u, int wr, int wc, int fr, int fq) const {
        float* base = slab + ((size_t)(u.pm * NSL + 2 * u.kq + pass) * BM + wr * 64 + fr) * D + u.pn * BM + wc * 32 + 4 * fq;
#pragma unroll
        for (int ai = 0; ai < 2; ++ai)
#pragma unroll
            for (int m = 0; m < 4; ++m)
#pragma unroll
                for (int bj = 0; bj < 2; ++bj)
#pragma unroll
                    for (int n = 0; n < 2; ++n) *(f32x4*)(base + (size_t)(ai * HALF + m * 16) * D + bj * HALF + n * 16) = acc[ai][bj][m][n];
    }
};
}
namespace att {
constexpr int KS_OFF = 0, KROW = 144, VT_OFF = 36864, VROW = 520, KM_OFF = 70144, VTM_OFF = 74752, VMROW = 72, RAWK_OFF = 79872, RAWV_OFF = RAWK_OFF + 32768, LDS_END = RAWV_OFF + 32768;
static_assert(LDS_END <= RING_BYTES, "attention LDS");
DI int crow(int i, int h) { return (i & 3) + 8 * (i >> 2) + 4 * h; }
struct Args { const bf16 *Q, *K, *V, *U, *KM, *VM, *UM; const float* sinks; bf16* O; };
#define MFMA32(a, b, c) __builtin_amdgcn_mfma_f32_32x32x16_bf16((a), (b), (c), 0, 0, 0)
template <int WIN> DI void pool_load(unsigned (&xs)[47], const bf16* U, unsigned urow0, int col) {
    const char* ub = (const char*)U; const unsigned off0 = ((urow0 - (unsigned)(WIN - 1)) * POOLW + (unsigned)col) * 2u;
#pragma unroll
    for (int i = 0; i < 31 + WIN; ++i) xs[i] = *(const unsigned*)(ub + (off0 + (unsigned)i * (POOLW * 2u)));
}
template <int WIN> DI void pool_store(const unsigned (&xs)[47], bf16* OP, unsigned prow0, int col) {
    char* pb = (char*)OP + ((size_t)(((prow0 >> 8) * 24u + (unsigned)(col >> 6)) * 256u + (prow0 & 255u)) * 128u + (unsigned)(col & 63) * 2u);
    float a0 = 0.f, a1 = 0.f; const float invw = 1.0f / (float)WIN;
#pragma unroll
    for (int j = 0; j < WIN - 1; ++j) { a0 += bflo(xs[j]); a1 += bfhi(xs[j]); }
#pragma unroll
    for (int t = 0; t < 32; ++t) { const float x0 = bflo(xs[WIN - 1 + t]), x1 = bfhi(xs[WIN - 1 + t]); a0 += x0; a1 += x1;
        *(unsigned*)(pb + t * 128) = pk2(a0 * invw - x0, a1 * invw - x1);
        a0 -= bflo(xs[t]); a1 -= bfhi(xs[t]); }
}
DI void phase(LAS unsigned char* lds, const Args& A, int c, int G, int tid0) {
    asm volatile("" : "+v"(tid0));
    const int wid = __builtin_amdgcn_readfirstlane(tid0 >> 6);
    constexpr int NUNIT = NB * 64 * NKV;
    if (c >= NUNIT) return;
    bf16x8 qa[4], qb[4];
#define ATT_DECODE(L_, b_, nb_, kh_) const int b_ = (L_) >> 7, nb_ = ((L_) >> 1) & 63, kh_ = (L_) & 1
#define ATT_LOAD_KV(L_) do { ATT_DECODE(L_, b2, nb2, kh2); const size_t rb2 = (size_t)b2 * SEQ; const int s02 = (nb2 - 1) * 128; \
        _Pragma("unroll") for (int pass = 0; pass < 4; ++pass) { const int s = s02 + (tid >> 3) + 64 * pass; \
            kv[pass] = *(const u32x4*)(A.K + (rb2 + (size_t)(s < 0 ? 0 : s)) * KVW + kh2 * 64 + 8 * (tid & 7)); } \
        _Pragma("unroll") for (int pass = 0; pass < 4; ++pass) { const int s = s02 + lane + 64 * pass; \
            vv[pass] = *(const u32x4*)(A.V + (rb2 + (size_t)(s < 0 ? 0 : s)) * KVW + kh2 * 64 + 8 * wid); } } while (0)
#define ATT_DMA_KV(L_) do { ATT_DECODE(L_, b2, nb2, kh2); const size_t rb2 = (size_t)b2 * SEQ; const int s02 = (nb2 - 1) * 128; \
        _Pragma("unroll") for (int pass = 0; pass < 4; ++pass) { const int s = s02 + (tid >> 3) + 64 * pass; const size_t go = (rb2 + (size_t)(s < 0 ? 0 : s)) * KVW + kh2 * 64 + 8 * (tid & 7); \
            __builtin_amdgcn_global_load_lds((const unsigned*)(A.K + go), (LAS unsigned*)(lds + RAWK_OFF + (pass * 512 + wid * 64) * 16), 16, 0, 0); \
            __builtin_amdgcn_global_load_lds((const unsigned*)(A.V + go), (LAS unsigned*)(lds + RAWV_OFF + (pass * 512 + wid * 64) * 16), 16, 0, 0); } } while (0)
#define ATT_RAW_KV() do { _Pragma("unroll") for (int pass = 0; pass < 4; ++pass) { kv[pass] = *(const LAS u32x4*)(lds + RAWK_OFF + (pass * 512 + tid) * 16); \
            vv[pass] = *(const LAS u32x4*)(lds + RAWV_OFF + ((lane + 64 * pass) * 8 + wid) * 16); } } while (0)
#define ATT_LOAD_Q(dst, L_, qs_) do { ATT_DECODE(L_, b2, nb2, kh2); const bf16* qp = A.Q + ((size_t)b2 * SEQ + (size_t)(nb2 * 128 + 32 * (qs_) + r)) * D + (kh2 * QG + wid) * HD + 8 * h; \
        _Pragma("unroll") for (int d0 = 0; d0 < 4; ++d0) dst[d0] = *(const bf16x8*)(qp + 16 * d0); } while (0)
    { const int tid = tid0, lane = tid & 63, r = lane & 31, h = lane >> 5; ATT_LOAD_Q(qa, c, 0); }
    for (int L = c; L < NUNIT; L += G) {
        int tid = tid0; asm volatile("" : "+v"(tid));
        const int lane = tid & 63, r = lane & 31, h = lane >> 5;
        ATT_DECODE(L, b, nb, kh);
        const size_t rowb = (size_t)b * SEQ;
        const int head = kh * QG + wid;
        const bool has_next = (L + G) < NUNIT;
        const float slope2 = __builtin_amdgcn_exp2f(-0.5f * (float)(head + 1)) * LOG2E, sink2 = A.sinks[head] * LOG2E;
        const int pg = 2 * kh + (wid & 1), pcol = 128 * pg + 2 * lane;
        const unsigned prow0 = (unsigned)(b * SEQ + nb * 128 + 32 * (wid >> 1)), urow0 = prow0 + (unsigned)(NMETA * (b + 1));
        unsigned xs[47];
        if (pg == 0) pool_load<2>(xs, A.U, urow0, pcol); else if (pg == 1) pool_load<4>(xs, A.U, urow0, pcol);
        else if (pg == 2) pool_load<8>(xs, A.U, urow0, pcol); else pool_load<16>(xs, A.U, urow0, pcol);
        __builtin_amdgcn_sched_barrier(0);
        u32x4 kv[4], vv[4];
        if (L == c) ATT_LOAD_KV(L); else ATT_RAW_KV();
#pragma unroll
        for (int pass = 0; pass < 4; ++pass) { const int j = (tid >> 3) + 64 * pass, cc = tid & 7; *(LAS u32x4*)(lds + KS_OFF + j * KROW + 16 * cc) = kv[pass]; }
#pragma unroll
        for (int pass = 0; pass < 4; ++pass) { const int j = lane + 64 * pass;
#pragma unroll
            for (int jj = 0; jj < 8; ++jj) { const unsigned w = vv[pass][jj >> 1]; ((LAS unsigned short*)(lds + VT_OFF + (8 * wid + jj) * VROW))[j] = (unsigned short)((jj & 1) ? (w >> 16) : (w & 0xffffu)); } }
        if (L == c) {
            u32x4 kmv = *(const u32x4*)(A.KM + (size_t)((tid >> 3) & (NMETA - 1)) * KVW + kh * 64 + 8 * (tid & 7));
            if (tid >= 8 * NMETA) kmv = (u32x4){0u, 0u, 0u, 0u};
            if (tid < 256) *(LAS u32x4*)(lds + KM_OFF + (tid >> 3) * KROW + 16 * (tid & 7)) = kmv;
            const int d = tid & 63, kg = tid >> 6;
#pragma unroll
            for (int kk = 0; kk < 4; ++kk) { const int key = 4 * kg + kk; unsigned short val = A.VM[(size_t)(key & (NMETA - 1)) * KVW + kh * 64 + d]; if (key >= NMETA) val = 0;
                ((LAS unsigned short*)(lds + VTM_OFF + d * VMROW))[key] = val; }
        }
        __syncthreads();
        if (pg == 0) pool_store<2>(xs, A.O, prow0, pcol); else if (pg == 1) pool_store<4>(xs, A.O, prow0, pcol);
        else if (pg == 2) pool_store<8>(xs, A.O, prow0, pcol); else pool_store<16>(xs, A.O, prow0, pcol);
        __builtin_amdgcn_sched_barrier(0);
        if (has_next) ATT_DMA_KV(L + G);
        __builtin_amdgcn_sched_barrier(0);
        f32x16 Bb;
#pragma unroll
        for (int i = 0; i < 16; ++i) Bb[i] = -slope2 * (float)(128 - crow(i, h) + r);
#define ATT_BB(i) Bb[i]
#pragma unroll
        for (int qs = 0; qs < 4; ++qs) {
            bf16x8 (&qr)[4] = (qs & 1) ? qb : qa;
            if (qs == 0) ATT_LOAD_Q(qb, L, 1); else if (qs == 1) ATT_LOAD_Q(qa, L, 2); else if (qs == 2) ATT_LOAD_Q(qb, L, 3); else if (has_next) ATT_LOAD_Q(qa, L + G, 0);
            __builtin_amdgcn_sched_barrier(0);
            const int qrow = nb * 128 + 32 * qs + r;
            float mx = sink2, lsum = 0.f;
            f32x16 o[2]; o[0] = (f32x16){}; o[1] = (f32x16){};
#define ATT_QK(S_, kt_) do { const LAS unsigned char* kp_ = lds + KS_OFF + (32 * (kt_) + r) * KROW + 16 * h; \
                _Pragma("unroll") for (int d0 = 0; d0 < 4; ++d0) S_ = MFMA32(*(const LAS bf16x8*)(kp_ + 32 * d0), qr[d0], S_); } while (0)
#define ATT_MAX3(a_, b_, c_) fmaxf(fmaxf(a_, b_), c_)
#define ATT_MAX16(S_) ATT_MAX3(ATT_MAX3(ATT_MAX3(S_[0], S_[1], S_[2]), ATT_MAX3(S_[3], S_[4], S_[5]), ATT_MAX3(S_[6], S_[7], S_[8])), ATT_MAX3(S_[9], S_[10], S_[11]), ATT_MAX3(ATT_MAX3(S_[12], S_[13], S_[14]), S_[15], S_[15]))
#define ATT_SUM16(P_) do { const f32x2 a_ = ((f32x2){P_[0], P_[1]} + (f32x2){P_[2], P_[3]}) + ((f32x2){P_[4], P_[5]} + (f32x2){P_[6], P_[7]}), b_ = ((f32x2){P_[8], P_[9]} + (f32x2){P_[10], P_[11]}) + ((f32x2){P_[12], P_[13]} + (f32x2){P_[14], P_[15]}); \
                const f32x2 c_ = a_ + b_; lsum += c_[0] + c_[1]; } while (0)
#define ATT_RESCALE(tmax_) do { if ((tmax_) - 8.0f > mx) { const float alpha = __builtin_amdgcn_exp2f(mx - (tmax_)); mx = (tmax_); lsum *= alpha; \
                _Pragma("unroll") for (int i = 0; i < 16; ++i) { o[0][i] *= alpha; o[1][i] *= alpha; } } } while (0)
#define ATT_PV(P_, kt_, s_) do { u32x4 pw; pw.x = pk2(P_[8 * (s_)], P_[8 * (s_) + 1]); pw.y = pk2(P_[8 * (s_) + 2], P_[8 * (s_) + 3]); pw.z = pk2(P_[8 * (s_) + 4], P_[8 * (s_) + 5]); pw.w = pk2(P_[8 * (s_) + 6], P_[8 * (s_) + 7]); \
                const bf16x8 pf = __builtin_bit_cast(bf16x8, pw); \
                _Pragma("unroll") for (int db = 0; db < 2; ++db) { const LAS unsigned char* vp = lds + VT_OFF + (32 * db + r) * VROW + (32 * (kt_) + 16 * (s_) + 4 * h) * 2; \
                    const s16x4 lo = *(const LAS s16x4*)vp, hi = *(const LAS s16x4*)(vp + 16); o[db] = MFMA32(__builtin_shufflevector(lo, hi, 0, 1, 2, 3, 4, 5, 6, 7), pf, o[db]); } } while (0)
#pragma unroll
            for (int tt = 1; tt < 4; ++tt) {
                if (nb == 0 && qs + tt < 4) continue;
                f32x16 S;
#pragma unroll
                for (int i = 0; i < 16; ++i) S[i] = ATT_BB(i);
                ATT_QK(S, qs + tt);
                const float shift = (32.0f * (float)tt) * slope2;
                float tmax = ATT_MAX16(S); tmax = fmaxf(tmax, shx(tmax, 32, lane)) + shift;
                ATT_RESCALE(tmax);
                const float mxs = mx - shift;
                { const float nm_ = -mxs; S = S + nm_; }
#pragma unroll
                for (int i = 0; i < 16; ++i) S[i] = __builtin_amdgcn_exp2f(S[i]);
                ATT_SUM16(S);
                ATT_PV(S, qs + tt, 0); ATT_PV(S, qs + tt, 1);
            }
            {
                const bool t0ok = !(nb == 0 && qs < 4);
                f32x16 S0, S4;
#pragma unroll
                for (int i = 0; i < 16; ++i) { S0[i] = ATT_BB(i); S4[i] = ATT_BB(i); }
                if (t0ok) ATT_QK(S0, qs);
                ATT_QK(S4, qs + 4);
                const float sh4 = 128.0f * slope2;
                S4 = S4 + sh4;
#pragma unroll
                for (int i = 0; i < 16; ++i) { const bool lo_ = crow(i, h) > r; S4[i] = lo_ ? (t0ok ? S0[i] : -1e30f) : S4[i]; }
                float tmax = ATT_MAX16(S4); tmax = fmaxf(tmax, shx(tmax, 32, lane));
                ATT_RESCALE(tmax);
                { const float nm_ = -mx; S4 = S4 + nm_; }
#pragma unroll
                for (int i = 0; i < 16; ++i) S4[i] = __builtin_amdgcn_exp2f(S4[i]);
                ATT_SUM16(S4);
#pragma unroll
                for (int i = 0; i < 16; ++i) { const bool lo_ = crow(i, h) > r; S0[i] = lo_ ? S4[i] : 0.f; }
                S4 = S4 - S0;
                if (t0ok) { ATT_PV(S0, qs, 0); ATT_PV(S0, qs, 1); }
                ATT_PV(S4, qs + 4, 0); ATT_PV(S4, qs + 4, 1);
            }
            {
                f32x16 S;
#pragma unroll
                for (int i = 0; i < 16; ++i) S[i] = (i < 8) ? -slope2 * (float)(NMETA - crow(i, h)) : 0.f;
                { const LAS unsigned char* kp_ = lds + KM_OFF + r * KROW + 16 * h;
#pragma unroll
                  for (int d0 = 0; d0 < 4; ++d0) S = MFMA32(*(const LAS bf16x8*)(kp_ + 32 * d0), qr[d0], S); }
                const float shift = -slope2 * (float)qrow;
                float tmax = fmaxf(fmaxf(fmaxf(S[0], S[1]), fmaxf(S[2], S[3])), fmaxf(fmaxf(S[4], S[5]), fmaxf(S[6], S[7])));
                tmax = fmaxf(tmax, shx(tmax, 32, lane)) + shift;
                ATT_RESCALE(tmax);
                const float mxs = mx - shift;
#pragma unroll
                for (int i = 0; i < 8; ++i) { const float p = __builtin_amdgcn_exp2f(S[i] - mxs); S[i] = p; lsum += p; }
                u32x4 pw; pw.x = pk2(S[0], S[1]); pw.y = pk2(S[2], S[3]); pw.z = pk2(S[4], S[5]); pw.w = pk2(S[6], S[7]);
                const bf16x8 pf = __builtin_bit_cast(bf16x8, pw);
#pragma unroll
                for (int db = 0; db < 2; ++db) { const LAS unsigned char* vp = lds + VTM_OFF + (32 * db + r) * VMROW + (4 * h) * 2;
                    const s16x4 lo = *(const LAS s16x4*)vp, hi = *(const LAS s16x4*)(vp + 16); o[db] = MFMA32(__builtin_shufflevector(lo, hi, 0, 1, 2, 3, 4, 5, 6, 7), pf, o[db]); }
            }
#undef ATT_QK
#undef ATT_MAX16
#undef ATT_RESCALE
#undef ATT_SUM16
#undef ATT_MAX3
#undef ATT_PV
            lsum += shx(lsum, 32, lane);
            lsum += __builtin_amdgcn_exp2f(sink2 - mx);
            const float inv = 1.0f / lsum;
            const unsigned orow = (unsigned)rowb + (unsigned)qrow;
            bf16* op = A.O + ((size_t)(((orow >> 8) * 24u + 8u + (unsigned)head) * 256u + (orow & 255u))) * 64;
            o[0] = o[0] * inv; o[1] = o[1] * inv;
#pragma unroll
            for (int db = 0; db < 2; ++db)
#pragma unroll
                for (int j = 0; j < 2; ++j) { const int g0 = 2 * j, g1 = 2 * j + 1;
                    const unsigned w0x = pk2(o[db][4 * g0], o[db][4 * g0 + 1]), w0y = pk2(o[db][4 * g0 + 2], o[db][4 * g0 + 3]);
                    const unsigned w1x = pk2(o[db][4 * g1], o[db][4 * g1 + 1]), w1y = pk2(o[db][4 * g1 + 2], o[db][4 * g1 + 3]);
                    const auto rx = __builtin_amdgcn_permlane32_swap(w1x, w0x, false, false), ry = __builtin_amdgcn_permlane32_swap(w1y, w0y, false, false);
                    u32x4 w; w.x = rx[0]; w.y = ry[0]; w.z = rx[1]; w.w = ry[1];
                    *(u32x4*)(op + 32 * db + 8 * (h ? g0 : g1)) = w; }
        }
        asm volatile("s_waitcnt vmcnt(8)" ::: "memory");
        __syncthreads();
    }
#undef ATT_DECODE
#undef ATT_BB
#undef ATT_LOAD_KV
#undef ATT_DMA_KV
#undef ATT_RAW_KV
#undef ATT_LOAD_Q
}
}
constexpr int NWAVES = 8;
struct Args { const float* in[18]; float* out; unsigned char* ws; int ph_lo, ph_hi; };
struct Frame {
    LAS unsigned char* lds;
    int tid, lane, wave, vcu, G;
    float* out; unsigned char* ws;
};
#define WSP(T, off) ((T*)(F.ws + (off)))
#define METAP(T, off) ((T*)(F.ws + WS_META + (off)))
enum { I_X = 0, I_META, I_NORM_MIX, I_W_IN, I_SINKS, I_W_ATTN_BR, I_W_POOL, I_POOL_SCALE, I_W_OUT, I_NORM_FFN, I_DW_GATE, I_DW_UP, I_DW_DOWN, I_ROUTER, I_MW_GATE, I_MW_UP, I_MW_DOWN, I_NORM_FINAL };

struct TrD { const float* W; unsigned char* WT; const float* kscale; const float* nscale; float scale; int N, ldw, k0, n0, drow0, tiled_nkt, fp8; };
DI void tr_set(TrD& d, const float* W, int N, void* WT, int ldw, int it, const float* kscale, const float* nscale, int tiled_nkt) {
    const int nblk = N / 32, kb = it / nblk, nb = it % nblk;
    d.W = W; d.N = N; d.WT = (unsigned char*)WT; d.ldw = ldw; d.k0 = 64 * kb; d.n0 = 32 * nb; d.drow0 = 32 * nb; d.kscale = kscale; d.nscale = nscale; d.scale = 1.f; d.tiled_nkt = tiled_nkt; d.fp8 = 0;
}
DI void tr_set_gu(TrD& d, const float* W, int N, void* WT, int it, int up, const float* kscale) {
    tr_set(d, W, N, WT, D, it, kscale, nullptr, 0); d.drow0 = (d.n0 / 128) * 256 + up * 128 + (d.n0 % 128);
}
DI void tr_decode(TrD& d, Frame& F, const Args& A, int it) {
    constexpr int I_IN = 16 * (INW / 32), I_SQ = 16 * 32, I_PL = 2 * 8, I_DGU = 16 * (DFF / 32), I_DD = (DFF / 64) * 32, I_MGU = 16 * (DFE / 32), I_MD = (DFE / 64) * 32;
    constexpr int PER_LAYER = I_IN + I_SQ + 4 * I_PL + I_SQ, N_DENSE = 2 * I_DGU + I_DD, PER_EXP = 2 * I_MGU + I_MD;
    int r = it;
    if (r < 2 * PER_LAYER) {
        const int l = r / PER_LAYER; r -= l * PER_LAYER;
        if (r < I_IN) { tr_set(d, A.in[I_W_IN] + (size_t)l * D * INW, INW, WSP(bf16, WS_WIN) + (size_t)l * INW * D, D, r, A.in[I_NORM_MIX] + l * D, nullptr, 0); return; } r -= I_IN;
        if (r < I_SQ) { tr_set(d, A.in[I_W_ATTN_BR] + (size_t)l * D * D, D, WSP(bf16, WS_WA) + (size_t)l * D * MRGK + 128, MRGK, r, nullptr, nullptr, 0); return; } r -= I_SQ;
        if (r < 4 * I_PL) { const int g = r / I_PL; r -= g * I_PL;
            tr_set(d, A.in[I_W_POOL] + ((size_t)l * 4 + g) * 128 * 256, 256, WSP(bf16, WS_WA) + ((size_t)l * D + g * 256) * MRGK, MRGK, r, nullptr, A.in[I_POOL_SCALE] + l * D + g * 256, 0); return; } r -= 4 * I_PL;
        tr_set(d, A.in[I_W_OUT] + (size_t)l * D * D, D, WSP(bf16, WS_WO) + (size_t)l * D * D, D, r, nullptr, nullptr, 0); return;
    }
    r -= 2 * PER_LAYER;
    if (r < N_DENSE) {
        if (r < I_DGU) { tr_set_gu(d, A.in[I_DW_GATE], DFF, WSP(bf16, WS_WGU), r, 0, A.in[I_NORM_FFN]); return; } r -= I_DGU;
        if (r < I_DGU) { tr_set_gu(d, A.in[I_DW_UP], DFF, WSP(bf16, WS_WGU), r, 1, A.in[I_NORM_FFN]); return; } r -= I_DGU;
        tr_set(d, A.in[I_DW_DOWN], D, WSP(bf16, WS_WD), DFF, r, nullptr, nullptr, DFF / 64); return;
    }
    r -= N_DENSE;
    { const int e = r / PER_EXP; r -= e * PER_EXP;
        unsigned char* gu8 = WSP(unsigned char, WS_MGU) + (size_t)e * 2 * DFE * D; unsigned char* dn8 = WSP(unsigned char, WS_MD) + (size_t)e * D * DFE;
        if (r < 2 * I_MGU) { const int up = r >= I_MGU ? 1 : 0; if (up) r -= I_MGU;
            tr_set_gu(d, (up ? A.in[I_MW_UP] : A.in[I_MW_GATE]) + (size_t)e * D * DFE, DFE, gu8, r, up, A.in[I_NORM_FFN] + D); d.scale = W8_GU; d.fp8 = 1; return; }
        r -= 2 * I_MGU;
        tr_set(d, A.in[I_MW_DOWN] + (size_t)e * DFE * D, D, dn8, 0, r, nullptr, nullptr, DFE / 128); d.scale = W8_DN; d.fp8 = 1; }
}
DI void tr_load(const TrD& d, f32x2 (&wv)[16], f32x4 (&ks)[4], f32x2& nraw, int lane) {
    const float* wp = d.W + (unsigned)((d.k0 + (lane >> 4)) * d.N + d.n0 + 2 * (lane & 15));
#pragma unroll
    for (int i = 0; i < 16; ++i) wv[i] = *(const f32x2*)(wp + (unsigned)(4 * i * d.N));
    const bool hk = d.kscale != nullptr, hn = d.nscale != nullptr;
    const float* kp = (hk ? d.kscale + d.k0 : d.W) + (d.fp8 ? 16 * (lane & 3) : 8 * (lane & 7));
#pragma unroll
    for (int q = 0; q < 4; ++q) ks[q] = *(const f32x4*)(kp + ((d.fp8 || q < 2) ? 4 * q : 0));
    nraw = *(const f32x2*)((hn ? d.nscale : d.W) + d.n0 + 2 * (lane & 15));
}
DI void tr_finish(const TrD& d, const f32x2 (&wv)[16], const f32x4 (&ksr)[4], f32x2 nraw, LAS float* scr, int lane) {
    const bool hk = d.kscale != nullptr, hn = d.nscale != nullptr;
    const float ns0 = hn ? nraw[0] * d.scale : d.scale, ns1 = hn ? nraw[1] * d.scale : d.scale;
    f32x4 ks[4];
#pragma unroll
    for (int q = 0; q < 4; ++q) ks[q] = hk ? ksr[q] : (f32x4){1.f, 1.f, 1.f, 1.f};
#pragma unroll
    for (int i = 0; i < 16; ++i) { LAS float* sp = scr + (4 * i + (lane >> 4)) * 33 + 2 * (lane & 15); sp[0] = wv[i][0] * ns0; sp[1] = wv[i][1] * ns1; }
    LDS_WAIT(); asm volatile("" ::: "memory");
    if (d.fp8) {
        const int c = lane & 3;
#pragma unroll
        for (int j = 0; j < 2; ++j) { const int n = (lane + 64 * j) >> 2; const LAS float* s = scr + (16 * c) * 33 + n;
            u32x4 w; w.x = pk4_fp8(s[0 * 33] * ks[0][0], s[1 * 33] * ks[0][1], s[2 * 33] * ks[0][2], s[3 * 33] * ks[0][3]); w.y = pk4_fp8(s[4 * 33] * ks[1][0], s[5 * 33] * ks[1][1], s[6 * 33] * ks[1][2], s[7 * 33] * ks[1][3]);
            w.z = pk4_fp8(s[8 * 33] * ks[2][0], s[9 * 33] * ks[2][1], s[10 * 33] * ks[2][2], s[11 * 33] * ks[2][3]); w.w = pk4_fp8(s[12 * 33] * ks[3][0], s[13 * 33] * ks[3][1], s[14 * 33] * ks[3][2], s[15 * 33] * ks[3][3]);
            const int dr = d.drow0 + n;
            unsigned char* dst = d.tiled_nkt ? d.WT + ((size_t)((dr >> 8) * d.tiled_nkt + (d.k0 >> 7)) * 256 + (dr & 255)) * 128 + (d.k0 & 127) + 16 * c : d.WT + (size_t)dr * d.ldw + d.k0 + 16 * c;
            *(u32x4*)dst = w; }
    } else {
        const int c = lane & 7;
#pragma unroll
        for (int j = 0; j < 4; ++j) { const int n = (lane >> 3) + 8 * j; const LAS float* s = scr + (8 * c) * 33 + n;
            u32x4 o; o.x = pk2(s[0 * 33] * ks[0][0], s[1 * 33] * ks[0][1]); o.y = pk2(s[2 * 33] * ks[0][2], s[3 * 33] * ks[0][3]); o.z = pk2(s[4 * 33] * ks[1][0], s[5 * 33] * ks[1][1]); o.w = pk2(s[6 * 33] * ks[1][2], s[7 * 33] * ks[1][3]);
            const int dr = d.drow0 + n;
            bf16* dst = d.tiled_nkt ? (bf16*)d.WT + ((size_t)((dr >> 8) * d.tiled_nkt + (d.k0 >> 6)) * 256 + (dr & 255)) * 64 + 8 * c : (bf16*)d.WT + (size_t)dr * d.ldw + d.k0 + 8 * c;
            *(u32x4*)dst = o; }
    }
    LDS_WAIT(); asm volatile("" ::: "memory");
}
DI void p0_prologue(Frame& F, const Args& A) {
    LAS float* scr = (LAS float*)(F.lds + RING_OFF + F.wave * 16384);
    const int gw = F.vcu * NWAVES + F.wave, NGW = F.G * NWAVES, lane = F.lane;
    constexpr int NITEMS = 2 * (16 * (INW / 32) + 16 * 32 + 4 * 2 * 8 + 16 * 32) + (2 * 16 * (DFF / 32) + (DFF / 64) * 32) + NE * (2 * 16 * (DFE / 32) + (DFE / 64) * 32);
    if (gw < NITEMS) {
        TrD dA, dB; f32x2 wA[16], wB[16]; f32x4 kA[4], kB[4]; f32x2 nA, nB;
        int it = gw;
        tr_decode(dA, F, A, it); tr_load(dA, wA, kA, nA, lane);
#define TR_TOUCH(wc, kc, nc) { _Pragma("unroll") for (int i_ = 0; i_ < 16; ++i_) asm volatile("" : "+v"(wc[i_])); _Pragma("unroll") for (int q_ = 0; q_ < 4; ++q_) asm volatile("" : "+v"(kc[q_])); asm volatile("" : "+v"(nc)); }
#define TR_STEP(dc, wc, kc, nc, dn, wn, kn, nn) { const int itn = it + NGW; const bool more = itn < NITEMS; tr_decode(dn, F, A, more ? itn : it); tr_load(dn, wn, kn, nn, lane); __builtin_amdgcn_sched_barrier(0); TR_TOUCH(wc, kc, nc) tr_finish(dc, wc, kc, nc, scr, lane); __builtin_amdgcn_sched_barrier(0); if (!more) break; it = itn; }
        for (;;) { TR_STEP(dA, wA, kA, nA, dB, wB, kB, nB) TR_STEP(dB, wB, kB, nB, dA, wA, kA, nA) }
#undef TR_STEP
#undef TR_TOUCH
    }
    const float* x = A.in[I_X]; bf16* HB = WSP(bf16, WS_HB); float* ssq = WSP(float, WS_SSQ);
    if (gw * 4 < M) {
        f32x4 va[4][4], vb[4][4];
        int m0 = gw * 4;
#define X_LOAD(v, mm) { _Pragma("unroll") for (int q = 0; q < 4; ++q) _Pragma("unroll") for (int j = 0; j < 4; ++j) v[q][j] = *((const f32x4*)(x + (size_t)((mm) + q) * D) + lane + 64 * j); }
#define X_STEP(v, vn) { const int mn = m0 + NGW * 4; const bool more = mn < M; X_LOAD(vn, more ? mn : m0) __builtin_amdgcn_sched_barrier(0); \
            _Pragma("unroll") for (int q = 0; q < 4; ++q) { float s = 0.f; u32x2* o8 = (u32x2*)(HB + (size_t)(m0 + q) * D) + lane; \
                _Pragma("unroll") for (int j = 0; j < 4; ++j) { s += (v[q][j][0] * v[q][j][0] + v[q][j][1] * v[q][j][1]) + (v[q][j][2] * v[q][j][2] + v[q][j][3] * v[q][j][3]); u32x2 w; w.x = pk2(v[q][j][0], v[q][j][1]); w.y = pk2(v[q][j][2], v[q][j][3]); o8[64 * j] = w; } \
                s = wave_sum(s, lane); \
                if (lane < 16) ssq[(size_t)(m0 + q) * 16 + lane] = lane == 0 ? s : 0.f; } \
            if (!more) break; m0 = mn; }
        X_LOAD(va, m0)
        for (;;) { X_STEP(va, vb) X_STEP(vb, va) }
#undef X_LOAD
#undef X_STEP
    }
    for (int m = gw; m < NMETA; m += NGW) {
        const f32x4* xr = (const f32x4*)(A.in[I_META] + (size_t)m * D) + lane; f32x4* ho = (f32x4*)(METAP(float, MO_HM) + (size_t)m * D) + lane; u32x2* o8 = (u32x2*)(METAP(bf16, MO_XM) + (size_t)m * D) + lane;
#pragma unroll
        for (int j = 0; j < 4; ++j) { const f32x4 v = xr[64 * j]; ho[64 * j] = v; u32x2 w; w.x = pk2(v[0], v[1]); w.y = pk2(v[2], v[3]); o8[64 * j] = w; }
    }
}

namespace meta {
DI f32x4 tile(const bf16* X, int ldx, const bf16* Wt, int ldw, int K, int lane) {
    const int i = lane & 15, q = lane >> 4; f32x4 acc = (f32x4){0.f, 0.f, 0.f, 0.f};
    const bf16* xp = X + (size_t)i * ldx + 8 * q; const bf16* wp = Wt + (size_t)i * ldw + 8 * q;
    for (int k0 = 0; k0 < K; k0 += 32) acc = __builtin_amdgcn_mfma_f32_16x16x32_bf16(*(const bf16x8*)(wp + k0), *(const bf16x8*)(xp + k0), acc, 0, 0, 0);
    return acc;
}
template <int NST, bool SSQ, int TILED_NKT = 0> DI f32x4 tile_split(const bf16* X, int ldx, const bf16* Wt, int ldw, int wave, int lane, LAS float* scr, float& ssq) {
    const int i = lane & 15, q = lane >> 4, ks = 32 * NST;
    const bf16* xp = X + (size_t)i * ldx + wave * ks + 8 * q; const bf16* wp = Wt + (size_t)i * ldw + wave * ks + 8 * q;
    bf16x8 a[NST], b[NST];
#pragma unroll
    for (int s = 0; s < NST; ++s) { const int kk = wave * ks + 32 * s + 8 * q, wr_ = ldw + i;
        a[s] = TILED_NKT ? *(const bf16x8*)(Wt + ((size_t)((wr_ >> 8) * TILED_NKT + (kk >> 6)) * 256 + (wr_ & 255)) * 64 + (kk & 63)) : *(const bf16x8*)(wp + 32 * s);
        b[s] = *(const bf16x8*)(xp + 32 * s); }
    f32x4 acc = (f32x4){0.f, 0.f, 0.f, 0.f}; float sq = 0.f;
#pragma unroll
    for (int s = 0; s < NST; ++s) { acc = __builtin_amdgcn_mfma_f32_16x16x32_bf16(a[s], b[s], acc, 0, 0, 0);
        if (SSQ) {
#pragma unroll
            for (int j = 0; j < 8; ++j) { const float x = bf2f((unsigned short)b[s][j]); sq += x * x; } } }
    __syncthreads();
    *(LAS f32x4*)(scr + (wave * 64 + lane) * 4) = acc;
    if (SSQ) { sq += shx(sq, 16, lane); sq += shx(sq, 32, lane); if (q == 0) scr[2048 + wave * 16 + i] = sq; }
    __syncthreads();
    f32x4 r = (f32x4){0.f, 0.f, 0.f, 0.f}; float t = 0.f;
#pragma unroll
    for (int w = 0; w < 8; ++w) { r += *(const LAS f32x4*)(scr + (w * 64 + lane) * 4); if (SSQ) t += scr[2048 + w * 16 + i]; }
    ssq = t; return r;
}
DI void inproj(Frame& F, LAS float* scr, int l, int col0) {
    const int lane = F.lane, i = lane & 15, q = lane >> 4; float ss;
    const f32x4 a = tile_split<4, true>(METAP(bf16, MO_XM), D, WSP(bf16, WS_WIN) + ((size_t)l * INW + col0) * D, D, F.wave, lane, scr, ss);
    if (F.wave != 0) return;
    const float rs = __builtin_amdgcn_rsqf(ss * (1.0f / D) + RMS_EPS);
    float* pr = METAP(float, MO_PROJ) + (size_t)i * INW + col0 + 4 * q;
#pragma unroll
    for (int j = 0; j < 4; ++j) { float v = a[j] * rs; const int c = col0 + 4 * q + j;
        if (c < D) v *= QSCALE; else if (c >= 1792) v = fast_sigmoid(v);
        pr[j] = v;
        if (c >= 1024 && c < 1152) METAP(bf16, MO_KM)[((size_t)l * NMETA + i) * KVW + (c - 1024)] = (bf16)f2bf(v);
        else if (c >= 1152 && c < 1280) METAP(bf16, MO_VM)[((size_t)l * NMETA + i) * KVW + (c - 1152)] = (bf16)f2bf(v);
        else if (c >= 1280 && c < 1792) { const bf16 ub = (bf16)f2bf(v);
#pragma unroll
            for (int b = 0; b < NB; ++b) WSP(bf16, WS_U)[((size_t)b * USEQ + i) * POOLW + (c - 1280)] = ub; } }
}
DI void attn_head(Frame& F, const Args& A, int l, int head) {
    const float* pr = METAP(float, MO_PROJ); const int t = F.tid, i = t >> 5, dl = t & 31, kvh = head / QG;
    const float slope2 = __builtin_amdgcn_exp2f(-0.5f * (float)(head + 1)) * LOG2E, sink2 = A.in[I_SINKS][l * NH + head] * LOG2E;
    const float q0 = pr[(size_t)i * INW + head * HD + dl], q1 = pr[(size_t)i * INW + head * HD + dl + 32];
    float k0[NMETA], k1[NMETA], v0[NMETA], v1[NMETA];
#pragma unroll
    for (int j = 0; j < NMETA; ++j) { const float* kp = pr + (size_t)j * INW + 1024 + kvh * HD + dl; k0[j] = kp[0]; k1[j] = kp[32]; v0[j] = kp[128]; v1[j] = kp[160]; }
    float lg[NMETA]; float mx = sink2;
#pragma unroll
    for (int j = 0; j < NMETA; ++j) { float s = q0 * k0[j] + q1 * k1[j];
#pragma unroll
        for (int o = 1; o < 32; o <<= 1) s += shx(s, o, F.lane);
        s = (j <= i) ? s - slope2 * (float)(i - j) : -1e30f; lg[j] = s; mx = fmaxf(mx, s); }
    float lsum = __builtin_amdgcn_exp2f(sink2 - mx), o0 = 0.f, o1 = 0.f;
#pragma unroll
    for (int j = 0; j < NMETA; ++j) { const float p = __builtin_amdgcn_exp2f(lg[j] - mx); lsum += p; o0 += p * v0[j]; o1 += p * v1[j]; }
    const float inv = 1.0f / lsum;
    bf16* op = METAP(bf16, MO_ATT) + (size_t)i * D + head * HD + dl;
    op[0] = (bf16)f2bf(o0 * inv); op[32] = (bf16)f2bf(o1 * inv);
}
DI void pool_rows(Frame& F) {
    const float* pr = METAP(float, MO_PROJ); const int col = F.tid, g = col >> 7, win = 2 << g;
    float u[NMETA];
#pragma unroll
    for (int tt = 0; tt < NMETA; ++tt) u[tt] = pr[(size_t)tt * INW + 1280 + col];
#pragma unroll
    for (int tt = 0; tt < NMETA; ++tt) { float s = 0.f; int cnt = 0;
#pragma unroll
        for (int j = 0; j < NMETA; ++j) if (j <= tt && j < win) { s += u[tt - j]; ++cnt; }
        METAP(bf16, MO_POOL)[(size_t)tt * POOLW + col] = (bf16)f2bf(s / (float)cnt - u[tt]); }
}
DI void merge(Frame& F, LAS float* scr, int l, int col0) {
    const int lane = F.lane, i = lane & 15, q = lane >> 4, g = col0 >> 8; float dummy;
    const f32x4 a = tile_split<4, false>(METAP(bf16, MO_ATT), D, WSP(bf16, WS_WA) + ((size_t)l * D + col0) * MRGK + 128, MRGK, F.wave, lane, scr, dummy);
    if (F.wave != 0) return;
    const f32x4 p = tile(METAP(bf16, MO_POOL) + g * 128, POOLW, WSP(bf16, WS_WA) + ((size_t)l * D + col0) * MRGK, MRGK, 128, lane);
    const float* pr = METAP(float, MO_PROJ) + (size_t)i * INW;
#pragma unroll
    for (int j = 0; j < 4; ++j) { const int c = col0 + 4 * q + j; METAP(bf16, MO_MRG)[(size_t)i * D + c] = (bf16)f2bf(pr[1792 + c] * a[j] + pr[2816 + c] * p[j]); }
}
DI void resid(Frame& F, const f32x4 o, int col0) {
    const int lane = F.lane, i = lane & 15, q = lane >> 4;
    float* hp = METAP(float, MO_HM) + (size_t)i * D + col0 + 4 * q; const f32x4 h = *(const f32x4*)hp + o; *(f32x4*)hp = h;
    u32x2 w; w.x = pk2(h[0], h[1]); w.y = pk2(h[2], h[3]); *(u32x2*)(METAP(bf16, MO_XM) + (size_t)i * D + col0 + 4 * q) = w;
}
DI void outproj(Frame& F, LAS float* scr, int l, int col0) { float dummy;
    const f32x4 o = tile_split<4, false>(METAP(bf16, MO_MRG), D, WSP(bf16, WS_WO) + ((size_t)l * D + col0) * D, D, F.wave, F.lane, scr, dummy);
    if (F.wave == 0) resid(F, o, col0); }
DI void gu(Frame& F, LAS float* scr, int n0) {
    const int lane = F.lane, i = lane & 15, q = lane >> 4; float ss, dummy;
    const bf16* wg = WSP(bf16, WS_WGU) + (size_t)((n0 / 128) * 256 + (n0 % 128)) * D;
    const f32x4 ga = tile_split<4, true>(METAP(bf16, MO_XM), D, wg, D, F.wave, lane, scr, ss);
    const f32x4 ua = tile_split<4, false>(METAP(bf16, MO_XM), D, wg + (size_t)128 * D, D, F.wave, lane, scr, dummy);
    if (F.wave != 0) return;
    const float rs = __builtin_amdgcn_rsqf(ss * (1.0f / D) + RMS_EPS);
    f32x4 o;
#pragma unroll
    for (int j = 0; j < 4; ++j) { const float gg = ga[j] * rs; o[j] = gg * fast_sigmoid(gg) * (ua[j] * rs); }
    u32x2 w; w.x = pk2(o[0], o[1]); w.y = pk2(o[2], o[3]); *(u32x2*)(METAP(bf16, MO_ACT) + (size_t)i * DFF + n0 + 4 * q) = w;
}
DI void down(Frame& F, LAS float* scr, int col0) { float dummy;
    const f32x4 o = tile_split<DFF / 256, false, DFF / 64>(METAP(bf16, MO_ACT), DFF, WSP(bf16, WS_WD), col0, F.wave, F.lane, scr, dummy);
    if (F.wave == 0) resid(F, o, col0); }
}
DI void moe_route(Frame& F, const Args& A) {
    LAS unsigned char* rwb = F.lds + RING_OFF;
    LAS unsigned* hist = (LAS unsigned*)(F.lds + XTRA_OFF);
    const float* router = A.in[I_ROUTER]; const float* gain = A.in[I_NORM_FFN] + D;
    for (int it = F.tid; it < 32 * 64; it += NWAVES * 64) {
        const int m = it >> 6, l = it & 63, r = l & 15, q = l >> 4, e = (r & 3) + 4 * ((r >> 2) & 1), lo = r >> 3, k0 = 64 * (m >> 1) + 16 * q + 8 * (m & 1);
        unsigned w[4];
#pragma unroll
        for (int p = 0; p < 4; ++p) {
            float x0 = router[(k0 + 2 * p) * NE + e] * gain[k0 + 2 * p], x1 = router[(k0 + 2 * p + 1) * NE + e] * gain[k0 + 2 * p + 1];
            if (lo) { const unsigned hh = pk2(x0, x1); x0 -= bflo(hh); x1 -= bfhi(hh); }
            w[p] = pk2(x0, x1); }
        *(LAS u32x4*)(rwb + m * 1024 + ((r * 64 + q * 16) ^ ((r & 8) ? 32 : 0))) = (u32x4){w[0], w[1], w[2], w[3]};
    }
    unsigned char* hb8 = WSP(unsigned char, WS_POOLED);
    const bf16* h = WSP(bf16, WS_HB); float* ssq = WSP(float, WS_SSQ); unsigned* toke = WSP(unsigned, WS_TOKE); float* tokw = WSP(float, WS_TOKW); unsigned* wgcnt = WSP(unsigned, WS_WGCNT);
    const int lane = F.lane, i = lane & 15, q = lane >> 4;
    const int boff = (i * 64 + q * 16) ^ ((i & 8) ? 32 : 0);
    for (int tile = F.vcu; tile < M / 256; tile += F.G) {
        if (F.tid < 16) hist[F.tid] = 0u;
        __syncthreads();
        const int tok0 = tile * 256 + F.wave * 32 + i;
        u32x4 ba[4][2], bb[4][2];
        f32x4 acc = (f32x4){0.f, 0.f, 0.f, 0.f}; float s = 0.f;
#define RT_LOAD(buf, c) { const bf16* hp_ = h + (size_t)(tok0 + 16 * ((c) >> 2)) * D + 256 * ((c) & 3) + 16 * q; \
            _Pragma("unroll") for (int u = 0; u < 4; ++u) { buf[u][0] = *(const u32x4*)(hp_ + 64 * u); buf[u][1] = *(const u32x4*)(hp_ + 64 * u + 8); } }
#define RT_PROC(buf, c) { unsigned char* o8_ = hb8 + (size_t)(tok0 + 16 * ((c) >> 2)) * D + 256 * ((c) & 3) + 16 * q; \
            _Pragma("unroll") for (int u = 0; u < 4; ++u) { unsigned o_[4]; \
                _Pragma("unroll") for (int hh = 0; hh < 2; ++hh) { const u32x4 a_ = buf[u][hh]; \
                    const bf16x8 wf_ = *(const LAS bf16x8*)(rwb + (2 * (4 * ((c) & 3) + u) + hh) * 1024 + boff); \
                    acc = __builtin_amdgcn_mfma_f32_16x16x32_bf16(wf_, __builtin_bit_cast(bf16x8, a_), acc, 0, 0, 0); \
                    const float f0 = bflo(a_[0]), f1 = bfhi(a_[0]), f2 = bflo(a_[1]), f3 = bfhi(a_[1]), f4 = bflo(a_[2]), f5 = bfhi(a_[2]), f6 = bflo(a_[3]), f7 = bfhi(a_[3]); \
                    s += ((f0 * f0 + f1 * f1) + (f2 * f2 + f3 * f3)) + ((f4 * f4 + f5 * f5) + (f6 * f6 + f7 * f7)); \
                    o_[2 * hh] = pk4_fp8(f0, f1, f2, f3); o_[2 * hh + 1] = pk4_fp8(f4, f5, f6, f7); } \
                *(u32x4*)(o8_ + 64 * u) = (u32x4){o_[0], o_[1], o_[2], o_[3]}; } }
        RT_LOAD(ba, 0)
        for (int c = 0; c < 8; c += 2) {
            RT_LOAD(bb, c + 1) __builtin_amdgcn_sched_barrier(0);
            RT_PROC(ba, c)
            RT_LOAD(ba, c + 2 < 8 ? c + 2 : c + 1) __builtin_amdgcn_sched_barrier(0);
            RT_PROC(bb, c + 1)
            if (c & 2) {
                const int tok = tok0 + 16 * (c >> 2);
                f32x4 x;
#pragma unroll
                for (int j = 0; j < 4; ++j) x[j] = acc[j] + shx(acc[j], 32, lane);
                s += shx(s, 16, lane); s += shx(s, 32, lane);
                int i1 = 0; float v1 = x[0];
#pragma unroll
                for (int j = 1; j < 4; ++j) if (x[j] > v1) { v1 = x[j]; i1 = j; }
                int i2 = -1; float v2 = -INFINITY;
#pragma unroll
                for (int j = 0; j < 4; ++j) if (j != i1 && x[j] > v2) { v2 = x[j]; i2 = j; }
                i1 += 4 * (q & 1); i2 += 4 * (q & 1);
                const float pv1 = shx(v1, 16, lane), pv2 = shx(v2, 16, lane);
                const int pi = __builtin_amdgcn_ds_bpermute((lane ^ 16) << 2, i1 | (i2 << 8)), pi1 = pi & 255, pi2 = pi >> 8;
                const bool mine = v1 > pv1 || (v1 == pv1 && i1 < pi1);
                const int e0 = mine ? i1 : pi1; const float t0 = mine ? v1 : pv1;
                const float ca = mine ? v2 : v1, cb = mine ? pv1 : pv2; const int cia = mine ? i2 : i1, cib = mine ? pi1 : pi2;
                const bool m2 = ca > cb || (ca == cb && cia < cib);
                const int e1 = m2 ? cia : cib; const float t1 = m2 ? ca : cb;
                const float rs = __builtin_amdgcn_rsqf(s * (1.0f / D) + RMS_EPS);
                const float w1 = 1.0f / (1.0f + __expf((t0 - t1) * rs)), w0 = 1.0f - w1;
                *(f32x4*)(ssq + (size_t)tok * 16 + 4 * q) = (f32x4){q == 0 ? s : 0.f, 0.f, 0.f, 0.f};
                if (q == 0) { toke[tok] = (unsigned)e0 | ((unsigned)e1 << 8); *(f32x2*)(tokw + 2 * tok) = (f32x2){w0, w1};
                    __hip_atomic_fetch_add((unsigned*)&hist[e0], 1u, __ATOMIC_RELAXED, __HIP_MEMORY_SCOPE_WORKGROUP); __hip_atomic_fetch_add((unsigned*)&hist[8 + e1], 1u, __ATOMIC_RELAXED, __HIP_MEMORY_SCOPE_WORKGROUP); }
                acc = (f32x4){0.f, 0.f, 0.f, 0.f}; s = 0.f;
            }
        }
#undef RT_LOAD
#undef RT_PROC
        __syncthreads();
        if (F.tid < 16) wgcnt[tile * 16 + F.tid] = hist[F.tid];
        __syncthreads();
    }
}
DI void moe_slots(Frame& F) {
    LAS unsigned* cnt = (LAS unsigned*)(F.lds + RING_OFF);
    LAS unsigned* tot = cnt + 4096;
    LAS unsigned* seg = tot + 16;
    LAS unsigned* pre = seg + 16;
    LAS unsigned char* es = (LAS unsigned char*)(pre + 16);
    const unsigned* wgcnt = WSP(unsigned, WS_WGCNT); const unsigned* toke = WSP(unsigned, WS_TOKE); const float* tokw = WSP(float, WS_TOKW);
    int* slot_tok = WSP(int, WS_SLOTTOK); float* slot_w = WSP(float, WS_SLOTW); float* slot_rs = WSP(float, WS_SLOTRS); const float* ssq = WSP(float, WS_SSQ); int* tab = WSP(int, WS_MOETAB);
    for (int i = F.tid; i < 4096; i += NWAVES * 64) cnt[i] = wgcnt[i];
    __syncthreads();
    { const int col = F.tid >> 5, pp = F.tid & 31; unsigned s = 0;
#pragma unroll
      for (int j = 0; j < 8; ++j) s += cnt[(pp * 8 + j) * 16 + col];
#pragma unroll
      for (int o = 1; o < 32; o <<= 1) s += (unsigned)__builtin_amdgcn_ds_bpermute((F.lane ^ o) << 2, (int)s);
      if (pp == 0) tot[col] = s; }
    __syncthreads();
    if (F.tid < 16) { const int k = F.tid >> 3, e = F.tid & 7; unsigned s = 0; for (int e2 = 0; e2 < e; ++e2) s += (tot[k * 8 + e2] + 255u) & ~255u; seg[F.tid] = s; }
    __syncthreads();
    if (F.vcu == 0) {
        if (F.tid < 16) tab[F.tid] = (int)seg[F.tid];
        if (F.tid < 2) { unsigned s = 0; for (int e = 0; e < NE; ++e) s += (tot[F.tid * 8 + e] + 255u) >> 8; tab[16 + F.tid] = (int)s; }
        for (int i = F.tid; i < 2 * MAXTILES; i += NWAVES * 64) { const int k = i / MAXTILES, t = i % MAXTILES; int e = NE - 1;
            for (int e2 = NE - 1; e2 >= 0; --e2) if ((unsigned)(t * 256) < seg[k * 8 + e2] + ((tot[k * 8 + e2] + 255u) & ~255u)) e = e2;
            tab[32 + i] = e; }
    }
    for (int sgi = F.vcu; sgi < 16; sgi += F.G) { const int k = sgi >> 3; const unsigned b0 = seg[sgi] + tot[sgi], b1 = seg[sgi] + ((tot[sgi] + 255u) & ~255u);
        for (unsigned p = b0 + F.tid; p < b1; p += NWAVES * 64) { slot_tok[k * NSLOT + p] = -1; slot_w[k * NSLOT + p] = 0.f; slot_rs[k * NSLOT + p] = 0.f; } }
    for (int tile = F.vcu; tile < M / 256; tile += F.G) {
        __syncthreads();
        { const int col = F.tid >> 5, pp = F.tid & 31; unsigned s = 0;
#pragma unroll
          for (int j = 0; j < 8; ++j) { const int t = pp * 8 + j; s += t < tile ? cnt[t * 16 + col] : 0u; }
#pragma unroll
          for (int o = 1; o < 32; o <<= 1) s += (unsigned)__builtin_amdgcn_ds_bpermute((F.lane ^ o) << 2, (int)s);
          if (pp == 0) pre[col] = s; }
        unsigned ee = 0u;
        if (F.tid < 256) ee = toke[tile * 256 + F.tid];
        LAS unsigned* wcnt = (LAS unsigned*)es;
        unsigned rk[2] = {0u, 0u};
        if (F.tid < 256) {
#pragma unroll
            for (int k = 0; k < 2; ++k) { const unsigned e = (ee >> (8 * k)) & 0xffu;
#pragma unroll
                for (int ex = 0; ex < NE; ++ex) { const unsigned long long b = __ballot(e == (unsigned)ex);
                    if (e == (unsigned)ex) rk[k] = (unsigned)__builtin_popcountll(b & ((1ull << F.lane) - 1ull));
                    if (F.lane == 0) wcnt[F.wave * 16 + k * 8 + ex] = (unsigned)__builtin_popcountll(b); } }
        }
        __syncthreads();
        if (F.tid < 256) {
            const int tok = tile * 256 + F.tid; const float rs = __builtin_amdgcn_rsqf(ssq[(size_t)tok * 16] * (1.0f / D) + RMS_EPS);
#pragma unroll
            for (int k = 0; k < 2; ++k) { const unsigned e = (ee >> (8 * k)) & 0xffu; unsigned rank = rk[k];
                for (int w = 0; w < F.wave; ++w) rank += wcnt[w * 16 + k * 8 + e];
                const unsigned p = seg[k * 8 + e] + pre[k * 8 + e] + rank; slot_tok[k * NSLOT + p] = tok; slot_w[k * NSLOT + p] = tokw[2 * tok + k]; slot_rs[k * NSLOT + p] = rs; }
        }
    }
    __syncthreads();
}
DI void moe_fix(Frame& F, int k, int ntail) {
    const int gw = F.vcu * NWAVES + F.wave, NGW = F.G * NWAVES, lane = F.lane;
    const int* slot_tok = WSP(int, WS_SLOTTOK) + k * NSLOT; const float* slot_w = WSP(float, WS_SLOTW) + k * NSLOT; const float* slab = WSP(float, WS_SLAB);
    const bf16* SRC = k == 0 ? WSP(bf16, WS_HB) : (const bf16*)F.out; bf16* DST = k == 0 ? (bf16*)F.out : WSP(bf16, WS_HB);
    for (int r = gw; r < ntail * 256; r += NGW) {
        const int tok = slot_tok[r]; if (tok < 0) continue;
        const float w = slot_w[r] * (1.0f / W8_DN); const int tile = r >> 8, row = r & 255;
#pragma unroll
        for (int j = 0; j < 4; ++j) {
            f32x4 s = (f32x4){0.f, 0.f, 0.f, 0.f};
#pragma unroll
            for (int kq = 0; kq < pg8::NSL; ++kq) s += *((const f32x4*)(slab + ((size_t)(tile * pg8::NSL + kq) * 256 + row) * D) + lane + 64 * j);
            const u32x2 h = *((const u32x2*)(SRC + (size_t)tok * D) + lane + 64 * j);
            u32x2 o; o.x = pk2(bflo(h.x) + w * s[0], bfhi(h.x) + w * s[1]); o.y = pk2(bflo(h.y) + w * s[2], bfhi(h.y) + w * s[3]);
            *((u32x2*)(DST + (size_t)tok * D) + lane + 64 * j) = o;
        }
    }
}
DI void final_norm(Frame& F, const Args& A) {
    const int gw = F.vcu * NWAVES + F.wave, NGW = F.G * NWAVES, lane = F.lane; const float* gain = A.in[I_NORM_FINAL]; const bf16* HB = WSP(bf16, WS_HB);
    f32x4 gv[4];
#pragma unroll
    for (int j = 0; j < 4; ++j) gv[j] = *((const f32x4*)gain + lane + 64 * j);
    for (int m0 = gw * 4; m0 < M; m0 += NGW * 4) {
        u32x2 q[4][4];
#pragma unroll
        for (int t = 0; t < 4; ++t)
#pragma unroll
            for (int j = 0; j < 4; ++j) q[t][j] = *((const u32x2*)(HB + (size_t)(m0 + t) * D) + lane + 64 * j);
#pragma unroll
        for (int t = 0; t < 4; ++t) { f32x4 v[4]; float s = 0.f; f32x4* xr = (f32x4*)(F.out + (size_t)(m0 + t) * D) + lane;
#pragma unroll
            for (int j = 0; j < 4; ++j) { v[j] = (f32x4){bflo(q[t][j].x), bfhi(q[t][j].x), bflo(q[t][j].y), bfhi(q[t][j].y)}; s += (v[j][0] * v[j][0] + v[j][1] * v[j][1]) + (v[j][2] * v[j][2] + v[j][3] * v[j][3]); }
            const float rs = __builtin_amdgcn_rsqf(wave_sum(s, lane) * (1.0f / D) + RMS_EPS);
#pragma unroll
            for (int j = 0; j < 4; ++j) xr[64 * j] = v[j] * rs * gv[j]; }
    }
}
#ifndef MK_PER_PHASE
#define MK_PER_PHASE 0
#endif
constexpr int NPHASES = 19;

DI void attn_phase(Frame& F, const Args& args, int l) {
    att::Args A{WSP(bf16, WS_Q), WSP(bf16, WS_K), WSP(bf16, WS_V), WSP(bf16, WS_U), METAP(bf16, MO_KM) + (size_t)l * NMETA * KVW, METAP(bf16, MO_VM) + (size_t)l * NMETA * KVW,
                METAP(bf16, MO_UM) + (size_t)l * NMETA * POOLW, args.in[I_SINKS] + l * NH, (bf16*)F.out};
    att::phase(F.lds + RING_OFF, A, F.vcu, F.G, F.tid);
}

__global__ void __launch_bounds__(NWAVES * 64, 2) fwd(Args args) {
    extern __shared__ __attribute__((aligned(16))) unsigned char lds[];
    Frame F;
    F.lds = (LAS unsigned char*)lds;
    F.tid = threadIdx.x; F.lane = F.tid & 63; F.wave = __builtin_amdgcn_readfirstlane(F.tid >> 6);
    const int wave0 = F.wave;
    F.G = gridDim.x; { const int bx = blockIdx.x; F.vcu = (F.G % 8 == 0) ? (bx % 8) * (F.G / 8) + bx / 8 : bx; }
    F.out = args.out; F.ws = args.ws;
    for (int u = F.tid; u < (LDS_BYTES - LDSCTL_OFF) / 4; u += NWAVES * 64) ((LAS unsigned*)(F.lds + LDSCTL_OFF))[u] = 0u;
    __syncthreads();
    gu32* ctl = (gu32*)(F.ws + WS_CTL);
    XcdBarrier bar; bar.bar = (unsigned*)(ctl + CW_BAR); bar.x = 0; bar.st = nullptr;
    if (!MK_PER_PHASE) bar = xcd_barrier_post((unsigned*)(ctl + CW_BAR), (volatile LAS unsigned*)(F.lds + MISC_OFF) + 8, F.tid);
    const int lo = args.ph_lo, hi = args.ph_hi;
#define IN(k) (lo <= (k) && (k) < hi)
#define SEAM(k) do { if (IN(k) && IN((k) + 1)) xcd_barrier(bar, (wave0 << 6) | hw_lane()); } while (0)
#define LAUNDER() do { GLOBAL_AS unsigned char* ws_g = (GLOBAL_AS unsigned char*)args.ws; GLOBAL_AS float* out_g = (GLOBAL_AS float*)args.out; F.tid = (wave0 << 6) | hw_lane(); asm volatile("" : "+s"(ws_g), "+s"(out_g), "+v"(F.tid)); F.ws = (unsigned char*)ws_g; F.out = (float*)out_g; F.lane = F.tid & 63; F.wave = __builtin_amdgcn_readfirstlane(F.tid >> 6); ssq = WSP(float, WS_SSQ); } while (0)
#define META_TASK(n, call) do { LAS float* mscr = (LAS float*)(F.lds + RING_OFF); for (int task = F.vcu; task < (n); task += F.G) { call; } __syncthreads(); } while (0)

    float* ssq;
    if (IN(0)) { LAUNDER(); p0_prologue(F, args); } SEAM(0);

    for (int l = 0; l < 2; ++l) {
        const int pb = l * 6;
        if (IN(pb + 1)) { LAUNDER();
            if (l == 0) { META_TASK(INW / 16, meta::inproj(F, mscr, 0, 16 * task)); } else { META_TASK(768 / 16, meta::inproj(F, mscr, 1, 1024 + 16 * task)); }
            pg8::ProbPlain P{(const char*)WSP(bf16, WS_HB), (const char*)(WSP(bf16, WS_WIN) + (size_t)l * INW * D), D * 2, D * 2, D / 64, 0, 128, (size_t)256 * (D * 2)};
            pg8::StaticOrder S; S.init(M, INW, F.G, (int)blockIdx.x); S.rev = (l == 1);
            pg8::EpiInProj E{ssq, WSP(bf16, WS_Q), WSP(bf16, WS_K), WSP(bf16, WS_V), WSP(bf16, WS_U), WSP(bf16, WS_G)};
            pg8::gemm_phase<pg8::ProbPlain, pg8::EpiInProj, pg8::StaticOrder, true>(F.lds + RING_OFF, P, S, E, F.tid);
        } SEAM(pb + 1);
        if (IN(pb + 2)) { LAUNDER();
            if (l == 0) { for (int hd = F.vcu; hd < NH + 1; hd += F.G) { if (hd < NH) meta::attn_head(F, args, 0, hd); else meta::pool_rows(F); } }
            attn_phase(F, args, l);
        } SEAM(pb + 2);
        if (IN(pb + 3)) { LAUNDER();
            if (l == 0) { META_TASK(D / 16, meta::merge(F, mscr, 0, 16 * task)); }
            pg8::ProbMerge P{(const char*)F.out, (const char*)(WSP(bf16, WS_WA) + (size_t)l * D * MRGK), MRGK * 2, MRGK / 64};
            pg8::StaticOrder S; S.init(M, D, F.G, (int)blockIdx.x); S.rev = true;
            pg8::EpiMerge E{WSP(bf16, WS_G), WSP(bf16, WS_Q)};
            pg8::gemm_phase<pg8::ProbMerge, pg8::EpiMerge, pg8::StaticOrder, true>(F.lds + RING_OFF, P, S, E, F.tid);
        } SEAM(pb + 3);
        if (IN(pb + 4)) { LAUNDER();
            if (l == 0) { META_TASK(D / 16, meta::outproj(F, mscr, 0, 16 * task)); }
            pg8::ProbPlain P{(const char*)WSP(bf16, WS_Q), (const char*)(WSP(bf16, WS_WO) + (size_t)l * D * D), D * 2, D * 2, D / 64, 0, 128, (size_t)256 * (D * 2)};
            pg8::StaticOrder S; S.init(M, D, F.G, (int)blockIdx.x); S.rev = false;
            pg8::EpiResid E{WSP(bf16, WS_HB), ssq};
            pg8::gemm_phase<pg8::ProbPlain, pg8::EpiResid, pg8::StaticOrder, true>(F.lds + RING_OFF, P, S, E, F.tid);
        } SEAM(pb + 4);
        if (l == 0) {
            if (IN(5)) { LAUNDER();
                META_TASK(DFF / 16, meta::gu(F, mscr, 16 * task));
                pg8::ProbPlain P{(const char*)WSP(bf16, WS_HB), (const char*)WSP(bf16, WS_WGU), D * 2, D * 2, D / 64, 0, 128, (size_t)256 * (D * 2)};
                pg8::StaticOrder S; S.init(M, 2 * DFF, F.G, (int)blockIdx.x); S.rev = true;
                pg8::EpiSwiGLU<false> E{ssq, WSP(bf16, WS_ACT), DFF / 64};
                pg8::gemm_phase<pg8::ProbPlain, pg8::EpiSwiGLU<false>, pg8::StaticOrder, true>(F.lds + RING_OFF, P, S, E, F.tid);
            } SEAM(5);
            if (IN(6)) { LAUNDER();
                META_TASK(D / 16, meta::down(F, mscr, 16 * task));
                pg8::ProbPlain P{(const char*)WSP(bf16, WS_ACT), (const char*)WSP(bf16, WS_WD), 128, 128, DFF / 64, 0, 32768, (size_t)(DFF / 64) * 32768, 32768, (size_t)(DFF / 64) * 32768};
                pg8::StaticOrder S; S.init(M, D, F.G, (int)blockIdx.x); S.rev = false;
                pg8::EpiResid E{WSP(bf16, WS_HB), ssq};
                pg8::gemm_phase<pg8::ProbPlain, pg8::EpiResid, pg8::StaticOrder, true>(F.lds + RING_OFF, P, S, E, F.tid);
            } SEAM(6);
        }
    }
    if (IN(11)) { LAUNDER(); moe_route(F, args); } SEAM(11);
    if (IN(12)) { LAUNDER(); moe_slots(F); } SEAM(12);
    for (int k = 0; k < 2; ++k) {
        const int* tab = WSP(int, WS_MOETAB); const int* slot_tok = WSP(int, WS_SLOTTOK) + k * NSLOT; const float* slot_w = WSP(float, WS_SLOTW) + k * NSLOT;
        if (IN(13 + 2 * k)) { LAUNDER();
            if (k == 1) moe_fix(F, 0, __builtin_amdgcn_readfirstlane(tab[16]) - 256);
            const int ntile = __builtin_amdgcn_readfirstlane(tab[16 + k]);
            LAS int* etab = (LAS int*)(F.lds + XTRA_OFF + 1024);
            for (int i = F.tid; i < MAXTILES; i += NWAVES * 64) etab[i] = tab[32 + k * MAXTILES + i];
            __syncthreads();
            pg8::ProbMoeGU P{(const char*)WSP(unsigned char, WS_POOLED), (const char*)WSP(unsigned char, WS_MGU), D, D, D / 128, slot_tok, etab, (LAS int*)(F.lds + XTRA_OFF), (size_t)2 * DFE * D};
            pg8::LinearOrder S{ntile, 2 * DFE / 256, F.G, F.vcu, false};
            pg8::EpiSwiGLU8 E{WSP(float, WS_SLOTRS) + k * NSLOT, WSP(unsigned char, WS_ACT)};
            pg8::gemm_phase<pg8::ProbMoeGU, pg8::EpiSwiGLU8, pg8::LinearOrder, true, true>(F.lds + RING_OFF, P, S, E, F.tid);
        } SEAM(13 + 2 * k);
        if (IN(14 + 2 * k)) { LAUNDER();
            const int ntile = __builtin_amdgcn_readfirstlane(tab[16 + k]);
            LAS int* etab = (LAS int*)(F.lds + XTRA_OFF + 1024);
            for (int i = F.tid; i < MAXTILES; i += NWAVES * 64) etab[i] = tab[32 + k * MAXTILES + i];
            __syncthreads();
            { pg8::ProbMoeDown P{(const char*)WSP(unsigned char, WS_ACT), (const char*)WSP(unsigned char, WS_MD), 128, 128, DFE / 128, etab, 32768, (size_t)(DFE / 128) * 32768, 32768, (size_t)(DFE / 128) * 32768, (size_t)D * DFE};
              pg8::LinearOrder S{256, D / 256, F.G, F.vcu, true}; S.base = ntile - 256;
              pg8::EpiMoeDown E{k == 0 ? WSP(bf16, WS_HB) : (bf16*)F.out, k == 0 ? (bf16*)F.out : WSP(bf16, WS_HB), slot_tok, slot_w, 1.0f / W8_DN};
              pg8::gemm_phase<pg8::ProbMoeDown, pg8::EpiMoeDown, pg8::LinearOrder, true, true>(F.lds + RING_OFF, P, S, E, F.tid); }
#pragma nounroll
            for (int pass = 0; pass < 2; ++pass) {
                pg8::ProbMoeDownQ P{(const char*)WSP(unsigned char, WS_ACT), (const char*)WSP(unsigned char, WS_MD), 128, 128, pass ? 6 : 8, etab, (size_t)(DFE / 128) * 32768, (size_t)(DFE / 128) * 32768, (size_t)D * DFE, pass ? 8 : 0, pass ? 22 : 14};
                pg8::QuarterOrder S{ntile - 256, F.G, pass ? (F.vcu + F.G / 2) % F.G : F.vcu};
                pg8::EpiSlab E{WSP(float, WS_SLAB), pass};
                pg8::gemm_phase<pg8::ProbMoeDownQ, pg8::EpiSlab, pg8::QuarterOrder, true, true>(F.lds + RING_OFF, P, S, E, F.tid); }
        } SEAM(14 + 2 * k);
    }
    if (IN(17)) { LAUNDER(); moe_fix(F, 1, __builtin_amdgcn_readfirstlane(WSP(int, WS_MOETAB)[17]) - 256); } SEAM(17);
    if (IN(18)) { LAUNDER(); final_norm(F, args); }
#undef IN
#undef SEAM
#undef META_TASK
#undef LAUNDER
}

extern "C" void kernel_launch(void* const* d_in, const int* in_sizes, int n_in, void* d_out, int out_size, void* d_ws, size_t ws_size, hipStream_t stream) {
    static int grid = 0;
    if (grid == 0) {
        if (n_in != 18 || in_sizes[0] != M * D || out_size != M * D || ws_size < WS_END) { fprintf(stderr, "kernel_launch: unexpected shapes (n_in %d, in0 %d, out %d, ws %zu); nothing launched\n", n_in, n_in > 0 ? in_sizes[0] : -1, out_size, ws_size); grid = -1; return; }
        int dev = 0, cus = 0, per_cu = 0;
        if (hipGetDevice(&dev) != hipSuccess || hipDeviceGetAttribute(&cus, hipDeviceAttributeMultiprocessorCount, dev) != hipSuccess) { grid = -1; return; }
        if (hipFuncSetAttribute((const void*)fwd, hipFuncAttributeMaxDynamicSharedMemorySize, LDS_BYTES) != hipSuccess) { fprintf(stderr, "kernel_launch: hipFuncSetAttribute failed\n"); grid = -1; return; }
        if (hipOccupancyMaxActiveBlocksPerMultiprocessor(&per_cu, (const void*)fwd, NWAVES * 64, LDS_BYTES) != hipSuccess || per_cu < 1) { fprintf(stderr, "kernel_launch: occupancy query reports %d workgroups per CU\n", per_cu); }
        (void)hipGetLastError();
        grid = cus;
    }
    if (grid < 0) return;
    if (hipMemsetAsync((char*)d_ws + WS_CTL, 0, CTL_ZERO_BYTES, stream) != hipSuccess) return;
    Args a{};
    for (int i = 0; i < 18; ++i) a.in[i] = (const float*)d_in[i];
    a.out = (float*)d_out; a.ws = (unsigned char*)d_ws;
#if MK_PER_PHASE
    for (int p = 0; p < NPHASES; ++p) { a.ph_lo = p; a.ph_hi = p + 1; hipLaunchKernelGGL(fwd, dim3(grid), dim3(NWAVES * 64), LDS_BYTES, stream, a); }
#else
    a.ph_lo = 0; a.ph_hi = NPHASES; hipLaunchKernelGGL(fwd, dim3(grid), dim3(NWAVES * 64), LDS_BYTES, stream, a);
#endif
}
```
